# Optimizing an MI355X kernel written in HIP

```python
import math
import jax, jax.numpy as jnp
from jax import lax
import numpy as np

D_MODEL = 1024
BATCH = 16
SEQ = 2048
DEPTH = 1

EPS = 1e-6
NEG_INF = -1e30

A_HEADS = 8
A_HEAD_DIM = 64
A_WIDTH = A_HEADS * A_HEAD_DIM
DILATED_PATTERNS = ((128, 1), (512, 4), (2048, 16))
A_BLOCK = 64

REL_BUCKETS = 32
REL_MAX_DISTANCE = 1024

B_HEADS = 8
B_Q_LORA = 256
B_KV_LORA = 128
B_QK_NOPE = 64
B_QK_ROPE = 32
B_V_DIM = 64
B_WIDTH = B_HEADS * B_V_DIM
ROPE_THETA = 10000.0
B_Q_BLOCK = 128

MIX_WIDTH = A_WIDTH + B_WIDTH
IN_PROJ_WIDTH = 3 * A_WIDTH + B_Q_LORA + B_KV_LORA + B_QK_ROPE

N_GROUPS = 4
EXPERTS_PER_GROUP = 8
N_EXPERTS = N_GROUPS * EXPERTS_PER_GROUP
TOP_K_IN_GROUP = 2
EXPERT_FF = 256
MOE_BLOCK = 128

kernel_name = "hymba_dilated_mla_hmoe_encoder"


def rmsnorm(x, g):
    xf = x.astype(jnp.float32)
    y = xf * lax.rsqrt(jnp.mean(xf * xf, axis=-1, keepdims=True) + EPS)
    return (y * g.astype(jnp.float32)).astype(x.dtype)


def t5_relative_bucket(rel):
    half = REL_BUCKETS // 2
    max_exact = half // 2
    n = np.abs(rel)
    large = max_exact + (np.log(np.maximum(n, 1) / max_exact)
                         / math.log(REL_MAX_DISTANCE / max_exact) * (half - max_exact)).astype(np.int32)
    large = np.minimum(large, half - 1)
    return (np.where(rel > 0, half, 0) + np.where(n < max_exact, n, large)).astype(np.int32)


def dilated_window_attention(q, k, v, rel_bias, dilation, half_steps):
    b, h, s, dh = q.shape
    L = s // dilation
    qb = math.gcd(L, A_BLOCK)
    nb = L // qb
    span = qb + 2 * half_steps

    def to_residue(t):
        return t.reshape(b, h, L, dilation, dh).transpose(0, 1, 3, 2, 4)

    qr, kr, vr = to_residue(q), to_residue(k), to_residue(v)
    pad = ((0, 0), (0, 0), (0, 0), (half_steps, half_steps), (0, 0))
    kp, vp = jnp.pad(kr, pad), jnp.pad(vr, pad)
    key_idx = np.arange(nb)[:, None] * qb + np.arange(span)[None, :]
    kb = jnp.take(kp, key_idx, axis=3)
    vb = jnp.take(vp, key_idx, axis=3)
    qblk = qr.reshape(b, h, dilation, nb, qb, dh)
    scores = jnp.einsum('bhrnqd,bhrnkd->bhrnqk', qblk, kb,
                        preferred_element_type=jnp.float32) * (dh ** -0.5)
    rel_steps = np.arange(span)[None, :] - half_steps - np.arange(qb)[:, None]
    buckets = t5_relative_bucket(rel_steps * dilation)
    bias = rel_bias[buckets].astype(jnp.float32).transpose(2, 0, 1)
    key_pos = key_idx - half_steps
    valid = ((np.abs(rel_steps) <= half_steps)[None]
             & (key_pos >= 0)[:, None, :] & (key_pos < L)[:, None, :])
    scores = jnp.where(valid[None, None, None], scores + bias[None, :, None, None], NEG_INF)
    m = jnp.max(scores, axis=-1, keepdims=True)
    p = jnp.exp(scores - m)
    l = jnp.sum(p, axis=-1, keepdims=True)
    o = jnp.einsum('bhrnqk,bhrnkd->bhrnqd', p, vb, preferred_element_type=jnp.float32) / l
    lse = (m + jnp.log(l))[..., 0]
    o = o.reshape(b, h, dilation, L, dh).transpose(0, 1, 3, 2, 4).reshape(b, h, s, dh)
    lse = lse.reshape(b, h, dilation, L).transpose(0, 1, 3, 2).reshape(b, h, s)
    return o, lse


def mixer_dilated(q, k, v, rel_bias):
    outs, lses = [], []
    for window, dilation in DILATED_PATTERNS:
        o, lse = dilated_window_attention(q, k, v, rel_bias, dilation, window // (2 * dilation))
        outs.append(o)
        lses.append(lse)
    w = jax.nn.softmax(jnp.stack(lses, 0), axis=0)
    return jnp.einsum('pbhs,pbhsd->bhsd', w, jnp.stack(outs, 0))


def apply_rope(x):
    s, d = x.shape[1], x.shape[-1]
    half = d // 2
    inv_freq = ROPE_THETA ** (-(jnp.arange(half, dtype=jnp.float32) / half))
    ang = jnp.arange(s, dtype=jnp.float32)[:, None] * inv_freq[None, :]
    cos, sin = jnp.cos(ang)[None, :, None, :], jnp.sin(ang)[None, :, None, :]
    x1, x2 = x[..., :half].astype(jnp.float32), x[..., half:].astype(jnp.float32)
    return jnp.concatenate([x1 * cos - x2 * sin, x1 * sin + x2 * cos], axis=-1).astype(x.dtype)


def mixer_mla(c_q, c_kv, k_rope, g_q_latent, w_q_up, g_kv_latent, w_kv_up):
    b, s, _ = c_q.shape
    q = (rmsnorm(c_q, g_q_latent) @ w_q_up).reshape(b, s, B_HEADS, B_QK_NOPE + B_QK_ROPE)
    q_nope, q_rope = q[..., :B_QK_NOPE], apply_rope(q[..., B_QK_NOPE:])
    kv = (rmsnorm(c_kv, g_kv_latent) @ w_kv_up).reshape(b, s, B_HEADS, B_QK_NOPE + B_V_DIM)
    k_nope, v = kv[..., :B_QK_NOPE], kv[..., B_QK_NOPE:].astype(jnp.float32)
    k_r = apply_rope(k_rope[:, :, None, :])[:, :, 0]
    scale = (B_QK_NOPE + B_QK_ROPE) ** -0.5
    nb = s // B_Q_BLOCK

    def block(args):
        qn, qr = args
        sc = (jnp.einsum('bqhd,bkhd->bhqk', qn, k_nope, preferred_element_type=jnp.float32)
              + jnp.einsum('bqhd,bkd->bhqk', qr, k_r, preferred_element_type=jnp.float32)) * scale
        p = jax.nn.softmax(sc, axis=-1)
        return jnp.einsum('bhqk,bkhd->bqhd', p, v)

    qn_b = q_nope.reshape(b, nb, B_Q_BLOCK, B_HEADS, B_QK_NOPE).transpose(1, 0, 2, 3, 4)
    qr_b = q_rope.reshape(b, nb, B_Q_BLOCK, B_HEADS, B_QK_ROPE).transpose(1, 0, 2, 3, 4)
    o = lax.map(block, (qn_b, qr_b))
    return o.transpose(1, 0, 2, 3, 4).reshape(b, s, B_WIDTH)


def hierarchical_moe(t, w_router_group, b_router_group, w_router_expert, b_router_expert,
                     w_gate, w_up, w_down):
    n_tok, d = t.shape
    group_logits = jnp.dot(t, w_router_group, preferred_element_type=jnp.float32) + b_router_group.astype(jnp.float32)
    group_probs = jax.nn.softmax(group_logits, axis=-1)
    group_idx = jnp.argmax(group_probs, axis=-1)
    group_gate = jnp.take_along_axis(group_probs, group_idx[:, None], axis=-1)
    expert_logits = (jnp.dot(t, w_router_expert, preferred_element_type=jnp.float32)
                     + b_router_expert.astype(jnp.float32)).reshape(n_tok, N_GROUPS, EXPERTS_PER_GROUP)
    in_group = jnp.take_along_axis(expert_logits, group_idx[:, None, None], axis=1)[:, 0]
    top_p, top_i = lax.top_k(jax.nn.softmax(in_group, axis=-1), TOP_K_IN_GROUP)
    gates = group_gate * top_p / jnp.sum(top_p, axis=-1, keepdims=True)
    expert_ids = group_idx[:, None] * EXPERTS_PER_GROUP + top_i

    n_assign = n_tok * TOP_K_IN_GROUP
    flat_expert = expert_ids.reshape(-1)
    flat_token = jnp.repeat(jnp.arange(n_tok), TOP_K_IN_GROUP)
    flat_gate = gates.reshape(-1)
    order = jnp.argsort(flat_expert)
    s_expert, s_token, s_gate = flat_expert[order], flat_token[order], flat_gate[order]
    counts = jnp.bincount(flat_expert, length=N_EXPERTS)
    starts = jnp.cumsum(counts) - counts
    padded = (counts + MOE_BLOCK - 1) // MOE_BLOCK * MOE_BLOCK
    padded_ends = jnp.cumsum(padded)
    padded_starts = padded_ends - padded
    dest = padded_starts[s_expert] + jnp.arange(n_assign) - starts[s_expert]
    n_blocks = -(-n_assign // MOE_BLOCK) + N_EXPERTS
    buf = jnp.zeros((n_blocks * MOE_BLOCK, d), t.dtype).at[dest].set(t[s_token])
    block_expert = jnp.minimum(
        jnp.searchsorted(padded_ends, jnp.arange(n_blocks) * MOE_BLOCK, side='right'), N_EXPERTS - 1)

    def expert_block(args):
        xb, e = args
        hb = jax.nn.silu(xb @ w_gate[e]) * (xb @ w_up[e])
        return hb @ w_down[e]

    out = lax.map(expert_block, (buf.reshape(n_blocks, MOE_BLOCK, d), block_expert))
    contrib = out.reshape(n_blocks * MOE_BLOCK, d)[dest].astype(jnp.float32) * s_gate[:, None]
    return jax.ops.segment_sum(contrib, s_token, num_segments=n_tok)


def setup_inputs(seed: int = 0) -> dict:
    key = jax.random.key(seed)
    ks = jax.random.split(key, 24)
    f32 = jnp.float32
    nrm = lambda k, shape, fan_in: jax.random.normal(k, shape, f32) * (fan_in ** -0.5)
    gain = lambda k, shape: 1.0 + 0.02 * jax.random.normal(k, shape, f32)
    return {
        "x": jax.random.normal(ks[0], (BATCH, SEQ, D_MODEL), f32),
        "g_attn_norm": gain(ks[1], (DEPTH, D_MODEL)),
        "w_in": nrm(ks[2], (DEPTH, D_MODEL, IN_PROJ_WIDTH), D_MODEL),
        "rel_bias": 0.5 * jax.random.normal(ks[3], (REL_BUCKETS, A_HEADS), f32),
        "g_q_latent": gain(ks[4], (DEPTH, B_Q_LORA)),
        "w_q_up": nrm(ks[5], (DEPTH, B_Q_LORA, B_HEADS * (B_QK_NOPE + B_QK_ROPE)), B_Q_LORA),
        "g_kv_latent": gain(ks[6], (DEPTH, B_KV_LORA)),
        "w_kv_up": nrm(ks[7], (DEPTH, B_KV_LORA, B_HEADS * (B_QK_NOPE + B_V_DIM)), B_KV_LORA),
        "g_out_a": gain(ks[8], (DEPTH, A_WIDTH)),
        "g_out_b": gain(ks[9], (DEPTH, B_WIDTH)),
        "w_out": nrm(ks[10], (DEPTH, MIX_WIDTH, D_MODEL), MIX_WIDTH),
        "g_ffn_norm": gain(ks[11], (DEPTH, D_MODEL)),
        "w_router_group": nrm(ks[12], (DEPTH, D_MODEL, N_GROUPS), D_MODEL),
        "b_router_group": 0.01 * jax.random.normal(ks[13], (DEPTH, N_GROUPS), f32),
        "w_router_expert": nrm(ks[14], (DEPTH, D_MODEL, N_EXPERTS), D_MODEL),
        "b_router_expert": 0.01 * jax.random.normal(ks[15], (DEPTH, N_EXPERTS), f32),
        "w_gate": nrm(ks[16], (DEPTH, N_EXPERTS, D_MODEL, EXPERT_FF), D_MODEL),
        "w_up": nrm(ks[17], (DEPTH, N_EXPERTS, D_MODEL, EXPERT_FF), D_MODEL),
        "w_down": nrm(ks[18], (DEPTH, N_EXPERTS, EXPERT_FF, D_MODEL), EXPERT_FF),
        "g_final": gain(ks[19], (D_MODEL,)),
    }


def reference(x, g_attn_norm, w_in, rel_bias, g_q_latent, w_q_up, g_kv_latent, w_kv_up,
              g_out_a, g_out_b, w_out, g_ffn_norm, w_router_group, b_router_group,
              w_router_expert, b_router_expert, w_gate, w_up, w_down, g_final):
    b, s, d = x.shape
    splits = list(np.cumsum([A_WIDTH, A_WIDTH, A_WIDTH, B_Q_LORA, B_KV_LORA]))
    for l in range(DEPTH):
        h = rmsnorm(x, g_attn_norm[l])
        proj = h @ w_in[l]
        q_a, k_a, v_a, c_q, c_kv, k_rope = jnp.split(proj, splits, axis=-1)
        heads = lambda t: t.reshape(b, s, A_HEADS, A_HEAD_DIM).transpose(0, 2, 1, 3)
        out_a = mixer_dilated(heads(q_a), heads(k_a), heads(v_a), rel_bias)
        out_a = out_a.transpose(0, 2, 1, 3).reshape(b, s, A_WIDTH)
        out_b = mixer_mla(c_q, c_kv, k_rope, g_q_latent[l], w_q_up[l], g_kv_latent[l], w_kv_up[l])
        mixed = jnp.concatenate([rmsnorm(out_a, g_out_a[l]), rmsnorm(out_b, g_out_b[l])], axis=-1)
        x = x + (mixed.astype(x.dtype) @ w_out[l])
        h2 = rmsnorm(x, g_ffn_norm[l]).reshape(b * s, d)
        y = hierarchical_moe(h2, w_router_group[l], b_router_group[l], w_router_expert[l],
                             b_router_expert[l], w_gate[l], w_up[l], w_down[l])
        x = x + y.reshape(b, s, d).astype(x.dtype)
    return rmsnorm(x, g_final)
```

```cpp
#include <hip/hip_runtime.h>
#include <stdint.h>
#include <stdio.h>

namespace {
typedef unsigned short bf16;
typedef short bf16x8 __attribute__((ext_vector_type(8)));
typedef float f32x4 __attribute__((ext_vector_type(4)));
typedef unsigned u32x4 __attribute__((ext_vector_type(4)));
typedef unsigned u32x2 __attribute__((ext_vector_type(2)));

constexpr int D = 1024, BATCH = 16, SEQ = 2048, T = BATCH * SEQ;
constexpr int NIN = 1952, NINP = 2048;
constexpr int NE = 32, FF = 256, CAP = 32768;
constexpr float EPS = 1e-6f;
constexpr float LOG2E = 1.4426950408889634f;
constexpr float QS_A = 0.125f * LOG2E;
constexpr float QS_B = 0.10206207261596577f * LOG2E;
constexpr int MP128 = T * 2 / 128 + NE;

constexpr size_t MiB = 1u << 20;
constexpr size_t WS_CTL = 0;
constexpr size_t CTL_BYTES = 64 * 1024;
constexpr size_t WS_RS0 = 2 * MiB;
constexpr size_t WS_RSQ = WS_RS0 + 128 * 1024;
constexpr size_t WS_RSKV = WS_RSQ + 128 * 1024;
constexpr size_t WS_RS1 = WS_RSKV + 128 * 1024;
constexpr size_t WS_ROPE = WS_RS1 + 128 * 1024;
constexpr size_t WS_BT = WS_ROPE + 256 * 1024;
constexpr size_t WS_AE = 3 * MiB;
constexpr size_t WS_APOS = WS_AE + 256 * 1024;
constexpr size_t WS_LSE = 4 * MiB;
constexpr size_t WS_WI = 8 * MiB;
constexpr size_t WS_WQ = 12 * MiB;
constexpr size_t WS_WKV = WS_WQ + 512 * 1024;
constexpr size_t WS_WO = 13 * MiB;
constexpr size_t WS_WGU = 16 * MiB;
constexpr size_t WS_WD = 48 * MiB;
constexpr size_t WS_XB = 64 * MiB;
constexpr size_t WS_QA = 128 * MiB, WS_KA = 160 * MiB, WS_VA = 192 * MiB;
constexpr size_t WS_LAT = 224 * MiB;
constexpr size_t WS_QB = 256 * MiB;
constexpr size_t WS_KB = 304 * MiB, WS_VB = 336 * MiB, WS_OB = 368 * MiB;
constexpr size_t WS_MIX = 400 * MiB;
constexpr size_t WS_KR = 464 * MiB;
constexpr size_t WS_TOK = 466 * MiB;
constexpr size_t WS_GATE = 470 * MiB;
constexpr size_t WS_END = 474 * MiB;
constexpr size_t WS_X1 = 128 * MiB;
constexpr size_t WS_HB = 192 * MiB;
constexpr size_t WS_YB = 256 * MiB;

__device__ __forceinline__ float bf2f(bf16 b) { return __uint_as_float(((unsigned)b) << 16); }
__device__ __forceinline__ bf16 f2bf(float f) { unsigned u = __float_as_uint(f); u += 0x7fffu + ((u >> 16) & 1u); return (bf16)(u >> 16); }
__device__ __forceinline__ unsigned pk2(float lo, float hi) { return (unsigned)f2bf(lo) | ((unsigned)f2bf(hi) << 16); }
__device__ __forceinline__ float wave_sum(float v) {
#pragma unroll
    for (int o = 1; o < 64; o <<= 1) v += __shfl_xor(v, o);
    return v;
}

__device__ __forceinline__ void transpose_item(const float* W, int ldw, const float* gain, bf16* WT, int ldwt, int k0, int n0, int dstrow0, float* scr, int lane, int gap16 = 0) {
#pragma unroll 8
    for (int i = 0; i < 32; ++i) { const int kk = 2 * i + (lane >> 5); float v = W[(size_t)(k0 + kk) * ldw + n0 + (lane & 31)]; if (gain) v *= gain[k0 + kk]; scr[kk * 33 + (lane & 31)] = v; }
    __builtin_amdgcn_fence(__ATOMIC_RELEASE, "wavefront"); asm volatile("s_waitcnt lgkmcnt(0)" ::: "memory");
    const int c = lane & 7;
#pragma unroll
    for (int j = 0; j < 4; ++j) { const int n = (lane >> 3) + 8 * j; const float* s = scr + (8 * c) * 33 + n;
        u32x4 o; o.x = pk2(s[0 * 33], s[1 * 33]); o.y = pk2(s[2 * 33], s[3 * 33]); o.z = pk2(s[4 * 33], s[5 * 33]); o.w = pk2(s[6 * 33], s[7 * 33]);
        *(u32x4*)(WT + (size_t)(dstrow0 + n + (n >> 4) * gap16) * ldwt + k0 + 8 * c) = o; }
    asm volatile("s_waitcnt lgkmcnt(0)" ::: "memory");
}
__device__ __forceinline__ int gu_dstrow(int n, int kind) { const int tt = n >> 6, w = (n >> 5) & 1, nn = (n >> 4) & 1, fr = n & 15; return tt * 128 + w * 64 + (nn * 2 + kind) * 16 + fr; }

struct ProArgs { const float* in[20]; unsigned char* ws; };

__global__ __launch_bounds__(256) void k_prologue(ProArgs a) {
    __shared__ float scr_all[4][64 * 33];
    const int lane = threadIdx.x & 63, wv = threadIdx.x >> 6;
    float* scr = scr_all[wv];
    const int gw = blockIdx.x * 4 + wv, NGW = gridDim.x * 4;
    unsigned char* ws = a.ws;
    constexpr int I_IN = 16 * 61, I_Q = 4 * 24, I_KV = 2 * 32, I_O = 16 * 32, I_G = 16 * 8, I_D = 4 * 32;
    constexpr int NITEMS = I_IN + I_Q + I_KV + I_O + 64 * I_G + 32 * I_D;
    for (int it = gw; it < NITEMS; it += NGW) {
        int r = it;
        if (r < I_IN) { const int kb = r / 61, nb = r % 61; transpose_item(a.in[2], NIN, a.in[1], (bf16*)(ws + WS_WI), 1024, kb * 64, nb * 32, nb * 32, scr, lane); continue; } r -= I_IN;
        if (r < I_Q) { const int kb = r / 24, nb = r % 24; transpose_item(a.in[5], 768, a.in[4], (bf16*)(ws + WS_WQ), 256, kb * 64, nb * 32, nb * 32, scr, lane); continue; } r -= I_Q;
        if (r < I_KV) { const int kb = r / 32, nb = r % 32; transpose_item(a.in[7], 1024, a.in[6], (bf16*)(ws + WS_WKV), 256, kb * 64, nb * 32, nb * 32, scr, lane); continue; } r -= I_KV;
        if (r < I_O) { const int kb = r / 32, nb = r % 32; transpose_item(a.in[10], 1024, nullptr, (bf16*)(ws + WS_WO), 1024, kb * 64, nb * 32, nb * 32, scr, lane); continue; } r -= I_O;
        if (r < 64 * I_G) { const int mtx = r / I_G, q = r % I_G, e = mtx >> 1, kind = mtx & 1, kb = q / 8, nb = q % 8;
            const float* W = (kind ? a.in[17] : a.in[16]) + (size_t)e * 1024 * 256;
            transpose_item(W, 256, a.in[11], (bf16*)(ws + WS_WGU) + (size_t)e * 512 * 1024, 1024, kb * 64, nb * 32, gu_dstrow(nb * 32, kind), scr, lane, 16); continue; } r -= 64 * I_G;
        { const int e = r / I_D, q = r % I_D, kb = q / 32, nb = q % 32;
            transpose_item(a.in[18] + (size_t)e * 256 * 1024, 1024, nullptr, (bf16*)(ws + WS_WD) + (size_t)e * 1024 * 256, 256, kb * 64, nb * 32, nb * 32, scr, lane); }
    }
    const size_t gt = (size_t)blockIdx.x * 256 + threadIdx.x, NGT = (size_t)gridDim.x * 256;
    for (size_t i = gt; i < (size_t)96 * 1024 / 8; i += NGT) ((u32x4*)((bf16*)(ws + WS_WI) + (size_t)1952 * 1024))[i] = (u32x4){0, 0, 0, 0};
    for (size_t i = gt; i < (size_t)1024 * 16; i += NGT) { const size_t row = i >> 4, c = i & 15; *(u32x4*)((bf16*)(ws + WS_WKV) + row * 256 + 128 + c * 8) = (u32x4){0, 0, 0, 0}; }
    for (int m = gw; m < T; m += NGW) {
        const f32x4* xr = (const f32x4*)(a.in[0] + (size_t)m * D) + lane; f32x4 v[4]; float s = 0.f;
#pragma unroll
        for (int j = 0; j < 4; ++j) { v[j] = xr[64 * j]; s += (v[j].x * v[j].x + v[j].y * v[j].y) + (v[j].z * v[j].z + v[j].w * v[j].w); }
        s = wave_sum(s);
        u32x2* o8 = (u32x2*)((bf16*)(ws + WS_XB) + (size_t)m * D) + lane;
#pragma unroll
        for (int j = 0; j < 4; ++j) { u32x2 o; o.x = pk2(v[j].x, v[j].y); o.y = pk2(v[j].z, v[j].w); o8[64 * j] = o; }
        if (lane == 0) ((float*)(ws + WS_RS0))[m] = rsqrtf(s * (1.f / D) + EPS);
    }
    for (size_t i = gt; i < (size_t)SEQ * 16; i += NGT) { const int s = (int)(i >> 4), f = (int)(i & 15);
        const float inv = (float)pow(10000.0, -(double)f / 16.0); const float ang = (float)s * inv;
        float2 cs; cs.x = (float)cos((double)ang); cs.y = (float)sin((double)ang); ((float2*)(ws + WS_ROPE))[i] = cs; }
    for (size_t i = gt; i < (size_t)3 * 8 * 132; i += NGT) { const int p = (int)(i / (8 * 132)), h = (int)((i / 132) % 8), jj = (int)(i % 132);
        float val = 0.f;
        if (jj <= 128) { const int dil = (p == 0) ? 1 : (p == 1) ? 4 : 16; const int rel = (jj - 64) * dil; const int n = rel < 0 ? -rel : rel;
            int large = 8 + (int)(log((double)(n > 1 ? n : 1) / 8.0) / log(128.0) * 8.0); if (large > 15) large = 15;
            const int bucket = (rel > 0 ? 16 : 0) + (n < 8 ? n : large);
            val = a.in[3][bucket * 8 + h] * LOG2E; }
        ((float*)(ws + WS_BT))[i] = val; }
}

constexpr int GBK = 32;
enum { GM_PLAIN = 0, GM_GATEUP = 1, GM_DOWN = 2 };
struct GemmArgs { const bf16* A; const bf16* Bt; unsigned char* ws; const bf16* xb; float* outf; int lda, ldb, K, ntn; };

struct MoeMap { int e, lrow0, cnt, crow0; bool valid; };
__device__ __forceinline__ MoeMap moe_map(const int* counts, int panel) {
    MoeMap m; m.valid = false; m.e = 0; m.lrow0 = 0; m.cnt = 0; m.crow0 = 0; int acc = 0;
    for (int e = 0; e < NE; ++e) { const int c = counts[e], np = (c + 127) >> 7;
        if (!m.valid && panel < acc + np) { m.valid = true; m.e = e; m.lrow0 = (panel - acc) * 128; m.cnt = c; m.crow0 = panel * 128; }
        acc += np; }
    return m;
}

template <int MODE, class Epi>
__global__ __launch_bounds__(256, 2) void k_gemm128(GemmArgs g) {
    Epi E;
    __shared__ __attribute__((aligned(16))) bf16 shm[2 * 128 * GBK];
    const int tid = threadIdx.x, wid = tid >> 6, lane = tid & 63, wr = wid >> 1, wc = wid & 1, fr = lane & 15, fq = lane >> 4;
    const int pm = blockIdx.x / g.ntn, pn = blockIdx.x % g.ntn;
    const int brow = pm * 128, bcol = pn * 128;
    const int* counts = (const int*)(g.ws + WS_CTL);
    const int* toks = (const int*)(g.ws + WS_TOK);
    MoeMap mm; mm.valid = true; mm.e = 0; mm.lrow0 = 0; mm.cnt = 0; mm.crow0 = 0;
    if (MODE != GM_PLAIN) { mm = moe_map(counts, pm); if (!mm.valid) return; }
    const bf16* Bg = g.Bt + (MODE != GM_PLAIN ? (size_t)mm.e * g.ntn * 128 * g.ldb : 0) + (size_t)bcol * g.ldb;
    bf16* SA = shm; bf16* SB = shm + 128 * GBK;
    const bf16* arow[2]; const bf16* brw[2];
#pragma unroll
    for (int i = 0; i < 2; ++i) { const int b = tid * 16 + i * 4096, r = b / 64, c = (b % 64) / 2;
        size_t ar;
        if (MODE == GM_GATEUP) { const int lr = mm.lrow0 + r; ar = (lr < mm.cnt) ? (size_t)toks[mm.e * CAP + lr] : 0; }
        else if (MODE == GM_DOWN) ar = (size_t)(mm.crow0 + r);
        else ar = (size_t)(brow + r);
        arow[i] = g.A + ar * g.lda + c; brw[i] = Bg + (size_t)r * g.ldb + c; }
    f32x4 acc[4][4];
#pragma unroll
    for (int m = 0; m < 4; ++m)
#pragma unroll
        for (int n = 0; n < 4; ++n) acc[m][n] = (f32x4){0.f, 0.f, 0.f, 0.f};
    bf16x8 At[4], Btl[4];
    for (int t = 0; t < g.K / GBK; ++t) {
#pragma unroll
        for (int i = 0; i < 2; ++i) { const int b = tid * 16 + i * 4096;
            __builtin_amdgcn_global_load_lds((const unsigned*)(arow[i] + t * GBK), (__attribute__((address_space(3))) unsigned*)((char*)SA + b), 16, 0, 0);
            __builtin_amdgcn_global_load_lds((const unsigned*)(brw[i] + t * GBK), (__attribute__((address_space(3))) unsigned*)((char*)SB + b), 16, 0, 0); }
        asm volatile("s_waitcnt vmcnt(0)" ::: "memory"); __syncthreads();
#pragma unroll
        for (int m = 0; m < 4; ++m) { At[m] = *(const bf16x8*)((char*)SA + (wr * 64 + m * 16 + fr) * GBK * 2 + fq * 16); Btl[m] = *(const bf16x8*)((char*)SB + (wc * 64 + m * 16 + fr) * GBK * 2 + fq * 16); }
#pragma unroll
        for (int m = 0; m < 4; ++m)
#pragma unroll
            for (int n = 0; n < 4; ++n) acc[m][n] = __builtin_amdgcn_mfma_f32_16x16x32_bf16(At[m], Btl[n], acc[m][n], 0, 0, 0);
        __syncthreads();
    }
#pragma unroll
    for (int m = 0; m < 4; ++m)
#pragma unroll
        for (int n = 0; n < 4; ++n)
#pragma unroll
            for (int j = 0; j < 4; ++j) {
                const int lr = wr * 64 + m * 16 + fq * 4 + j, lc = wc * 64 + n * 16 + fr;
                E.elem(g, mm, brow + lr, bcol + lc, lr, acc[m][n][j], acc[m][n ^ 1][j], n);
            }
}

struct EpiInProj {
    __device__ __forceinline__ void elem(const GemmArgs& g, const MoeMap&, int row, int col, int, float v, float, int) const {
        v *= ((const float*)(g.ws + WS_RS0))[row];
        if (col < 512) ((bf16*)(g.ws + WS_QA))[(size_t)row * 512 + col] = f2bf(v * QS_A);
        else if (col < 1024) ((bf16*)(g.ws + WS_KA))[(size_t)row * 512 + col - 512] = f2bf(v);
        else if (col < 1536) ((bf16*)(g.ws + WS_VA))[(size_t)row * 512 + col - 1024] = f2bf(v);
        else ((bf16*)(g.ws + WS_LAT))[(size_t)row * 512 + col - 1536] = f2bf(v);
    }
};
struct EpiQup {
    __device__ __forceinline__ void elem(const GemmArgs& g, const MoeMap&, int row, int col, int, float v, float, int) const {
        v *= ((const float*)(g.ws + WS_RSQ))[row] * QS_B;
        ((bf16*)(g.ws + WS_QB))[(size_t)row * 768 + col] = f2bf(v);
    }
};
struct EpiKVup {
    __device__ __forceinline__ void elem(const GemmArgs& g, const MoeMap&, int row, int col, int, float v, float, int) const {
        v *= ((const float*)(g.ws + WS_RSKV))[row];
        const int head = col >> 7, w = col & 127;
        if (w < 64) ((bf16*)(g.ws + WS_KB))[(size_t)row * 512 + head * 64 + w] = f2bf(v);
        else ((bf16*)(g.ws + WS_VB))[(size_t)row * 512 + head * 64 + w - 64] = f2bf(v);
    }
};
struct EpiOut {
    __device__ __forceinline__ void elem(const GemmArgs& g, const MoeMap&, int row, int col, int, float v, float, int) const {
        const size_t o = (size_t)row * 1024 + col;
        ((bf16*)(g.ws + WS_X1))[o] = f2bf(bf2f(g.xb[o]) + v);
    }
};
struct EpiGateUp {
    __device__ __forceinline__ void elem(const GemmArgs& g, const MoeMap& mm, int, int col, int lr, float v, float partner, int n) const {
        if (n & 1) return;
        const int lrow = mm.lrow0 + lr;
        const int tok = lrow < mm.cnt ? ((const int*)(g.ws + WS_TOK))[mm.e * CAP + lrow] : 0;
        const float rs = ((const float*)(g.ws + WS_RS1))[tok];
        const float gg = v * rs, uu = partner * rs;
        const float hb = gg / (1.f + __expf(-gg)) * uu;
        const int pn = col >> 7, w = (col >> 6) & 1, fr = col & 15;
        const int real = pn * 64 + w * 32 + (n >> 1) * 16 + fr;
        ((bf16*)(g.ws + WS_HB))[(size_t)(mm.crow0 + lr) * 256 + real] = f2bf(hb);
    }
};
struct EpiDown {
    __device__ __forceinline__ void elem(const GemmArgs& g, const MoeMap& mm, int, int col, int lr, float v, float, int) const {
        const int lrow = mm.lrow0 + lr;
        const float gt = lrow < mm.cnt ? ((const float*)(g.ws + WS_GATE))[mm.e * CAP + lrow] : 0.f;
        ((bf16*)(g.ws + WS_YB))[(size_t)(mm.crow0 + lr) * 1024 + col] = f2bf(v * gt);
    }
};

__global__ __launch_bounds__(256) void k_lat(unsigned char* ws) {
    const int lane = threadIdx.x & 63, gw = blockIdx.x * 4 + (threadIdx.x >> 6), NGW = gridDim.x * 4;
    const bf16* LAT = (const bf16*)(ws + WS_LAT);
    for (int m = gw; m < T; m += NGW) {
        const bf16* r = LAT + (size_t)m * 512;
        float sq = 0.f, skv = 0.f;
        for (int i = lane; i < 256; i += 64) { const float v = bf2f(r[i]); sq += v * v; }
        for (int i = lane; i < 128; i += 64) { const float v = bf2f(r[256 + i]); skv += v * v; }
        sq = wave_sum(sq); skv = wave_sum(skv);
        if (lane == 0) { ((float*)(ws + WS_RSQ))[m] = rsqrtf(sq * (1.f / 256.f) + EPS); ((float*)(ws + WS_RSKV))[m] = rsqrtf(skv * (1.f / 128.f) + EPS); }
        if (lane < 16) { const float x1 = bf2f(r[384 + lane]), x2 = bf2f(r[400 + lane]); const float2 cs = ((const float2*)(ws + WS_ROPE))[(m & (SEQ - 1)) * 16 + lane];
            bf16* kr = (bf16*)(ws + WS_KR) + (size_t)m * 32; kr[lane] = f2bf(x1 * cs.x - x2 * cs.y); kr[16 + lane] = f2bf(x1 * cs.y + x2 * cs.x); }
    }
}
__global__ __launch_bounds__(256) void k_rope_q(unsigned char* ws) {
    const size_t idx = (size_t)blockIdx.x * 256 + threadIdx.x; if (idx >= (size_t)T * 8 * 16) return;
    const int i = (int)(idx & 15), h = (int)((idx >> 4) & 7); const size_t t = idx >> 7;
    bf16* q = (bf16*)(ws + WS_QB) + t * 768 + h * 96 + 64;
    const float x1 = bf2f(q[i]), x2 = bf2f(q[16 + i]); const float2 cs = ((const float2*)(ws + WS_ROPE))[(t & (SEQ - 1)) * 16 + i];
    q[i] = f2bf(x1 * cs.x - x2 * cs.y); q[16 + i] = f2bf(x1 * cs.y + x2 * cs.x);
}
__global__ __launch_bounds__(256) void k_attnA_naive(unsigned char* ws, bf16* OA, float* LSE) {
    const int idx = blockIdx.x * 256 + threadIdx.x; const int s = idx & (SEQ - 1), h = (idx >> 11) & 7, b = idx >> 14;
    const bf16* QA = (const bf16*)(ws + WS_QA); const bf16* KA = (const bf16*)(ws + WS_KA); const bf16* VA = (const bf16*)(ws + WS_VA);
    const float* BT = (const float*)(ws + WS_BT);
    float q[64], o[64];
    const size_t t = (size_t)b * SEQ + s;
#pragma unroll
    for (int i = 0; i < 64; ++i) { q[i] = bf2f(QA[t * 512 + h * 64 + i]); o[i] = 0.f; }
    float m = -1e30f, l = 0.f;
    for (int p = 0; p < 3; ++p) { const int dil = (p == 0) ? 1 : (p == 1) ? 4 : 16;
        for (int j = -64; j <= 64; ++j) { const int pos = s + j * dil; if (pos < 0 || pos >= SEQ) continue;
            const bf16* kp = KA + ((size_t)b * SEQ + pos) * 512 + h * 64; const bf16* vp = VA + ((size_t)b * SEQ + pos) * 512 + h * 64;
            float sc = BT[(p * 8 + h) * 132 + j + 64];
#pragma unroll
            for (int i = 0; i < 64; ++i) sc += q[i] * bf2f(kp[i]);
            const float mn = fmaxf(m, sc), al = exp2f(m - mn), pe = exp2f(sc - mn);
            l = l * al + pe; m = mn;
#pragma unroll
            for (int i = 0; i < 64; ++i) o[i] = o[i] * al + pe * bf2f(vp[i]);
        } }
    const float il = 1.f / l;
#pragma unroll
    for (int i = 0; i < 64; ++i) OA[t * 512 + h * 64 + i] = f2bf(o[i] * il);
    LSE[t * 8 + h] = m + log2f(l);
}
__global__ __launch_bounds__(256) void k_attnB_naive(unsigned char* ws) {
    const int idx = blockIdx.x * 256 + threadIdx.x; const int s = idx & (SEQ - 1), h = (idx >> 11) & 7, b = idx >> 14;
    const bf16* QB = (const bf16*)(ws + WS_QB); const bf16* KB = (const bf16*)(ws + WS_KB); const bf16* VB = (const bf16*)(ws + WS_VB); const bf16* KR = (const bf16*)(ws + WS_KR);
    float q[96], o[64];
    const size_t t = (size_t)b * SEQ + s;
#pragma unroll
    for (int i = 0; i < 96; ++i) q[i] = bf2f(QB[t * 768 + h * 96 + i]);
#pragma unroll
    for (int i = 0; i < 64; ++i) o[i] = 0.f;
    float m = -1e30f, l = 0.f;
    for (int key = 0; key < SEQ; ++key) { const size_t tk = (size_t)b * SEQ + key;
        const bf16* kp = KB + tk * 512 + h * 64; const bf16* rp = KR + tk * 32; const bf16* vp = VB + tk * 512 + h * 64;
        float sc = 0.f;
#pragma unroll
        for (int i = 0; i < 64; ++i) sc += q[i] * bf2f(kp[i]);
#pragma unroll
        for (int i = 0; i < 32; ++i) sc += q[64 + i] * bf2f(rp[i]);
        const float mn = fmaxf(m, sc), al = exp2f(m - mn), pe = exp2f(sc - mn);
        l = l * al + pe; m = mn;
#pragma unroll
        for (int i = 0; i < 64; ++i) o[i] = o[i] * al + pe * bf2f(vp[i]);
    }
    const float il = 1.f / l;
#pragma unroll
    for (int i = 0; i < 64; ++i) ((bf16*)(ws + WS_OB))[t * 512 + h * 64 + i] = f2bf(o[i] * il);
}
__global__ __launch_bounds__(256) void k_mixnorm(unsigned char* ws, const bf16* OA, const float* LSE, int np, const float* ga, const float* gb) {
    const int lane = threadIdx.x & 63, gw = blockIdx.x * 4 + (threadIdx.x >> 6), NGW = gridDim.x * 4;
    for (int m = gw; m < T; m += NGW) {
        const int head = lane >> 3; float a[8];
        float ls[3], mx = -1e30f;
        _Pragma("unroll") for (int p = 0; p < 3; ++p) { ls[p] = -1e30f; if (p < np) { ls[p] = LSE[((size_t)p * T + m) * 8 + head]; mx = fmaxf(mx, ls[p]); } }
        float wsum = 0.f; _Pragma("unroll") for (int p = 0; p < 3; ++p) { ls[p] = (p < np) ? exp2f(ls[p] - mx) : 0.f; wsum += ls[p]; }
#pragma unroll
        for (int i = 0; i < 8; ++i) a[i] = 0.f;
        _Pragma("unroll") for (int p = 0; p < 3; ++p) if (p < np) { const u32x4 v = *(const u32x4*)(OA + ((size_t)p * T + m) * 512 + lane * 8); const float w = ls[p] / wsum;
            a[0] += w * __uint_as_float(v.x << 16); a[1] += w * __uint_as_float(v.x & 0xffff0000u); a[2] += w * __uint_as_float(v.y << 16); a[3] += w * __uint_as_float(v.y & 0xffff0000u);
            a[4] += w * __uint_as_float(v.z << 16); a[5] += w * __uint_as_float(v.z & 0xffff0000u); a[6] += w * __uint_as_float(v.w << 16); a[7] += w * __uint_as_float(v.w & 0xffff0000u); }
        float sa = 0.f;
#pragma unroll
        for (int i = 0; i < 8; ++i) sa += a[i] * a[i];
        sa = wave_sum(sa); const float ra = rsqrtf(sa * (1.f / 512.f) + EPS);
        float bv[8]; { const u32x4 v = *(const u32x4*)((const bf16*)(ws + WS_OB) + (size_t)m * 512 + lane * 8);
            bv[0] = __uint_as_float(v.x << 16); bv[1] = __uint_as_float(v.x & 0xffff0000u); bv[2] = __uint_as_float(v.y << 16); bv[3] = __uint_as_float(v.y & 0xffff0000u);
            bv[4] = __uint_as_float(v.z << 16); bv[5] = __uint_as_float(v.z & 0xffff0000u); bv[6] = __uint_as_float(v.w << 16); bv[7] = __uint_as_float(v.w & 0xffff0000u); }
        float sb = 0.f;
#pragma unroll
        for (int i = 0; i < 8; ++i) sb += bv[i] * bv[i];
        sb = wave_sum(sb); const float rb = rsqrtf(sb * (1.f / 512.f) + EPS);
        u32x4 oa, ob; const float* gpa = ga + lane * 8; const float* gpb = gb + lane * 8;
        oa.x = pk2(a[0] * ra * gpa[0], a[1] * ra * gpa[1]); oa.y = pk2(a[2] * ra * gpa[2], a[3] * ra * gpa[3]); oa.z = pk2(a[4] * ra * gpa[4], a[5] * ra * gpa[5]); oa.w = pk2(a[6] * ra * gpa[6], a[7] * ra * gpa[7]);
        ob.x = pk2(bv[0] * rb * gpb[0], bv[1] * rb * gpb[1]); ob.y = pk2(bv[2] * rb * gpb[2], bv[3] * rb * gpb[3]); ob.z = pk2(bv[4] * rb * gpb[4], bv[5] * rb * gpb[5]); ob.w = pk2(bv[6] * rb * gpb[6], bv[7] * rb * gpb[7]);
        bf16* mix = (bf16*)(ws + WS_MIX) + (size_t)m * 1024;
        *(u32x4*)(mix + lane * 8) = oa; *(u32x4*)(mix + 512 + lane * 8) = ob;
    }
}
__global__ __launch_bounds__(256) void k_router(unsigned char* ws, const float* gffn, const float* wrg, const float* brg, const float* wre, const float* bre) {
    __shared__ float h2s[4][1024]; __shared__ float lgs[4][64];
    const int lane = threadIdx.x & 63, wv = threadIdx.x >> 6, gw = blockIdx.x * 4 + wv, NGW = gridDim.x * 4;
    int* counts = (int*)(ws + WS_CTL);
    for (int m = gw; m < T; m += NGW) {
        const bf16* xr = (const bf16*)(ws + WS_X1) + (size_t)m * 1024; float xv[16]; float s = 0.f;
#pragma unroll
        for (int i = 0; i < 16; ++i) { xv[i] = bf2f(xr[lane + 64 * i]); s += xv[i] * xv[i]; }
        s = wave_sum(s); const float rs = rsqrtf(s * (1.f / D) + EPS);
        if (lane == 0) ((float*)(ws + WS_RS1))[m] = rs;
#pragma unroll
        for (int i = 0; i < 16; ++i) h2s[wv][lane + 64 * i] = xv[i] * rs * gffn[lane + 64 * i];
        asm volatile("s_waitcnt lgkmcnt(0)" ::: "memory");
        float acc = 0.f;
        if (lane < 4) { for (int k = 0; k < D; ++k) acc += h2s[wv][k] * wrg[k * 4 + lane]; acc += brg[lane]; }
        else if (lane < 36) { const int e = lane - 4; for (int k = 0; k < D; ++k) acc += h2s[wv][k] * wre[k * 32 + e]; acc += bre[e]; }
        lgs[wv][lane] = acc;
        asm volatile("s_waitcnt lgkmcnt(0)" ::: "memory");
        if (lane == 0) {
            const float* L = lgs[wv];
            int gi = 0; float gm = L[0]; for (int i = 1; i < 4; ++i) if (L[i] > gm) { gm = L[i]; gi = i; }
            float gs = 0.f; for (int i = 0; i < 4; ++i) gs += __expf(L[i] - gm);
            const float ggate = 1.f / gs;
            const float* EL = L + 4 + gi * 8;
            int i1 = 0; float m1 = EL[0]; for (int i = 1; i < 8; ++i) if (EL[i] > m1) { m1 = EL[i]; i1 = i; }
            int i2 = -1; float m2 = -3.0e38f; for (int i = 0; i < 8; ++i) if (i != i1 && EL[i] > m2) { m2 = EL[i]; i2 = i; }
            const float p2 = __expf(m2 - m1); const float g1 = ggate / (1.f + p2), g2 = ggate * p2 / (1.f + p2);
            const int e1 = gi * 8 + i1, e2 = gi * 8 + i2;
            const int p1 = atomicAdd(&counts[e1], 1), pp2 = atomicAdd(&counts[e2], 1);
            ((int*)(ws + WS_TOK))[e1 * CAP + p1] = m; ((int*)(ws + WS_TOK))[e2 * CAP + pp2] = m;
            ((float*)(ws + WS_GATE))[e1 * CAP + p1] = g1; ((float*)(ws + WS_GATE))[e2 * CAP + pp2] = g2;
            ((int*)(ws + WS_AE))[m * 2] = e1; ((int*)(ws + WS_AE))[m * 2 + 1] = e2; ((int*)(ws + WS_APOS))[m * 2] = p1; ((int*)(ws + WS_APOS))[m * 2 + 1] = pp2;
        }
        asm volatile("s_waitcnt lgkmcnt(0)" ::: "memory");
    }
}
__global__ __launch_bounds__(256) void k_final(unsigned char* ws, const float* gfin, float* out) {
    const int lane = threadIdx.x & 63, gw = blockIdx.x * 4 + (threadIdx.x >> 6), NGW = gridDim.x * 4;
    const int* counts = (const int*)(ws + WS_CTL);
    int pst[NE]; { int acc = 0; _Pragma("unroll") for (int e = 0; e < NE; ++e) { pst[e] = acc * 128; acc += (counts[e] + 127) >> 7; } }
    for (int m = gw; m < T; m += NGW) {
        const int e1 = ((const int*)(ws + WS_AE))[m * 2], e2 = ((const int*)(ws + WS_AE))[m * 2 + 1];
        int r1 = ((const int*)(ws + WS_APOS))[m * 2], r2 = ((const int*)(ws + WS_APOS))[m * 2 + 1];
        int b1 = 0, b2 = 0;
#pragma unroll
        for (int e = 0; e < NE; ++e) { b1 = (e == e1) ? pst[e] : b1; b2 = (e == e2) ? pst[e] : b2; }
        r1 += b1; r2 += b2;
        const bf16* xr = (const bf16*)(ws + WS_X1) + (size_t)m * 1024; const bf16* y1 = (const bf16*)(ws + WS_YB) + (size_t)r1 * 1024; const bf16* y2 = (const bf16*)(ws + WS_YB) + (size_t)r2 * 1024;
        float v[16]; float s = 0.f;
#pragma unroll
        for (int j = 0; j < 4; ++j) { const u32x2 a = *((const u32x2*)xr + lane + 64 * j), b = *((const u32x2*)y1 + lane + 64 * j), c = *((const u32x2*)y2 + lane + 64 * j);
            v[4 * j + 0] = __uint_as_float(a.x << 16) + __uint_as_float(b.x << 16) + __uint_as_float(c.x << 16);
            v[4 * j + 1] = __uint_as_float(a.x & 0xffff0000u) + __uint_as_float(b.x & 0xffff0000u) + __uint_as_float(c.x & 0xffff0000u);
            v[4 * j + 2] = __uint_as_float(a.y << 16) + __uint_as_float(b.y << 16) + __uint_as_float(c.y << 16);
            v[4 * j + 3] = __uint_as_float(a.y & 0xffff0000u) + __uint_as_float(b.y & 0xffff0000u) + __uint_as_float(c.y & 0xffff0000u); }
#pragma unroll
        for (int i = 0; i < 16; ++i) s += v[i] * v[i];
        s = wave_sum(s); const float rs = rsqrtf(s * (1.f / D) + EPS);
#pragma unroll
        for (int j = 0; j < 4; ++j) { const f32x4 g4 = *((const f32x4*)gfin + lane + 64 * j); f32x4 o; o.x = v[4 * j] * rs * g4.x; o.y = v[4 * j + 1] * rs * g4.y; o.z = v[4 * j + 2] * rs * g4.z; o.w = v[4 * j + 3] * rs * g4.w;
            *((f32x4*)(out + (size_t)m * D) + lane + 64 * j) = o; }
    }
}
}

extern "C" void kernel_launch(void* const* d_in, const int* in_sizes, int n_in, void* d_out, int out_size, void* d_ws, size_t ws_size, hipStream_t stream) {
    if (n_in != 20 || ws_size < WS_END || out_size != T * D) { fprintf(stderr, "kernel_launch: unexpected shapes (n_in %d, ws %zu, out %d)\n", n_in, ws_size, out_size); return; }
    unsigned char* ws = (unsigned char*)d_ws;
    const float* in[20]; for (int i = 0; i < 20; ++i) in[i] = (const float*)d_in[i];
    (void)hipMemsetAsync(ws + WS_CTL, 0, CTL_BYTES, stream);
    ProArgs pa{}; for (int i = 0; i < 20; ++i) pa.in[i] = in[i]; pa.ws = ws;
    k_prologue<<<1024, 256, 0, stream>>>(pa);
    GemmArgs g{};
    g.ws = ws; g.xb = (const bf16*)(ws + WS_XB); g.outf = nullptr;
    g.A = (const bf16*)(ws + WS_XB); g.lda = 1024; g.Bt = (const bf16*)(ws + WS_WI); g.ldb = 1024; g.K = 1024; g.ntn = NINP / 128;
    k_gemm128<GM_PLAIN, EpiInProj><<<(T / 128) * g.ntn, 256, 0, stream>>>(g);
    k_lat<<<1024, 256, 0, stream>>>(ws);
    g.A = (const bf16*)(ws + WS_LAT); g.lda = 512; g.Bt = (const bf16*)(ws + WS_WQ); g.ldb = 256; g.K = 256; g.ntn = 768 / 128;
    k_gemm128<GM_PLAIN, EpiQup><<<(T / 128) * g.ntn, 256, 0, stream>>>(g);
    g.A = (const bf16*)(ws + WS_LAT) + 256; g.lda = 512; g.Bt = (const bf16*)(ws + WS_WKV); g.ldb = 256; g.K = 256; g.ntn = 1024 / 128;
    k_gemm128<GM_PLAIN, EpiKVup><<<(T / 128) * g.ntn, 256, 0, stream>>>(g);
    k_rope_q<<<(T * 8 * 16) / 256, 256, 0, stream>>>(ws);
    k_attnA_naive<<<(T * 8) / 256, 256, 0, stream>>>(ws, (bf16*)d_out, (float*)(ws + WS_LSE));
    k_attnB_naive<<<(T * 8) / 256, 256, 0, stream>>>(ws);
    k_mixnorm<<<1024, 256, 0, stream>>>(ws, (const bf16*)d_out, (const float*)(ws + WS_LSE), 1, in[8], in[9]);
    g.A = (const bf16*)(ws + WS_MIX); g.lda = 1024; g.Bt = (const bf16*)(ws + WS_WO); g.ldb = 1024; g.K = 1024; g.ntn = 1024 / 128;
    k_gemm128<GM_PLAIN, EpiOut><<<(T / 128) * g.ntn, 256, 0, stream>>>(g);
    k_router<<<1024, 256, 0, stream>>>(ws, in[11], in[12], in[13], in[14], in[15]);
    g.A = (const bf16*)(ws + WS_X1); g.lda = 1024; g.Bt = (const bf16*)(ws + WS_WGU); g.ldb = 1024; g.K = 1024; g.ntn = 512 / 128;
    k_gemm128<GM_GATEUP, EpiGateUp><<<MP128 * g.ntn, 256, 0, stream>>>(g);
    g.A = (const bf16*)(ws + WS_HB); g.lda = 256; g.Bt = (const bf16*)(ws + WS_WD); g.ldb = 256; g.K = 256; g.ntn = 1024 / 128;
    k_gemm128<GM_DOWN, EpiDown><<<MP128 * g.ntn, 256, 0, stream>>>(g);
    k_final<<<1024, 256, 0, stream>>>(ws, in[19], (float*)d_out);
}
```

```cpp
#include <hip/hip_runtime.h>
#include <stdint.h>
#include <stdio.h>

#ifndef MK_SPLIT
#define MK_SPLIT 0
#endif

#define LAS __attribute__((address_space(3)))
#define GAS __attribute__((address_space(1)))

namespace {
typedef unsigned short bf16;
typedef short bf16x8 __attribute__((ext_vector_type(8)));
typedef float f32x4 __attribute__((ext_vector_type(4)));
typedef unsigned u32x4 __attribute__((ext_vector_type(4)));
typedef unsigned u32x2 __attribute__((ext_vector_type(2)));

constexpr int D = 1024, BATCH = 16, SEQ = 2048, T = BATCH * SEQ;
constexpr int NIN = 1952, NINP = 2048;
constexpr int NE = 32, CAP = 32768;
constexpr float EPS = 1e-6f;
constexpr float LOG2E = 1.4426950408889634f;
constexpr float QS_A = 0.125f * LOG2E;
constexpr float QS_B = 0.10206207261596577f * LOG2E;
constexpr int NWAVES = 8;
constexpr int NPHASE = 10;

constexpr size_t MiB = 1u << 20;
constexpr size_t WS_CTL = 0;
constexpr size_t CTL_BYTES = 1 * MiB;
constexpr int CW_COUNTS = 64;
constexpr int CW_BAR = 4096;
constexpr size_t CTL_SSQQ = 128 * 1024, CTL_SSQKV = 256 * 1024, CTL_SSQ1 = 384 * 1024;
constexpr size_t WS_RS0 = 2 * MiB;
constexpr size_t WS_ROPE = WS_RS0 + 512 * 1024;
constexpr size_t WS_BT = WS_ROPE + 256 * 1024;
constexpr size_t WS_AE = 3 * MiB;
constexpr size_t WS_APOS = WS_AE + 256 * 1024;
constexpr size_t WS_LSE = 4 * MiB;
constexpr size_t WS_WI = 8 * MiB;
constexpr size_t WS_WQKV = 12 * MiB;
constexpr size_t WS_WO = 13 * MiB;
constexpr size_t WS_WGU = 16 * MiB;
constexpr size_t WS_WD = 48 * MiB;
constexpr size_t WS_XB = 64 * MiB;
constexpr size_t WS_QA = 128 * MiB, WS_KA = 160 * MiB, WS_VA = 192 * MiB;
constexpr size_t WS_LAT = 224 * MiB;
constexpr size_t WS_QB = 256 * MiB;
constexpr size_t WS_KB = 304 * MiB, WS_VB = 336 * MiB, WS_OB = 368 * MiB;
constexpr size_t WS_MIX = 400 * MiB;
constexpr size_t WS_KR = 464 * MiB;
constexpr size_t WS_TOK = 466 * MiB;
constexpr size_t WS_GATE = 470 * MiB;
constexpr size_t WS_END = 474 * MiB;
constexpr size_t WS_X1 = 128 * MiB;
constexpr size_t WS_HB = 192 * MiB;
constexpr size_t WS_YB = 256 * MiB;

constexpr int RING_BYTES = 131072;
constexpr int LDSCTL_OFF = RING_BYTES;
constexpr int MISC_OFF = LDSCTL_OFF + 320;
constexpr int MOE_OFF = LDSCTL_OFF + 1024;
constexpr int LDS_BYTES = 147456;

__device__ __forceinline__ float bf2f(bf16 b) { return __uint_as_float(((unsigned)b) << 16); }
__device__ __forceinline__ bf16 f2bf(float f) { unsigned u = __float_as_uint(f); u += 0x7fffu + ((u >> 16) & 1u); return (bf16)(u >> 16); }
__device__ __forceinline__ unsigned pk2(float lo, float hi) { return (unsigned)f2bf(lo) | ((unsigned)f2bf(hi) << 16); }
__device__ __forceinline__ float wave_sum(float v) {
#pragma unroll
    for (int o = 1; o < 64; o <<= 1) v += __shfl_xor(v, o);
    return v;
}
#define LDS_WAIT() asm volatile("s_waitcnt lgkmcnt(0)" ::: "memory")

#define XB_TMO      128
#define XB_XCNT(j)  (256  + 64 * (j))
#define XB_XSUB(j)  (1280 + 64 * (j))
#define XB_XGEN(j)  (2304 + 64 * (j))
#define XB_TOP      3328
#define XB_TOPGEN   3392
#define XCD_BAR_WORDS 3456
#define XB_SPIN_CAP (1u << 18)
__device__ __forceinline__ unsigned xb_ld(unsigned* p)              { return __hip_atomic_load(p, __ATOMIC_RELAXED, __HIP_MEMORY_SCOPE_AGENT); }
__device__ __forceinline__ unsigned xb_add(unsigned* p, unsigned v) { return __hip_atomic_fetch_add(p, v, __ATOMIC_RELAXED, __HIP_MEMORY_SCOPE_AGENT); }
__device__ __forceinline__ unsigned xb_xcc_id() { return (unsigned)__builtin_amdgcn_s_getreg((3 << 11) | 20) & 0xFu; }
#define XB_SPIN(cond, bar) do { unsigned _sp = 0; while (cond) { __builtin_amdgcn_s_sleep(1); \
    if ((++_sp & 255u) == 0u) { if (xb_ld(&(bar)[XB_TMO])) break; if (_sp > XB_SPIN_CAP) { atomicAdd(&(bar)[XB_TMO], 1u); break; } } } } while (0)
struct XcdBarrier { unsigned* bar; unsigned x; volatile LAS unsigned* st; };
__device__ __forceinline__ XcdBarrier xcd_barrier_post(unsigned* bar, volatile LAS unsigned* st) {
    XcdBarrier b; b.bar = bar; b.x = xb_xcc_id(); b.st = st;
    if (threadIdx.x == 0) (void)xb_add(&bar[XB_XCNT(b.x)], 1u);
    return b;
}
__device__ __forceinline__ void xcd_barrier_complete(unsigned* bar, unsigned x, unsigned& nloc, unsigned& nx) {
    const unsigned G = gridDim.x * gridDim.y * gridDim.z;
    unsigned sum, cnt, mine, sp = 0u;
    for (;;) {
        sum = 0u; cnt = 0u; mine = 0u;
#pragma unroll
        for (unsigned j = 0; j < 16; ++j) { const unsigned c = xb_ld(&bar[XB_XCNT(j)]); sum += c; cnt += (c > 0u) ? 1u : 0u; mine = (j == x) ? c : mine; }
        if (sum == G) break;
        __builtin_amdgcn_s_sleep(1);
        if ((++sp & 255u) == 0u) { if (xb_ld(&bar[XB_TMO])) break; if (sp > XB_SPIN_CAP) { atomicAdd(&bar[XB_TMO], 1u); break; } }
    }
    nloc = mine > 0u ? mine : 1u; nx = cnt > 0u ? cnt : 1u;
}
__device__ __forceinline__ void xcd_barrier(const XcdBarrier& b) {
    asm volatile("s_waitcnt vmcnt(0)" ::: "memory");
    __syncthreads();
    if (threadIdx.x == 0) {
        unsigned* bar = b.bar;
        __builtin_amdgcn_s_waitcnt(0);
        unsigned nloc = b.st[0], nx = b.st[1];
        if (nloc == 0u) { xcd_barrier_complete(bar, b.x, nloc, nx); b.st[0] = nloc; b.st[1] = nx; }
        const unsigned old = xb_add(&bar[XB_XSUB(b.x)], 1u);
        const unsigned gen = old / nloc;
        if (old + 1u == (gen + 1u) * nloc) {
            __builtin_amdgcn_fence(__ATOMIC_RELEASE, "agent");
            asm volatile("s_waitcnt vmcnt(0)" ::: "memory");
            const unsigned og = xb_add(&bar[XB_TOP], 1u);
            const unsigned tg = og / nx;
            if (og + 1u == (tg + 1u) * nx) xb_add(&bar[XB_TOPGEN], 1u);
            else XB_SPIN(xb_ld(&bar[XB_TOPGEN]) == tg, bar);
            __builtin_amdgcn_fence(__ATOMIC_ACQUIRE, "agent");
            xb_add(&bar[XB_XGEN(b.x)], 1u);
            asm volatile("s_waitcnt vmcnt(0)" ::: "memory");
        } else {
            XB_SPIN(xb_ld(&bar[XB_XGEN(b.x)]) == gen, bar);
            __builtin_amdgcn_fence(__ATOMIC_ACQUIRE, "agent");
            asm volatile("s_waitcnt vmcnt(0)" ::: "memory");
        }
    }
    __syncthreads();
}

namespace pg8 {
constexpr int BM = 256, BK = 64, HALF = 128, HTB = HALF * BK * 2, STAGE_BYTES = 8 * HTB, NXCD = 8, WGM = 8;
__device__ __forceinline__ int lds_byte(int r, int c) { const int st = (r >> 4) * 2 + (c >> 5), rr = r & 15, cc = c & 31, ob = rr * 64 + cc * 2; return st * 1024 + (ob ^ (((ob >> 9) & 1) << 5)); }
__device__ __forceinline__ void stage_rc(int b, int& R, int& C) { const int st = b / 1024, sb = b % 1024, swz = sb ^ (((sb >> 9) & 1) << 5); R = (st >> 1) * 16 + swz / 64; C = (st & 1) * 32 + (swz % 64) / 2; }
struct Unit { int pm, pn, e, lr0; };
struct StaticOrder {
    int nM, nN, nwg, G, c;
    __device__ void init(int M, int N, int G_, int c_) { nM = M / BM; nN = N / BM; nwg = nM * nN; G = G_; c = c_; }
    __device__ bool next(int i, Unit& u) const {
        const long L = (long)i * G + c; if (L >= nwg) return false;
        int wgid = (int)L; { const int q = nwg / NXCD, r = nwg % NXCD, xcd = wgid % NXCD, off = wgid / NXCD; wgid = (xcd < r ? xcd * (q + 1) : r * (q + 1) + (xcd - r) * q) + off; }
        const int nig = WGM * nN, gid = wgid / nig, fm = gid * WGM, gsz = (nM - fm) < WGM ? (nM - fm) : WGM;
        u.pm = fm + ((wgid % nig) % gsz); u.pn = (wgid % nig) / gsz; u.e = 0; u.lr0 = 0; return true;
    }
};

template <class Epi, class Sched, bool ALIGN_EPI>
__device__ __forceinline__ void gemm_phase(LAS unsigned char* lds, const int K, const int ldb, const Sched& S, const Epi& E) {
    const int tid = threadIdx.x, wid = __builtin_amdgcn_readfirstlane(tid >> 6), lane = tid & 63, wr = wid >> 2, wc = wid & 3, fr = lane & 15, fq = lane >> 4;
    const int nt = K / BK;
    int Rr[2], Cc[2]; unsigned voffB[2];
#pragma unroll
    for (int i = 0; i < 2; ++i) { stage_rc(tid * 16 + i * 8192, Rr[i], Cc[i]); voffB[i] = (unsigned)(Rr[i] * ldb + Cc[i]) * 2u; }
    const size_t kstep = (size_t)(BK * 2);
    const size_t hstepB = (size_t)HALF * ldb * 2;
    const unsigned ldsw = (unsigned)wid * 1024u;
    const int aoff = lds_byte(wr * 64 + fr, fq * 8), boff = lds_byte(wc * 32 + fr, fq * 8);
#define PG8_SA(b, h) (((b) * 2 + (h)) * HTB)
#define PG8_SB(b, h) ((4 + (b) * 2 + (h)) * HTB)
#define PG8_STAGE(bufoff, gbase, voff) do { _Pragma("unroll") for (int _i = 0; _i < 2; ++_i) \
        __builtin_amdgcn_global_load_lds((const unsigned*)((const char*)(gbase) + (voff)[_i]), (LAS unsigned*)(lds + (bufoff) + ldsw + _i * 8192), 16, 0, 0); } while (0)
#define PG8_LDA(dst, b, h) do { _Pragma("unroll") for (int m = 0; m < 4; ++m) _Pragma("unroll") for (int k = 0; k < 2; ++k) dst[m][k] = *(const LAS bf16x8*)(lds + PG8_SA(b, h) + aoff + m * 2048 + k * 1024); } while (0)
#define PG8_LDB(dst, b, h) do { _Pragma("unroll") for (int n = 0; n < 2; ++n) _Pragma("unroll") for (int k = 0; k < 2; ++k) dst[n][k] = *(const LAS bf16x8*)(lds + PG8_SB(b, h) + boff + n * 2048 + k * 1024); } while (0)
#define PG8_MMA(ai, bj, At, Bt) do { __builtin_amdgcn_s_setprio(1); _Pragma("unroll") for (int m = 0; m < 4; ++m) _Pragma("unroll") for (int n = 0; n < 2; ++n) _Pragma("unroll") for (int k = 0; k < 2; ++k) \
        acc[ai][bj][m][n] = __builtin_amdgcn_mfma_f32_16x16x32_bf16(Bt[n][k], At[m][k], acc[ai][bj][m][n], 0, 0, 0); __builtin_amdgcn_s_setprio(0); } while (0)
#define PG8_WAIT_V(n) asm volatile("s_waitcnt vmcnt(" #n ")" ::: "memory")
#define PG8_WAIT_L(n) asm volatile("s_waitcnt lgkmcnt(" #n ")" ::: "memory")
#define PG8_BAR __builtin_amdgcn_s_barrier()
#define PG8_SCHED __builtin_amdgcn_sched_barrier(0)
    Unit cur, nxt; int ui = 0;
    if (!S.next(0, cur)) return;
    f32x4 acc[2][2][4][2];
#pragma unroll
    for (int a = 0; a < 2; ++a)
#pragma unroll
        for (int b = 0; b < 2; ++b)
#pragma unroll
            for (int m = 0; m < 4; ++m)
#pragma unroll
                for (int n = 0; n < 2; ++n) acc[a][b][m][n] = (f32x4){0.f, 0.f, 0.f, 0.f};
    bf16x8 At[4][2], B0[2][2], B1[2][2];
    const char* cA = S.a_base(cur); const char* cB = S.b_base(cur);
    unsigned vAc[2][2], vAn[2][2], v2[2][2];
    S.a_offs(cur, Rr, Cc, vAc);
    PG8_STAGE(PG8_SB(0, 0), cB, voffB); PG8_STAGE(PG8_SB(0, 1), cB + hstepB, voffB); PG8_STAGE(PG8_SA(0, 0), cA, vAc[0]); PG8_STAGE(PG8_SA(0, 1), cA, vAc[1]);
    if (wr == 1) PG8_BAR;
    PG8_WAIT_V(2); PG8_BAR;
    PG8_STAGE(PG8_SB(1, 0), cB + kstep, voffB); PG8_STAGE(PG8_SA(1, 0), cA + kstep, vAc[0]); PG8_STAGE(PG8_SB(1, 1), cB + hstepB + kstep, voffB);
    PG8_WAIT_V(6); PG8_BAR;
    for (;;) {
        const bool has_next = S.next(ui + 1, nxt);
        const char* nA = has_next ? S.a_base(nxt) : cA; const char* nB = has_next ? S.b_base(nxt) : cB;
        if (has_next) S.a_offs(nxt, Rr, Cc, vAn);
        else {
#pragma unroll
            for (int h = 0; h < 2; ++h)
#pragma unroll
                for (int i = 0; i < 2; ++i) vAn[h][i] = vAc[h][i]; }
#pragma unroll 1
        for (int t = 0; t < nt; t += 2) {
            const bool last = (t == nt - 2);
            const char* a1 = cA + (size_t)(t + 1) * kstep;
            const char* a2 = last ? nA : cA + (size_t)(t + 2) * kstep; const char* b2 = last ? nB : cB + (size_t)(t + 2) * kstep;
            const char* a3 = a2 + kstep; const char* b3 = b2 + kstep;
#pragma unroll
            for (int h = 0; h < 2; ++h)
#pragma unroll
                for (int i = 0; i < 2; ++i) v2[h][i] = last ? vAn[h][i] : vAc[h][i];
            PG8_LDB(B0, 0, 0); PG8_LDB(B1, 0, 1); PG8_SCHED; PG8_LDA(At, 0, 0); PG8_STAGE(PG8_SA(1, 1), a1, vAc[1]);
            PG8_WAIT_V(8); PG8_WAIT_L(0); PG8_BAR; PG8_MMA(0, 0, At, B0); PG8_MMA(0, 1, At, B1); PG8_BAR; PG8_SCHED;
            PG8_LDA(At, 0, 1); PG8_STAGE(PG8_SB(0, 0), b2, voffB); PG8_STAGE(PG8_SB(0, 1), b2 + hstepB, voffB); PG8_STAGE(PG8_SA(0, 0), a2, v2[0]);
            PG8_WAIT_V(8); PG8_WAIT_L(0); PG8_BAR; PG8_MMA(1, 0, At, B0); PG8_MMA(1, 1, At, B1); PG8_BAR; PG8_SCHED;
            PG8_LDB(B0, 1, 0); PG8_LDB(B1, 1, 1); PG8_SCHED; PG8_LDA(At, 1, 0); PG8_STAGE(PG8_SA(0, 1), a2, v2[1]);
            PG8_WAIT_V(8); PG8_WAIT_L(0); PG8_BAR; PG8_MMA(0, 0, At, B0); PG8_MMA(0, 1, At, B1); PG8_BAR; PG8_SCHED;
            PG8_LDA(At, 1, 1); PG8_STAGE(PG8_SB(1, 0), b3, voffB); PG8_STAGE(PG8_SB(1, 1), b3 + hstepB, voffB); PG8_STAGE(PG8_SA(1, 0), a3, v2[0]);
            PG8_WAIT_V(8); PG8_WAIT_L(0); PG8_BAR; PG8_MMA(1, 0, At, B0); PG8_MMA(1, 1, At, B1); PG8_BAR; PG8_SCHED;
        }
        if constexpr (ALIGN_EPI) { if (wr == 0) PG8_BAR; }
        E(acc, cur, wr, wc, fr, fq);
        if (!has_next) break;
#pragma unroll
        for (int a = 0; a < 2; ++a)
#pragma unroll
            for (int b = 0; b < 2; ++b)
#pragma unroll
                for (int m = 0; m < 4; ++m)
#pragma unroll
                    for (int n = 0; n < 2; ++n) acc[a][b][m][n] = (f32x4){0.f, 0.f, 0.f, 0.f};
        cur = nxt; cA = nA; cB = nB; ++ui;
#pragma unroll
        for (int h = 0; h < 2; ++h)
#pragma unroll
            for (int i = 0; i < 2; ++i) vAc[h][i] = vAn[h][i];
        if constexpr (ALIGN_EPI) { if (wr == 1) PG8_BAR; }
    }
    PG8_WAIT_V(0);
    if constexpr (!ALIGN_EPI) { if (wr == 0) PG8_BAR; }
    PG8_BAR;
#undef PG8_SA
#undef PG8_SB
#undef PG8_STAGE
#undef PG8_LDA
#undef PG8_LDB
#undef PG8_MMA
#undef PG8_WAIT_V
#undef PG8_WAIT_L
#undef PG8_BAR
#undef PG8_SCHED
}
}
using pg8::Unit;

struct PlainSched {
    pg8::StaticOrder so; const bf16* A; const bf16* Bt; int lda, ldb; int acol_pn, acol_off;
    __device__ __forceinline__ bool next(int i, Unit& u) const { return so.next(i, u); }
    __device__ __forceinline__ const char* a_base(const Unit& u) const { return (const char*)(A + (size_t)u.pm * 256 * lda + (u.pn >= acol_pn ? acol_off : 0)); }
    __device__ __forceinline__ const char* b_base(const Unit& u) const { return (const char*)(Bt + (size_t)u.pn * 256 * ldb); }
    __device__ __forceinline__ void a_offs(const Unit&, const int (&R)[2], const int (&C)[2], unsigned (&v)[2][2]) const {
#pragma unroll
        for (int h = 0; h < 2; ++h)
#pragma unroll
            for (int i = 0; i < 2; ++i) v[h][i] = (unsigned)((h * 128 + R[i]) * lda + C[i]) * 2u; }
};
struct MoeSched {
    int G, c, NT, npanels; const LAS int* pst; const LAS int* cnt; const int* toks; const bf16* A; const bf16* Bt; int lda, ldb; size_t bstride; bool gather;
    __device__ __forceinline__ bool next(int i, Unit& u) const {
        const int L = i * G + c; if (L >= npanels * NT) return false;
        u.pm = L / NT; u.pn = L % NT; int e = 0;
#pragma unroll 1
        for (int q = 1; q < NE; ++q) e = (pst[q] <= u.pm) ? q : e;
        u.e = e; u.lr0 = (u.pm - pst[e]) * 256; return true; }
    __device__ __forceinline__ const char* a_base(const Unit& u) const { return gather ? (const char*)A : (const char*)(A + (size_t)u.pm * 256 * lda); }
    __device__ __forceinline__ const char* b_base(const Unit& u) const { return (const char*)(Bt + (size_t)u.e * bstride + (size_t)u.pn * 256 * ldb); }
    __device__ __forceinline__ void a_offs(const Unit& u, const int (&R)[2], const int (&C)[2], unsigned (&v)[2][2]) const {
        const int ce = cnt[u.e];
#pragma unroll
        for (int h = 0; h < 2; ++h)
#pragma unroll
            for (int i = 0; i < 2; ++i) {
                if (gather) { const int lrow = u.lr0 + h * 128 + R[i]; const int tok = lrow < ce ? toks[u.e * CAP + lrow] : 0; v[h][i] = (unsigned)(tok * lda + C[i]) * 2u; }
                else v[h][i] = (unsigned)((h * 128 + R[i]) * lda + C[i]) * 2u; } }
};

__device__ __forceinline__ void st4(bf16* p, f32x4 v) { u32x2 o; o.x = pk2(v.x, v.y); o.y = pk2(v.z, v.w); *(u32x2*)p = o; }
__device__ __forceinline__ float sq4(f32x4 v) { return (v.x * v.x + v.y * v.y) + (v.z * v.z + v.w * v.w); }

struct EpiInProj {
    unsigned char* ws;
    __device__ __forceinline__ void operator()(const f32x4 (&acc)[2][2][4][2], const Unit& u, int wr, int wc, int fr, int fq) const {
        const float* rs0 = (const float*)(ws + WS_RS0);
        const int reg = u.pn >> 1;
        bf16* dst = (bf16*)(ws + (reg == 0 ? WS_QA : reg == 1 ? WS_KA : reg == 2 ? WS_VA : WS_LAT));
        const float qs = (reg == 0) ? QS_A : 1.f;
#pragma unroll
        for (int ai = 0; ai < 2; ++ai)
#pragma unroll
            for (int m = 0; m < 4; ++m) {
                const int row = u.pm * 256 + ai * 128 + wr * 64 + m * 16 + fr;
                const float rs = rs0[row]; const float sc = rs * qs;
                float ssq = 0.f;
#pragma unroll
                for (int bj = 0; bj < 2; ++bj)
#pragma unroll
                    for (int n = 0; n < 2; ++n) {
                        const int lc = (u.pn & 1) * 256 + bj * 128 + wc * 32 + n * 16 + fq * 4;
                        const f32x4 v = acc[ai][bj][m][n] * sc;
                        st4(dst + (size_t)row * 512 + lc, v);
                        if (u.pn == 6 || (u.pn == 7 && bj == 0)) ssq += sq4(v);
                    }
                if (u.pn >= 6) {
                    ssq += __shfl_xor(ssq, 16); ssq += __shfl_xor(ssq, 32);
                    if (fq == 0) atomicAdd((float*)(ws + (u.pn == 6 ? CTL_SSQQ : CTL_SSQKV)) + row, ssq);
                    if (u.pn == 7 && wc == 0) {
                        const f32x4 x1 = acc[ai][1][m][0] * rs, x2 = acc[ai][1][m][1] * rs;
                        const float2* cs = (const float2*)(ws + WS_ROPE) + (row & (SEQ - 1)) * 16 + fq * 4;
                        f32x4 y1, y2;
#pragma unroll
                        for (int j = 0; j < 4; ++j) { const float2 c = cs[j]; y1[j] = x1[j] * c.x - x2[j] * c.y; y2[j] = x1[j] * c.y + x2[j] * c.x; }
                        bf16* kr = (bf16*)(ws + WS_KR) + (size_t)row * 32 + fq * 4;
                        st4(kr, y1); st4(kr + 16, y2);
                    }
                }
            }
    }
};
struct EpiUps {
    unsigned char* ws;
    __device__ __forceinline__ void operator()(const f32x4 (&acc)[2][2][4][2], const Unit& u, int wr, int wc, int fr, int fq) const {
        const bool isq = u.pn < 3;
        const float* ssq = (const float*)(ws + (isq ? CTL_SSQQ : CTL_SSQKV));
#pragma unroll
        for (int ai = 0; ai < 2; ++ai)
#pragma unroll
            for (int m = 0; m < 4; ++m) {
                const int row = u.pm * 256 + ai * 128 + wr * 64 + m * 16 + fr;
                const float rs = rsqrtf(ssq[row] * (isq ? (1.f / 256.f) : (1.f / 128.f)) + EPS) * (isq ? QS_B : 1.f);
#pragma unroll
                for (int bj = 0; bj < 2; ++bj) {
                    if (isq) {
                        const int cg = u.pn * 8 + bj * 4 + wc;
                        bf16* q = (bf16*)(ws + WS_QB) + (size_t)row * 768 + cg * 32 + fq * 4;
                        f32x4 a = acc[ai][bj][m][0] * rs, b = acc[ai][bj][m][1] * rs;
                        if (cg % 3 == 2) {
                            const float2* cs = (const float2*)(ws + WS_ROPE) + (row & (SEQ - 1)) * 16 + fq * 4;
                            f32x4 y1, y2;
#pragma unroll
                            for (int j = 0; j < 4; ++j) { const float2 c = cs[j]; y1[j] = a[j] * c.x - b[j] * c.y; y2[j] = a[j] * c.y + b[j] * c.x; }
                            a = y1; b = y2;
                        }
                        st4(q, a); st4(q + 16, b);
                    } else {
                        const int head = (u.pn - 3) * 2 + bj;
                        bf16* dst = (bf16*)(ws + (wc < 2 ? WS_KB : WS_VB)) + (size_t)row * 512 + head * 64 + (wc & 1) * 32 + fq * 4;
                        st4(dst, acc[ai][bj][m][0] * rs); st4(dst + 16, acc[ai][bj][m][1] * rs);
                    }
                }
            }
    }
};
struct EpiOut {
    unsigned char* ws;
    __device__ __forceinline__ void operator()(const f32x4 (&acc)[2][2][4][2], const Unit& u, int wr, int wc, int fr, int fq) const {
        const bf16* xb = (const bf16*)(ws + WS_XB); bf16* x1 = (bf16*)(ws + WS_X1);
#pragma unroll
        for (int ai = 0; ai < 2; ++ai)
#pragma unroll
            for (int m = 0; m < 4; ++m) {
                const int row = u.pm * 256 + ai * 128 + wr * 64 + m * 16 + fr; float ssq = 0.f;
#pragma unroll
                for (int bj = 0; bj < 2; ++bj)
#pragma unroll
                    for (int n = 0; n < 2; ++n) {
                        const size_t o = (size_t)row * 1024 + u.pn * 256 + bj * 128 + wc * 32 + n * 16 + fq * 4;
                        const u32x2 xv = *(const u32x2*)(xb + o);
                        f32x4 v = acc[ai][bj][m][n];
                        v.x += __uint_as_float(xv.x << 16); v.y += __uint_as_float(xv.x & 0xffff0000u); v.z += __uint_as_float(xv.y << 16); v.w += __uint_as_float(xv.y & 0xffff0000u);
                        st4(x1 + o, v); ssq += sq4(v);
                    }
                ssq += __shfl_xor(ssq, 16); ssq += __shfl_xor(ssq, 32);
                if (fq == 0) atomicAdd((float*)(ws + CTL_SSQ1) + row, ssq);
            }
    }
};
struct EpiGateUp {
    unsigned char* ws; const LAS int* cnt;
    __device__ __forceinline__ void operator()(const f32x4 (&acc)[2][2][4][2], const Unit& u, int wr, int wc, int fr, int fq) const {
        const int ce = cnt[u.e]; const int* toks = (const int*)(ws + WS_TOK) + u.e * CAP; const float* ssq1 = (const float*)(ws + CTL_SSQ1);
#pragma unroll
        for (int ai = 0; ai < 2; ++ai)
#pragma unroll
            for (int m = 0; m < 4; ++m) {
                const int lr = ai * 128 + wr * 64 + m * 16 + fr; const int lrow = u.lr0 + lr;
                const int tok = lrow < ce ? toks[lrow] : 0;
                const float rs = rsqrtf(ssq1[tok] * (1.f / D) + EPS);
                bf16* dst = (bf16*)(ws + WS_HB) + (size_t)(u.pm * 256 + lr) * 256 + u.pn * 128 + wc * 32 + fq * 4;
#pragma unroll
                for (int n = 0; n < 2; ++n) { const f32x4 g = acc[ai][0][m][n] * rs, up = acc[ai][1][m][n] * rs; f32x4 h;
#pragma unroll
                    for (int j = 0; j < 4; ++j) h[j] = g[j] / (1.f + __expf(-g[j])) * up[j];
                    st4(dst + n * 16, h); }
            }
    }
};
struct EpiDown {
    unsigned char* ws; const LAS int* cnt;
    __device__ __forceinline__ void operator()(const f32x4 (&acc)[2][2][4][2], const Unit& u, int wr, int wc, int fr, int fq) const {
        const int ce = cnt[u.e]; const float* gates = (const float*)(ws + WS_GATE) + u.e * CAP;
#pragma unroll
        for (int ai = 0; ai < 2; ++ai)
#pragma unroll
            for (int m = 0; m < 4; ++m) {
                const int lr = ai * 128 + wr * 64 + m * 16 + fr; const int lrow = u.lr0 + lr;
                const float gt = lrow < ce ? gates[lrow] : 0.f;
                bf16* dst = (bf16*)(ws + WS_YB) + (size_t)(u.pm * 256 + lr) * 1024 + u.pn * 256 + wc * 32 + fq * 4;
#pragma unroll
                for (int bj = 0; bj < 2; ++bj)
#pragma unroll
                    for (int n = 0; n < 2; ++n) st4(dst + bj * 128 + n * 16, acc[ai][bj][m][n] * gt);
            }
    }
};

struct Args { const float* in[20]; float* out; unsigned char* ws; int ph_lo, ph_hi; };
struct Frame { LAS unsigned char* lds; int tid, lane, wave, vcu, G; const float* const* in; float* out; unsigned char* ws; };

__device__ __forceinline__ void transpose_item(const float* W, int ldw, const float* gain, bf16* WT, int ldwt, int k0, int n0, int dstrow0, LAS float* scr, int lane) {
#pragma unroll 8
    for (int i = 0; i < 32; ++i) { const int kk = 2 * i + (lane >> 5); float v = W[(size_t)(k0 + kk) * ldw + n0 + (lane & 31)]; if (gain) v *= gain[k0 + kk]; scr[kk * 33 + (lane & 31)] = v; }
    LDS_WAIT();
    const int c = lane & 7;
#pragma unroll
    for (int j = 0; j < 4; ++j) { const int n = (lane >> 3) + 8 * j; const LAS float* s = scr + (8 * c) * 33 + n;
        u32x4 o; o.x = pk2(s[0 * 33], s[1 * 33]); o.y = pk2(s[2 * 33], s[3 * 33]); o.z = pk2(s[4 * 33], s[5 * 33]); o.w = pk2(s[6 * 33], s[7 * 33]);
        *(u32x4*)(WT + (size_t)(dstrow0 + n) * ldwt + k0 + 8 * c) = o; }
    LDS_WAIT();
}

__device__ __forceinline__ void p_prologue(const Frame& F) {
    unsigned char* ws = F.ws; const int lane = F.lane;
    LAS float* scr = (LAS float*)(F.lds + F.wave * 16384);
    const int gw = F.vcu * NWAVES + F.wave, NGW = F.G * NWAVES;
    constexpr int I_IN = 16 * 61, I_Q = 4 * 24, I_KV = 2 * 32, I_O = 16 * 32, I_G = 16 * 8, I_D = 4 * 32;
    constexpr int NITEMS = I_IN + I_Q + I_KV + I_O + 64 * I_G + 32 * I_D;
    for (int it = gw; it < NITEMS; it += NGW) {
        int r = it;
        if (r < I_IN) { const int kb = r / 61, nb = r % 61; transpose_item(F.in[2], NIN, F.in[1], (bf16*)(ws + WS_WI), 1024, kb * 64, nb * 32, nb * 32, scr, lane); continue; } r -= I_IN;
        if (r < I_Q) { const int kb = r / 24, nb = r % 24; transpose_item(F.in[5], 768, F.in[4], (bf16*)(ws + WS_WQKV), 256, kb * 64, nb * 32, nb * 32, scr, lane); continue; } r -= I_Q;
        if (r < I_KV) { const int kb = r / 32, nb = r % 32; transpose_item(F.in[7], 1024, F.in[6], (bf16*)(ws + WS_WQKV), 256, kb * 64, nb * 32, 768 + nb * 32, scr, lane); continue; } r -= I_KV;
        if (r < I_O) { const int kb = r / 32, nb = r % 32; transpose_item(F.in[10], 1024, nullptr, (bf16*)(ws + WS_WO), 1024, kb * 64, nb * 32, nb * 32, scr, lane); continue; } r -= I_O;
        if (r < 64 * I_G) { const int mtx = r / I_G, q = r % I_G, e = mtx >> 1, kind = mtx & 1, kb = q / 8, nb = q % 8;
            const float* W = (kind ? F.in[17] : F.in[16]) + (size_t)e * 1024 * 256; const int n0 = nb * 32;
            transpose_item(W, 256, F.in[11], (bf16*)(ws + WS_WGU) + (size_t)e * 512 * 1024, 1024, kb * 64, n0, 256 * (n0 >> 7) + kind * 128 + (n0 & 127), scr, lane); continue; } r -= 64 * I_G;
        { const int e = r / I_D, q = r % I_D, kb = q / 32, nb = q % 32;
            transpose_item(F.in[18] + (size_t)e * 256 * 1024, 1024, nullptr, (bf16*)(ws + WS_WD) + (size_t)e * 1024 * 256, 256, kb * 64, nb * 32, nb * 32, scr, lane); }
    }
    const size_t gt = (size_t)F.vcu * 512 + F.tid, NGT = (size_t)F.G * 512;
    for (size_t i = gt; i < (size_t)96 * 1024 / 8; i += NGT) ((u32x4*)((bf16*)(ws + WS_WI) + (size_t)1952 * 1024))[i] = (u32x4){0, 0, 0, 0};
    for (size_t i = gt; i < (size_t)1024 * 16; i += NGT) { const size_t row = i >> 4, c = i & 15; *(u32x4*)((bf16*)(ws + WS_WQKV) + (768 + row) * 256 + 128 + c * 8) = (u32x4){0, 0, 0, 0}; }
    for (int m = gw; m < T; m += NGW) {
        const f32x4* xr = (const f32x4*)(F.in[0] + (size_t)m * D) + lane; f32x4 v[4]; float s = 0.f;
#pragma unroll
        for (int j = 0; j < 4; ++j) { v[j] = xr[64 * j]; s += sq4(v[j]); }
        s = wave_sum(s);
        u32x2* o8 = (u32x2*)((bf16*)(ws + WS_XB) + (size_t)m * D) + lane;
#pragma unroll
        for (int j = 0; j < 4; ++j) { u32x2 o; o.x = pk2(v[j].x, v[j].y); o.y = pk2(v[j].z, v[j].w); o8[64 * j] = o; }
        if (lane == 0) ((float*)(ws + WS_RS0))[m] = rsqrtf(s * (1.f / D) + EPS);
    }
    for (size_t i = gt; i < (size_t)SEQ * 16; i += NGT) { const int s = (int)(i >> 4), f = (int)(i & 15);
        const float inv = (float)pow(10000.0, -(double)f / 16.0); const float ang = (float)s * inv;
        float2 cs; cs.x = (float)cos((double)ang); cs.y = (float)sin((double)ang); ((float2*)(ws + WS_ROPE))[i] = cs; }
    for (size_t i = gt; i < (size_t)3 * 8 * 132; i += NGT) { const int p = (int)(i / (8 * 132)), h = (int)((i / 132) % 8), jj = (int)(i % 132);
        float val = 0.f;
        if (jj <= 128) { const int dil = (p == 0) ? 1 : (p == 1) ? 4 : 16; const int rel = (jj - 64) * dil; const int n = rel < 0 ? -rel : rel;
            int large = 8 + (int)(log((double)(n > 1 ? n : 1) / 8.0) / log(128.0) * 8.0); if (large > 15) large = 15;
            const int bucket = (rel > 0 ? 16 : 0) + (n < 8 ? n : large);
            val = F.in[3][bucket * 8 + h] * LOG2E; }
        ((float*)(ws + WS_BT))[i] = val; }
}

__device__ __forceinline__ void p_attnA_naive(const Frame& F, bf16* OA, float* LSE) {
    unsigned char* ws = F.ws;
    const bf16* QA = (const bf16*)(ws + WS_QA); const bf16* KA = (const bf16*)(ws + WS_KA); const bf16* VA = (const bf16*)(ws + WS_VA);
    const float* BT = (const float*)(ws + WS_BT);
    for (int idx = F.vcu * 512 + F.tid; idx < T * 8; idx += F.G * 512) {
        const int s = idx & (SEQ - 1), h = (idx >> 11) & 7, b = idx >> 14;
        float q[64], o[64];
        const size_t t = (size_t)b * SEQ + s;
#pragma unroll
        for (int i = 0; i < 64; ++i) { q[i] = bf2f(QA[t * 512 + h * 64 + i]); o[i] = 0.f; }
        float m = -1e30f, l = 0.f;
        for (int p = 0; p < 3; ++p) { const int dil = (p == 0) ? 1 : (p == 1) ? 4 : 16;
            for (int j = -64; j <= 64; ++j) { const int pos = s + j * dil; if (pos < 0 || pos >= SEQ) continue;
                const bf16* kp = KA + ((size_t)b * SEQ + pos) * 512 + h * 64; const bf16* vp = VA + ((size_t)b * SEQ + pos) * 512 + h * 64;
                float sc = BT[(p * 8 + h) * 132 + j + 64];
#pragma unroll
                for (int i = 0; i < 64; ++i) sc += q[i] * bf2f(kp[i]);
                const float mn = fmaxf(m, sc), al = exp2f(m - mn), pe = exp2f(sc - mn);
                l = l * al + pe; m = mn;
#pragma unroll
                for (int i = 0; i < 64; ++i) o[i] = o[i] * al + pe * bf2f(vp[i]);
            } }
        const float il = 1.f / l;
#pragma unroll
        for (int i = 0; i < 64; ++i) OA[t * 512 + h * 64 + i] = f2bf(o[i] * il);
        LSE[t * 8 + h] = m + log2f(l);
    }
}
__device__ __forceinline__ void p_attnB_naive(const Frame& F) {
    unsigned char* ws = F.ws;
    const bf16* QB = (const bf16*)(ws + WS_QB); const bf16* KB = (const bf16*)(ws + WS_KB); const bf16* VB = (const bf16*)(ws + WS_VB); const bf16* KR = (const bf16*)(ws + WS_KR);
    for (int idx = F.vcu * 512 + F.tid; idx < T * 8; idx += F.G * 512) {
        const int s = idx & (SEQ - 1), h = (idx >> 11) & 7, b = idx >> 14;
        float q[96], o[64];
        const size_t t = (size_t)b * SEQ + s;
#pragma unroll
        for (int i = 0; i < 96; ++i) q[i] = bf2f(QB[t * 768 + h * 96 + i]);
#pragma unroll
        for (int i = 0; i < 64; ++i) o[i] = 0.f;
        float m = -1e30f, l = 0.f;
        for (int key = 0; key < SEQ; ++key) { const size_t tk = (size_t)b * SEQ + key;
            const bf16* kp = KB + tk * 512 + h * 64; const bf16* rp = KR + tk * 32; const bf16* vp = VB + tk * 512 + h * 64;
            float sc = 0.f;
#pragma unroll
            for (int i = 0; i < 64; ++i) sc += q[i] * bf2f(kp[i]);
#pragma unroll
            for (int i = 0; i < 32; ++i) sc += q[64 + i] * bf2f(rp[i]);
            const float mn = fmaxf(m, sc), al = exp2f(m - mn), pe = exp2f(sc - mn);
            l = l * al + pe; m = mn;
#pragma unroll
            for (int i = 0; i < 64; ++i) o[i] = o[i] * al + pe * bf2f(vp[i]);
        }
        const float il = 1.f / l;
#pragma unroll
        for (int i = 0; i < 64; ++i) ((bf16*)(ws + WS_OB))[t * 512 + h * 64 + i] = f2bf(o[i] * il);
    }
}
__device__ __forceinline__ void unpack8(u32x4 v, float (&a)[8]) {
    a[0] = __uint_as_float(v.x << 16); a[1] = __uint_as_float(v.x & 0xffff0000u); a[2] = __uint_as_float(v.y << 16); a[3] = __uint_as_float(v.y & 0xffff0000u);
    a[4] = __uint_as_float(v.z << 16); a[5] = __uint_as_float(v.z & 0xffff0000u); a[6] = __uint_as_float(v.w << 16); a[7] = __uint_as_float(v.w & 0xffff0000u); }
template <int NP>
__device__ __forceinline__ void p_mixnorm(const Frame& F, const bf16* OA, const float* LSE) {
    unsigned char* ws = F.ws; const int lane = F.lane; const float* ga = F.in[8]; const float* gb = F.in[9];
    for (int m = F.vcu * NWAVES + F.wave; m < T; m += F.G * NWAVES) {
        const int head = lane >> 3; float a[8], w[NP], mx = -1e30f;
#pragma unroll
        for (int p = 0; p < NP; ++p) { w[p] = LSE[((size_t)p * T + m) * 8 + head]; mx = fmaxf(mx, w[p]); }
        float wsum = 0.f;
#pragma unroll
        for (int p = 0; p < NP; ++p) { w[p] = exp2f(w[p] - mx); wsum += w[p]; }
#pragma unroll
        for (int i = 0; i < 8; ++i) a[i] = 0.f;
#pragma unroll
        for (int p = 0; p < NP; ++p) { float t8[8]; unpack8(*(const u32x4*)(OA + ((size_t)p * T + m) * 512 + lane * 8), t8); const float ww = w[p] / wsum;
#pragma unroll
            for (int i = 0; i < 8; ++i) a[i] += ww * t8[i]; }
        float sa = 0.f;
#pragma unroll
        for (int i = 0; i < 8; ++i) sa += a[i] * a[i];
        sa = wave_sum(sa); const float ra = rsqrtf(sa * (1.f / 512.f) + EPS);
        float bv[8]; unpack8(*(const u32x4*)((const bf16*)(ws + WS_OB) + (size_t)m * 512 + lane * 8), bv);
        float sb = 0.f;
#pragma unroll
        for (int i = 0; i < 8; ++i) sb += bv[i] * bv[i];
        sb = wave_sum(sb); const float rb = rsqrtf(sb * (1.f / 512.f) + EPS);
        u32x4 oa, ob; const float* gpa = ga + lane * 8; const float* gpb = gb + lane * 8;
        oa.x = pk2(a[0] * ra * gpa[0], a[1] * ra * gpa[1]); oa.y = pk2(a[2] * ra * gpa[2], a[3] * ra * gpa[3]); oa.z = pk2(a[4] * ra * gpa[4], a[5] * ra * gpa[5]); oa.w = pk2(a[6] * ra * gpa[6], a[7] * ra * gpa[7]);
        ob.x = pk2(bv[0] * rb * gpb[0], bv[1] * rb * gpb[1]); ob.y = pk2(bv[2] * rb * gpb[2], bv[3] * rb * gpb[3]); ob.z = pk2(bv[4] * rb * gpb[4], bv[5] * rb * gpb[5]); ob.w = pk2(bv[6] * rb * gpb[6], bv[7] * rb * gpb[7]);
        bf16* mix = (bf16*)(ws + WS_MIX) + (size_t)m * 1024;
        *(u32x4*)(mix + lane * 8) = oa; *(u32x4*)(mix + 512 + lane * 8) = ob;
    }
}
__device__ __forceinline__ void p_router(const Frame& F) {
    unsigned char* ws = F.ws; const int lane = F.lane;
    LAS float* h2s = (LAS float*)(F.lds + F.wave * 8192); LAS float* lgs = h2s + 1024;
    const float* gffn = F.in[11]; const float* wrg = F.in[12]; const float* brg = F.in[13]; const float* wre = F.in[14]; const float* bre = F.in[15];
    int* counts = (int*)(ws + WS_CTL) + CW_COUNTS; const float* ssq1 = (const float*)(ws + CTL_SSQ1);
    for (int m = F.vcu * NWAVES + F.wave; m < T; m += F.G * NWAVES) {
        const bf16* xr = (const bf16*)(ws + WS_X1) + (size_t)m * 1024;
        const float rs = rsqrtf(ssq1[m] * (1.f / D) + EPS);
#pragma unroll
        for (int i = 0; i < 16; ++i) h2s[lane + 64 * i] = bf2f(xr[lane + 64 * i]) * rs * gffn[lane + 64 * i];
        LDS_WAIT();
        float acc = 0.f;
        if (lane < 4) { for (int k = 0; k < D; ++k) acc += h2s[k] * wrg[k * 4 + lane]; acc += brg[lane]; }
        else if (lane < 36) { const int e = lane - 4; for (int k = 0; k < D; ++k) acc += h2s[k] * wre[k * 32 + e]; acc += bre[e]; }
        lgs[lane] = acc;
        LDS_WAIT();
        if (lane == 0) {
            const LAS float* L = lgs;
            int gi = 0; float gm = L[0]; for (int i = 1; i < 4; ++i) if (L[i] > gm) { gm = L[i]; gi = i; }
            float gs = 0.f; for (int i = 0; i < 4; ++i) gs += __expf(L[i] - gm);
            const float ggate = 1.f / gs;
            const LAS float* EL = L + 4 + gi * 8;
            int i1 = 0; float m1 = EL[0]; for (int i = 1; i < 8; ++i) if (EL[i] > m1) { m1 = EL[i]; i1 = i; }
            int i2 = -1; float m2 = -3.0e38f; for (int i = 0; i < 8; ++i) if (i != i1 && EL[i] > m2) { m2 = EL[i]; i2 = i; }
            const float p2 = __expf(m2 - m1); const float g1 = ggate / (1.f + p2), g2 = ggate * p2 / (1.f + p2);
            const int e1 = gi * 8 + i1, e2 = gi * 8 + i2;
            const int p1 = atomicAdd(&counts[e1], 1), pp2 = atomicAdd(&counts[e2], 1);
            ((int*)(ws + WS_TOK))[e1 * CAP + p1] = m; ((int*)(ws + WS_TOK))[e2 * CAP + pp2] = m;
            ((float*)(ws + WS_GATE))[e1 * CAP + p1] = g1; ((float*)(ws + WS_GATE))[e2 * CAP + pp2] = g2;
            ((int*)(ws + WS_AE))[m * 2] = e1; ((int*)(ws + WS_AE))[m * 2 + 1] = e2; ((int*)(ws + WS_APOS))[m * 2] = p1; ((int*)(ws + WS_APOS))[m * 2 + 1] = pp2;
        }
        LDS_WAIT();
    }
}
__device__ __forceinline__ void moe_tables(const Frame& F) {
    LAS int* pst = (LAS int*)(F.lds + MOE_OFF); LAS int* cnt = pst + 40;
    const int* counts = (const int*)(F.ws + WS_CTL) + CW_COUNTS;
    __syncthreads();
    if (F.tid < NE) cnt[F.tid] = counts[F.tid];
    __syncthreads();
    if (F.tid == 0) { int acc = 0; for (int e = 0; e < NE; ++e) { pst[e] = acc; acc += (cnt[e] + 255) >> 8; } pst[NE] = acc; }
    __syncthreads();
}
__device__ __forceinline__ void p_final(const Frame& F) {
    unsigned char* ws = F.ws; const int lane = F.lane; const float* gfin = F.in[19];
    const LAS int* pst = (const LAS int*)(F.lds + MOE_OFF);
    for (int m = F.vcu * NWAVES + F.wave; m < T; m += F.G * NWAVES) {
        const int e1 = ((const int*)(ws + WS_AE))[m * 2], e2 = ((const int*)(ws + WS_AE))[m * 2 + 1];
        const int r1 = ((const int*)(ws + WS_APOS))[m * 2] + pst[e1] * 256, r2 = ((const int*)(ws + WS_APOS))[m * 2 + 1] + pst[e2] * 256;
        const bf16* xr = (const bf16*)(ws + WS_X1) + (size_t)m * 1024; const bf16* y1 = (const bf16*)(ws + WS_YB) + (size_t)r1 * 1024; const bf16* y2 = (const bf16*)(ws + WS_YB) + (size_t)r2 * 1024;
        float v[16]; float s = 0.f;
#pragma unroll
        for (int j = 0; j < 4; ++j) { const u32x2 a = *((const u32x2*)xr + lane + 64 * j), b = *((const u32x2*)y1 + lane + 64 * j), c = *((const u32x2*)y2 + lane + 64 * j);
            v[4 * j + 0] = __uint_as_float(a.x << 16) + __uint_as_float(b.x << 16) + __uint_as_float(c.x << 16);
            v[4 * j + 1] = __uint_as_float(a.x & 0xffff0000u) + __uint_as_float(b.x & 0xffff0000u) + __uint_as_float(c.x & 0xffff0000u);
            v[4 * j + 2] = __uint_as_float(a.y << 16) + __uint_as_float(b.y << 16) + __uint_as_float(c.y << 16);
            v[4 * j + 3] = __uint_as_float(a.y & 0xffff0000u) + __uint_as_float(b.y & 0xffff0000u) + __uint_as_float(c.y & 0xffff0000u); }
#pragma unroll
        for (int i = 0; i < 16; ++i) s += v[i] * v[i];
        s = wave_sum(s); const float rs = rsqrtf(s * (1.f / D) + EPS);
#pragma unroll
        for (int j = 0; j < 4; ++j) { const f32x4 g4 = *((const f32x4*)gfin + lane + 64 * j); f32x4 o; o.x = v[4 * j] * rs * g4.x; o.y = v[4 * j + 1] * rs * g4.y; o.z = v[4 * j + 2] * rs * g4.z; o.w = v[4 * j + 3] * rs * g4.w;
            *((f32x4*)(F.out + (size_t)m * D) + lane + 64 * j) = o; }
    }
}

__global__ void __launch_bounds__(NWAVES * 64, 2) mk_fwd(Args args) {
    extern __shared__ __attribute__((aligned(16))) unsigned char lds_raw[];
    Frame F;
    F.lds = (LAS unsigned char*)lds_raw;
    F.tid = threadIdx.x; F.lane = F.tid & 63; F.wave = __builtin_amdgcn_readfirstlane(F.tid >> 6);
    F.G = gridDim.x; { const int bx = blockIdx.x; F.vcu = (F.G % 8 == 0) ? (bx % 8) * (F.G / 8) + bx / 8 : bx; }
    F.in = args.in; F.out = args.out; F.ws = args.ws;
    unsigned char* ws = args.ws;
    for (int u = F.tid; u < (LDS_BYTES - LDSCTL_OFF) / 4; u += NWAVES * 64) ((LAS unsigned*)(F.lds + LDSCTL_OFF))[u] = 0u;
    __syncthreads();
#if MK_SPLIT
#define GRID_BAR() do { } while (0)
#else
    volatile LAS unsigned* MISC = (volatile LAS unsigned*)(F.lds + MISC_OFF);
    XcdBarrier bar = xcd_barrier_post((unsigned*)(ws + WS_CTL) + CW_BAR, MISC + 8);
#define GRID_BAR() xcd_barrier(bar)
#endif
    const int lo = args.ph_lo, hi = args.ph_hi;
#ifndef PH_MASK
#define PH_MASK 0x3ff
#endif
#define IN(k) (((PH_MASK >> (k)) & 1) && lo <= (k) && (k) < hi)
#define BOTH(k) (IN(k) && IN((k) + 1))
    bf16* OA = (bf16*)args.out; float* LSE = (float*)(ws + WS_LSE);
    const LAS int* pst = (const LAS int*)(F.lds + MOE_OFF); const LAS int* cnt = pst + 40;

    if (IN(0)) { p_prologue(F); if (BOTH(0)) GRID_BAR(); }
    if (IN(1)) {
        PlainSched S; S.so.init(T, NINP, F.G, (int)blockIdx.x); S.A = (const bf16*)(ws + WS_XB); S.Bt = (const bf16*)(ws + WS_WI); S.lda = 1024; S.ldb = 1024; S.acol_pn = 1 << 30; S.acol_off = 0;
        EpiInProj E{ws};
        pg8::gemm_phase<EpiInProj, PlainSched, true>(F.lds, 1024, 1024, S, E);
        if (BOTH(1)) GRID_BAR();
    }
    if (IN(2)) {
        PlainSched S; S.so.init(T, 768 + 1024, F.G, (int)blockIdx.x); S.A = (const bf16*)(ws + WS_LAT); S.Bt = (const bf16*)(ws + WS_WQKV); S.lda = 512; S.ldb = 256; S.acol_pn = 3; S.acol_off = 256;
        EpiUps E{ws};
        pg8::gemm_phase<EpiUps, PlainSched, true>(F.lds, 256, 256, S, E);
        if (BOTH(2)) GRID_BAR();
    }
    if (IN(3)) { p_attnA_naive(F, OA, LSE); p_attnB_naive(F); if (BOTH(3)) GRID_BAR(); }
    if (IN(4)) { p_mixnorm<1>(F, OA, LSE); if (BOTH(4)) GRID_BAR(); }
    if (IN(5)) {
        PlainSched S; S.so.init(T, 1024, F.G, (int)blockIdx.x); S.A = (const bf16*)(ws + WS_MIX); S.Bt = (const bf16*)(ws + WS_WO); S.lda = 1024; S.ldb = 1024; S.acol_pn = 1 << 30; S.acol_off = 0;
        EpiOut E{ws};
        pg8::gemm_phase<EpiOut, PlainSched, true>(F.lds, 1024, 1024, S, E);
        if (BOTH(5)) GRID_BAR();
    }
    if (IN(6)) { p_router(F); if (BOTH(6)) GRID_BAR(); }
    if (IN(7)) {
        moe_tables(F);
        MoeSched S; S.G = F.G; S.c = (int)blockIdx.x; S.NT = 2; S.npanels = pst[NE]; S.pst = pst; S.cnt = cnt; S.toks = (const int*)(ws + WS_TOK);
        S.A = (const bf16*)(ws + WS_X1); S.Bt = (const bf16*)(ws + WS_WGU); S.lda = 1024; S.ldb = 1024; S.bstride = (size_t)512 * 1024; S.gather = true;
        EpiGateUp E{ws, cnt};
        pg8::gemm_phase<EpiGateUp, MoeSched, true>(F.lds, 1024, 1024, S, E);
        if (BOTH(7)) GRID_BAR();
    }
    if (IN(8)) {
        moe_tables(F);
        MoeSched S; S.G = F.G; S.c = (int)blockIdx.x; S.NT = 4; S.npanels = pst[NE]; S.pst = pst; S.cnt = cnt; S.toks = (const int*)(ws + WS_TOK);
        S.A = (const bf16*)(ws + WS_HB); S.Bt = (const bf16*)(ws + WS_WD); S.lda = 256; S.ldb = 256; S.bstride = (size_t)1024 * 256; S.gather = false;
        EpiDown E{ws, cnt};
        pg8::gemm_phase<EpiDown, MoeSched, true>(F.lds, 256, 256, S, E);
        if (BOTH(8)) GRID_BAR();
    }
    if (IN(9)) { moe_tables(F); p_final(F); }
#undef IN
#undef BOTH
}
}

extern "C" void kernel_launch(void* const* d_in, const int* in_sizes, int n_in, void* d_out, int out_size, void* d_ws, size_t ws_size, hipStream_t stream) {
    static int grid = 0;
    if (grid == 0) {
        if (n_in != 20 || ws_size < WS_END || out_size != T * D) { fprintf(stderr, "kernel_launch: unexpected shapes (n_in %d, ws %zu, out %d)\n", n_in, ws_size, out_size); grid = -1; return; }
        int dev = 0, cus = 0, per_cu = 0;
        if (hipGetDevice(&dev) != hipSuccess || hipDeviceGetAttribute(&cus, hipDeviceAttributeMultiprocessorCount, dev) != hipSuccess) { grid = -1; return; }
        if (hipFuncSetAttribute((const void*)mk_fwd, hipFuncAttributeMaxDynamicSharedMemorySize, LDS_BYTES) != hipSuccess) { fprintf(stderr, "kernel_launch: hipFuncSetAttribute failed\n"); grid = -1; return; }
        if (hipOccupancyMaxActiveBlocksPerMultiprocessor(&per_cu, (const void*)mk_fwd, NWAVES * 64, LDS_BYTES) != hipSuccess || per_cu < 1) { fprintf(stderr, "kernel_launch: occupancy query says %d\n", per_cu); }
        (void)hipGetLastError();
        grid = cus;
    }
    if (grid < 0) return;
    (void)hipMemsetAsync((char*)d_ws + WS_CTL, 0, CTL_BYTES, stream);
    Args a{};
    for (int i = 0; i < 20; ++i) a.in[i] = (const float*)d_in[i];
    a.out = (float*)d_out; a.ws = (unsigned char*)d_ws;
#if MK_SPLIT
    for (int p = 0; p < NPHASE; ++p) { a.ph_lo = p; a.ph_hi = p + 1; hipLaunchKernelGGL(mk_fwd, dim3(grid), dim3(NWAVES * 64), LDS_BYTES, stream, a); }
#else
    a.ph_lo = 0; a.ph_hi = NPHASE;
    hipLaunchKernelGGL(mk_fwd, dim3(grid), dim3(NWAVES * 64), LDS_BYTES, stream, a);
#endif
}
```

```cpp
#include <hip/hip_runtime.h>
#include <stdint.h>
#include <stdio.h>

#ifndef MK_SPLIT
#define MK_SPLIT 0
#endif

#define LAS __attribute__((address_space(3)))
#define GAS __attribute__((address_space(1)))

namespace {
typedef unsigned short bf16;
typedef short bf16x8 __attribute__((ext_vector_type(8)));
typedef float f32x4 __attribute__((ext_vector_type(4)));
typedef unsigned u32x4 __attribute__((ext_vector_type(4)));
typedef unsigned u32x2 __attribute__((ext_vector_type(2)));

constexpr int D = 1024, BATCH = 16, SEQ = 2048, T = BATCH * SEQ;
constexpr int NIN = 1952, NINP = 2048;
constexpr int NE = 32, CAP = 32768;
constexpr float EPS = 1e-6f;
constexpr float LOG2E = 1.4426950408889634f;
constexpr float QS_A = 0.125f * LOG2E;
constexpr float QS_B = 0.10206207261596577f * LOG2E;
constexpr int NWAVES = 8;
constexpr int NPHASE = 10;

constexpr size_t MiB = 1u << 20;
constexpr size_t WS_CTL = 0;
constexpr size_t CTL_BYTES = 1 * MiB;
constexpr int CW_COUNTS = 64;
constexpr int CW_BAR = 4096;
constexpr size_t CTL_SSQQ = 128 * 1024, CTL_SSQKV = 256 * 1024, CTL_SSQ1 = 384 * 1024;
constexpr size_t WS_RS0 = 2 * MiB;
constexpr size_t WS_ROPE = WS_RS0 + 512 * 1024;
constexpr size_t WS_BT = WS_ROPE + 256 * 1024;
constexpr size_t WS_AE = 3 * MiB;
constexpr size_t WS_APOS = WS_AE + 256 * 1024;
constexpr size_t WS_LSE = 4 * MiB;
constexpr size_t WS_WI = 8 * MiB;
constexpr size_t WS_WQKV = 12 * MiB;
constexpr size_t WS_WO = 13 * MiB;
constexpr size_t WS_WGU = 16 * MiB;
constexpr size_t WS_WD = 48 * MiB;
constexpr size_t WS_XB = 64 * MiB;
constexpr size_t WS_QA = 128 * MiB, WS_KA = 160 * MiB, WS_VA = 192 * MiB;
constexpr size_t WS_LAT = 224 * MiB;
constexpr size_t WS_QB = 256 * MiB;
constexpr size_t WS_KB = 304 * MiB, WS_VB = 336 * MiB, WS_OB = 368 * MiB;
constexpr size_t WS_MIX = 400 * MiB;
constexpr size_t WS_KR = 464 * MiB;
constexpr size_t WS_TOK = 466 * MiB;
constexpr size_t WS_GATE = 470 * MiB;
constexpr size_t WS_END = 474 * MiB;
constexpr size_t WS_X1 = 128 * MiB;
constexpr size_t WS_HB = 192 * MiB;
constexpr size_t WS_YB = 256 * MiB;

constexpr int RING_BYTES = 131072;
constexpr int LDSCTL_OFF = RING_BYTES;
constexpr int MISC_OFF = LDSCTL_OFF + 320;
constexpr int MOE_OFF = LDSCTL_OFF + 1024;
constexpr int LDS_BYTES = 147456;

__device__ __forceinline__ float bf2f(bf16 b) { return __uint_as_float(((unsigned)b) << 16); }
__device__ __forceinline__ bf16 f2bf(float f) { unsigned u = __float_as_uint(f); u += 0x7fffu + ((u >> 16) & 1u); return (bf16)(u >> 16); }
__device__ __forceinline__ unsigned pk2(float lo, float hi) { return (unsigned)f2bf(lo) | ((unsigned)f2bf(hi) << 16); }
__device__ __forceinline__ float wave_sum(float v) {
#pragma unroll
    for (int o = 1; o < 64; o <<= 1) v += __shfl_xor(v, o);
    return v;
}
#define LDS_WAIT() asm volatile("s_waitcnt lgkmcnt(0)" ::: "memory")

#define XB_TMO      128
#define XB_XCNT(j)  (256  + 64 * (j))
#define XB_XSUB(j)  (1280 + 64 * (j))
#define XB_XGEN(j)  (2304 + 64 * (j))
#define XB_TOP      3328
#define XB_TOPGEN   3392
#define XCD_BAR_WORDS 3456
#define XB_SPIN_CAP (1u << 18)
__device__ __forceinline__ unsigned xb_ld(unsigned* p)              { return __hip_atomic_load(p, __ATOMIC_RELAXED, __HIP_MEMORY_SCOPE_AGENT); }
__device__ __forceinline__ unsigned xb_add(unsigned* p, unsigned v) { return __hip_atomic_fetch_add(p, v, __ATOMIC_RELAXED, __HIP_MEMORY_SCOPE_AGENT); }
__device__ __forceinline__ unsigned xb_xcc_id() { return (unsigned)__builtin_amdgcn_s_getreg((3 << 11) | 20) & 0xFu; }
#define XB_SPIN(cond, bar) do { unsigned _sp = 0; while (cond) { __builtin_amdgcn_s_sleep(1); \
    if ((++_sp & 255u) == 0u) { if (xb_ld(&(bar)[XB_TMO])) break; if (_sp > XB_SPIN_CAP) { atomicAdd(&(bar)[XB_TMO], 1u); break; } } } } while (0)
struct XcdBarrier { unsigned* bar; unsigned x; volatile LAS unsigned* st; };
__device__ __forceinline__ XcdBarrier xcd_barrier_post(unsigned* bar, volatile LAS unsigned* st) {
    XcdBarrier b; b.bar = bar; b.x = xb_xcc_id(); b.st = st;
    if (threadIdx.x == 0) (void)xb_add(&bar[XB_XCNT(b.x)], 1u);
    return b;
}
__device__ __forceinline__ void xcd_barrier_complete(unsigned* bar, unsigned x, unsigned& nloc, unsigned& nx) {
    const unsigned G = gridDim.x * gridDim.y * gridDim.z;
    unsigned sum, cnt, mine, sp = 0u;
    for (;;) {
        sum = 0u; cnt = 0u; mine = 0u;
#pragma unroll
        for (unsigned j = 0; j < 16; ++j) { const unsigned c = xb_ld(&bar[XB_XCNT(j)]); sum += c; cnt += (c > 0u) ? 1u : 0u; mine = (j == x) ? c : mine; }
        if (sum == G) break;
        __builtin_amdgcn_s_sleep(1);
        if ((++sp & 255u) == 0u) { if (xb_ld(&bar[XB_TMO])) break; if (sp > XB_SPIN_CAP) { atomicAdd(&bar[XB_TMO], 1u); break; } }
    }
    nloc = mine > 0u ? mine : 1u; nx = cnt > 0u ? cnt : 1u;
}
__device__ __forceinline__ void xcd_barrier(const XcdBarrier& b) {
    asm volatile("s_waitcnt vmcnt(0)" ::: "memory");
    __syncthreads();
    if (threadIdx.x == 0) {
        unsigned* bar = b.bar;
        __builtin_amdgcn_s_waitcnt(0);
        unsigned nloc = b.st[0], nx = b.st[1];
        if (nloc == 0u) { xcd_barrier_complete(bar, b.x, nloc, nx); b.st[0] = nloc; b.st[1] = nx; }
        const unsigned old = xb_add(&bar[XB_XSUB(b.x)], 1u);
        const unsigned gen = old / nloc;
        if (old + 1u == (gen + 1u) * nloc) {
            __builtin_amdgcn_fence(__ATOMIC_RELEASE, "agent");
            asm volatile("s_waitcnt vmcnt(0)" ::: "memory");
            const unsigned og = xb_add(&bar[XB_TOP], 1u);
            const unsigned tg = og / nx;
            if (og + 1u == (tg + 1u) * nx) xb_add(&bar[XB_TOPGEN], 1u);
            else XB_SPIN(xb_ld(&bar[XB_TOPGEN]) == tg, bar);
            __builtin_amdgcn_fence(__ATOMIC_ACQUIRE, "agent");
            xb_add(&bar[XB_XGEN(b.x)], 1u);
            asm volatile("s_waitcnt vmcnt(0)" ::: "memory");
        } else {
            XB_SPIN(xb_ld(&bar[XB_XGEN(b.x)]) == gen, bar);
            __builtin_amdgcn_fence(__ATOMIC_ACQUIRE, "agent");
            asm volatile("s_waitcnt vmcnt(0)" ::: "memory");
        }
    }
    __syncthreads();
}

namespace pg8 {
constexpr int BM = 256, BK = 64, HALF = 128, HTB = HALF * BK * 2, STAGE_BYTES = 8 * HTB, NXCD = 8, WGM = 8;
__device__ __forceinline__ int lds_byte(int r, int c) { const int st = (r >> 4) * 2 + (c >> 5), rr = r & 15, cc = c & 31, ob = rr * 64 + cc * 2; return st * 1024 + (ob ^ (((ob >> 9) & 1) << 5)); }
__device__ __forceinline__ void stage_rc(int b, int& R, int& C) { const int st = b / 1024, sb = b % 1024, swz = sb ^ (((sb >> 9) & 1) << 5); R = (st >> 1) * 16 + swz / 64; C = (st & 1) * 32 + (swz % 64) / 2; }
struct Unit { int pm, pn, e, lr0; };
struct StaticOrder {
    int nM, nN, nwg, G, c;
    __device__ void init(int M, int N, int G_, int c_) { nM = M / BM; nN = N / BM; nwg = nM * nN; G = G_; c = c_; }
    __device__ bool next(int i, Unit& u) const {
        const long L = (long)i * G + c; if (L >= nwg) return false;
        int wgid = (int)L; { const int q = nwg / NXCD, r = nwg % NXCD, xcd = wgid % NXCD, off = wgid / NXCD; wgid = (xcd < r ? xcd * (q + 1) : r * (q + 1) + (xcd - r) * q) + off; }
        const int nig = WGM * nN, gid = wgid / nig, fm = gid * WGM, gsz = (nM - fm) < WGM ? (nM - fm) : WGM;
        u.pm = fm + ((wgid % nig) % gsz); u.pn = (wgid % nig) / gsz; u.e = 0; u.lr0 = 0; return true;
    }
};

template <class Epi, class Sched, bool ALIGN_EPI>
__device__ __forceinline__ void gemm_phase(LAS unsigned char* lds, const int K, const int ldb, const Sched& S, const Epi& E) {
    const int tid = threadIdx.x, wid = __builtin_amdgcn_readfirstlane(tid >> 6), lane = tid & 63, wr = wid >> 2, wc = wid & 3, fr = lane & 15, fq = lane >> 4;
    const int nt = K / BK;
    int Rr[2], Cc[2]; unsigned voffB[2];
#pragma unroll
    for (int i = 0; i < 2; ++i) { stage_rc(tid * 16 + i * 8192, Rr[i], Cc[i]); voffB[i] = (unsigned)(Rr[i] * ldb + Cc[i]) * 2u; }
    const size_t kstep = (size_t)(BK * 2);
    const size_t hstepB = (size_t)HALF * ldb * 2;
    const unsigned ldsw = (unsigned)wid * 1024u;
    const int aoff = lds_byte(wr * 64 + fr, fq * 8), boff = lds_byte(wc * 32 + fr, fq * 8);
#define PG8_SA(b, h) (((b) * 2 + (h)) * HTB)
#define PG8_SB(b, h) ((4 + (b) * 2 + (h)) * HTB)
#define PG8_STAGE(bufoff, gbase, voff) do { _Pragma("unroll") for (int _i = 0; _i < 2; ++_i) \
        __builtin_amdgcn_global_load_lds((const unsigned*)((const char*)(gbase) + (voff)[_i]), (LAS unsigned*)(lds + (bufoff) + ldsw + _i * 8192), 16, 0, 0); } while (0)
#define PG8_LDA(dst, b, h) do { _Pragma("unroll") for (int m = 0; m < 4; ++m) _Pragma("unroll") for (int k = 0; k < 2; ++k) dst[m][k] = *(const LAS bf16x8*)(lds + PG8_SA(b, h) + aoff + m * 2048 + k * 1024); } while (0)
#define PG8_LDB(dst, b, h) do { _Pragma("unroll") for (int n = 0; n < 2; ++n) _Pragma("unroll") for (int k = 0; k < 2; ++k) dst[n][k] = *(const LAS bf16x8*)(lds + PG8_SB(b, h) + boff + n * 2048 + k * 1024); } while (0)
#define PG8_MMA(ai, bj, At, Bt) do { __builtin_amdgcn_s_setprio(1); _Pragma("unroll") for (int m = 0; m < 4; ++m) _Pragma("unroll") for (int n = 0; n < 2; ++n) _Pragma("unroll") for (int k = 0; k < 2; ++k) \
        acc[ai][bj][m][n] = __builtin_amdgcn_mfma_f32_16x16x32_bf16(Bt[n][k], At[m][k], acc[ai][bj][m][n], 0, 0, 0); __builtin_amdgcn_s_setprio(0); } while (0)
#define PG8_WAIT_V(n) asm volatile("s_waitcnt vmcnt(" #n ")" ::: "memory")
#define PG8_WAIT_L(n) asm volatile("s_waitcnt lgkmcnt(" #n ")" ::: "memory")
#define PG8_BAR __builtin_amdgcn_s_barrier()
#define PG8_SCHED __builtin_amdgcn_sched_barrier(0)
    Unit cur, nxt; int ui = 0;
    if (!S.next(0, cur)) return;
    f32x4 acc[2][2][4][2];
#pragma unroll
    for (int a = 0; a < 2; ++a)
#pragma unroll
        for (int b = 0; b < 2; ++b)
#pragma unroll
            for (int m = 0; m < 4; ++m)
#pragma unroll
                for (int n = 0; n < 2; ++n) acc[a][b][m][n] = (f32x4){0.f, 0.f, 0.f, 0.f};
    bf16x8 At[4][2], B0[2][2], B1[2][2];
    const char* cA = S.a_base(cur); const char* cB = S.b_base(cur);
    unsigned vAc[2][2], vAn[2][2], v2[2][2];
    S.a_offs(cur, Rr, Cc, vAc);
    PG8_STAGE(PG8_SB(0, 0), cB, voffB); PG8_STAGE(PG8_SB(0, 1), cB + hstepB, voffB); PG8_STAGE(PG8_SA(0, 0), cA, vAc[0]); PG8_STAGE(PG8_SA(0, 1), cA, vAc[1]);
    if (wr == 1) PG8_BAR;
    PG8_WAIT_V(2); PG8_BAR;
    PG8_STAGE(PG8_SB(1, 0), cB + kstep, voffB); PG8_STAGE(PG8_SA(1, 0), cA + kstep, vAc[0]); PG8_STAGE(PG8_SB(1, 1), cB + hstepB + kstep, voffB);
    PG8_WAIT_V(6); PG8_BAR;
    for (;;) {
        const bool has_next = S.next(ui + 1, nxt);
        const char* nA = has_next ? S.a_base(nxt) : cA; const char* nB = has_next ? S.b_base(nxt) : cB;
        if (has_next) S.a_offs(nxt, Rr, Cc, vAn);
        else {
#pragma unroll
            for (int h = 0; h < 2; ++h)
#pragma unroll
                for (int i = 0; i < 2; ++i) vAn[h][i] = vAc[h][i]; }
#pragma unroll 1
        for (int t = 0; t < nt; t += 2) {
            const bool last = (t == nt - 2);
            const char* a1 = cA + (size_t)(t + 1) * kstep;
            const char* a2 = last ? nA : cA + (size_t)(t + 2) * kstep; const char* b2 = last ? nB : cB + (size_t)(t + 2) * kstep;
            const char* a3 = a2 + kstep; const char* b3 = b2 + kstep;
#pragma unroll
            for (int h = 0; h < 2; ++h)
#pragma unroll
                for (int i = 0; i < 2; ++i) v2[h][i] = last ? vAn[h][i] : vAc[h][i];
            PG8_LDB(B0, 0, 0); PG8_LDB(B1, 0, 1); PG8_SCHED; PG8_LDA(At, 0, 0); PG8_STAGE(PG8_SA(1, 1), a1, vAc[1]);
            PG8_WAIT_V(8); PG8_WAIT_L(0); PG8_BAR; PG8_MMA(0, 0, At, B0); PG8_MMA(0, 1, At, B1); PG8_BAR; PG8_SCHED;
            PG8_LDA(At, 0, 1); PG8_STAGE(PG8_SB(0, 0), b2, voffB); PG8_STAGE(PG8_SB(0, 1), b2 + hstepB, voffB); PG8_STAGE(PG8_SA(0, 0), a2, v2[0]);
            PG8_WAIT_V(8); PG8_WAIT_L(0); PG8_BAR; PG8_MMA(1, 0, At, B0); PG8_MMA(1, 1, At, B1); PG8_BAR; PG8_SCHED;
            PG8_LDB(B0, 1, 0); PG8_LDB(B1, 1, 1); PG8_SCHED; PG8_LDA(At, 1, 0); PG8_STAGE(PG8_SA(0, 1), a2, v2[1]);
            PG8_WAIT_V(8); PG8_WAIT_L(0); PG8_BAR; PG8_MMA(0, 0, At, B0); PG8_MMA(0, 1, At, B1); PG8_BAR; PG8_SCHED;
            PG8_LDA(At, 1, 1); PG8_STAGE(PG8_SB(1, 0), b3, voffB); PG8_STAGE(PG8_SB(1, 1), b3 + hstepB, voffB); PG8_STAGE(PG8_SA(1, 0), a3, v2[0]);
            PG8_WAIT_V(8); PG8_WAIT_L(0); PG8_BAR; PG8_MMA(1, 0, At, B0); PG8_MMA(1, 1, At, B1); PG8_BAR; PG8_SCHED;
        }
        if constexpr (ALIGN_EPI) { if (wr == 0) PG8_BAR; }
        E(acc, cur, wr, wc, fr, fq);
        if (!has_next) break;
#pragma unroll
        for (int a = 0; a < 2; ++a)
#pragma unroll
            for (int b = 0; b < 2; ++b)
#pragma unroll
                for (int m = 0; m < 4; ++m)
#pragma unroll
                    for (int n = 0; n < 2; ++n) acc[a][b][m][n] = (f32x4){0.f, 0.f, 0.f, 0.f};
        cur = nxt; cA = nA; cB = nB; ++ui;
#pragma unroll
        for (int h = 0; h < 2; ++h)
#pragma unroll
            for (int i = 0; i < 2; ++i) vAc[h][i] = vAn[h][i];
        if constexpr (ALIGN_EPI) { if (wr == 1) PG8_BAR; }
    }
    PG8_WAIT_V(0);
    if constexpr (!ALIGN_EPI) { if (wr == 0) PG8_BAR; }
    PG8_BAR;
#undef PG8_SA
#undef PG8_SB
#undef PG8_STAGE
#undef PG8_LDA
#undef PG8_LDB
#undef PG8_MMA
#undef PG8_WAIT_V
#undef PG8_WAIT_L
#undef PG8_BAR
#undef PG8_SCHED
}
}
using pg8::Unit;

struct PlainSched {
    pg8::StaticOrder so; const bf16* A; const bf16* Bt; int lda, ldb; int acol_pn, acol_off;
    __device__ __forceinline__ bool next(int i, Unit& u) const { return so.next(i, u); }
    __device__ __forceinline__ const char* a_base(const Unit& u) const { return (const char*)(A + (size_t)u.pm * 256 * lda + (u.pn >= acol_pn ? acol_off : 0)); }
    __device__ __forceinline__ const char* b_base(const Unit& u) const { return (const char*)(Bt + (size_t)u.pn * 256 * ldb); }
    __device__ __forceinline__ void a_offs(const Unit&, const int (&R)[2], const int (&C)[2], unsigned (&v)[2][2]) const {
#pragma unroll
        for (int h = 0; h < 2; ++h)
#pragma unroll
            for (int i = 0; i < 2; ++i) v[h][i] = (unsigned)((h * 128 + R[i]) * lda + C[i]) * 2u; }
};
struct MoeSched {
    int G, c, NT, npanels; const LAS int* pst; const LAS int* cnt; const int* toks; const bf16* A; const bf16* Bt; int lda, ldb; size_t bstride; bool gather;
    __device__ __forceinline__ bool next(int i, Unit& u) const {
        const int L = i * G + c; if (L >= npanels * NT) return false;
        u.pm = L / NT; u.pn = L % NT; int e = 0;
#pragma unroll 1
        for (int q = 1; q < NE; ++q) e = (pst[q] <= u.pm) ? q : e;
        u.e = e; u.lr0 = (u.pm - pst[e]) * 256; return true; }
    __device__ __forceinline__ const char* a_base(const Unit& u) const { return gather ? (const char*)A : (const char*)(A + (size_t)u.pm * 256 * lda); }
    __device__ __forceinline__ const char* b_base(const Unit& u) const { return (const char*)(Bt + (size_t)u.e * bstride + (size_t)u.pn * 256 * ldb); }
    __device__ __forceinline__ void a_offs(const Unit& u, const int (&R)[2], const int (&C)[2], unsigned (&v)[2][2]) const {
        const int ce = cnt[u.e];
#pragma unroll
        for (int h = 0; h < 2; ++h)
#pragma unroll
            for (int i = 0; i < 2; ++i) {
                if (gather) { const int lrow = u.lr0 + h * 128 + R[i]; const int tok = lrow < ce ? toks[u.e * CAP + lrow] : 0; v[h][i] = (unsigned)(tok * lda + C[i]) * 2u; }
                else v[h][i] = (unsigned)((h * 128 + R[i]) * lda + C[i]) * 2u; } }
};

__device__ __forceinline__ void st4(bf16* p, f32x4 v) { u32x2 o; o.x = pk2(v.x, v.y); o.y = pk2(v.z, v.w); *(u32x2*)p = o; }
__device__ __forceinline__ float sq4(f32x4 v) { return (v.x * v.x + v.y * v.y) + (v.z * v.z + v.w * v.w); }

struct EpiInProj {
    unsigned char* ws;
    __device__ __forceinline__ void operator()(const f32x4 (&acc)[2][2][4][2], const Unit& u, int wr, int wc, int fr, int fq) const {
        const float* rs0 = (const float*)(ws + WS_RS0);
        const int reg = u.pn >> 1;
        bf16* dst = (bf16*)(ws + (reg == 0 ? WS_QA : reg == 1 ? WS_KA : reg == 2 ? WS_VA : WS_LAT));
        const float qs = (reg == 0) ? QS_A : 1.f;
#pragma unroll
        for (int ai = 0; ai < 2; ++ai)
#pragma unroll
            for (int m = 0; m < 4; ++m) {
                const int row = u.pm * 256 + ai * 128 + wr * 64 + m * 16 + fr;
                const float rs = rs0[row]; const float sc = rs * qs;
                float ssq = 0.f;
#pragma unroll
                for (int bj = 0; bj < 2; ++bj)
#pragma unroll
                    for (int n = 0; n < 2; ++n) {
                        const int lc = (u.pn & 1) * 256 + bj * 128 + wc * 32 + n * 16 + fq * 4;
                        const f32x4 v = acc[ai][bj][m][n] * sc;
                        st4(dst + (size_t)row * 512 + lc, v);
                        if (u.pn == 6 || (u.pn == 7 && bj == 0)) ssq += sq4(v);
                    }
                if (u.pn >= 6) {
                    ssq += __shfl_xor(ssq, 16); ssq += __shfl_xor(ssq, 32);
                    if (fq == 0) atomicAdd((float*)(ws + (u.pn == 6 ? CTL_SSQQ : CTL_SSQKV)) + row, ssq);
                    if (u.pn == 7 && wc == 0) {
                        const f32x4 x1 = acc[ai][1][m][0] * rs, x2 = acc[ai][1][m][1] * rs;
                        const float2* cs = (const float2*)(ws + WS_ROPE) + (row & (SEQ - 1)) * 16 + fq * 4;
                        f32x4 y1, y2;
#pragma unroll
                        for (int j = 0; j < 4; ++j) { const float2 c = cs[j]; y1[j] = x1[j] * c.x - x2[j] * c.y; y2[j] = x1[j] * c.y + x2[j] * c.x; }
                        bf16* kr = (bf16*)(ws + WS_KR) + (size_t)row * 32 + fq * 4;
                        st4(kr, y1); st4(kr + 16, y2);
                    }
                }
            }
    }
};
struct EpiUps {
    unsigned char* ws;
    __device__ __forceinline__ void operator()(const f32x4 (&acc)[2][2][4][2], const Unit& u, int wr, int wc, int fr, int fq) const {
        const bool isq = u.pn < 3;
        const float* ssq = (const float*)(ws + (isq ? CTL_SSQQ : CTL_SSQKV));
#pragma unroll
        for (int ai = 0; ai < 2; ++ai)
#pragma unroll
            for (int m = 0; m < 4; ++m) {
                const int row = u.pm * 256 + ai * 128 + wr * 64 + m * 16 + fr;
                const float rs = rsqrtf(ssq[row] * (isq ? (1.f / 256.f) : (1.f / 128.f)) + EPS) * (isq ? QS_B : 1.f);
#pragma unroll
                for (int bj = 0; bj < 2; ++bj) {
                    if (isq) {
                        const int cg = u.pn * 8 + bj * 4 + wc;
                        bf16* q = (bf16*)(ws + WS_QB) + (size_t)row * 768 + cg * 32 + fq * 4;
                        f32x4 a = acc[ai][bj][m][0] * rs, b = acc[ai][bj][m][1] * rs;
                        if (cg % 3 == 2) {
                            const float2* cs = (const float2*)(ws + WS_ROPE) + (row & (SEQ - 1)) * 16 + fq * 4;
                            f32x4 y1, y2;
#pragma unroll
                            for (int j = 0; j < 4; ++j) { const float2 c = cs[j]; y1[j] = a[j] * c.x - b[j] * c.y; y2[j] = a[j] * c.y + b[j] * c.x; }
                            a = y1; b = y2;
                        }
                        st4(q, a); st4(q + 16, b);
                    } else {
                        const int head = (u.pn - 3) * 2 + bj;
                        bf16* dst = (bf16*)(ws + (wc < 2 ? WS_KB : WS_VB)) + (size_t)row * 512 + head * 64 + (wc & 1) * 32 + fq * 4;
                        st4(dst, acc[ai][bj][m][0] * rs); st4(dst + 16, acc[ai][bj][m][1] * rs);
                    }
                }
            }
    }
};
struct EpiOut {
    unsigned char* ws;
    __device__ __forceinline__ void operator()(const f32x4 (&acc)[2][2][4][2], const Unit& u, int wr, int wc, int fr, int fq) const {
        const bf16* xb = (const bf16*)(ws + WS_XB); bf16* x1 = (bf16*)(ws + WS_X1);
#pragma unroll
        for (int ai = 0; ai < 2; ++ai)
#pragma unroll
            for (int m = 0; m < 4; ++m) {
                const int row = u.pm * 256 + ai * 128 + wr * 64 + m * 16 + fr; float ssq = 0.f;
#pragma unroll
                for (int bj = 0; bj < 2; ++bj)
#pragma unroll
                    for (int n = 0; n < 2; ++n) {
                        const size_t o = (size_t)row * 1024 + u.pn * 256 + bj * 128 + wc * 32 + n * 16 + fq * 4;
                        const u32x2 xv = *(const u32x2*)(xb + o);
                        f32x4 v = acc[ai][bj][m][n];
                        v.x += __uint_as_float(xv.x << 16); v.y += __uint_as_float(xv.x & 0xffff0000u); v.z += __uint_as_float(xv.y << 16); v.w += __uint_as_float(xv.y & 0xffff0000u);
                        st4(x1 + o, v); ssq += sq4(v);
                    }
                ssq += __shfl_xor(ssq, 16); ssq += __shfl_xor(ssq, 32);
                if (fq == 0) atomicAdd((float*)(ws + CTL_SSQ1) + row, ssq);
            }
    }
};
struct EpiGateUp {
    unsigned char* ws; const LAS int* cnt;
    __device__ __forceinline__ void operator()(const f32x4 (&acc)[2][2][4][2], const Unit& u, int wr, int wc, int fr, int fq) const {
        const int ce = cnt[u.e]; const int* toks = (const int*)(ws + WS_TOK) + u.e * CAP; const float* ssq1 = (const float*)(ws + CTL_SSQ1);
#pragma unroll
        for (int ai = 0; ai < 2; ++ai)
#pragma unroll
            for (int m = 0; m < 4; ++m) {
                const int lr = ai * 128 + wr * 64 + m * 16 + fr; const int lrow = u.lr0 + lr;
                const int tok = lrow < ce ? toks[lrow] : 0;
                const float rs = rsqrtf(ssq1[tok] * (1.f / D) + EPS);
                bf16* dst = (bf16*)(ws + WS_HB) + (size_t)(u.pm * 256 + lr) * 256 + u.pn * 128 + wc * 32 + fq * 4;
#pragma unroll
                for (int n = 0; n < 2; ++n) { const f32x4 g = acc[ai][0][m][n] * rs, up = acc[ai][1][m][n] * rs; f32x4 h;
#pragma unroll
                    for (int j = 0; j < 4; ++j) h[j] = g[j] / (1.f + __expf(-g[j])) * up[j];
                    st4(dst + n * 16, h); }
            }
    }
};
struct EpiDown {
    unsigned char* ws; const LAS int* cnt;
    __device__ __forceinline__ void operator()(const f32x4 (&acc)[2][2][4][2], const Unit& u, int wr, int wc, int fr, int fq) const {
        const int ce = cnt[u.e]; const float* gates = (const float*)(ws + WS_GATE) + u.e * CAP;
#pragma unroll
        for (int ai = 0; ai < 2; ++ai)
#pragma unroll
            for (int m = 0; m < 4; ++m) {
                const int lr = ai * 128 + wr * 64 + m * 16 + fr; const int lrow = u.lr0 + lr;
                const float gt = lrow < ce ? gates[lrow] : 0.f;
                bf16* dst = (bf16*)(ws + WS_YB) + (size_t)(u.pm * 256 + lr) * 1024 + u.pn * 256 + wc * 32 + fq * 4;
#pragma unroll
                for (int bj = 0; bj < 2; ++bj)
#pragma unroll
                    for (int n = 0; n < 2; ++n) st4(dst + bj * 128 + n * 16, acc[ai][bj][m][n] * gt);
            }
    }
};

struct Args { const float* in[20]; float* out; unsigned char* ws; int ph_lo, ph_hi; };
struct Frame { LAS unsigned char* lds; int tid, lane, wave, vcu, G; const float* const* in; float* out; unsigned char* ws; };

__device__ __forceinline__ void transpose_item(const float* W, int ldw, const float* gain, bf16* WT, int ldwt, int k0, int n0, int dstrow0, LAS float* scr, int lane) {
#pragma unroll 8
    for (int i = 0; i < 32; ++i) { const int kk = 2 * i + (lane >> 5); float v = W[(size_t)(k0 + kk) * ldw + n0 + (lane & 31)]; if (gain) v *= gain[k0 + kk]; scr[kk * 33 + (lane & 31)] = v; }
    LDS_WAIT();
    const int c = lane & 7;
#pragma unroll
    for (int j = 0; j < 4; ++j) { const int n = (lane >> 3) + 8 * j; const LAS float* s = scr + (8 * c) * 33 + n;
        u32x4 o; o.x = pk2(s[0 * 33], s[1 * 33]); o.y = pk2(s[2 * 33], s[3 * 33]); o.z = pk2(s[4 * 33], s[5 * 33]); o.w = pk2(s[6 * 33], s[7 * 33]);
        *(u32x4*)(WT + (size_t)(dstrow0 + n) * ldwt + k0 + 8 * c) = o; }
    LDS_WAIT();
}

__device__ __forceinline__ void p_prologue(const Frame& F) {
    unsigned char* ws = F.ws; const int lane = F.lane;
    LAS float* scr = (LAS float*)(F.lds + F.wave * 16384);
    const int gw = F.vcu * NWAVES + F.wave, NGW = F.G * NWAVES;
    constexpr int I_IN = 16 * 61, I_Q = 4 * 24, I_KV = 2 * 32, I_O = 16 * 32, I_G = 16 * 8, I_D = 4 * 32;
    constexpr int NITEMS = I_IN + I_Q + I_KV + I_O + 64 * I_G + 32 * I_D;
    for (int it = gw; it < NITEMS; it += NGW) {
        int r = it;
        if (r < I_IN) { const int kb = r / 61, nb = r % 61; transpose_item(F.in[2], NIN, F.in[1], (bf16*)(ws + WS_WI), 1024, kb * 64, nb * 32, nb * 32, scr, lane); continue; } r -= I_IN;
        if (r < I_Q) { const int kb = r / 24, nb = r % 24; transpose_item(F.in[5], 768, F.in[4], (bf16*)(ws + WS_WQKV), 256, kb * 64, nb * 32, nb * 32, scr, lane); continue; } r -= I_Q;
        if (r < I_KV) { const int kb = r / 32, nb = r % 32; transpose_item(F.in[7], 1024, F.in[6], (bf16*)(ws + WS_WQKV), 256, kb * 64, nb * 32, 768 + nb * 32, scr, lane); continue; } r -= I_KV;
        if (r < I_O) { const int kb = r / 32, nb = r % 32; transpose_item(F.in[10], 1024, nullptr, (bf16*)(ws + WS_WO), 1024, kb * 64, nb * 32, nb * 32, scr, lane); continue; } r -= I_O;
        if (r < 64 * I_G) { const int mtx = r / I_G, q = r % I_G, e = mtx >> 1, kind = mtx & 1, kb = q / 8, nb = q % 8;
            const float* W = (kind ? F.in[17] : F.in[16]) + (size_t)e * 1024 * 256; const int n0 = nb * 32;
            transpose_item(W, 256, F.in[11], (bf16*)(ws + WS_WGU) + (size_t)e * 512 * 1024, 1024, kb * 64, n0, 256 * (n0 >> 7) + kind * 128 + (n0 & 127), scr, lane); continue; } r -= 64 * I_G;
        { const int e = r / I_D, q = r % I_D, kb = q / 32, nb = q % 32;
            transpose_item(F.in[18] + (size_t)e * 256 * 1024, 1024, nullptr, (bf16*)(ws + WS_WD) + (size_t)e * 1024 * 256, 256, kb * 64, nb * 32, nb * 32, scr, lane); }
    }
    const size_t gt = (size_t)F.vcu * 512 + F.tid, NGT = (size_t)F.G * 512;
    for (size_t i = gt; i < (size_t)96 * 1024 / 8; i += NGT) ((u32x4*)((bf16*)(ws + WS_WI) + (size_t)1952 * 1024))[i] = (u32x4){0, 0, 0, 0};
    for (size_t i = gt; i < (size_t)1024 * 16; i += NGT) { const size_t row = i >> 4, c = i & 15; *(u32x4*)((bf16*)(ws + WS_WQKV) + (768 + row) * 256 + 128 + c * 8) = (u32x4){0, 0, 0, 0}; }
    for (int m = gw; m < T; m += NGW) {
        const f32x4* xr = (const f32x4*)(F.in[0] + (size_t)m * D) + lane; f32x4 v[4]; float s = 0.f;
#pragma unroll
        for (int j = 0; j < 4; ++j) { v[j] = xr[64 * j]; s += sq4(v[j]); }
        s = wave_sum(s);
        u32x2* o8 = (u32x2*)((bf16*)(ws + WS_XB) + (size_t)m * D) + lane;
#pragma unroll
        for (int j = 0; j < 4; ++j) { u32x2 o; o.x = pk2(v[j].x, v[j].y); o.y = pk2(v[j].z, v[j].w); o8[64 * j] = o; }
        if (lane == 0) ((float*)(ws + WS_RS0))[m] = rsqrtf(s * (1.f / D) + EPS);
    }
    for (size_t i = gt; i < (size_t)SEQ * 16; i += NGT) { const int s = (int)(i >> 4), f = (int)(i & 15);
        const float inv = (float)pow(10000.0, -(double)f / 16.0); const float ang = (float)s * inv;
        float2 cs; cs.x = (float)cos((double)ang); cs.y = (float)sin((double)ang); ((float2*)(ws + WS_ROPE))[i] = cs; }
    for (size_t i = gt; i < (size_t)3 * 8 * 132; i += NGT) { const int p = (int)(i / (8 * 132)), h = (int)((i / 132) % 8), jj = (int)(i % 132);
        float val = 0.f;
        if (jj <= 128) { const int dil = (p == 0) ? 1 : (p == 1) ? 4 : 16; const int rel = (jj - 64) * dil; const int n = rel < 0 ? -rel : rel;
            int large = 8 + (int)(log((double)(n > 1 ? n : 1) / 8.0) / log(128.0) * 8.0); if (large > 15) large = 15;
            const int bucket = (rel > 0 ? 16 : 0) + (n < 8 ? n : large);
            val = F.in[3][bucket * 8 + h] * LOG2E; }
        ((float*)(ws + WS_BT))[i] = val; }
}

__device__ __forceinline__ void p_attnA_naive(const Frame& F, bf16* OA, float* LSE) {
    unsigned char* ws = F.ws;
    const bf16* QA = (const bf16*)(ws + WS_QA); const bf16* KA = (const bf16*)(ws + WS_KA); const bf16* VA = (const bf16*)(ws + WS_VA);
    const float* BT = (const float*)(ws + WS_BT);
    for (int idx = F.vcu * 512 + F.tid; idx < T * 8; idx += F.G * 512) {
        const int s = idx & (SEQ - 1), h = (idx >> 11) & 7, b = idx >> 14;
        float q[64], o[64];
        const size_t t = (size_t)b * SEQ + s;
#pragma unroll
        for (int i = 0; i < 64; ++i) { q[i] = bf2f(QA[t * 512 + h * 64 + i]); o[i] = 0.f; }
        float m = -1e30f, l = 0.f;
        for (int p = 0; p < 3; ++p) { const int dil = (p == 0) ? 1 : (p == 1) ? 4 : 16;
            for (int j = -64; j <= 64; ++j) { const int pos = s + j * dil; if (pos < 0 || pos >= SEQ) continue;
                const bf16* kp = KA + ((size_t)b * SEQ + pos) * 512 + h * 64; const bf16* vp = VA + ((size_t)b * SEQ + pos) * 512 + h * 64;
                float sc = BT[(p * 8 + h) * 132 + j + 64];
#pragma unroll
                for (int i = 0; i < 64; ++i) sc += q[i] * bf2f(kp[i]);
                const float mn = fmaxf(m, sc), al = exp2f(m - mn), pe = exp2f(sc - mn);
                l = l * al + pe; m = mn;
#pragma unroll
                for (int i = 0; i < 64; ++i) o[i] = o[i] * al + pe * bf2f(vp[i]);
            } }
        const float il = 1.f / l;
#pragma unroll
        for (int i = 0; i < 64; ++i) OA[t * 512 + h * 64 + i] = f2bf(o[i] * il);
        LSE[t * 8 + h] = m + log2f(l);
    }
}
__device__ __forceinline__ void p_attnB_naive(const Frame& F) {
    unsigned char* ws = F.ws;
    const bf16* QB = (const bf16*)(ws + WS_QB); const bf16* KB = (const bf16*)(ws + WS_KB); const bf16* VB = (const bf16*)(ws + WS_VB); const bf16* KR = (const bf16*)(ws + WS_KR);
    for (int idx = F.vcu * 512 + F.tid; idx < T * 8; idx += F.G * 512) {
        const int s = idx & (SEQ - 1), h = (idx >> 11) & 7, b = idx >> 14;
        float q[96], o[64];
        const size_t t = (size_t)b * SEQ + s;
#pragma unroll
        for (int i = 0; i < 96; ++i) q[i] = bf2f(QB[t * 768 + h * 96 + i]);
#pragma unroll
        for (int i = 0; i < 64; ++i) o[i] = 0.f;
        float m = -1e30f, l = 0.f;
        for (int key = 0; key < SEQ; ++key) { const size_t tk = (size_t)b * SEQ + key;
            const bf16* kp = KB + tk * 512 + h * 64; const bf16* rp = KR + tk * 32; const bf16* vp = VB + tk * 512 + h * 64;
            float sc = 0.f;
#pragma unroll
            for (int i = 0; i < 64; ++i) sc += q[i] * bf2f(kp[i]);
#pragma unroll
            for (int i = 0; i < 32; ++i) sc += q[64 + i] * bf2f(rp[i]);
            const float mn = fmaxf(m, sc), al = exp2f(m - mn), pe = exp2f(sc - mn);
            l = l * al + pe; m = mn;
#pragma unroll
            for (int i = 0; i < 64; ++i) o[i] = o[i] * al + pe * bf2f(vp[i]);
        }
        const float il = 1.f / l;
#pragma unroll
        for (int i = 0; i < 64; ++i) ((bf16*)(ws + WS_OB))[t * 512 + h * 64 + i] = f2bf(o[i] * il);
    }
}

typedef float f32x16 __attribute__((ext_vector_type(16)));
typedef short s16x4 __attribute__((ext_vector_type(4)));
typedef short v4i16_t __attribute__((ext_vector_type(4)));
typedef float f32x2_t __attribute__((ext_vector_type(2))); typedef __bf16 bf16x2_t __attribute__((ext_vector_type(2)));
__device__ __forceinline__ unsigned cvtpk(float lo, float hi) { f32x2_t v = {lo, hi}; bf16x2_t b = __builtin_convertvector(v, bf16x2_t); return __builtin_bit_cast(unsigned, b); }
__device__ __forceinline__ s16x4 vtr(const LAS unsigned char* p) { return __builtin_bit_cast(s16x4, __builtin_amdgcn_ds_read_tr16_b64_v4i16((LAS v4i16_t*)p)); }
__device__ __forceinline__ int crow(int r, int hi) { return (r & 3) + 8 * (r >> 2) + 4 * hi; }
#define ATT_WAIT_BAR() asm volatile("s_waitcnt vmcnt(0) lgkmcnt(0)\n\ts_barrier" ::: "memory")
#define GLDS16(src, dst) __builtin_amdgcn_global_load_lds((const unsigned*)(src), (LAS unsigned*)(dst), 16, 0, 0)

template <int NS>
__device__ __forceinline__ void sm_update(f32x16 (&p)[NS], float& m, float& l, f32x16& o0, f32x16& o1, bf16x8 (&pf)[2 * NS]) {
    float mx = p[0][0];
#pragma unroll
    for (int s = 0; s < NS; ++s)
#pragma unroll
        for (int r = 0; r < 16; ++r) mx = fmaxf(mx, p[s][r]);
    { auto rr = __builtin_amdgcn_permlane32_swap(__float_as_uint(mx), __float_as_uint(mx), false, false); mx = fmaxf(__uint_as_float(rr[0]), __uint_as_float(rr[1])); }
    const float mn = fmaxf(m, mx); const float al = __builtin_amdgcn_exp2f(m - mn); m = mn;
    float sum = 0.f;
#pragma unroll
    for (int s = 0; s < NS; ++s)
#pragma unroll
        for (int r = 0; r < 16; ++r) { p[s][r] = __builtin_amdgcn_exp2f(p[s][r] - mn); sum += p[s][r]; }
    l = l * al + sum;
#pragma unroll
    for (int r = 0; r < 16; ++r) { o0[r] *= al; o1[r] *= al; }
#pragma unroll
    for (int s = 0; s < NS; ++s)
#pragma unroll
        for (int k = 0; k < 2; ++k) { u32x4 w; w.x = cvtpk(p[s][8 * k + 0], p[s][8 * k + 1]); w.y = cvtpk(p[s][8 * k + 2], p[s][8 * k + 3]); w.z = cvtpk(p[s][8 * k + 4], p[s][8 * k + 5]); w.w = cvtpk(p[s][8 * k + 6], p[s][8 * k + 7]);
            pf[2 * s + k] = __builtin_bit_cast(bf16x8, w); }
}
__device__ __forceinline__ void pv_step(f32x16& o0, f32x16& o1, const LAS unsigned char* vp, int dstride, bf16x8 pfk) {
    const s16x4 a0 = vtr(vp), a1 = vtr(vp + 512), b0 = vtr(vp + dstride), b1 = vtr(vp + dstride + 512);
    const bf16x8 v0 = (bf16x8){a0[0], a0[1], a0[2], a0[3], a1[0], a1[1], a1[2], a1[3]};
    const bf16x8 v1 = (bf16x8){b0[0], b0[1], b0[2], b0[3], b1[0], b1[1], b1[2], b1[3]};
    o0 = __builtin_amdgcn_mfma_f32_32x32x16_bf16(v0, pfk, o0, 0, 0, 0);
    o1 = __builtin_amdgcn_mfma_f32_32x32x16_bf16(v1, pfk, o1, 0, 0, 0);
}
__device__ __forceinline__ void store_o(bf16* orow, const f32x16& o0, const f32x16& o1, float il, int hi) {
#pragma unroll
    for (int g = 0; g < 4; ++g) {
        u32x2 w0, w1; w0.x = cvtpk(o0[4 * g] * il, o0[4 * g + 1] * il); w0.y = cvtpk(o0[4 * g + 2] * il, o0[4 * g + 3] * il);
        w1.x = cvtpk(o1[4 * g] * il, o1[4 * g + 1] * il); w1.y = cvtpk(o1[4 * g + 2] * il, o1[4 * g + 3] * il);
        *(u32x2*)(orow + 8 * g + 4 * hi) = w0; *(u32x2*)(orow + 32 + 8 * g + 4 * hi) = w1; }
}

constexpr int B_KBUF = 12288, B_VBUF = 8192, B_VOFF = 2 * B_KBUF;
__device__ __forceinline__ void attnB_unit(const Frame& F, int b, int head, int qb) {
    unsigned char* ws = F.ws; LAS unsigned char* lds = F.lds;
    const int lane = F.lane, wave = F.wave, r32 = lane & 31, hi = lane >> 5;
    const bf16* QB = (const bf16*)(ws + WS_QB); const bf16* KB = (const bf16*)(ws + WS_KB); const bf16* VB = (const bf16*)(ws + WS_VB); const bf16* KR = (const bf16*)(ws + WS_KR);
    const size_t t0 = (size_t)b * SEQ;
    const size_t tq = t0 + qb * 256 + wave * 32 + r32;
    bf16x8 qf[6];
#pragma unroll
    for (int ks = 0; ks < 6; ++ks) qf[ks] = *(const bf16x8*)(QB + tq * 768 + head * 96 + ks * 16 + hi * 8);
    const bf16* ksrc = KB + (t0 + lane) * 512 + head * 64 + wave * 8;
    const bf16* rsrc = KR + (t0 + lane) * 32 + (wave & 3) * 8;
    const bf16* vsrc = VB + (t0 + 16 * (wave & 3) + (lane >> 2)) * 512 + head * 64 + (wave >> 2) * 32 + (lane & 3) * 8;
#define B_ISSUE(kt, buf) do { GLDS16(ksrc + (size_t)(kt) * 64 * 512, lds + (buf) * B_KBUF + wave * 1024); \
        if (wave < 4) GLDS16(rsrc + (size_t)(kt) * 64 * 32, lds + (buf) * B_KBUF + (8 + wave) * 1024); \
        GLDS16(vsrc + (size_t)(kt) * 64 * 512, lds + B_VOFF + (buf) * B_VBUF + wave * 1024); } while (0)
    float m = -1e30f, l = 0.f; f32x16 o0, o1;
#pragma unroll
    for (int r = 0; r < 16; ++r) { o0[r] = 0.f; o1[r] = 0.f; }
    const int kfo = hi * 1024 + r32 * 16;
    const int vbo = ((lane >> 4) & 1) * 32 + (lane & 3) * 8 + (4 * hi + ((lane & 15) >> 2)) * 64;
    B_ISSUE(0, 0);
    for (int kt = 0; kt < SEQ / 64; ++kt) {
        const int buf = kt & 1;
        ATT_WAIT_BAR();
        if (kt + 1 < SEQ / 64) B_ISSUE(kt + 1, buf ^ 1);
        const LAS unsigned char* kb = lds + buf * B_KBUF + kfo; const LAS unsigned char* vb = lds + B_VOFF + buf * B_VBUF + vbo;
        f32x16 p[2];
#pragma unroll
        for (int r = 0; r < 16; ++r) { p[0][r] = 0.f; p[1][r] = 0.f; }
#pragma unroll
        for (int ks = 0; ks < 6; ++ks) {
            const bf16x8 k0 = *(const LAS bf16x8*)(kb + ks * 2048), k1 = *(const LAS bf16x8*)(kb + ks * 2048 + 512);
            p[0] = __builtin_amdgcn_mfma_f32_32x32x16_bf16(k0, qf[ks], p[0], 0, 0, 0);
            p[1] = __builtin_amdgcn_mfma_f32_32x32x16_bf16(k1, qf[ks], p[1], 0, 0, 0);
        }
        bf16x8 pf[4];
        sm_update<2>(p, m, l, o0, o1, pf);
#pragma unroll
        for (int s = 0; s < 4; ++s) pv_step(o0, o1, vb + s * 1024, 4096, pf[s]);
    }
#undef B_ISSUE
    { auto rr = __builtin_amdgcn_permlane32_swap(__float_as_uint(l), __float_as_uint(l), false, false); l = __uint_as_float(rr[0]) + __uint_as_float(rr[1]); }
    store_o((bf16*)(ws + WS_OB) + tq * 512 + head * 64, o0, o1, 1.f / l, hi);
}
__device__ __forceinline__ void p_attnB(const Frame& F) {
    for (int i = 0; i < 4; ++i) { const int u = F.vcu * 4 + i; if (u >= BATCH * 8 * 8) break; const int bh = u >> 3, qb = u & 7; attnB_unit(F, bh >> 3, bh & 7, qb); }
    ATT_WAIT_BAR();
}

constexpr int A_NSL = 384, A_VOFF = 8 * A_NSL * 16, A_TAB = A_VOFF + 2 * A_NSL * 64;
__device__ __forceinline__ void attnA_unit(const Frame& F, int b, int head, int pat, int g, bf16* OA, float* LSE) {
    unsigned char* ws = F.ws; LAS unsigned char* lds = F.lds;
    const int lane = F.lane, wave = F.wave, r32 = lane & 31, hi = lane >> 5;
    const bf16* QA = (const bf16*)(ws + WS_QA); const bf16* KA = (const bf16*)(ws + WS_KA); const bf16* VA = (const bf16*)(ws + WS_VA);
    const int dil = (pat == 0) ? 1 : (pat == 1) ? 4 : 16, L = SEQ / dil;
    const int nslots = (pat == 2) ? 256 : 384;
    const size_t t0 = (size_t)b * SEQ;
#define A_POS(s, pos) do { int kn_; if (pat == 2) { kn_ = (s) & 127; pos = 2 * g + ((s) >> 7) + 16 * kn_; } \
        else if (pat == 1) { kn_ = 256 * (g & 1) - 64 + (s); kn_ = kn_ < 0 ? 0 : (kn_ > 511 ? 511 : kn_); pos = (g >> 1) + 4 * kn_; } \
        else { kn_ = 256 * g - 64 + (s); kn_ = kn_ < 0 ? 0 : (kn_ > 2047 ? 2047 : kn_); pos = kn_; } } while (0)
    for (int kp = wave; kp < 8 * (nslots / 64); kp += 8) { const int sg = kp >> 3; int pos; A_POS(64 * sg + lane, pos);
        GLDS16(KA + (t0 + pos) * 512 + head * 64 + wave * 8, lds + wave * (A_NSL * 16) + sg * 1024); }
    { const int nvg = nslots / 16;
        for (int vp = wave; vp < 2 * nvg; vp += 8) { const int d0 = vp / nvg, vg = vp - d0 * nvg; int pos; A_POS(16 * vg + (lane >> 2), pos);
            GLDS16(VA + (t0 + pos) * 512 + head * 64 + d0 * 32 + (lane & 3) * 8, lds + A_VOFF + d0 * (A_NSL * 64) + vg * 1024); } }
#undef A_POS
    LAS float* tab = (LAS float*)(lds + A_TAB);
    if (F.tid < 192) { const int idx = F.tid - 32; tab[F.tid] = (idx >= 0 && idx <= 128) ? ((const float*)(ws + WS_BT))[(pat * 8 + head) * 132 + idx] : -INFINITY; }
    int c, n0, hb, wstart;
    if (pat == 2) { c = 2 * g + (wave >> 2); n0 = 32 * (wave & 3); hb = 128 * (wave >> 2); wstart = 0; }
    else if (pat == 1) { c = g >> 1; n0 = 256 * (g & 1) + 32 * wave; hb = 0; wstart = 256 * (g & 1) - 64; }
    else { c = 0; n0 = 256 * g + 32 * wave; hb = 0; wstart = 256 * g - 64; }
    const size_t tq = t0 + c + dil * (n0 + r32);
    bf16x8 qf[4];
#pragma unroll
    for (int ks = 0; ks < 4; ++ks) qf[ks] = *(const bf16x8*)(QA + tq * 512 + head * 64 + ks * 16 + hi * 8);
    float m = -1e30f, l = 0.f; f32x16 o0, o1;
#pragma unroll
    for (int r = 0; r < 16; ++r) { o0[r] = 0.f; o1[r] = 0.f; }
    const int vbo = ((lane >> 4) & 1) * 32 + (lane & 3) * 8 + (4 * hi + ((lane & 15) >> 2)) * 64;
    ATT_WAIT_BAR();
#pragma unroll 1
    for (int i = 0; i < 5; ++i) {
        const int kt0 = n0 - 64 + 32 * i; if (kt0 < 0 || kt0 >= L) continue;
        const int slot0 = hb + kt0 - wstart;
        const LAS unsigned char* kb = lds + hi * (A_NSL * 16) + (slot0 + r32) * 16;
        f32x16 p[1];
#pragma unroll
        for (int r = 0; r < 16; ++r) p[0][r] = 0.f;
#pragma unroll
        for (int ks = 0; ks < 4; ++ks) { const bf16x8 kf = *(const LAS bf16x8*)(kb + ks * 2 * (A_NSL * 16)); p[0] = __builtin_amdgcn_mfma_f32_32x32x16_bf16(kf, qf[ks], p[0], 0, 0, 0); }
        const LAS float* tb = tab + (32 * i + 32 + 4 * hi - r32);
#pragma unroll
        for (int r = 0; r < 16; ++r) p[0][r] += tb[(r & 3) + 8 * (r >> 2)];
        bf16x8 pf[2];
        sm_update<1>(p, m, l, o0, o1, pf);
        const LAS unsigned char* vb = lds + A_VOFF + slot0 * 64 + vbo;
#pragma unroll
        for (int s = 0; s < 2; ++s) pv_step(o0, o1, vb + s * 1024, A_NSL * 64, pf[s]);
    }
    { auto rr = __builtin_amdgcn_permlane32_swap(__float_as_uint(l), __float_as_uint(l), false, false); l = __uint_as_float(rr[0]) + __uint_as_float(rr[1]); }
    store_o(OA + ((size_t)pat * T + tq) * 512 + head * 64, o0, o1, 1.f / l, hi);
    if (hi == 0) LSE[((size_t)pat * T + tq) * 8 + head] = m + __builtin_amdgcn_logf(l);
    ATT_WAIT_BAR();
}
__device__ __forceinline__ void p_attnA(const Frame& F, bf16* OA, float* LSE) {
    const int bh = F.vcu >> 1;
    if (bh >= BATCH * 8) return;
    for (int k = 0; k < 12; ++k) { const int u = 2 * k + (F.vcu & 1); attnA_unit(F, bh >> 3, bh & 7, u >> 3, u & 7, OA, LSE); }
}

__device__ __forceinline__ void unpack8(u32x4 v, float (&a)[8]) {
    a[0] = __uint_as_float(v.x << 16); a[1] = __uint_as_float(v.x & 0xffff0000u); a[2] = __uint_as_float(v.y << 16); a[3] = __uint_as_float(v.y & 0xffff0000u);
    a[4] = __uint_as_float(v.z << 16); a[5] = __uint_as_float(v.z & 0xffff0000u); a[6] = __uint_as_float(v.w << 16); a[7] = __uint_as_float(v.w & 0xffff0000u); }
template <int NP>
__device__ __forceinline__ void p_mixnorm(const Frame& F, const bf16* OA, const float* LSE) {
    unsigned char* ws = F.ws; const int lane = F.lane; const float* ga = F.in[8]; const float* gb = F.in[9];
    for (int m = F.vcu * NWAVES + F.wave; m < T; m += F.G * NWAVES) {
        const int head = lane >> 3; float a[8], w[NP], mx = -1e30f;
#pragma unroll
        for (int p = 0; p < NP; ++p) { w[p] = LSE[((size_t)p * T + m) * 8 + head]; mx = fmaxf(mx, w[p]); }
        float wsum = 0.f;
#pragma unroll
        for (int p = 0; p < NP; ++p) { w[p] = exp2f(w[p] - mx); wsum += w[p]; }
#pragma unroll
        for (int i = 0; i < 8; ++i) a[i] = 0.f;
#pragma unroll
        for (int p = 0; p < NP; ++p) { float t8[8]; unpack8(*(const u32x4*)(OA + ((size_t)p * T + m) * 512 + lane * 8), t8); const float ww = w[p] / wsum;
#pragma unroll
            for (int i = 0; i < 8; ++i) a[i] += ww * t8[i]; }
        float sa = 0.f;
#pragma unroll
        for (int i = 0; i < 8; ++i) sa += a[i] * a[i];
        sa = wave_sum(sa); const float ra = rsqrtf(sa * (1.f / 512.f) + EPS);
        float bv[8]; unpack8(*(const u32x4*)((const bf16*)(ws + WS_OB) + (size_t)m * 512 + lane * 8), bv);
        float sb = 0.f;
#pragma unroll
        for (int i = 0; i < 8; ++i) sb += bv[i] * bv[i];
        sb = wave_sum(sb); const float rb = rsqrtf(sb * (1.f / 512.f) + EPS);
        u32x4 oa, ob; const float* gpa = ga + lane * 8; const float* gpb = gb + lane * 8;
        oa.x = pk2(a[0] * ra * gpa[0], a[1] * ra * gpa[1]); oa.y = pk2(a[2] * ra * gpa[2], a[3] * ra * gpa[3]); oa.z = pk2(a[4] * ra * gpa[4], a[5] * ra * gpa[5]); oa.w = pk2(a[6] * ra * gpa[6], a[7] * ra * gpa[7]);
        ob.x = pk2(bv[0] * rb * gpb[0], bv[1] * rb * gpb[1]); ob.y = pk2(bv[2] * rb * gpb[2], bv[3] * rb * gpb[3]); ob.z = pk2(bv[4] * rb * gpb[4], bv[5] * rb * gpb[5]); ob.w = pk2(bv[6] * rb * gpb[6], bv[7] * rb * gpb[7]);
        bf16* mix = (bf16*)(ws + WS_MIX) + (size_t)m * 1024;
        *(u32x4*)(mix + lane * 8) = oa; *(u32x4*)(mix + 512 + lane * 8) = ob;
    }
}
__device__ __forceinline__ void p_router(const Frame& F) {
    unsigned char* ws = F.ws; const int lane = F.lane;
    LAS float* h2s = (LAS float*)(F.lds + F.wave * 8192); LAS float* lgs = h2s + 1024;
    const float* gffn = F.in[11]; const float* wrg = F.in[12]; const float* brg = F.in[13]; const float* wre = F.in[14]; const float* bre = F.in[15];
    int* counts = (int*)(ws + WS_CTL) + CW_COUNTS; const float* ssq1 = (const float*)(ws + CTL_SSQ1);
    for (int m = F.vcu * NWAVES + F.wave; m < T; m += F.G * NWAVES) {
        const bf16* xr = (const bf16*)(ws + WS_X1) + (size_t)m * 1024;
        const float rs = rsqrtf(ssq1[m] * (1.f / D) + EPS);
#pragma unroll
        for (int i = 0; i < 16; ++i) h2s[lane + 64 * i] = bf2f(xr[lane + 64 * i]) * rs * gffn[lane + 64 * i];
        LDS_WAIT();
        float acc = 0.f;
        if (lane < 4) { for (int k = 0; k < D; ++k) acc += h2s[k] * wrg[k * 4 + lane]; acc += brg[lane]; }
        else if (lane < 36) { const int e = lane - 4; for (int k = 0; k < D; ++k) acc += h2s[k] * wre[k * 32 + e]; acc += bre[e]; }
        lgs[lane] = acc;
        LDS_WAIT();
        if (lane == 0) {
            const LAS float* L = lgs;
            int gi = 0; float gm = L[0]; for (int i = 1; i < 4; ++i) if (L[i] > gm) { gm = L[i]; gi = i; }
            float gs = 0.f; for (int i = 0; i < 4; ++i) gs += __expf(L[i] - gm);
            const float ggate = 1.f / gs;
            const LAS float* EL = L + 4 + gi * 8;
            int i1 = 0; float m1 = EL[0]; for (int i = 1; i < 8; ++i) if (EL[i] > m1) { m1 = EL[i]; i1 = i; }
            int i2 = -1; float m2 = -3.0e38f; for (int i = 0; i < 8; ++i) if (i != i1 && EL[i] > m2) { m2 = EL[i]; i2 = i; }
            const float p2 = __expf(m2 - m1); const float g1 = ggate / (1.f + p2), g2 = ggate * p2 / (1.f + p2);
            const int e1 = gi * 8 + i1, e2 = gi * 8 + i2;
            const int p1 = atomicAdd(&counts[e1], 1), pp2 = atomicAdd(&counts[e2], 1);
            ((int*)(ws + WS_TOK))[e1 * CAP + p1] = m; ((int*)(ws + WS_TOK))[e2 * CAP + pp2] = m;
            ((float*)(ws + WS_GATE))[e1 * CAP + p1] = g1; ((float*)(ws + WS_GATE))[e2 * CAP + pp2] = g2;
            ((int*)(ws + WS_AE))[m * 2] = e1; ((int*)(ws + WS_AE))[m * 2 + 1] = e2; ((int*)(ws + WS_APOS))[m * 2] = p1; ((int*)(ws + WS_APOS))[m * 2 + 1] = pp2;
        }
        LDS_WAIT();
    }
}
__device__ __forceinline__ void moe_tables(const Frame& F) {
    LAS int* pst = (LAS int*)(F.lds + MOE_OFF); LAS int* cnt = pst + 40;
    const int* counts = (const int*)(F.ws + WS_CTL) + CW_COUNTS;
    __syncthreads();
    if (F.tid < NE) cnt[F.tid] = counts[F.tid];
    __syncthreads();
    if (F.tid == 0) { int acc = 0; for (int e = 0; e < NE; ++e) { pst[e] = acc; acc += (cnt[e] + 255) >> 8; } pst[NE] = acc; }
    __syncthreads();
}
__device__ __forceinline__ void p_final(const Frame& F) {
    unsigned char* ws = F.ws; const int lane = F.lane; const float* gfin = F.in[19];
    const LAS int* pst = (const LAS int*)(F.lds + MOE_OFF);
    for (int m = F.vcu * NWAVES + F.wave; m < T; m += F.G * NWAVES) {
        const int e1 = ((const int*)(ws + WS_AE))[m * 2], e2 = ((const int*)(ws + WS_AE))[m * 2 + 1];
        const int r1 = ((const int*)(ws + WS_APOS))[m * 2] + pst[e1] * 256, r2 = ((const int*)(ws + WS_APOS))[m * 2 + 1] + pst[e2] * 256;
        const bf16* xr = (const bf16*)(ws + WS_X1) + (size_t)m * 1024; const bf16* y1 = (const bf16*)(ws + WS_YB) + (size_t)r1 * 1024; const bf16* y2 = (const bf16*)(ws + WS_YB) + (size_t)r2 * 1024;
        float v[16]; float s = 0.f;
#pragma unroll
        for (int j = 0; j < 4; ++j) { const u32x2 a = *((const u32x2*)xr + lane + 64 * j), b = *((const u32x2*)y1 + lane + 64 * j), c = *((const u32x2*)y2 + lane + 64 * j);
            v[4 * j + 0] = __uint_as_float(a.x << 16) + __uint_as_float(b.x << 16) + __uint_as_float(c.x << 16);
            v[4 * j + 1] = __uint_as_float(a.x & 0xffff0000u) + __uint_as_float(b.x & 0xffff0000u) + __uint_as_float(c.x & 0xffff0000u);
            v[4 * j + 2] = __uint_as_float(a.y << 16) + __uint_as_float(b.y << 16) + __uint_as_float(c.y << 16);
            v[4 * j + 3] = __uint_as_float(a.y & 0xffff0000u) + __uint_as_float(b.y & 0xffff0000u) + __uint_as_float(c.y & 0xffff0000u); }
#pragma unroll
        for (int i = 0; i < 16; ++i) s += v[i] * v[i];
        s = wave_sum(s); const float rs = rsqrtf(s * (1.f / D) + EPS);
#pragma unroll
        for (int j = 0; j < 4; ++j) { const f32x4 g4 = *((const f32x4*)gfin + lane + 64 * j); f32x4 o; o.x = v[4 * j] * rs * g4.x; o.y = v[4 * j + 1] * rs * g4.y; o.z = v[4 * j + 2] * rs * g4.z; o.w = v[4 * j + 3] * rs * g4.w;
            *((f32x4*)(F.out + (size_t)m * D) + lane + 64 * j) = o; }
    }
}

__global__ void __launch_bounds__(NWAVES * 64, 2) mk_fwd(Args args) {
    extern __shared__ __attribute__((aligned(16))) unsigned char lds_raw[];
    Frame F;
    F.lds = (LAS unsigned char*)lds_raw;
    F.tid = threadIdx.x; F.lane = F.tid & 63; F.wave = __builtin_amdgcn_readfirstlane(F.tid >> 6);
    F.G = gridDim.x; { const int bx = blockIdx.x; F.vcu = (F.G % 8 == 0) ? (bx % 8) * (F.G / 8) + bx / 8 : bx; }
    F.in = args.in; F.out = args.out; F.ws = args.ws;
    unsigned char* ws = args.ws;
    for (int u = F.tid; u < (LDS_BYTES - LDSCTL_OFF) / 4; u += NWAVES * 64) ((LAS unsigned*)(F.lds + LDSCTL_OFF))[u] = 0u;
    __syncthreads();
#if MK_SPLIT
#define GRID_BAR() do { } while (0)
#else
    volatile LAS unsigned* MISC = (volatile LAS unsigned*)(F.lds + MISC_OFF);
    XcdBarrier bar = xcd_barrier_post((unsigned*)(ws + WS_CTL) + CW_BAR, MISC + 8);
#define GRID_BAR() xcd_barrier(bar)
#endif
    const int lo = args.ph_lo, hi = args.ph_hi;
#ifndef PH_MASK
#define PH_MASK 0x3ff
#endif
#define IN(k) (((PH_MASK >> (k)) & 1) && lo <= (k) && (k) < hi)
#define BOTH(k) (IN(k) && IN((k) + 1))
    bf16* OA = (bf16*)args.out; float* LSE = (float*)(ws + WS_LSE);
    const LAS int* pst = (const LAS int*)(F.lds + MOE_OFF); const LAS int* cnt = pst + 40;

    if (IN(0)) { p_prologue(F); if (BOTH(0)) GRID_BAR(); }
    if (IN(1)) {
        PlainSched S; S.so.init(T, NINP, F.G, (int)blockIdx.x); S.A = (const bf16*)(ws + WS_XB); S.Bt = (const bf16*)(ws + WS_WI); S.lda = 1024; S.ldb = 1024; S.acol_pn = 1 << 30; S.acol_off = 0;
        EpiInProj E{ws};
        pg8::gemm_phase<EpiInProj, PlainSched, true>(F.lds, 1024, 1024, S, E);
        if (BOTH(1)) GRID_BAR();
    }
    if (IN(2)) {
        PlainSched S; S.so.init(T, 768 + 1024, F.G, (int)blockIdx.x); S.A = (const bf16*)(ws + WS_LAT); S.Bt = (const bf16*)(ws + WS_WQKV); S.lda = 512; S.ldb = 256; S.acol_pn = 3; S.acol_off = 256;
        EpiUps E{ws};
        pg8::gemm_phase<EpiUps, PlainSched, true>(F.lds, 256, 256, S, E);
        if (BOTH(2)) GRID_BAR();
    }
#ifndef ATTN_A_NAIVE
#define ATTN_A_NAIVE 0
#endif
#ifndef ATTN_B_NAIVE
#define ATTN_B_NAIVE 0
#endif
    if (IN(3)) {
        if (ATTN_A_NAIVE) p_attnA_naive(F, OA, LSE); else p_attnA(F, OA, LSE);
        if (ATTN_B_NAIVE) p_attnB_naive(F); else p_attnB(F);
        if (BOTH(3)) GRID_BAR(); }
    if (IN(4)) { if (ATTN_A_NAIVE) p_mixnorm<1>(F, OA, LSE); else p_mixnorm<3>(F, OA, LSE); if (BOTH(4)) GRID_BAR(); }
    if (IN(5)) {
        PlainSched S; S.so.init(T, 1024, F.G, (int)blockIdx.x); S.A = (const bf16*)(ws + WS_MIX); S.Bt = (const bf16*)(ws + WS_WO); S.lda = 1024; S.ldb = 1024; S.acol_pn = 1 << 30; S.acol_off = 0;
        EpiOut E{ws};
        pg8::gemm_phase<EpiOut, PlainSched, true>(F.lds, 1024, 1024, S, E);
        if (BOTH(5)) GRID_BAR();
    }
    if (IN(6)) { p_router(F); if (BOTH(6)) GRID_BAR(); }
    if (IN(7)) {
        moe_tables(F);
        MoeSched S; S.G = F.G; S.c = (int)blockIdx.x; S.NT = 2; S.npanels = pst[NE]; S.pst = pst; S.cnt = cnt; S.toks = (const int*)(ws + WS_TOK);
        S.A = (const bf16*)(ws + WS_X1); S.Bt = (const bf16*)(ws + WS_WGU); S.lda = 1024; S.ldb = 1024; S.bstride = (size_t)512 * 1024; S.gather = true;
        EpiGateUp E{ws, cnt};
        pg8::gemm_phase<EpiGateUp, MoeSched, true>(F.lds, 1024, 1024, S, E);
        if (BOTH(7)) GRID_BAR();
    }
    if (IN(8)) {
        moe_tables(F);
        MoeSched S; S.G = F.G; S.c = (int)blockIdx.x; S.NT = 4; S.npanels = pst[NE]; S.pst = pst; S.cnt = cnt; S.toks = (const int*)(ws + WS_TOK);
        S.A = (const bf16*)(ws + WS_HB); S.Bt = (const bf16*)(ws + WS_WD); S.lda = 256; S.ldb = 256; S.bstride = (size_t)1024 * 256; S.gather = false;
        EpiDown E{ws, cnt};
        pg8::gemm_phase<EpiDown, MoeSched, true>(F.lds, 256, 256, S, E);
        if (BOTH(8)) GRID_BAR();
    }
    if (IN(9)) { moe_tables(F); p_final(F); }
#undef IN
#undef BOTH
}
}

extern "C" void kernel_launch(void* const* d_in, const int* in_sizes, int n_in, void* d_out, int out_size, void* d_ws, size_t ws_size, hipStream_t stream) {
    static int grid = 0;
    if (grid == 0) {
        if (n_in != 20 || ws_size < WS_END || out_size != T * D) { fprintf(stderr, "kernel_launch: unexpected shapes (n_in %d, ws %zu, out %d)\n", n_in, ws_size, out_size); grid = -1; return; }
        int dev = 0, cus = 0, per_cu = 0;
        if (hipGetDevice(&dev) != hipSuccess || hipDeviceGetAttribute(&cus, hipDeviceAttributeMultiprocessorCount, dev) != hipSuccess) { grid = -1; return; }
        if (hipFuncSetAttribute((const void*)mk_fwd, hipFuncAttributeMaxDynamicSharedMemorySize, LDS_BYTES) != hipSuccess) { fprintf(stderr, "kernel_launch: hipFuncSetAttribute failed\n"); grid = -1; return; }
        if (hipOccupancyMaxActiveBlocksPerMultiprocessor(&per_cu, (const void*)mk_fwd, NWAVES * 64, LDS_BYTES) != hipSuccess || per_cu < 1) { fprintf(stderr, "kernel_launch: occupancy query says %d\n", per_cu); }
        (void)hipGetLastError();
        grid = cus;
    }
    if (grid < 0) return;
    (void)hipMemsetAsync((char*)d_ws + WS_CTL, 0, CTL_BYTES, stream);
    Args a{};
    for (int i = 0; i < 20; ++i) a.in[i] = (const float*)d_in[i];
    a.out = (float*)d_out; a.ws = (unsigned char*)d_ws;
#if MK_SPLIT
    for (int p = 0; p < NPHASE; ++p) { a.ph_lo = p; a.ph_hi = p + 1; hipLaunchKernelGGL(mk_fwd, dim3(grid), dim3(NWAVES * 64), LDS_BYTES, stream, a); }
#else
    a.ph_lo = 0; a.ph_hi = NPHASE;
    hipLaunchKernelGGL(mk_fwd, dim3(grid), dim3(NWAVES * 64), LDS_BYTES, stream, a);
#endif
}
```

```cpp
#include <hip/hip_runtime.h>
#include <stdint.h>
#include <stdio.h>

#ifndef MK_SPLIT
#define MK_SPLIT 0
#endif

#define LAS __attribute__((address_space(3)))
#define GAS __attribute__((address_space(1)))

namespace {
typedef unsigned short bf16;
typedef short bf16x8 __attribute__((ext_vector_type(8)));
typedef float f32x4 __attribute__((ext_vector_type(4)));
typedef unsigned u32x4 __attribute__((ext_vector_type(4)));
typedef unsigned u32x2 __attribute__((ext_vector_type(2)));

constexpr int D = 1024, BATCH = 16, SEQ = 2048, T = BATCH * SEQ;
constexpr int NIN = 1952, NINP = 2048;
constexpr int NE = 32, CAP = 32768;
constexpr float EPS = 1e-6f;
constexpr float LOG2E = 1.4426950408889634f;
constexpr float QS_A = 0.125f * LOG2E;
constexpr float QS_B = 0.10206207261596577f * LOG2E;
constexpr int NWAVES = 8;
constexpr int NPHASE = 10;

constexpr size_t MiB = 1u << 20;
constexpr size_t WS_CTL = 0;
constexpr size_t CTL_BYTES = 1 * MiB;
constexpr int CW_COUNTS = 64;
constexpr int CW_BAR = 4096;
constexpr size_t CTL_SSQQ = 128 * 1024, CTL_SSQKV = 256 * 1024, CTL_SSQ1 = 384 * 1024;
constexpr size_t WS_RS0 = 2 * MiB;
constexpr size_t WS_ROPE = WS_RS0 + 512 * 1024;
constexpr size_t WS_BT = WS_ROPE + 256 * 1024;
constexpr size_t WS_AE = 3 * MiB;
constexpr size_t WS_APOS = WS_AE + 256 * 1024;
constexpr size_t WS_LSE = 4 * MiB;
constexpr size_t WS_WR = 7 * MiB;
constexpr size_t WS_WI = 8 * MiB;
constexpr size_t WS_WQKV = 12 * MiB;
constexpr size_t WS_WO = 13 * MiB;
constexpr size_t WS_WGU = 16 * MiB;
constexpr size_t WS_WD = 48 * MiB;
constexpr size_t WS_XB = 64 * MiB;
constexpr size_t WS_QA = 128 * MiB, WS_KA = 160 * MiB, WS_VA = 192 * MiB;
constexpr size_t WS_LAT = 224 * MiB;
constexpr size_t WS_QB = 256 * MiB;
constexpr size_t WS_KB = 304 * MiB, WS_VB = 336 * MiB, WS_OB = 368 * MiB;
constexpr size_t WS_MIX = 400 * MiB;
constexpr size_t WS_KR = 464 * MiB;
constexpr size_t WS_TOK = 466 * MiB;
constexpr size_t WS_GATE = 470 * MiB;
constexpr size_t WS_END = 474 * MiB;
constexpr size_t WS_X1 = 128 * MiB;
constexpr size_t WS_HB = 192 * MiB;
constexpr size_t WS_YB = 256 * MiB;

constexpr int RING_BYTES = 131072;
constexpr int LDSCTL_OFF = RING_BYTES;
constexpr int MISC_OFF = LDSCTL_OFF + 320;
constexpr int MOE_OFF = LDSCTL_OFF + 1024;
constexpr int LDS_BYTES = 147456;

__device__ __forceinline__ float bf2f(bf16 b) { return __uint_as_float(((unsigned)b) << 16); }
__device__ __forceinline__ bf16 f2bf(float f) { unsigned u = __float_as_uint(f); u += 0x7fffu + ((u >> 16) & 1u); return (bf16)(u >> 16); }
__device__ __forceinline__ unsigned pk2(float lo, float hi) { return (unsigned)f2bf(lo) | ((unsigned)f2bf(hi) << 16); }
__device__ __forceinline__ float wave_sum(float v) {
#pragma unroll
    for (int o = 1; o < 64; o <<= 1) v += __shfl_xor(v, o);
    return v;
}
#define LDS_WAIT() asm volatile("s_waitcnt lgkmcnt(0)" ::: "memory")

#define XB_TMO      128
#define XB_XCNT(j)  (256  + 64 * (j))
#define XB_XSUB(j)  (1280 + 64 * (j))
#define XB_XGEN(j)  (2304 + 64 * (j))
#define XB_TOP      3328
#define XB_TOPGEN   3392
#define XCD_BAR_WORDS 3456
#define XB_SPIN_CAP (1u << 18)
__device__ __forceinline__ unsigned xb_ld(unsigned* p)              { return __hip_atomic_load(p, __ATOMIC_RELAXED, __HIP_MEMORY_SCOPE_AGENT); }
__device__ __forceinline__ unsigned xb_add(unsigned* p, unsigned v) { return __hip_atomic_fetch_add(p, v, __ATOMIC_RELAXED, __HIP_MEMORY_SCOPE_AGENT); }
__device__ __forceinline__ unsigned xb_xcc_id() { return (unsigned)__builtin_amdgcn_s_getreg((3 << 11) | 20) & 0xFu; }
#define XB_SPIN(cond, bar) do { unsigned _sp = 0; while (cond) { __builtin_amdgcn_s_sleep(1); \
    if ((++_sp & 255u) == 0u) { if (xb_ld(&(bar)[XB_TMO])) break; if (_sp > XB_SPIN_CAP) { atomicAdd(&(bar)[XB_TMO], 1u); break; } } } } while (0)
struct XcdBarrier { unsigned* bar; unsigned x; volatile LAS unsigned* st; };
__device__ __forceinline__ XcdBarrier xcd_barrier_post(unsigned* bar, volatile LAS unsigned* st) {
    XcdBarrier b; b.bar = bar; b.x = xb_xcc_id(); b.st = st;
    if (threadIdx.x == 0) (void)xb_add(&bar[XB_XCNT(b.x)], 1u);
    return b;
}
__device__ __forceinline__ void xcd_barrier_complete(unsigned* bar, unsigned x, unsigned& nloc, unsigned& nx) {
    const unsigned G = gridDim.x * gridDim.y * gridDim.z;
    unsigned sum, cnt, mine, sp = 0u;
    for (;;) {
        sum = 0u; cnt = 0u; mine = 0u;
#pragma unroll
        for (unsigned j = 0; j < 16; ++j) { const unsigned c = xb_ld(&bar[XB_XCNT(j)]); sum += c; cnt += (c > 0u) ? 1u : 0u; mine = (j == x) ? c : mine; }
        if (sum == G) break;
        __builtin_amdgcn_s_sleep(1);
        if ((++sp & 255u) == 0u) { if (xb_ld(&bar[XB_TMO])) break; if (sp > XB_SPIN_CAP) { atomicAdd(&bar[XB_TMO], 1u); break; } }
    }
    nloc = mine > 0u ? mine : 1u; nx = cnt > 0u ? cnt : 1u;
}
__device__ __forceinline__ void xcd_barrier(const XcdBarrier& b) {
    asm volatile("s_waitcnt vmcnt(0)" ::: "memory");
    __syncthreads();
    if (threadIdx.x == 0) {
        unsigned* bar = b.bar;
        __builtin_amdgcn_s_waitcnt(0);
        unsigned nloc = b.st[0], nx = b.st[1];
        if (nloc == 0u) { xcd_barrier_complete(bar, b.x, nloc, nx); b.st[0] = nloc; b.st[1] = nx; }
        const unsigned old = xb_add(&bar[XB_XSUB(b.x)], 1u);
        const unsigned gen = old / nloc;
        if (old + 1u == (gen + 1u) * nloc) {
            __builtin_amdgcn_fence(__ATOMIC_RELEASE, "agent");
            asm volatile("s_waitcnt vmcnt(0)" ::: "memory");
            const unsigned og = xb_add(&bar[XB_TOP], 1u);
            const unsigned tg = og / nx;
            if (og + 1u == (tg + 1u) * nx) xb_add(&bar[XB_TOPGEN], 1u);
            else XB_SPIN(xb_ld(&bar[XB_TOPGEN]) == tg, bar);
            __builtin_amdgcn_fence(__ATOMIC_ACQUIRE, "agent");
            xb_add(&bar[XB_XGEN(b.x)], 1u);
            asm volatile("s_waitcnt vmcnt(0)" ::: "memory");
        } else {
            XB_SPIN(xb_ld(&bar[XB_XGEN(b.x)]) == gen, bar);
            __builtin_amdgcn_fence(__ATOMIC_ACQUIRE, "agent");
            asm volatile("s_waitcnt vmcnt(0)" ::: "memory");
        }
    }
    __syncthreads();
}

namespace pg8 {
constexpr int BM = 256, BK = 64, HALF = 128, HTB = HALF * BK * 2, STAGE_BYTES = 8 * HTB, NXCD = 8, WGM = 8;
__device__ __forceinline__ int lds_byte(int r, int c) { const int st = (r >> 4) * 2 + (c >> 5), rr = r & 15, cc = c & 31, ob = rr * 64 + cc * 2; return st * 1024 + (ob ^ (((ob >> 9) & 1) << 5)); }
__device__ __forceinline__ void stage_rc(int b, int& R, int& C) { const int st = b / 1024, sb = b % 1024, swz = sb ^ (((sb >> 9) & 1) << 5); R = (st >> 1) * 16 + swz / 64; C = (st & 1) * 32 + (swz % 64) / 2; }
struct Unit { int pm, pn, e, lr0; };
struct StaticOrder {
    int nM, nN, nwg, G, c;
    __device__ void init(int M, int N, int G_, int c_) { nM = M / BM; nN = N / BM; nwg = nM * nN; G = G_; c = c_; }
    __device__ bool next(int i, Unit& u) const {
        const long L = (long)i * G + c; if (L >= nwg) return false;
        int wgid = (int)L; { const int q = nwg / NXCD, r = nwg % NXCD, xcd = wgid % NXCD, off = wgid / NXCD; wgid = (xcd < r ? xcd * (q + 1) : r * (q + 1) + (xcd - r) * q) + off; }
        const int nig = WGM * nN, gid = wgid / nig, fm = gid * WGM, gsz = (nM - fm) < WGM ? (nM - fm) : WGM;
        u.pm = fm + ((wgid % nig) % gsz); u.pn = (wgid % nig) / gsz; u.e = 0; u.lr0 = 0; return true;
    }
};

template <class Epi, class Sched, bool ALIGN_EPI>
__device__ __forceinline__ void gemm_phase(LAS unsigned char* lds, const int K, const int ldb, const Sched& S, const Epi& E) {
    const int tid = threadIdx.x, wid = __builtin_amdgcn_readfirstlane(tid >> 6), lane = tid & 63, wr = wid >> 2, wc = wid & 3, fr = lane & 15, fq = lane >> 4;
    const int nt = K / BK;
    int Rr[2], Cc[2]; unsigned voffB[2];
#pragma unroll
    for (int i = 0; i < 2; ++i) { stage_rc(tid * 16 + i * 8192, Rr[i], Cc[i]); voffB[i] = (unsigned)(Rr[i] * ldb + Cc[i]) * 2u; }
    const size_t kstep = (size_t)(BK * 2);
    const size_t hstepB = (size_t)HALF * ldb * 2;
    const unsigned ldsw = (unsigned)wid * 1024u;
    const int aoff = lds_byte(wr * 64 + fr, fq * 8), boff = lds_byte(wc * 32 + fr, fq * 8);
#define PG8_SA(b, h) (((b) * 2 + (h)) * HTB)
#define PG8_SB(b, h) ((4 + (b) * 2 + (h)) * HTB)
#define PG8_STAGE(bufoff, gbase, voff) do { _Pragma("unroll") for (int _i = 0; _i < 2; ++_i) \
        __builtin_amdgcn_global_load_lds((const unsigned*)((const char*)(gbase) + (voff)[_i]), (LAS unsigned*)(lds + (bufoff) + ldsw + _i * 8192), 16, 0, 0); } while (0)
#define PG8_LDA(dst, b, h) do { _Pragma("unroll") for (int m = 0; m < 4; ++m) _Pragma("unroll") for (int k = 0; k < 2; ++k) dst[m][k] = *(const LAS bf16x8*)(lds + PG8_SA(b, h) + aoff + m * 2048 + k * 1024); } while (0)
#define PG8_LDB(dst, b, h) do { _Pragma("unroll") for (int n = 0; n < 2; ++n) _Pragma("unroll") for (int k = 0; k < 2; ++k) dst[n][k] = *(const LAS bf16x8*)(lds + PG8_SB(b, h) + boff + n * 2048 + k * 1024); } while (0)
#define PG8_MMA(ai, bj, At, Bt) do { __builtin_amdgcn_s_setprio(1); _Pragma("unroll") for (int m = 0; m < 4; ++m) _Pragma("unroll") for (int n = 0; n < 2; ++n) _Pragma("unroll") for (int k = 0; k < 2; ++k) \
        acc[ai][bj][m][n] = __builtin_amdgcn_mfma_f32_16x16x32_bf16(Bt[n][k], At[m][k], acc[ai][bj][m][n], 0, 0, 0); __builtin_amdgcn_s_setprio(0); } while (0)
#define PG8_WAIT_V(n) asm volatile("s_waitcnt vmcnt(" #n ")" ::: "memory")
#define PG8_WAIT_L(n) asm volatile("s_waitcnt lgkmcnt(" #n ")" ::: "memory")
#define PG8_BAR __builtin_amdgcn_s_barrier()
#define PG8_SCHED __builtin_amdgcn_sched_barrier(0)
    Unit cur, nxt; int ui = 0;
    if (!S.next(0, cur)) return;
    f32x4 acc[2][2][4][2];
#pragma unroll
    for (int a = 0; a < 2; ++a)
#pragma unroll
        for (int b = 0; b < 2; ++b)
#pragma unroll
            for (int m = 0; m < 4; ++m)
#pragma unroll
                for (int n = 0; n < 2; ++n) acc[a][b][m][n] = (f32x4){0.f, 0.f, 0.f, 0.f};
    bf16x8 At[4][2], B0[2][2], B1[2][2];
    const char* cA = S.a_base(cur); const char* cB = S.b_base(cur);
    unsigned vAc[2][2], vAn[2][2], v2[2][2];
    S.a_offs(cur, Rr, Cc, vAc);
    PG8_STAGE(PG8_SB(0, 0), cB, voffB); PG8_STAGE(PG8_SB(0, 1), cB + hstepB, voffB); PG8_STAGE(PG8_SA(0, 0), cA, vAc[0]); PG8_STAGE(PG8_SA(0, 1), cA, vAc[1]);
    if (wr == 1) PG8_BAR;
    PG8_WAIT_V(2); PG8_BAR;
    PG8_STAGE(PG8_SB(1, 0), cB + kstep, voffB); PG8_STAGE(PG8_SA(1, 0), cA + kstep, vAc[0]); PG8_STAGE(PG8_SB(1, 1), cB + hstepB + kstep, voffB);
    PG8_WAIT_V(6); PG8_BAR;
    for (;;) {
        const bool has_next = S.next(ui + 1, nxt);
        const char* nA = has_next ? S.a_base(nxt) : cA; const char* nB = has_next ? S.b_base(nxt) : cB;
        if (has_next) S.a_offs(nxt, Rr, Cc, vAn);
        else {
#pragma unroll
            for (int h = 0; h < 2; ++h)
#pragma unroll
                for (int i = 0; i < 2; ++i) vAn[h][i] = vAc[h][i]; }
#pragma unroll 1
        for (int t = 0; t < nt; t += 2) {
            const bool last = (t == nt - 2);
            const char* a1 = cA + (size_t)(t + 1) * kstep;
            const char* a2 = last ? nA : cA + (size_t)(t + 2) * kstep; const char* b2 = last ? nB : cB + (size_t)(t + 2) * kstep;
            const char* a3 = a2 + kstep; const char* b3 = b2 + kstep;
#pragma unroll
            for (int h = 0; h < 2; ++h)
#pragma unroll
                for (int i = 0; i < 2; ++i) v2[h][i] = last ? vAn[h][i] : vAc[h][i];
            PG8_LDB(B0, 0, 0); PG8_LDB(B1, 0, 1); PG8_SCHED; PG8_LDA(At, 0, 0); PG8_STAGE(PG8_SA(1, 1), a1, vAc[1]);
            PG8_WAIT_V(8); PG8_WAIT_L(0); PG8_BAR; PG8_MMA(0, 0, At, B0); PG8_MMA(0, 1, At, B1); PG8_BAR; PG8_SCHED;
            PG8_LDA(At, 0, 1); PG8_STAGE(PG8_SB(0, 0), b2, voffB); PG8_STAGE(PG8_SB(0, 1), b2 + hstepB, voffB); PG8_STAGE(PG8_SA(0, 0), a2, v2[0]);
            PG8_WAIT_V(8); PG8_WAIT_L(0); PG8_BAR; PG8_MMA(1, 0, At, B0); PG8_MMA(1, 1, At, B1); PG8_BAR; PG8_SCHED;
            PG8_LDB(B0, 1, 0); PG8_LDB(B1, 1, 1); PG8_SCHED; PG8_LDA(At, 1, 0); PG8_STAGE(PG8_SA(0, 1), a2, v2[1]);
            PG8_WAIT_V(8); PG8_WAIT_L(0); PG8_BAR; PG8_MMA(0, 0, At, B0); PG8_MMA(0, 1, At, B1); PG8_BAR; PG8_SCHED;
            PG8_LDA(At, 1, 1); PG8_STAGE(PG8_SB(1, 0), b3, voffB); PG8_STAGE(PG8_SB(1, 1), b3 + hstepB, voffB); PG8_STAGE(PG8_SA(1, 0), a3, v2[0]);
            PG8_WAIT_V(8); PG8_WAIT_L(0); PG8_BAR; PG8_MMA(1, 0, At, B0); PG8_MMA(1, 1, At, B1); PG8_BAR; PG8_SCHED;
        }
        if constexpr (ALIGN_EPI) { if (wr == 0) PG8_BAR; }
        E(acc, cur, wr, wc, fr, fq);
        if (!has_next) break;
#pragma unroll
        for (int a = 0; a < 2; ++a)
#pragma unroll
            for (int b = 0; b < 2; ++b)
#pragma unroll
                for (int m = 0; m < 4; ++m)
#pragma unroll
                    for (int n = 0; n < 2; ++n) acc[a][b][m][n] = (f32x4){0.f, 0.f, 0.f, 0.f};
        cur = nxt; cA = nA; cB = nB; ++ui;
#pragma unroll
        for (int h = 0; h < 2; ++h)
#pragma unroll
            for (int i = 0; i < 2; ++i) vAc[h][i] = vAn[h][i];
        if constexpr (ALIGN_EPI) { if (wr == 1) PG8_BAR; }
    }
    PG8_WAIT_V(0);
    if constexpr (!ALIGN_EPI) { if (wr == 0) PG8_BAR; }
    PG8_BAR;
#undef PG8_SA
#undef PG8_SB
#undef PG8_STAGE
#undef PG8_LDA
#undef PG8_LDB
#undef PG8_MMA
#undef PG8_WAIT_V
#undef PG8_WAIT_L
#undef PG8_BAR
#undef PG8_SCHED
}
}
using pg8::Unit;

struct PlainSched {
    pg8::StaticOrder so; const bf16* A; const bf16* Bt; int lda, ldb; int acol_pn, acol_off;
    __device__ __forceinline__ bool next(int i, Unit& u) const { return so.next(i, u); }
    __device__ __forceinline__ const char* a_base(const Unit& u) const { return (const char*)(A + (size_t)u.pm * 256 * lda + (u.pn >= acol_pn ? acol_off : 0)); }
    __device__ __forceinline__ const char* b_base(const Unit& u) const { return (const char*)(Bt + (size_t)u.pn * 256 * ldb); }
    __device__ __forceinline__ void a_offs(const Unit&, const int (&R)[2], const int (&C)[2], unsigned (&v)[2][2]) const {
#pragma unroll
        for (int h = 0; h < 2; ++h)
#pragma unroll
            for (int i = 0; i < 2; ++i) v[h][i] = (unsigned)((h * 128 + R[i]) * lda + C[i]) * 2u; }
};
struct MoeSched {
    int G, c, NT, npanels; const LAS int* pst; const LAS int* cnt; const int* toks; const bf16* A; const bf16* Bt; int lda, ldb; size_t bstride; bool gather;
    __device__ __forceinline__ bool next(int i, Unit& u) const {
        const int L = i * G + c; if (L >= npanels * NT) return false;
        u.pm = L / NT; u.pn = L % NT; int e = 0;
#pragma unroll 1
        for (int q = 1; q < NE; ++q) e = (pst[q] <= u.pm) ? q : e;
        u.e = e; u.lr0 = (u.pm - pst[e]) * 256; return true; }
    __device__ __forceinline__ const char* a_base(const Unit& u) const { return gather ? (const char*)A : (const char*)(A + (size_t)u.pm * 256 * lda); }
    __device__ __forceinline__ const char* b_base(const Unit& u) const { return (const char*)(Bt + (size_t)u.e * bstride + (size_t)u.pn * 256 * ldb); }
    __device__ __forceinline__ void a_offs(const Unit& u, const int (&R)[2], const int (&C)[2], unsigned (&v)[2][2]) const {
        const int ce = cnt[u.e];
#pragma unroll
        for (int h = 0; h < 2; ++h)
#pragma unroll
            for (int i = 0; i < 2; ++i) {
                if (gather) { const int lrow = u.lr0 + h * 128 + R[i]; const int tok = lrow < ce ? toks[u.e * CAP + lrow] : 0; v[h][i] = (unsigned)(tok * lda + C[i]) * 2u; }
                else v[h][i] = (unsigned)((h * 128 + R[i]) * lda + C[i]) * 2u; } }
};

__device__ __forceinline__ void st4(bf16* p, f32x4 v) { u32x2 o; o.x = pk2(v.x, v.y); o.y = pk2(v.z, v.w); *(u32x2*)p = o; }
__device__ __forceinline__ float sq4(f32x4 v) { return (v.x * v.x + v.y * v.y) + (v.z * v.z + v.w * v.w); }

struct EpiInProj {
    unsigned char* ws;
    __device__ __forceinline__ void operator()(const f32x4 (&acc)[2][2][4][2], const Unit& u, int wr, int wc, int fr, int fq) const {
        const float* rs0 = (const float*)(ws + WS_RS0);
        const int reg = u.pn >> 1;
        bf16* dst = (bf16*)(ws + (reg == 0 ? WS_QA : reg == 1 ? WS_KA : reg == 2 ? WS_VA : WS_LAT));
        const float qs = (reg == 0) ? QS_A : 1.f;
#pragma unroll
        for (int ai = 0; ai < 2; ++ai)
#pragma unroll
            for (int m = 0; m < 4; ++m) {
                const int row = u.pm * 256 + ai * 128 + wr * 64 + m * 16 + fr;
                const float rs = rs0[row]; const float sc = rs * qs;
                float ssq = 0.f;
#pragma unroll
                for (int bj = 0; bj < 2; ++bj)
#pragma unroll
                    for (int n = 0; n < 2; ++n) {
                        const int lc = (u.pn & 1) * 256 + bj * 128 + wc * 32 + n * 16 + fq * 4;
                        const f32x4 v = acc[ai][bj][m][n] * sc;
                        st4(dst + (size_t)row * 512 + lc, v);
                        if (u.pn == 6 || (u.pn == 7 && bj == 0)) ssq += sq4(v);
                    }
                if (u.pn >= 6) {
                    ssq += __shfl_xor(ssq, 16); ssq += __shfl_xor(ssq, 32);
                    if (fq == 0) atomicAdd((float*)(ws + (u.pn == 6 ? CTL_SSQQ : CTL_SSQKV)) + row, ssq);
                    if (u.pn == 7 && wc == 0) {
                        const f32x4 x1 = acc[ai][1][m][0] * rs, x2 = acc[ai][1][m][1] * rs;
                        const float2* cs = (const float2*)(ws + WS_ROPE) + (row & (SEQ - 1)) * 16 + fq * 4;
                        f32x4 y1, y2;
#pragma unroll
                        for (int j = 0; j < 4; ++j) { const float2 c = cs[j]; y1[j] = x1[j] * c.x - x2[j] * c.y; y2[j] = x1[j] * c.y + x2[j] * c.x; }
                        bf16* kr = (bf16*)(ws + WS_KR) + (size_t)row * 32 + fq * 4;
                        st4(kr, y1); st4(kr + 16, y2);
                    }
                }
            }
    }
};
struct EpiUps {
    unsigned char* ws;
    __device__ __forceinline__ void operator()(const f32x4 (&acc)[2][2][4][2], const Unit& u, int wr, int wc, int fr, int fq) const {
        const bool isq = u.pn < 3;
        const float* ssq = (const float*)(ws + (isq ? CTL_SSQQ : CTL_SSQKV));
#pragma unroll
        for (int ai = 0; ai < 2; ++ai)
#pragma unroll
            for (int m = 0; m < 4; ++m) {
                const int row = u.pm * 256 + ai * 128 + wr * 64 + m * 16 + fr;
                const float rs = rsqrtf(ssq[row] * (isq ? (1.f / 256.f) : (1.f / 128.f)) + EPS) * (isq ? QS_B : 1.f);
#pragma unroll
                for (int bj = 0; bj < 2; ++bj) {
                    if (isq) {
                        const int cg = u.pn * 8 + bj * 4 + wc;
                        bf16* q = (bf16*)(ws + WS_QB) + (size_t)row * 768 + cg * 32 + fq * 4;
                        f32x4 a = acc[ai][bj][m][0] * rs, b = acc[ai][bj][m][1] * rs;
                        if (cg % 3 == 2) {
                            const float2* cs = (const float2*)(ws + WS_ROPE) + (row & (SEQ - 1)) * 16 + fq * 4;
                            f32x4 y1, y2;
#pragma unroll
                            for (int j = 0; j < 4; ++j) { const float2 c = cs[j]; y1[j] = a[j] * c.x - b[j] * c.y; y2[j] = a[j] * c.y + b[j] * c.x; }
                            a = y1; b = y2;
                        }
                        st4(q, a); st4(q + 16, b);
                    } else {
                        const int head = (u.pn - 3) * 2 + bj;
                        bf16* dst = (bf16*)(ws + (wc < 2 ? WS_KB : WS_VB)) + (size_t)row * 512 + head * 64 + (wc & 1) * 32 + fq * 4;
                        st4(dst, acc[ai][bj][m][0] * rs); st4(dst + 16, acc[ai][bj][m][1] * rs);
                    }
                }
            }
    }
};
struct EpiOut {
    unsigned char* ws;
    __device__ __forceinline__ void operator()(const f32x4 (&acc)[2][2][4][2], const Unit& u, int wr, int wc, int fr, int fq) const {
        const bf16* xb = (const bf16*)(ws + WS_XB); bf16* x1 = (bf16*)(ws + WS_X1);
#pragma unroll
        for (int ai = 0; ai < 2; ++ai)
#pragma unroll
            for (int m = 0; m < 4; ++m) {
                const int row = u.pm * 256 + ai * 128 + wr * 64 + m * 16 + fr; float ssq = 0.f;
#pragma unroll
                for (int bj = 0; bj < 2; ++bj)
#pragma unroll
                    for (int n = 0; n < 2; ++n) {
                        const size_t o = (size_t)row * 1024 + u.pn * 256 + bj * 128 + wc * 32 + n * 16 + fq * 4;
                        const u32x2 xv = *(const u32x2*)(xb + o);
                        f32x4 v = acc[ai][bj][m][n];
                        v.x += __uint_as_float(xv.x << 16); v.y += __uint_as_float(xv.x & 0xffff0000u); v.z += __uint_as_float(xv.y << 16); v.w += __uint_as_float(xv.y & 0xffff0000u);
                        st4(x1 + o, v); ssq += sq4(v);
                    }
                ssq += __shfl_xor(ssq, 16); ssq += __shfl_xor(ssq, 32);
                if (fq == 0) atomicAdd((float*)(ws + CTL_SSQ1) + row, ssq);
            }
    }
};
struct EpiGateUp {
    unsigned char* ws; const LAS int* cnt;
    __device__ __forceinline__ void operator()(const f32x4 (&acc)[2][2][4][2], const Unit& u, int wr, int wc, int fr, int fq) const {
        const int ce = cnt[u.e]; const int* toks = (const int*)(ws + WS_TOK) + u.e * CAP; const float* ssq1 = (const float*)(ws + CTL_SSQ1);
#pragma unroll
        for (int ai = 0; ai < 2; ++ai)
#pragma unroll
            for (int m = 0; m < 4; ++m) {
                const int lr = ai * 128 + wr * 64 + m * 16 + fr; const int lrow = u.lr0 + lr;
                const int tok = lrow < ce ? toks[lrow] : 0;
                const float rs = rsqrtf(ssq1[tok] * (1.f / D) + EPS);
                bf16* dst = (bf16*)(ws + WS_HB) + (size_t)(u.pm * 256 + lr) * 256 + u.pn * 128 + wc * 32 + fq * 4;
#pragma unroll
                for (int n = 0; n < 2; ++n) { const f32x4 g = acc[ai][0][m][n] * rs, up = acc[ai][1][m][n] * rs; f32x4 h;
#pragma unroll
                    for (int j = 0; j < 4; ++j) h[j] = g[j] / (1.f + __expf(-g[j])) * up[j];
                    st4(dst + n * 16, h); }
            }
    }
};
struct EpiDown {
    unsigned char* ws; const LAS int* cnt;
    __device__ __forceinline__ void operator()(const f32x4 (&acc)[2][2][4][2], const Unit& u, int wr, int wc, int fr, int fq) const {
        const int ce = cnt[u.e]; const float* gates = (const float*)(ws + WS_GATE) + u.e * CAP;
#pragma unroll
        for (int ai = 0; ai < 2; ++ai)
#pragma unroll
            for (int m = 0; m < 4; ++m) {
                const int lr = ai * 128 + wr * 64 + m * 16 + fr; const int lrow = u.lr0 + lr;
                const float gt = lrow < ce ? gates[lrow] : 0.f;
                bf16* dst = (bf16*)(ws + WS_YB) + (size_t)(u.pm * 256 + lr) * 1024 + u.pn * 256 + wc * 32 + fq * 4;
#pragma unroll
                for (int bj = 0; bj < 2; ++bj)
#pragma unroll
                    for (int n = 0; n < 2; ++n) st4(dst + bj * 128 + n * 16, acc[ai][bj][m][n] * gt);
            }
    }
};

struct Args { const float* in[20]; float* out; unsigned char* ws; int ph_lo, ph_hi, flags, pad; };
struct Frame { LAS unsigned char* lds; int tid, lane, wave, vcu, G; const float* const* in; float* out; unsigned char* ws; };

__device__ __forceinline__ void transpose_item(const float* W, int ldw, const float* gain, bf16* WT, int ldwt, int k0, int n0, int dstrow0, LAS float* scr, int lane) {
#pragma unroll 8
    for (int i = 0; i < 32; ++i) { const int kk = 2 * i + (lane >> 5); float v = W[(size_t)(k0 + kk) * ldw + n0 + (lane & 31)]; if (gain) v *= gain[k0 + kk]; scr[kk * 33 + (lane & 31)] = v; }
    LDS_WAIT();
    const int c = lane & 7;
#pragma unroll
    for (int j = 0; j < 4; ++j) { const int n = (lane >> 3) + 8 * j; const LAS float* s = scr + (8 * c) * 33 + n;
        u32x4 o; o.x = pk2(s[0 * 33], s[1 * 33]); o.y = pk2(s[2 * 33], s[3 * 33]); o.z = pk2(s[4 * 33], s[5 * 33]); o.w = pk2(s[6 * 33], s[7 * 33]);
        *(u32x4*)(WT + (size_t)(dstrow0 + n) * ldwt + k0 + 8 * c) = o; }
    LDS_WAIT();
}

__device__ __forceinline__ void p_prologue(const Frame& F) {
    unsigned char* ws = F.ws; const int lane = F.lane;
    LAS float* scr = (LAS float*)(F.lds + F.wave * 16384);
    const int gw = F.vcu * NWAVES + F.wave, NGW = F.G * NWAVES;
    constexpr int I_IN = 16 * 61, I_Q = 4 * 24, I_KV = 2 * 32, I_O = 16 * 32, I_G = 16 * 8, I_D = 4 * 32;
    constexpr int NITEMS = I_IN + I_Q + I_KV + I_O + 64 * I_G + 32 * I_D;
    for (int it = gw; it < NITEMS; it += NGW) {
        int r = it;
        if (r < I_IN) { const int kb = r / 61, nb = r % 61; transpose_item(F.in[2], NIN, F.in[1], (bf16*)(ws + WS_WI), 1024, kb * 64, nb * 32, nb * 32, scr, lane); continue; } r -= I_IN;
        if (r < I_Q) { const int kb = r / 24, nb = r % 24; transpose_item(F.in[5], 768, F.in[4], (bf16*)(ws + WS_WQKV), 256, kb * 64, nb * 32, nb * 32, scr, lane); continue; } r -= I_Q;
        if (r < I_KV) { const int kb = r / 32, nb = r % 32; transpose_item(F.in[7], 1024, F.in[6], (bf16*)(ws + WS_WQKV), 256, kb * 64, nb * 32, 768 + nb * 32, scr, lane); continue; } r -= I_KV;
        if (r < I_O) { const int kb = r / 32, nb = r % 32; transpose_item(F.in[10], 1024, nullptr, (bf16*)(ws + WS_WO), 1024, kb * 64, nb * 32, nb * 32, scr, lane); continue; } r -= I_O;
        if (r < 64 * I_G) { const int mtx = r / I_G, q = r % I_G, e = mtx >> 1, kind = mtx & 1, kb = q / 8, nb = q % 8;
            const float* W = (kind ? F.in[17] : F.in[16]) + (size_t)e * 1024 * 256; const int n0 = nb * 32;
            transpose_item(W, 256, F.in[11], (bf16*)(ws + WS_WGU) + (size_t)e * 512 * 1024, 1024, kb * 64, n0, 256 * (n0 >> 7) + kind * 128 + (n0 & 127), scr, lane); continue; } r -= 64 * I_G;
        { const int e = r / I_D, q = r % I_D, kb = q / 32, nb = q % 32;
            transpose_item(F.in[18] + (size_t)e * 256 * 1024, 1024, nullptr, (bf16*)(ws + WS_WD) + (size_t)e * 1024 * 256, 256, kb * 64, nb * 32, nb * 32, scr, lane); }
    }
    const size_t gt = (size_t)F.vcu * 512 + F.tid, NGT = (size_t)F.G * 512;
    for (size_t i = gt; i < (size_t)96 * 1024 / 8; i += NGT) ((u32x4*)((bf16*)(ws + WS_WI) + (size_t)1952 * 1024))[i] = (u32x4){0, 0, 0, 0};
    for (size_t i = gt; i < (size_t)1024 * 16; i += NGT) { const size_t row = i >> 4, c = i & 15; *(u32x4*)((bf16*)(ws + WS_WQKV) + (768 + row) * 256 + 128 + c * 8) = (u32x4){0, 0, 0, 0}; }
    for (int m = gw; m < T; m += NGW) {
        const f32x4* xr = (const f32x4*)(F.in[0] + (size_t)m * D) + lane; f32x4 v[4]; float s = 0.f;
#pragma unroll
        for (int j = 0; j < 4; ++j) { v[j] = xr[64 * j]; s += sq4(v[j]); }
        s = wave_sum(s);
        u32x2* o8 = (u32x2*)((bf16*)(ws + WS_XB) + (size_t)m * D) + lane;
#pragma unroll
        for (int j = 0; j < 4; ++j) { u32x2 o; o.x = pk2(v[j].x, v[j].y); o.y = pk2(v[j].z, v[j].w); o8[64 * j] = o; }
        if (lane == 0) ((float*)(ws + WS_RS0))[m] = rsqrtf(s * (1.f / D) + EPS);
    }
    for (size_t i = gt; i < (size_t)48 * 1024; i += NGT) { const int c = (int)(i >> 10), k = (int)(i & 1023);
        float w = 0.f; if (c < 4) w = F.in[12][k * 4 + c] * F.in[11][k]; else if (c < 36) w = F.in[14][k * 32 + c - 4] * F.in[11][k];
        const bf16 hi = f2bf(w); const bf16 lo = f2bf(w - bf2f(hi));
        ((bf16*)(ws + WS_WR))[i] = hi; ((bf16*)(ws + WS_WR))[(size_t)48 * 1024 + i] = lo; }
    for (size_t i = gt; i < (size_t)SEQ * 16; i += NGT) { const int s = (int)(i >> 4), f = (int)(i & 15);
        const float inv = (float)pow(10000.0, -(double)f / 16.0); const float ang = (float)s * inv;
        float2 cs; cs.x = (float)cos((double)ang); cs.y = (float)sin((double)ang); ((float2*)(ws + WS_ROPE))[i] = cs; }
    for (size_t i = gt; i < (size_t)3 * 8 * 132; i += NGT) { const int p = (int)(i / (8 * 132)), h = (int)((i / 132) % 8), jj = (int)(i % 132);
        float val = 0.f;
        if (jj <= 128) { const int dil = (p == 0) ? 1 : (p == 1) ? 4 : 16; const int rel = (jj - 64) * dil; const int n = rel < 0 ? -rel : rel;
            int large = 8 + (int)(log((double)(n > 1 ? n : 1) / 8.0) / log(128.0) * 8.0); if (large > 15) large = 15;
            const int bucket = (rel > 0 ? 16 : 0) + (n < 8 ? n : large);
            val = F.in[3][bucket * 8 + h] * LOG2E; }
        ((float*)(ws + WS_BT))[i] = val; }
}

__device__ __forceinline__ void p_attnA_naive(const Frame& F, bf16* OA, float* LSE) {
    unsigned char* ws = F.ws;
    const bf16* QA = (const bf16*)(ws + WS_QA); const bf16* KA = (const bf16*)(ws + WS_KA); const bf16* VA = (const bf16*)(ws + WS_VA);
    const float* BT = (const float*)(ws + WS_BT);
    for (int idx = F.vcu * 512 + F.tid; idx < T * 8; idx += F.G * 512) {
        const int s = idx & (SEQ - 1), h = (idx >> 11) & 7, b = idx >> 14;
        float q[64], o[64];
        const size_t t = (size_t)b * SEQ + s;
#pragma unroll
        for (int i = 0; i < 64; ++i) { q[i] = bf2f(QA[t * 512 + h * 64 + i]); o[i] = 0.f; }
        float m = -1e30f, l = 0.f;
        for (int p = 0; p < 3; ++p) { const int dil = (p == 0) ? 1 : (p == 1) ? 4 : 16;
            for (int j = -64; j <= 64; ++j) { const int pos = s + j * dil; if (pos < 0 || pos >= SEQ) continue;
                const bf16* kp = KA + ((size_t)b * SEQ + pos) * 512 + h * 64; const bf16* vp = VA + ((size_t)b * SEQ + pos) * 512 + h * 64;
                float sc = BT[(p * 8 + h) * 132 + j + 64];
#pragma unroll
                for (int i = 0; i < 64; ++i) sc += q[i] * bf2f(kp[i]);
                const float mn = fmaxf(m, sc), al = exp2f(m - mn), pe = exp2f(sc - mn);
                l = l * al + pe; m = mn;
#pragma unroll
                for (int i = 0; i < 64; ++i) o[i] = o[i] * al + pe * bf2f(vp[i]);
            } }
        const float il = 1.f / l;
#pragma unroll
        for (int i = 0; i < 64; ++i) OA[t * 512 + h * 64 + i] = f2bf(o[i] * il);
        LSE[t * 8 + h] = m + log2f(l);
    }
}
__device__ __forceinline__ void p_attnB_naive(const Frame& F) {
    unsigned char* ws = F.ws;
    const bf16* QB = (const bf16*)(ws + WS_QB); const bf16* KB = (const bf16*)(ws + WS_KB); const bf16* VB = (const bf16*)(ws + WS_VB); const bf16* KR = (const bf16*)(ws + WS_KR);
    for (int idx = F.vcu * 512 + F.tid; idx < T * 8; idx += F.G * 512) {
        const int s = idx & (SEQ - 1), h = (idx >> 11) & 7, b = idx >> 14;
        float q[96], o[64];
        const size_t t = (size_t)b * SEQ + s;
#pragma unroll
        for (int i = 0; i < 96; ++i) q[i] = bf2f(QB[t * 768 + h * 96 + i]);
#pragma unroll
        for (int i = 0; i < 64; ++i) o[i] = 0.f;
        float m = -1e30f, l = 0.f;
        for (int key = 0; key < SEQ; ++key) { const size_t tk = (size_t)b * SEQ + key;
            const bf16* kp = KB + tk * 512 + h * 64; const bf16* rp = KR + tk * 32; const bf16* vp = VB + tk * 512 + h * 64;
            float sc = 0.f;
#pragma unroll
            for (int i = 0; i < 64; ++i) sc += q[i] * bf2f(kp[i]);
#pragma unroll
            for (int i = 0; i < 32; ++i) sc += q[64 + i] * bf2f(rp[i]);
            const float mn = fmaxf(m, sc), al = exp2f(m - mn), pe = exp2f(sc - mn);
            l = l * al + pe; m = mn;
#pragma unroll
            for (int i = 0; i < 64; ++i) o[i] = o[i] * al + pe * bf2f(vp[i]);
        }
        const float il = 1.f / l;
#pragma unroll
        for (int i = 0; i < 64; ++i) ((bf16*)(ws + WS_OB))[t * 512 + h * 64 + i] = f2bf(o[i] * il);
    }
}

typedef float f32x16 __attribute__((ext_vector_type(16)));
typedef short s16x4 __attribute__((ext_vector_type(4)));
typedef short v4i16_t __attribute__((ext_vector_type(4)));
typedef float f32x2_t __attribute__((ext_vector_type(2))); typedef __bf16 bf16x2_t __attribute__((ext_vector_type(2)));
__device__ __forceinline__ unsigned cvtpk(float lo, float hi) { f32x2_t v = {lo, hi}; bf16x2_t b = __builtin_convertvector(v, bf16x2_t); return __builtin_bit_cast(unsigned, b); }
__device__ __forceinline__ s16x4 vtr(const LAS unsigned char* p) { return __builtin_bit_cast(s16x4, __builtin_amdgcn_ds_read_tr16_b64_v4i16((LAS v4i16_t*)p)); }
__device__ __forceinline__ int crow(int r, int hi) { return (r & 3) + 8 * (r >> 2) + 4 * hi; }
#define ATT_WAIT_BAR() asm volatile("s_waitcnt vmcnt(0) lgkmcnt(0)\n\ts_barrier" ::: "memory")
#define GLDS16(src, dst) __builtin_amdgcn_global_load_lds((const unsigned*)(src), (LAS unsigned*)(dst), 16, 0, 0)

template <int NS>
__device__ __forceinline__ void sm_update(f32x16 (&p)[NS], float& m, float& l, f32x16& o0, f32x16& o1, bf16x8 (&pf)[2 * NS]) {
    float mx = p[0][0];
#pragma unroll
    for (int s = 0; s < NS; ++s)
#pragma unroll
        for (int r = 0; r < 16; ++r) mx = fmaxf(mx, p[s][r]);
    { auto rr = __builtin_amdgcn_permlane32_swap(__float_as_uint(mx), __float_as_uint(mx), false, false); mx = fmaxf(__uint_as_float(rr[0]), __uint_as_float(rr[1])); }
    const float mn = fmaxf(m, mx); const float al = __builtin_amdgcn_exp2f(m - mn); m = mn;
    float sum = 0.f;
#pragma unroll
    for (int s = 0; s < NS; ++s)
#pragma unroll
        for (int r = 0; r < 16; ++r) { p[s][r] = __builtin_amdgcn_exp2f(p[s][r] - mn); sum += p[s][r]; }
    l = l * al + sum;
#pragma unroll
    for (int r = 0; r < 16; ++r) { o0[r] *= al; o1[r] *= al; }
#pragma unroll
    for (int s = 0; s < NS; ++s)
#pragma unroll
        for (int k = 0; k < 2; ++k) { u32x4 w; w.x = cvtpk(p[s][8 * k + 0], p[s][8 * k + 1]); w.y = cvtpk(p[s][8 * k + 2], p[s][8 * k + 3]); w.z = cvtpk(p[s][8 * k + 4], p[s][8 * k + 5]); w.w = cvtpk(p[s][8 * k + 6], p[s][8 * k + 7]);
            pf[2 * s + k] = __builtin_bit_cast(bf16x8, w); }
}
__device__ __forceinline__ void pv_step(f32x16& o0, f32x16& o1, const LAS unsigned char* vp, int dstride, bf16x8 pfk) {
    const s16x4 a0 = vtr(vp), a1 = vtr(vp + 512), b0 = vtr(vp + dstride), b1 = vtr(vp + dstride + 512);
    const bf16x8 v0 = (bf16x8){a0[0], a0[1], a0[2], a0[3], a1[0], a1[1], a1[2], a1[3]};
    const bf16x8 v1 = (bf16x8){b0[0], b0[1], b0[2], b0[3], b1[0], b1[1], b1[2], b1[3]};
    o0 = __builtin_amdgcn_mfma_f32_32x32x16_bf16(v0, pfk, o0, 0, 0, 0);
    o1 = __builtin_amdgcn_mfma_f32_32x32x16_bf16(v1, pfk, o1, 0, 0, 0);
}
__device__ __forceinline__ void store_o(bf16* orow, const f32x16& o0, const f32x16& o1, float il, int hi) {
#pragma unroll
    for (int g = 0; g < 4; ++g) {
        u32x2 w0, w1; w0.x = cvtpk(o0[4 * g] * il, o0[4 * g + 1] * il); w0.y = cvtpk(o0[4 * g + 2] * il, o0[4 * g + 3] * il);
        w1.x = cvtpk(o1[4 * g] * il, o1[4 * g + 1] * il); w1.y = cvtpk(o1[4 * g + 2] * il, o1[4 * g + 3] * il);
        *(u32x2*)(orow + 8 * g + 4 * hi) = w0; *(u32x2*)(orow + 32 + 8 * g + 4 * hi) = w1; }
}

constexpr int B_KBUF = 12288, B_VBUF = 8192, B_VOFF = 2 * B_KBUF;
__device__ __forceinline__ void attnB_unit(const Frame& F, int b, int head, int qb) {
    unsigned char* ws = F.ws; LAS unsigned char* lds = F.lds;
    const int lane = F.lane, wave = F.wave, r32 = lane & 31, hi = lane >> 5;
    const bf16* QB = (const bf16*)(ws + WS_QB); const bf16* KB = (const bf16*)(ws + WS_KB); const bf16* VB = (const bf16*)(ws + WS_VB); const bf16* KR = (const bf16*)(ws + WS_KR);
    const size_t t0 = (size_t)b * SEQ;
    const size_t tq = t0 + qb * 256 + wave * 32 + r32;
    bf16x8 qf[6];
#pragma unroll
    for (int ks = 0; ks < 6; ++ks) qf[ks] = *(const bf16x8*)(QB + tq * 768 + head * 96 + ks * 16 + hi * 8);
    const bf16* ksrc = KB + (t0 + lane) * 512 + head * 64 + wave * 8;
    const bf16* rsrc = KR + (t0 + lane) * 32 + (wave & 3) * 8;
    const bf16* vsrc = VB + (t0 + 16 * (wave & 3) + (lane >> 2)) * 512 + head * 64 + (wave >> 2) * 32 + (lane & 3) * 8;
#define B_ISSUE(kt, buf) do { GLDS16(ksrc + (size_t)(kt) * 64 * 512, lds + (buf) * B_KBUF + wave * 1024); \
        if (wave < 4) GLDS16(rsrc + (size_t)(kt) * 64 * 32, lds + (buf) * B_KBUF + (8 + wave) * 1024); \
        GLDS16(vsrc + (size_t)(kt) * 64 * 512, lds + B_VOFF + (buf) * B_VBUF + wave * 1024); } while (0)
    float m = -1e30f, l = 0.f; f32x16 o0, o1;
#pragma unroll
    for (int r = 0; r < 16; ++r) { o0[r] = 0.f; o1[r] = 0.f; }
    const int kfo = hi * 1024 + r32 * 16;
    const int vbo = ((lane >> 4) & 1) * 32 + (lane & 3) * 8 + (4 * hi + ((lane & 15) >> 2)) * 64;
    B_ISSUE(0, 0);
    for (int kt = 0; kt < SEQ / 64; ++kt) {
        const int buf = kt & 1;
        ATT_WAIT_BAR();
        if (kt + 1 < SEQ / 64) B_ISSUE(kt + 1, buf ^ 1);
        const LAS unsigned char* kb = lds + buf * B_KBUF + kfo; const LAS unsigned char* vb = lds + B_VOFF + buf * B_VBUF + vbo;
        f32x16 p[2];
#pragma unroll
        for (int r = 0; r < 16; ++r) { p[0][r] = 0.f; p[1][r] = 0.f; }
#pragma unroll
        for (int ks = 0; ks < 6; ++ks) {
            const bf16x8 k0 = *(const LAS bf16x8*)(kb + ks * 2048), k1 = *(const LAS bf16x8*)(kb + ks * 2048 + 512);
            p[0] = __builtin_amdgcn_mfma_f32_32x32x16_bf16(k0, qf[ks], p[0], 0, 0, 0);
            p[1] = __builtin_amdgcn_mfma_f32_32x32x16_bf16(k1, qf[ks], p[1], 0, 0, 0);
        }
        bf16x8 pf[4];
        sm_update<2>(p, m, l, o0, o1, pf);
#pragma unroll
        for (int s = 0; s < 4; ++s) pv_step(o0, o1, vb + s * 1024, 4096, pf[s]);
    }
#undef B_ISSUE
    { auto rr = __builtin_amdgcn_permlane32_swap(__float_as_uint(l), __float_as_uint(l), false, false); l = __uint_as_float(rr[0]) + __uint_as_float(rr[1]); }
    store_o((bf16*)(ws + WS_OB) + tq * 512 + head * 64, o0, o1, 1.f / l, hi);
}
__device__ __forceinline__ void p_attnB(const Frame& F) {
    for (int i = 0; i < 4; ++i) { const int u = F.vcu * 4 + i; if (u >= BATCH * 8 * 8) break; const int bh = u >> 3, qb = u & 7; attnB_unit(F, bh >> 3, bh & 7, qb); }
    ATT_WAIT_BAR();
}

constexpr int A_NSL = 384, A_VOFF = 8 * A_NSL * 16, A_TAB = A_VOFF + 2 * A_NSL * 64;
__device__ __forceinline__ void attnA_unit(const Frame& F, int b, int head, int pat, int g, bf16* OA, float* LSE) {
    unsigned char* ws = F.ws; LAS unsigned char* lds = F.lds;
    const int lane = F.lane, wave = F.wave, r32 = lane & 31, hi = lane >> 5;
    const bf16* QA = (const bf16*)(ws + WS_QA); const bf16* KA = (const bf16*)(ws + WS_KA); const bf16* VA = (const bf16*)(ws + WS_VA);
    const int dil = (pat == 0) ? 1 : (pat == 1) ? 4 : 16, L = SEQ / dil;
    const int nslots = (pat == 2) ? 256 : 384;
    const size_t t0 = (size_t)b * SEQ;
#define A_POS(s, pos) do { int kn_; if (pat == 2) { kn_ = (s) & 127; pos = 2 * g + ((s) >> 7) + 16 * kn_; } \
        else if (pat == 1) { kn_ = 256 * (g & 1) - 64 + (s); kn_ = kn_ < 0 ? 0 : (kn_ > 511 ? 511 : kn_); pos = (g >> 1) + 4 * kn_; } \
        else { kn_ = 256 * g - 64 + (s); kn_ = kn_ < 0 ? 0 : (kn_ > 2047 ? 2047 : kn_); pos = kn_; } } while (0)
    for (int kp = wave; kp < 8 * (nslots / 64); kp += 8) { const int sg = kp >> 3; int pos; A_POS(64 * sg + lane, pos);
        GLDS16(KA + (t0 + pos) * 512 + head * 64 + wave * 8, lds + wave * (A_NSL * 16) + sg * 1024); }
    { const int nvg = nslots / 16;
        for (int vp = wave; vp < 2 * nvg; vp += 8) { const int d0 = vp / nvg, vg = vp - d0 * nvg; int pos; A_POS(16 * vg + (lane >> 2), pos);
            GLDS16(VA + (t0 + pos) * 512 + head * 64 + d0 * 32 + (lane & 3) * 8, lds + A_VOFF + d0 * (A_NSL * 64) + vg * 1024); } }
#undef A_POS
    LAS float* tab = (LAS float*)(lds + A_TAB);
    if (F.tid < 192) { const int idx = F.tid - 32; tab[F.tid] = (idx >= 0 && idx <= 128) ? ((const float*)(ws + WS_BT))[(pat * 8 + head) * 132 + idx] : -INFINITY; }
    int c, n0, hb, wstart;
    if (pat == 2) { c = 2 * g + (wave >> 2); n0 = 32 * (wave & 3); hb = 128 * (wave >> 2); wstart = 0; }
    else if (pat == 1) { c = g >> 1; n0 = 256 * (g & 1) + 32 * wave; hb = 0; wstart = 256 * (g & 1) - 64; }
    else { c = 0; n0 = 256 * g + 32 * wave; hb = 0; wstart = 256 * g - 64; }
    const size_t tq = t0 + c + dil * (n0 + r32);
    bf16x8 qf[4];
#pragma unroll
    for (int ks = 0; ks < 4; ++ks) qf[ks] = *(const bf16x8*)(QA + tq * 512 + head * 64 + ks * 16 + hi * 8);
    float m = -1e30f, l = 0.f; f32x16 o0, o1;
#pragma unroll
    for (int r = 0; r < 16; ++r) { o0[r] = 0.f; o1[r] = 0.f; }
    const int vbo = ((lane >> 4) & 1) * 32 + (lane & 3) * 8 + (4 * hi + ((lane & 15) >> 2)) * 64;
    ATT_WAIT_BAR();
#pragma unroll 1
    for (int i = 0; i < 5; ++i) {
        const int kt0 = n0 - 64 + 32 * i; if (kt0 < 0 || kt0 >= L) continue;
        const int slot0 = hb + kt0 - wstart;
        const LAS unsigned char* kb = lds + hi * (A_NSL * 16) + (slot0 + r32) * 16;
        f32x16 p[1];
#pragma unroll
        for (int r = 0; r < 16; ++r) p[0][r] = 0.f;
#pragma unroll
        for (int ks = 0; ks < 4; ++ks) { const bf16x8 kf = *(const LAS bf16x8*)(kb + ks * 2 * (A_NSL * 16)); p[0] = __builtin_amdgcn_mfma_f32_32x32x16_bf16(kf, qf[ks], p[0], 0, 0, 0); }
        const LAS float* tb = tab + (32 * i + 32 + 4 * hi - r32);
#pragma unroll
        for (int r = 0; r < 16; ++r) p[0][r] += tb[(r & 3) + 8 * (r >> 2)];
        bf16x8 pf[2];
        sm_update<1>(p, m, l, o0, o1, pf);
        const LAS unsigned char* vb = lds + A_VOFF + slot0 * 64 + vbo;
#pragma unroll
        for (int s = 0; s < 2; ++s) pv_step(o0, o1, vb + s * 1024, A_NSL * 64, pf[s]);
    }
    { auto rr = __builtin_amdgcn_permlane32_swap(__float_as_uint(l), __float_as_uint(l), false, false); l = __uint_as_float(rr[0]) + __uint_as_float(rr[1]); }
    store_o(OA + ((size_t)pat * T + tq) * 512 + head * 64, o0, o1, 1.f / l, hi);
    if (hi == 0) LSE[((size_t)pat * T + tq) * 8 + head] = m + __builtin_amdgcn_logf(l);
    ATT_WAIT_BAR();
}
__device__ __forceinline__ void p_attnA(const Frame& F, bf16* OA, float* LSE) {
    const int bh = F.vcu >> 1;
    if (bh >= BATCH * 8) return;
    for (int k = 0; k < 12; ++k) { const int u = 2 * k + (F.vcu & 1); attnA_unit(F, bh >> 3, bh & 7, u >> 3, u & 7, OA, LSE); }
}

__device__ __forceinline__ void unpack8(u32x4 v, float (&a)[8]) {
    a[0] = __uint_as_float(v.x << 16); a[1] = __uint_as_float(v.x & 0xffff0000u); a[2] = __uint_as_float(v.y << 16); a[3] = __uint_as_float(v.y & 0xffff0000u);
    a[4] = __uint_as_float(v.z << 16); a[5] = __uint_as_float(v.z & 0xffff0000u); a[6] = __uint_as_float(v.w << 16); a[7] = __uint_as_float(v.w & 0xffff0000u); }
template <int NP>
__device__ __forceinline__ void p_mixnorm(const Frame& F, const bf16* OA, const float* LSE) {
    unsigned char* ws = F.ws; const int lane = F.lane; const float* ga = F.in[8]; const float* gb = F.in[9];
    for (int m = F.vcu * NWAVES + F.wave; m < T; m += F.G * NWAVES) {
        const int head = lane >> 3; float a[8], w[NP], mx = -1e30f;
#pragma unroll
        for (int p = 0; p < NP; ++p) { w[p] = LSE[((size_t)p * T + m) * 8 + head]; mx = fmaxf(mx, w[p]); }
        float wsum = 0.f;
#pragma unroll
        for (int p = 0; p < NP; ++p) { w[p] = exp2f(w[p] - mx); wsum += w[p]; }
#pragma unroll
        for (int i = 0; i < 8; ++i) a[i] = 0.f;
#pragma unroll
        for (int p = 0; p < NP; ++p) { float t8[8]; unpack8(*(const u32x4*)(OA + ((size_t)p * T + m) * 512 + lane * 8), t8); const float ww = w[p] / wsum;
#pragma unroll
            for (int i = 0; i < 8; ++i) a[i] += ww * t8[i]; }
        float sa = 0.f;
#pragma unroll
        for (int i = 0; i < 8; ++i) sa += a[i] * a[i];
        sa = wave_sum(sa); const float ra = rsqrtf(sa * (1.f / 512.f) + EPS);
        float bv[8]; unpack8(*(const u32x4*)((const bf16*)(ws + WS_OB) + (size_t)m * 512 + lane * 8), bv);
        float sb = 0.f;
#pragma unroll
        for (int i = 0; i < 8; ++i) sb += bv[i] * bv[i];
        sb = wave_sum(sb); const float rb = rsqrtf(sb * (1.f / 512.f) + EPS);
        u32x4 oa, ob; const float* gpa = ga + lane * 8; const float* gpb = gb + lane * 8;
        oa.x = pk2(a[0] * ra * gpa[0], a[1] * ra * gpa[1]); oa.y = pk2(a[2] * ra * gpa[2], a[3] * ra * gpa[3]); oa.z = pk2(a[4] * ra * gpa[4], a[5] * ra * gpa[5]); oa.w = pk2(a[6] * ra * gpa[6], a[7] * ra * gpa[7]);
        ob.x = pk2(bv[0] * rb * gpb[0], bv[1] * rb * gpb[1]); ob.y = pk2(bv[2] * rb * gpb[2], bv[3] * rb * gpb[3]); ob.z = pk2(bv[4] * rb * gpb[4], bv[5] * rb * gpb[5]); ob.w = pk2(bv[6] * rb * gpb[6], bv[7] * rb * gpb[7]);
        bf16* mix = (bf16*)(ws + WS_MIX) + (size_t)m * 1024;
        *(u32x4*)(mix + lane * 8) = oa; *(u32x4*)(mix + 512 + lane * 8) = ob;
    }
}
typedef float f32x4r __attribute__((ext_vector_type(4)));
__device__ __forceinline__ void p_router(const Frame& F) {
    unsigned char* ws = F.ws; const int lane = F.lane, wave = F.wave;
    LAS float* lg = (LAS float*)(F.lds + wave * (16 * 52 * 4));
    LAS int* cnt_l = (LAS int*)(F.lds + 32768); LAS int* base_l = cnt_l + 32;
    const bf16* X1 = (const bf16*)(ws + WS_X1); const bf16* WR = (const bf16*)(ws + WS_WR);
    const float* brg = F.in[13]; const float* bre = F.in[15];
    int* counts = (int*)(ws + WS_CTL) + CW_COUNTS; const float* ssq1 = (const float*)(ws + CTL_SSQ1);
    if (F.tid < 32) cnt_l[F.tid] = 0;
    __syncthreads();
    for (int unit = F.vcu; unit < T / 128; unit += F.G) {
        const int tok0 = unit * 128 + wave * 16;
        f32x4 acc[3];
#pragma unroll
        for (int ct = 0; ct < 3; ++ct) acc[ct] = (f32x4){0.f, 0.f, 0.f, 0.f};
        const bf16* arow = X1 + (size_t)(tok0 + (lane & 15)) * 1024 + (lane >> 4) * 8;
        const bf16* brow = WR + (size_t)(lane & 15) * 1024 + (lane >> 4) * 8;
#pragma unroll 4
        for (int kk = 0; kk < 32; ++kk) {
            const bf16x8 a = *(const bf16x8*)(arow + kk * 32);
#pragma unroll
            for (int ct = 0; ct < 3; ++ct) {
                const bf16x8 bh = *(const bf16x8*)(brow + (size_t)(ct * 16) * 1024 + kk * 32), bl = *(const bf16x8*)(brow + (size_t)(48 + ct * 16) * 1024 + kk * 32);
                acc[ct] = __builtin_amdgcn_mfma_f32_16x16x32_bf16(a, bh, acc[ct], 0, 0, 0);
                acc[ct] = __builtin_amdgcn_mfma_f32_16x16x32_bf16(a, bl, acc[ct], 0, 0, 0);
            }
        }
#pragma unroll
        for (int ct = 0; ct < 3; ++ct)
#pragma unroll
            for (int j = 0; j < 4; ++j) lg[(4 * (lane >> 4) + j) * 52 + ct * 16 + (lane & 15)] = acc[ct][j];
        LDS_WAIT();
        int e1 = 0, e2 = 0, q1 = 0, q2 = 0; float g1 = 0.f, g2 = 0.f; const int m = tok0 + lane;
        if (lane < 16) {
            const float rs = rsqrtf(ssq1[m] * (1.f / D) + EPS);
            const LAS float* L = lg + lane * 52;
            int gi = 0; float gm = L[0] * rs + brg[0];
            float gl1 = L[1] * rs + brg[1], gl2 = L[2] * rs + brg[2], gl3 = L[3] * rs + brg[3]; const float gl0 = gm;
            if (gl1 > gm) { gm = gl1; gi = 1; } if (gl2 > gm) { gm = gl2; gi = 2; } if (gl3 > gm) { gm = gl3; gi = 3; }
            const float gs = __expf(gl0 - gm) + __expf(gl1 - gm) + __expf(gl2 - gm) + __expf(gl3 - gm);
            const float ggate = 1.f / gs;
            const LAS float* EL = L + 4 + gi * 8; const float* eb = bre + gi * 8;
            int i1 = 0; float m1 = EL[0] * rs + eb[0];
            for (int i = 1; i < 8; ++i) { const float v = EL[i] * rs + eb[i]; if (v > m1) { m1 = v; i1 = i; } }
            int i2 = -1; float m2 = -3.0e38f;
            for (int i = 0; i < 8; ++i) { const float v = EL[i] * rs + eb[i]; if (i != i1 && v > m2) { m2 = v; i2 = i; } }
            const float p2 = __expf(m2 - m1); g1 = ggate / (1.f + p2); g2 = ggate * p2 / (1.f + p2);
            e1 = gi * 8 + i1; e2 = gi * 8 + i2;
            q1 = __hip_atomic_fetch_add(cnt_l + e1, 1, __ATOMIC_RELAXED, __HIP_MEMORY_SCOPE_WORKGROUP);
            q2 = __hip_atomic_fetch_add(cnt_l + e2, 1, __ATOMIC_RELAXED, __HIP_MEMORY_SCOPE_WORKGROUP);
        }
        __syncthreads();
        if (F.tid < 32) { const int c = cnt_l[F.tid]; base_l[F.tid] = c ? atomicAdd(&counts[F.tid], c) : 0; }
        __syncthreads();
        if (lane < 16) {
            const int p1 = base_l[e1] + q1, pp2 = base_l[e2] + q2;
            ((int*)(ws + WS_TOK))[e1 * CAP + p1] = m; ((int*)(ws + WS_TOK))[e2 * CAP + pp2] = m;
            ((float*)(ws + WS_GATE))[e1 * CAP + p1] = g1; ((float*)(ws + WS_GATE))[e2 * CAP + pp2] = g2;
            ((int*)(ws + WS_AE))[m * 2] = e1; ((int*)(ws + WS_AE))[m * 2 + 1] = e2; ((int*)(ws + WS_APOS))[m * 2] = p1; ((int*)(ws + WS_APOS))[m * 2 + 1] = pp2;
        }
        __syncthreads();
        if (F.tid < 32) cnt_l[F.tid] = 0;
        __syncthreads();
    }
}
__device__ __forceinline__ void moe_tables(const Frame& F) {
    LAS int* pst = (LAS int*)(F.lds + MOE_OFF); LAS int* cnt = pst + 40;
    const int* counts = (const int*)(F.ws + WS_CTL) + CW_COUNTS;
    __syncthreads();
    if (F.tid < NE) cnt[F.tid] = counts[F.tid];
    __syncthreads();
    if (F.tid == 0) { int acc = 0; for (int e = 0; e < NE; ++e) { pst[e] = acc; acc += (cnt[e] + 255) >> 8; } pst[NE] = acc; }
    __syncthreads();
}
__device__ __forceinline__ void p_final(const Frame& F) {
    unsigned char* ws = F.ws; const int lane = F.lane; const float* gfin = F.in[19];
    const LAS int* pst = (const LAS int*)(F.lds + MOE_OFF);
    for (int m = F.vcu * NWAVES + F.wave; m < T; m += F.G * NWAVES) {
        const int e1 = ((const int*)(ws + WS_AE))[m * 2], e2 = ((const int*)(ws + WS_AE))[m * 2 + 1];
        const int r1 = ((const int*)(ws + WS_APOS))[m * 2] + pst[e1] * 256, r2 = ((const int*)(ws + WS_APOS))[m * 2 + 1] + pst[e2] * 256;
        const bf16* xr = (const bf16*)(ws + WS_X1) + (size_t)m * 1024; const bf16* y1 = (const bf16*)(ws + WS_YB) + (size_t)r1 * 1024; const bf16* y2 = (const bf16*)(ws + WS_YB) + (size_t)r2 * 1024;
        float v[16]; float s = 0.f;
#pragma unroll
        for (int j = 0; j < 4; ++j) { const u32x2 a = *((const u32x2*)xr + lane + 64 * j), b = *((const u32x2*)y1 + lane + 64 * j), c = *((const u32x2*)y2 + lane + 64 * j);
            v[4 * j + 0] = __uint_as_float(a.x << 16) + __uint_as_float(b.x << 16) + __uint_as_float(c.x << 16);
            v[4 * j + 1] = __uint_as_float(a.x & 0xffff0000u) + __uint_as_float(b.x & 0xffff0000u) + __uint_as_float(c.x & 0xffff0000u);
            v[4 * j + 2] = __uint_as_float(a.y << 16) + __uint_as_float(b.y << 16) + __uint_as_float(c.y << 16);
            v[4 * j + 3] = __uint_as_float(a.y & 0xffff0000u) + __uint_as_float(b.y & 0xffff0000u) + __uint_as_float(c.y & 0xffff0000u); }
#pragma unroll
        for (int i = 0; i < 16; ++i) s += v[i] * v[i];
        s = wave_sum(s); const float rs = rsqrtf(s * (1.f / D) + EPS);
#pragma unroll
        for (int j = 0; j < 4; ++j) { const f32x4 g4 = *((const f32x4*)gfin + lane + 64 * j); f32x4 o; o.x = v[4 * j] * rs * g4.x; o.y = v[4 * j + 1] * rs * g4.y; o.z = v[4 * j + 2] * rs * g4.z; o.w = v[4 * j + 3] * rs * g4.w;
            *((f32x4*)(F.out + (size_t)m * D) + lane + 64 * j) = o; }
    }
}

__global__ void __launch_bounds__(NWAVES * 64, 2) mk_fwd(Args args) {
    extern __shared__ __attribute__((aligned(16))) unsigned char lds_raw[];
    Frame F;
    F.lds = (LAS unsigned char*)lds_raw;
    F.tid = threadIdx.x; F.lane = F.tid & 63; F.wave = __builtin_amdgcn_readfirstlane(F.tid >> 6);
    F.G = gridDim.x; { const int bx = blockIdx.x; F.vcu = (F.G % 8 == 0) ? (bx % 8) * (F.G / 8) + bx / 8 : bx; }
    F.in = args.in; F.out = args.out; F.ws = args.ws;
    unsigned char* ws = args.ws;
    for (int u = F.tid; u < (LDS_BYTES - LDSCTL_OFF) / 4; u += NWAVES * 64) ((LAS unsigned*)(F.lds + LDSCTL_OFF))[u] = 0u;
    __syncthreads();
#if MK_SPLIT
#define GRID_BAR() do { } while (0)
#else
    volatile LAS unsigned* MISC = (volatile LAS unsigned*)(F.lds + MISC_OFF);
    XcdBarrier bar = xcd_barrier_post((unsigned*)(ws + WS_CTL) + CW_BAR, MISC + 8);
#define GRID_BAR() xcd_barrier(bar)
#endif
    const int lo = args.ph_lo, hi = args.ph_hi;
#ifndef PH_MASK
#define PH_MASK 0x3ff
#endif
#define IN(k) (((PH_MASK >> (k)) & 1) && lo <= (k) && (k) < hi)
#define BOTH(k) (IN(k) && IN((k) + 1))
    bf16* OA = (bf16*)args.out; float* LSE = (float*)(ws + WS_LSE);
    const LAS int* pst = (const LAS int*)(F.lds + MOE_OFF); const LAS int* cnt = pst + 40;

    if (IN(0)) { p_prologue(F); if (BOTH(0)) GRID_BAR(); }
    if (IN(1)) {
        PlainSched S; S.so.init(T, NINP, F.G, (int)blockIdx.x); S.A = (const bf16*)(ws + WS_XB); S.Bt = (const bf16*)(ws + WS_WI); S.lda = 1024; S.ldb = 1024; S.acol_pn = 1 << 30; S.acol_off = 0;
        EpiInProj E{ws};
        pg8::gemm_phase<EpiInProj, PlainSched, true>(F.lds, 1024, 1024, S, E);
        if (BOTH(1)) GRID_BAR();
    }
    if (IN(2)) {
        PlainSched S; S.so.init(T, 768 + 1024, F.G, (int)blockIdx.x); S.A = (const bf16*)(ws + WS_LAT); S.Bt = (const bf16*)(ws + WS_WQKV); S.lda = 512; S.ldb = 256; S.acol_pn = 3; S.acol_off = 256;
        EpiUps E{ws};
        pg8::gemm_phase<EpiUps, PlainSched, true>(F.lds, 256, 256, S, E);
        if (BOTH(2)) GRID_BAR();
    }
#ifndef ATTN_A_NAIVE
#define ATTN_A_NAIVE 0
#endif
#ifndef ATTN_B_NAIVE
#define ATTN_B_NAIVE 0
#endif
    if (IN(3)) {
        if (!(args.flags & 2)) { if (ATTN_A_NAIVE) p_attnA_naive(F, OA, LSE); else p_attnA(F, OA, LSE); }
        if (!(args.flags & 1)) { if (ATTN_B_NAIVE) p_attnB_naive(F); else p_attnB(F); }
        if (BOTH(3)) GRID_BAR(); }
    if (IN(4)) { if (ATTN_A_NAIVE) p_mixnorm<1>(F, OA, LSE); else p_mixnorm<3>(F, OA, LSE); if (BOTH(4)) GRID_BAR(); }
    if (IN(5)) {
        PlainSched S; S.so.init(T, 1024, F.G, (int)blockIdx.x); S.A = (const bf16*)(ws + WS_MIX); S.Bt = (const bf16*)(ws + WS_WO); S.lda = 1024; S.ldb = 1024; S.acol_pn = 1 << 30; S.acol_off = 0;
        EpiOut E{ws};
        pg8::gemm_phase<EpiOut, PlainSched, true>(F.lds, 1024, 1024, S, E);
        if (BOTH(5)) GRID_BAR();
    }
    if (IN(6)) { p_router(F); if (BOTH(6)) GRID_BAR(); }
    if (IN(7)) {
        moe_tables(F);
        MoeSched S; S.G = F.G; S.c = (int)blockIdx.x; S.NT = 2; S.npanels = pst[NE]; S.pst = pst; S.cnt = cnt; S.toks = (const int*)(ws + WS_TOK);
        S.A = (const bf16*)(ws + WS_X1); S.Bt = (const bf16*)(ws + WS_WGU); S.lda = 1024; S.ldb = 1024; S.bstride = (size_t)512 * 1024; S.gather = true;
        EpiGateUp E{ws, cnt};
        pg8::gemm_phase<EpiGateUp, MoeSched, true>(F.lds, 1024, 1024, S, E);
        if (BOTH(7)) GRID_BAR();
    }
    if (IN(8)) {
        moe_tables(F);
        MoeSched S; S.G = F.G; S.c = (int)blockIdx.x; S.NT = 4; S.npanels = pst[NE]; S.pst = pst; S.cnt = cnt; S.toks = (const int*)(ws + WS_TOK);
        S.A = (const bf16*)(ws + WS_HB); S.Bt = (const bf16*)(ws + WS_WD); S.lda = 256; S.ldb = 256; S.bstride = (size_t)1024 * 256; S.gather = false;
        EpiDown E{ws, cnt};
        pg8::gemm_phase<EpiDown, MoeSched, true>(F.lds, 256, 256, S, E);
        if (BOTH(8)) GRID_BAR();
    }
    if (IN(9)) { moe_tables(F); p_final(F); }
#undef IN
#undef BOTH
}
}

extern "C" void kernel_launch(void* const* d_in, const int* in_sizes, int n_in, void* d_out, int out_size, void* d_ws, size_t ws_size, hipStream_t stream) {
    static int grid = 0;
    if (grid == 0) {
        if (n_in != 20 || ws_size < WS_END || out_size != T * D) { fprintf(stderr, "kernel_launch: unexpected shapes (n_in %d, ws %zu, out %d)\n", n_in, ws_size, out_size); grid = -1; return; }
        int dev = 0, cus = 0, per_cu = 0;
        if (hipGetDevice(&dev) != hipSuccess || hipDeviceGetAttribute(&cus, hipDeviceAttributeMultiprocessorCount, dev) != hipSuccess) { grid = -1; return; }
        if (hipFuncSetAttribute((const void*)mk_fwd, hipFuncAttributeMaxDynamicSharedMemorySize, LDS_BYTES) != hipSuccess) { fprintf(stderr, "kernel_launch: hipFuncSetAttribute failed\n"); grid = -1; return; }
        if (hipOccupancyMaxActiveBlocksPerMultiprocessor(&per_cu, (const void*)mk_fwd, NWAVES * 64, LDS_BYTES) != hipSuccess || per_cu < 1) { fprintf(stderr, "kernel_launch: occupancy query says %d\n", per_cu); }
        (void)hipGetLastError();
        grid = cus;
    }
    if (grid < 0) return;
    (void)hipMemsetAsync((char*)d_ws + WS_CTL, 0, CTL_BYTES, stream);
    Args a{};
    for (int i = 0; i < 20; ++i) a.in[i] = (const float*)d_in[i];
    a.out = (float*)d_out; a.ws = (unsigned char*)d_ws;
#if MK_SPLIT
    for (int p = 0; p < NPHASE; ++p) { a.ph_lo = p; a.ph_hi = p + 1; hipLaunchKernelGGL(mk_fwd, dim3(grid), dim3(NWAVES * 64), LDS_BYTES, stream, a); }
#else
#ifndef PROBE_PREFIX
#define PROBE_PREFIX -1
#endif
#ifndef PROBE_FLAGS
#define PROBE_FLAGS 0
#endif
    if (PROBE_PREFIX >= 0) {
        a.ph_lo = 0; a.ph_hi = PROBE_PREFIX + 1; a.flags = PROBE_FLAGS;
        hipLaunchKernelGGL(mk_fwd, dim3(grid), dim3(NWAVES * 64), LDS_BYTES, stream, a);
        (void)hipMemsetAsync((char*)d_ws + WS_CTL, 0, CTL_BYTES, stream);
    }
    a.ph_lo = 0; a.ph_hi = NPHASE; a.flags = 0;
    hipLaunchKernelGGL(mk_fwd, dim3(grid), dim3(NWAVES * 64), LDS_BYTES, stream, a);
#endif
}
```

```cpp
#include <hip/hip_runtime.h>
#include <stdint.h>
#include <stdio.h>

#ifndef MK_SPLIT
#define MK_SPLIT 0
#endif

#define LAS __attribute__((address_space(3)))
#define GAS __attribute__((address_space(1)))

namespace {
typedef unsigned short bf16;
typedef short bf16x8 __attribute__((ext_vector_type(8)));
typedef float f32x4 __attribute__((ext_vector_type(4)));
typedef unsigned u32x4 __attribute__((ext_vector_type(4)));
typedef unsigned u32x2 __attribute__((ext_vector_type(2)));

constexpr int D = 1024, BATCH = 16, SEQ = 2048, T = BATCH * SEQ;
constexpr int NIN = 1952, NINP = 2048;
constexpr int NE = 32, CAP = 32768;
constexpr float EPS = 1e-6f;
constexpr float LOG2E = 1.4426950408889634f;
constexpr float QS_A = 0.125f * LOG2E;
constexpr float QS_B = 0.10206207261596577f * LOG2E;
constexpr int NWAVES = 8;
constexpr int NPHASE = 10;

constexpr size_t MiB = 1u << 20;
constexpr size_t WS_CTL = 0;
constexpr size_t CTL_BYTES = 1 * MiB;
constexpr int CW_COUNTS = 64;
constexpr int CW_BAR = 4096;
constexpr size_t CTL_SSQQ = 128 * 1024, CTL_SSQKV = 256 * 1024, CTL_SSQ1 = 384 * 1024;
constexpr size_t WS_RS0 = 2 * MiB;
constexpr size_t WS_ROPE = WS_RS0 + 512 * 1024;
constexpr size_t WS_BT = WS_ROPE + 256 * 1024;
constexpr size_t WS_AE = 3 * MiB;
constexpr size_t WS_APOS = WS_AE + 256 * 1024;
constexpr size_t WS_LSE = 4 * MiB;
constexpr size_t WS_WR = 7 * MiB;
constexpr size_t WS_WI = 8 * MiB;
constexpr size_t WS_WQKV = 12 * MiB;
constexpr size_t WS_WO = 13 * MiB;
constexpr size_t WS_WGU = 16 * MiB;
constexpr size_t WS_WD = 48 * MiB;
constexpr size_t WS_XB = 64 * MiB;
constexpr size_t WS_QA = 128 * MiB, WS_KA = 160 * MiB, WS_VA = 192 * MiB;
constexpr size_t WS_LAT = 224 * MiB;
constexpr size_t WS_QB = 256 * MiB;
constexpr size_t WS_KB = 304 * MiB, WS_VB = 336 * MiB, WS_OB = 368 * MiB;
constexpr size_t WS_MIX = 400 * MiB;
constexpr size_t WS_KR = 464 * MiB;
constexpr size_t WS_TOK = 466 * MiB;
constexpr size_t WS_GATE = 470 * MiB;
constexpr size_t WS_END = 474 * MiB;
constexpr size_t WS_X1 = 128 * MiB;
constexpr size_t WS_HB = 192 * MiB;
constexpr size_t WS_YB = 256 * MiB;

constexpr int RING_BYTES = 131072;
constexpr int LDSCTL_OFF = RING_BYTES;
constexpr int MISC_OFF = LDSCTL_OFF + 320;
constexpr int MOE_OFF = LDSCTL_OFF + 1024;
constexpr int LDS_BYTES = 147456;

__device__ __forceinline__ float bf2f(bf16 b) { return __uint_as_float(((unsigned)b) << 16); }
__device__ __forceinline__ bf16 f2bf(float f) { unsigned u = __float_as_uint(f); u += 0x7fffu + ((u >> 16) & 1u); return (bf16)(u >> 16); }
typedef float f32x2_t __attribute__((ext_vector_type(2))); typedef __bf16 bf16x2_t __attribute__((ext_vector_type(2)));
__device__ __forceinline__ unsigned cvtpk(float lo, float hi) { f32x2_t v = {lo, hi}; bf16x2_t b = __builtin_convertvector(v, bf16x2_t); return __builtin_bit_cast(unsigned, b); }
__device__ __forceinline__ unsigned pk2(float lo, float hi) { return cvtpk(lo, hi); }
__device__ __forceinline__ float wave_sum(float v) {
#pragma unroll
    for (int o = 1; o < 64; o <<= 1) v += __shfl_xor(v, o);
    return v;
}
__device__ __forceinline__ void unpack8(u32x4 v, float (&a)[8]) {
    a[0] = __uint_as_float(v.x << 16); a[1] = __uint_as_float(v.x & 0xffff0000u); a[2] = __uint_as_float(v.y << 16); a[3] = __uint_as_float(v.y & 0xffff0000u);
    a[4] = __uint_as_float(v.z << 16); a[5] = __uint_as_float(v.z & 0xffff0000u); a[6] = __uint_as_float(v.w << 16); a[7] = __uint_as_float(v.w & 0xffff0000u); }
#define LDS_WAIT() asm volatile("s_waitcnt lgkmcnt(0)" ::: "memory")

#define XB_TMO      128
#define XB_XCNT(j)  (256  + 64 * (j))
#define XB_XSUB(j)  (1280 + 64 * (j))
#define XB_XGEN(j)  (2304 + 64 * (j))
#define XB_TOP      3328
#define XB_TOPGEN   3392
#define XCD_BAR_WORDS 3456
#define XB_SPIN_CAP (1u << 18)
__device__ __forceinline__ unsigned xb_ld(unsigned* p)              { return __hip_atomic_load(p, __ATOMIC_RELAXED, __HIP_MEMORY_SCOPE_AGENT); }
__device__ __forceinline__ unsigned xb_add(unsigned* p, unsigned v) { return __hip_atomic_fetch_add(p, v, __ATOMIC_RELAXED, __HIP_MEMORY_SCOPE_AGENT); }
__device__ __forceinline__ unsigned xb_xcc_id() { return (unsigned)__builtin_amdgcn_s_getreg((3 << 11) | 20) & 0xFu; }
#define XB_SPIN(cond, bar) do { unsigned _sp = 0; while (cond) { __builtin_amdgcn_s_sleep(1); \
    if ((++_sp & 255u) == 0u) { if (xb_ld(&(bar)[XB_TMO])) break; if (_sp > XB_SPIN_CAP) { atomicAdd(&(bar)[XB_TMO], 1u); break; } } } } while (0)
struct XcdBarrier { unsigned* bar; unsigned x; volatile LAS unsigned* st; };
__device__ __forceinline__ XcdBarrier xcd_barrier_post(unsigned* bar, volatile LAS unsigned* st) {
    XcdBarrier b; b.bar = bar; b.x = xb_xcc_id(); b.st = st;
    if (threadIdx.x == 0) (void)xb_add(&bar[XB_XCNT(b.x)], 1u);
    return b;
}
__device__ __forceinline__ void xcd_barrier_complete(unsigned* bar, unsigned x, unsigned& nloc, unsigned& nx) {
    const unsigned G = gridDim.x * gridDim.y * gridDim.z;
    unsigned sum, cnt, mine, sp = 0u;
    for (;;) {
        sum = 0u; cnt = 0u; mine = 0u;
#pragma unroll
        for (unsigned j = 0; j < 16; ++j) { const unsigned c = xb_ld(&bar[XB_XCNT(j)]); sum += c; cnt += (c > 0u) ? 1u : 0u; mine = (j == x) ? c : mine; }
        if (sum == G) break;
        __builtin_amdgcn_s_sleep(1);
        if ((++sp & 255u) == 0u) { if (xb_ld(&bar[XB_TMO])) break; if (sp > XB_SPIN_CAP) { atomicAdd(&bar[XB_TMO], 1u); break; } }
    }
    nloc = mine > 0u ? mine : 1u; nx = cnt > 0u ? cnt : 1u;
}
__device__ __forceinline__ void xcd_barrier(const XcdBarrier& b) {
    asm volatile("s_waitcnt vmcnt(0)" ::: "memory");
    __syncthreads();
    if (threadIdx.x == 0) {
        unsigned* bar = b.bar;
        __builtin_amdgcn_s_waitcnt(0);
        unsigned nloc = b.st[0], nx = b.st[1];
        if (nloc == 0u) { xcd_barrier_complete(bar, b.x, nloc, nx); b.st[0] = nloc; b.st[1] = nx; }
        const unsigned old = xb_add(&bar[XB_XSUB(b.x)], 1u);
        const unsigned gen = old / nloc;
        if (old + 1u == (gen + 1u) * nloc) {
            __builtin_amdgcn_fence(__ATOMIC_RELEASE, "agent");
            asm volatile("s_waitcnt vmcnt(0)" ::: "memory");
            const unsigned og = xb_add(&bar[XB_TOP], 1u);
            const unsigned tg = og / nx;
            if (og + 1u == (tg + 1u) * nx) xb_add(&bar[XB_TOPGEN], 1u);
            else XB_SPIN(xb_ld(&bar[XB_TOPGEN]) == tg, bar);
            __builtin_amdgcn_fence(__ATOMIC_ACQUIRE, "agent");
            xb_add(&bar[XB_XGEN(b.x)], 1u);
            asm volatile("s_waitcnt vmcnt(0)" ::: "memory");
        } else {
            XB_SPIN(xb_ld(&bar[XB_XGEN(b.x)]) == gen, bar);
            __builtin_amdgcn_fence(__ATOMIC_ACQUIRE, "agent");
            asm volatile("s_waitcnt vmcnt(0)" ::: "memory");
        }
    }
    __syncthreads();
}

namespace pg8 {
constexpr int BM = 256, BK = 64, HALF = 128, HTB = HALF * BK * 2, STAGE_BYTES = 8 * HTB, NXCD = 8, WGM = 8;
__device__ __forceinline__ int lds_byte(int r, int c) { const int st = (r >> 4) * 2 + (c >> 5), rr = r & 15, cc = c & 31, ob = rr * 64 + cc * 2; return st * 1024 + (ob ^ (((ob >> 9) & 1) << 5)); }
__device__ __forceinline__ void stage_rc(int b, int& R, int& C) { const int st = b / 1024, sb = b % 1024, swz = sb ^ (((sb >> 9) & 1) << 5); R = (st >> 1) * 16 + swz / 64; C = (st & 1) * 32 + (swz % 64) / 2; }
__device__ __forceinline__ int perm32(int rho) { const int n = rho >> 4, i = rho & 15; return 8 * (i >> 2) + 4 * n + (i & 3); }
struct Unit { int pm, pn, e, lr0; };
struct StaticOrder {
    int nM, nN, nwg, G, c;
    __device__ void init(int M, int N, int G_, int c_) { nM = M / BM; nN = N / BM; nwg = nM * nN; G = G_; c = c_; }
    __device__ bool next(int i, Unit& u) const {
        const long L = (long)i * G + c; if (L >= nwg) return false;
        int wgid = (int)L; { const int q = nwg / NXCD, r = nwg % NXCD, xcd = wgid % NXCD, off = wgid / NXCD; wgid = (xcd < r ? xcd * (q + 1) : r * (q + 1) + (xcd - r) * q) + off; }
        const int nig = WGM * nN, gid = wgid / nig, fm = gid * WGM, gsz = (nM - fm) < WGM ? (nM - fm) : WGM;
        u.pm = fm + ((wgid % nig) % gsz); u.pn = (wgid % nig) / gsz; u.e = 0; u.lr0 = 0; return true;
    }
};

template <class Epi, class Sched, bool ALIGN_EPI>
__device__ __forceinline__ void gemm_phase(LAS unsigned char* lds, const int K, const int ldb, const Sched& S, const Epi& E) {
    const int tid = threadIdx.x, wid = __builtin_amdgcn_readfirstlane(tid >> 6), lane = tid & 63, wr = wid >> 2, wc = wid & 3, fr = lane & 15, fq = lane >> 4;
    const int nt = K / BK;
    int Rr[2], Cc[2]; unsigned voffB[2];
#pragma unroll
    for (int i = 0; i < 2; ++i) { stage_rc(tid * 16 + i * 8192, Rr[i], Cc[i]); const int Rb = (Rr[i] & ~31) + perm32(Rr[i] & 31); voffB[i] = (unsigned)(Rb * ldb + Cc[i]) * 2u; }
    const size_t kstep = (size_t)(BK * 2);
    const size_t hstepB = (size_t)HALF * ldb * 2;
    const unsigned ldsw = (unsigned)wid * 1024u;
    const int aoff = lds_byte(wr * 64 + fr, fq * 8), boff = lds_byte(wc * 32 + fr, fq * 8);
#define PG8_SA(b, h) (((b) * 2 + (h)) * HTB)
#define PG8_SB(b, h) ((4 + (b) * 2 + (h)) * HTB)
#define PG8_STAGE(bufoff, gbase, voff) do { _Pragma("unroll") for (int _i = 0; _i < 2; ++_i) \
        __builtin_amdgcn_global_load_lds((const unsigned*)((const char*)(gbase) + (voff)[_i]), (LAS unsigned*)(lds + (bufoff) + ldsw + _i * 8192), 16, 0, 0); } while (0)
#define PG8_LDA(dst, b, h) do { _Pragma("unroll") for (int m = 0; m < 4; ++m) _Pragma("unroll") for (int k = 0; k < 2; ++k) dst[m][k] = *(const LAS bf16x8*)(lds + PG8_SA(b, h) + aoff + m * 2048 + k * 1024); } while (0)
#define PG8_LDB(dst, b, h) do { _Pragma("unroll") for (int n = 0; n < 2; ++n) _Pragma("unroll") for (int k = 0; k < 2; ++k) dst[n][k] = *(const LAS bf16x8*)(lds + PG8_SB(b, h) + boff + n * 2048 + k * 1024); } while (0)
#define PG8_MMA(ai, bj, At, Bt) do { __builtin_amdgcn_s_setprio(1); _Pragma("unroll") for (int m = 0; m < 4; ++m) _Pragma("unroll") for (int n = 0; n < 2; ++n) _Pragma("unroll") for (int k = 0; k < 2; ++k) \
        acc[ai][bj][m][n] = __builtin_amdgcn_mfma_f32_16x16x32_bf16(Bt[n][k], At[m][k], acc[ai][bj][m][n], 0, 0, 0); __builtin_amdgcn_s_setprio(0); } while (0)
#define PG8_WAIT_V(n) asm volatile("s_waitcnt vmcnt(" #n ")" ::: "memory")
#define PG8_WAIT_L(n) asm volatile("s_waitcnt lgkmcnt(" #n ")" ::: "memory")
#define PG8_BAR __builtin_amdgcn_s_barrier()
#define PG8_SCHED __builtin_amdgcn_sched_barrier(0)
    Unit cur, nxt; int ui = 0;
    if (!S.next(0, cur)) return;
    f32x4 acc[2][2][4][2];
#pragma unroll
    for (int a = 0; a < 2; ++a)
#pragma unroll
        for (int b = 0; b < 2; ++b)
#pragma unroll
            for (int m = 0; m < 4; ++m)
#pragma unroll
                for (int n = 0; n < 2; ++n) acc[a][b][m][n] = (f32x4){0.f, 0.f, 0.f, 0.f};
    bf16x8 At[4][2], B0[2][2], B1[2][2];
    const char* cA = S.a_base(cur); const char* cB = S.b_base(cur);
    unsigned vAc[2][2], vAn[2][2], v2[2][2];
    S.a_offs(cur, Rr, Cc, vAc);
    PG8_STAGE(PG8_SB(0, 0), cB, voffB); PG8_STAGE(PG8_SB(0, 1), cB + hstepB, voffB); PG8_STAGE(PG8_SA(0, 0), cA, vAc[0]); PG8_STAGE(PG8_SA(0, 1), cA, vAc[1]);
    if (wr == 1) PG8_BAR;
    PG8_WAIT_V(2); PG8_BAR;
    PG8_STAGE(PG8_SB(1, 0), cB + kstep, voffB); PG8_STAGE(PG8_SA(1, 0), cA + kstep, vAc[0]); PG8_STAGE(PG8_SB(1, 1), cB + hstepB + kstep, voffB);
    PG8_WAIT_V(6); PG8_BAR;
    for (;;) {
        const bool has_next = S.next(ui + 1, nxt);
        const char* nA = has_next ? S.a_base(nxt) : cA; const char* nB = has_next ? S.b_base(nxt) : cB;
        if (has_next) S.a_offs(nxt, Rr, Cc, vAn);
        else {
#pragma unroll
            for (int h = 0; h < 2; ++h)
#pragma unroll
                for (int i = 0; i < 2; ++i) vAn[h][i] = vAc[h][i]; }
#pragma unroll 1
        for (int t = 0; t < nt; t += 2) {
            const bool last = (t == nt - 2);
            const char* a1 = cA + (size_t)(t + 1) * kstep;
            const char* a2 = last ? nA : cA + (size_t)(t + 2) * kstep; const char* b2 = last ? nB : cB + (size_t)(t + 2) * kstep;
            const char* a3 = a2 + kstep; const char* b3 = b2 + kstep;
#pragma unroll
            for (int h = 0; h < 2; ++h)
#pragma unroll
                for (int i = 0; i < 2; ++i) v2[h][i] = last ? vAn[h][i] : vAc[h][i];
            PG8_LDB(B0, 0, 0); PG8_LDB(B1, 0, 1); PG8_SCHED; PG8_LDA(At, 0, 0); PG8_STAGE(PG8_SA(1, 1), a1, vAc[1]);
            PG8_WAIT_V(8); PG8_WAIT_L(0); PG8_BAR; PG8_MMA(0, 0, At, B0); PG8_MMA(0, 1, At, B1); PG8_BAR; PG8_SCHED;
            PG8_LDA(At, 0, 1); PG8_STAGE(PG8_SB(0, 0), b2, voffB); PG8_STAGE(PG8_SB(0, 1), b2 + hstepB, voffB); PG8_STAGE(PG8_SA(0, 0), a2, v2[0]);
            PG8_WAIT_V(8); PG8_WAIT_L(0); PG8_BAR; PG8_MMA(1, 0, At, B0); PG8_MMA(1, 1, At, B1); PG8_BAR; PG8_SCHED;
            PG8_LDB(B0, 1, 0); PG8_LDB(B1, 1, 1); PG8_SCHED; PG8_LDA(At, 1, 0); PG8_STAGE(PG8_SA(0, 1), a2, v2[1]);
            PG8_WAIT_V(8); PG8_WAIT_L(0); PG8_BAR; PG8_MMA(0, 0, At, B0); PG8_MMA(0, 1, At, B1); PG8_BAR; PG8_SCHED;
            PG8_LDA(At, 1, 1); PG8_STAGE(PG8_SB(1, 0), b3, voffB); PG8_STAGE(PG8_SB(1, 1), b3 + hstepB, voffB); PG8_STAGE(PG8_SA(1, 0), a3, v2[0]);
            PG8_WAIT_V(8); PG8_WAIT_L(0); PG8_BAR; PG8_MMA(1, 0, At, B0); PG8_MMA(1, 1, At, B1); PG8_BAR; PG8_SCHED;
        }
        if constexpr (ALIGN_EPI) { if (wr == 0) PG8_BAR; }
        E(acc, cur, wr, wc, fr, fq);
        if (!has_next) break;
#pragma unroll
        for (int a = 0; a < 2; ++a)
#pragma unroll
            for (int b = 0; b < 2; ++b)
#pragma unroll
                for (int m = 0; m < 4; ++m)
#pragma unroll
                    for (int n = 0; n < 2; ++n) acc[a][b][m][n] = (f32x4){0.f, 0.f, 0.f, 0.f};
        cur = nxt; cA = nA; cB = nB; ++ui;
#pragma unroll
        for (int h = 0; h < 2; ++h)
#pragma unroll
            for (int i = 0; i < 2; ++i) vAc[h][i] = vAn[h][i];
        if constexpr (ALIGN_EPI) { if (wr == 1) PG8_BAR; }
    }
    PG8_WAIT_V(0);
    if constexpr (!ALIGN_EPI) { if (wr == 0) PG8_BAR; }
    PG8_BAR;
#undef PG8_SA
#undef PG8_SB
#undef PG8_STAGE
#undef PG8_LDA
#undef PG8_LDB
#undef PG8_MMA
#undef PG8_WAIT_V
#undef PG8_WAIT_L
#undef PG8_BAR
#undef PG8_SCHED
}
}
using pg8::Unit;

struct PlainSched {
    pg8::StaticOrder so; const bf16* A; const bf16* Bt; int lda, ldb; int acol_pn, acol_off;
    __device__ __forceinline__ bool next(int i, Unit& u) const { return so.next(i, u); }
    __device__ __forceinline__ const char* a_base(const Unit& u) const { return (const char*)(A + (size_t)u.pm * 256 * lda + (u.pn >= acol_pn ? acol_off : 0)); }
    __device__ __forceinline__ const char* b_base(const Unit& u) const { return (const char*)(Bt + (size_t)u.pn * 256 * ldb); }
    __device__ __forceinline__ void a_offs(const Unit&, const int (&R)[2], const int (&C)[2], unsigned (&v)[2][2]) const {
#pragma unroll
        for (int h = 0; h < 2; ++h)
#pragma unroll
            for (int i = 0; i < 2; ++i) v[h][i] = (unsigned)((h * 128 + R[i]) * lda + C[i]) * 2u; }
};
struct MoeSched {
    int G, c, NT, npanels; const LAS int* pst; const LAS int* cnt; const int* toks; const bf16* A; const bf16* Bt; int lda, ldb; size_t bstride; bool gather;
    __device__ __forceinline__ bool next(int i, Unit& u) const {
        const int L = i * G + c; if (L >= npanels * NT) return false;
        u.pm = L / NT; u.pn = L % NT; int e = 0;
#pragma unroll 1
        for (int q = 1; q < NE; ++q) e = (pst[q] <= u.pm) ? q : e;
        u.e = e; u.lr0 = (u.pm - pst[e]) * 256; return true; }
    __device__ __forceinline__ const char* a_base(const Unit& u) const { return gather ? (const char*)A : (const char*)(A + (size_t)u.pm * 256 * lda); }
    __device__ __forceinline__ const char* b_base(const Unit& u) const { return (const char*)(Bt + (size_t)u.e * bstride + (size_t)u.pn * 256 * ldb); }
    __device__ __forceinline__ void a_offs(const Unit& u, const int (&R)[2], const int (&C)[2], unsigned (&v)[2][2]) const {
        const int ce = cnt[u.e];
#pragma unroll
        for (int h = 0; h < 2; ++h)
#pragma unroll
            for (int i = 0; i < 2; ++i) {
                if (gather) { const int lrow = u.lr0 + h * 128 + R[i]; const int tok = lrow < ce ? toks[u.e * CAP + lrow] : 0; v[h][i] = (unsigned)(tok * lda + C[i]) * 2u; }
                else v[h][i] = (unsigned)((h * 128 + R[i]) * lda + C[i]) * 2u; } }
};

__device__ __forceinline__ void st8(bf16* p, f32x4 a, f32x4 b) { u32x4 o; o.x = pk2(a.x, a.y); o.y = pk2(a.z, a.w); o.z = pk2(b.x, b.y); o.w = pk2(b.z, b.w); *(u32x4*)p = o; }
__device__ __forceinline__ void st4(bf16* p, f32x4 v) { u32x2 o; o.x = pk2(v.x, v.y); o.y = pk2(v.z, v.w); *(u32x2*)p = o; }
__device__ __forceinline__ float sq4(f32x4 v) { return (v.x * v.x + v.y * v.y) + (v.z * v.z + v.w * v.w); }

struct EpiInProj {
    unsigned char* ws;
    __device__ __forceinline__ void operator()(const f32x4 (&acc)[2][2][4][2], const Unit& u, int wr, int wc, int fr, int fq) const {
        const float* rs0 = (const float*)(ws + WS_RS0);
        const int reg = u.pn >> 1;
        bf16* dst = (bf16*)(ws + (reg == 0 ? WS_QA : reg == 1 ? WS_KA : reg == 2 ? WS_VA : WS_LAT));
        const float qs = (reg == 0) ? QS_A : 1.f;
#pragma unroll
        for (int ai = 0; ai < 2; ++ai)
#pragma unroll
            for (int m = 0; m < 4; ++m) {
                const int row = u.pm * 256 + ai * 128 + wr * 64 + m * 16 + fr;
                const float rs = rs0[row]; const float sc = rs * qs;
                float ssq = 0.f;
#pragma unroll
                for (int bj = 0; bj < 2; ++bj) {
                    const int lc = (u.pn & 1) * 256 + bj * 128 + wc * 32 + fq * 8;
                    const f32x4 v0 = acc[ai][bj][m][0] * sc, v1 = acc[ai][bj][m][1] * sc;
                    st8(dst + (size_t)row * 512 + lc, v0, v1);
                    if (u.pn == 6 || (u.pn == 7 && bj == 0)) ssq += sq4(v0) + sq4(v1);
                }
                if (u.pn >= 6) {
                    ssq += __shfl_xor(ssq, 16); ssq += __shfl_xor(ssq, 32);
                    if (fq == 0) atomicAdd((float*)(ws + (u.pn == 6 ? CTL_SSQQ : CTL_SSQKV)) + row, ssq);
                    if (u.pn == 7 && wc == 0) {
                        const f32x4 x1 = acc[ai][1][m][0] * rs, x2 = acc[ai][1][m][1] * rs;
                        const float2* cs = (const float2*)(ws + WS_ROPE) + (row & (SEQ - 1)) * 16 + fq * 4;
                        f32x4 y1, y2;
#pragma unroll
                        for (int j = 0; j < 4; ++j) { const float2 c = cs[j]; y1[j] = x1[j] * c.x - x2[j] * c.y; y2[j] = x1[j] * c.y + x2[j] * c.x; }
                        bf16* kr = (bf16*)(ws + WS_KR) + (size_t)row * 32 + fq * 4;
                        st4(kr, y1); st4(kr + 16, y2);
                    }
                }
            }
    }
};
struct EpiUps {
    unsigned char* ws;
    __device__ __forceinline__ void operator()(const f32x4 (&acc)[2][2][4][2], const Unit& u, int wr, int wc, int fr, int fq) const {
        const bool isq = u.pn < 3;
        const float* ssq = (const float*)(ws + (isq ? CTL_SSQQ : CTL_SSQKV));
#pragma unroll
        for (int ai = 0; ai < 2; ++ai)
#pragma unroll
            for (int m = 0; m < 4; ++m) {
                const int row = u.pm * 256 + ai * 128 + wr * 64 + m * 16 + fr;
                const float rs = rsqrtf(ssq[row] * (isq ? (1.f / 256.f) : (1.f / 128.f)) + EPS) * (isq ? QS_B : 1.f);
#pragma unroll
                for (int bj = 0; bj < 2; ++bj) {
                    if (isq) {
                        const int cg = u.pn * 8 + bj * 4 + wc;
                        bf16* q = (bf16*)(ws + WS_QB) + (size_t)row * 768 + cg * 32;
                        f32x4 a = acc[ai][bj][m][0] * rs, b = acc[ai][bj][m][1] * rs;
                        if (cg % 3 == 2) {
                            const float2* cs = (const float2*)(ws + WS_ROPE) + (row & (SEQ - 1)) * 16 + fq * 4;
                            f32x4 y1, y2;
#pragma unroll
                            for (int j = 0; j < 4; ++j) { const float2 c = cs[j]; y1[j] = a[j] * c.x - b[j] * c.y; y2[j] = a[j] * c.y + b[j] * c.x; }
                            st4(q + fq * 4, y1); st4(q + 16 + fq * 4, y2);
                        } else st8(q + fq * 8, a, b);
                    } else {
                        const int head = (u.pn - 3) * 2 + bj;
                        bf16* dst = (bf16*)(ws + (wc < 2 ? WS_KB : WS_VB)) + (size_t)row * 512 + head * 64 + (wc & 1) * 32 + fq * 8;
                        st8(dst, acc[ai][bj][m][0] * rs, acc[ai][bj][m][1] * rs);
                    }
                }
            }
    }
};
struct EpiOut {
    unsigned char* ws;
    __device__ __forceinline__ void operator()(const f32x4 (&acc)[2][2][4][2], const Unit& u, int wr, int wc, int fr, int fq) const {
        const bf16* xb = (const bf16*)(ws + WS_XB); bf16* x1 = (bf16*)(ws + WS_X1);
#pragma unroll
        for (int ai = 0; ai < 2; ++ai)
#pragma unroll
            for (int m = 0; m < 4; ++m) {
                const int row = u.pm * 256 + ai * 128 + wr * 64 + m * 16 + fr; float ssq = 0.f;
#pragma unroll
                for (int bj = 0; bj < 2; ++bj) {
                    const size_t o = (size_t)row * 1024 + u.pn * 256 + bj * 128 + wc * 32 + fq * 8;
                    float xv[8]; unpack8(*(const u32x4*)(xb + o), xv);
                    f32x4 v0 = acc[ai][bj][m][0], v1 = acc[ai][bj][m][1];
                    v0.x += xv[0]; v0.y += xv[1]; v0.z += xv[2]; v0.w += xv[3]; v1.x += xv[4]; v1.y += xv[5]; v1.z += xv[6]; v1.w += xv[7];
                    st8(x1 + o, v0, v1); ssq += sq4(v0) + sq4(v1);
                }
                ssq += __shfl_xor(ssq, 16); ssq += __shfl_xor(ssq, 32);
                if (fq == 0) atomicAdd((float*)(ws + CTL_SSQ1) + row, ssq);
            }
    }
};
struct EpiGateUp {
    unsigned char* ws; const LAS int* cnt;
    __device__ __forceinline__ void operator()(const f32x4 (&acc)[2][2][4][2], const Unit& u, int wr, int wc, int fr, int fq) const {
        const int ce = cnt[u.e]; const int* toks = (const int*)(ws + WS_TOK) + u.e * CAP; const float* ssq1 = (const float*)(ws + CTL_SSQ1);
#pragma unroll
        for (int ai = 0; ai < 2; ++ai)
#pragma unroll
            for (int m = 0; m < 4; ++m) {
                const int lr = ai * 128 + wr * 64 + m * 16 + fr; const int lrow = u.lr0 + lr;
                const int tok = lrow < ce ? toks[lrow] : 0;
                const float rs = rsqrtf(ssq1[tok] * (1.f / D) + EPS);
                bf16* dst = (bf16*)(ws + WS_HB) + (size_t)(u.pm * 256 + lr) * 256 + u.pn * 128 + wc * 32 + fq * 8;
                f32x4 h[2];
#pragma unroll
                for (int n = 0; n < 2; ++n) { const f32x4 g = acc[ai][0][m][n] * rs, up = acc[ai][1][m][n] * rs;
#pragma unroll
                    for (int j = 0; j < 4; ++j) h[n][j] = g[j] / (1.f + __expf(-g[j])) * up[j]; }
                st8(dst, h[0], h[1]);
            }
    }
};
struct EpiDown {
    unsigned char* ws; const LAS int* cnt;
    __device__ __forceinline__ void operator()(const f32x4 (&acc)[2][2][4][2], const Unit& u, int wr, int wc, int fr, int fq) const {
        const int ce = cnt[u.e]; const float* gates = (const float*)(ws + WS_GATE) + u.e * CAP;
#pragma unroll
        for (int ai = 0; ai < 2; ++ai)
#pragma unroll
            for (int m = 0; m < 4; ++m) {
                const int lr = ai * 128 + wr * 64 + m * 16 + fr; const int lrow = u.lr0 + lr;
                const float gt = lrow < ce ? gates[lrow] : 0.f;
                bf16* dst = (bf16*)(ws + WS_YB) + (size_t)(u.pm * 256 + lr) * 1024 + u.pn * 256 + wc * 32 + fq * 8;
#pragma unroll
                for (int bj = 0; bj < 2; ++bj) st8(dst + bj * 128, acc[ai][bj][m][0] * gt, acc[ai][bj][m][1] * gt);
            }
    }
};

struct Args { const float* in[20]; float* out; unsigned char* ws; int ph_lo, ph_hi, flags, pad; };
struct Frame { LAS unsigned char* lds; int tid, lane, wave, vcu, G; const float* const* in; float* out; unsigned char* ws; };

__device__ __forceinline__ void transpose_item(const float* W, int ldw, const float* gain, bf16* WT, int ldwt, int k0, int n0, int dstrow0, LAS float* scr, int lane, bool ropeperm = false) {
#pragma unroll 8
    for (int i = 0; i < 32; ++i) { const int kk = 2 * i + (lane >> 5); float v = W[(size_t)(k0 + kk) * ldw + n0 + (lane & 31)]; if (gain) v *= gain[k0 + kk]; scr[kk * 33 + (lane & 31)] = v; }
    LDS_WAIT();
    const int c = lane & 7;
#pragma unroll
    for (int j = 0; j < 4; ++j) { const int n = (lane >> 3) + 8 * j; const LAS float* s = scr + (8 * c) * 33 + n;
        u32x4 o; o.x = pk2(s[0 * 33], s[1 * 33]); o.y = pk2(s[2 * 33], s[3 * 33]); o.z = pk2(s[4 * 33], s[5 * 33]); o.w = pk2(s[6 * 33], s[7 * 33]);
        const int dn = ropeperm ? (8 * ((n & 15) >> 2) + 4 * (n >> 4) + (n & 3)) : n;
        *(u32x4*)(WT + (size_t)(dstrow0 + dn) * ldwt + k0 + 8 * c) = o; }
    LDS_WAIT();
}

__device__ __forceinline__ void p_prologue(const Frame& F) {
    unsigned char* ws = F.ws; const int lane = F.lane;
    LAS float* scr = (LAS float*)(F.lds + F.wave * 16384);
    const int gw = F.vcu * NWAVES + F.wave, NGW = F.G * NWAVES;
    constexpr int I_IN = 16 * 61, I_Q = 4 * 24, I_KV = 2 * 32, I_O = 16 * 32, I_G = 16 * 8, I_D = 4 * 32;
    constexpr int NITEMS = I_IN + I_Q + I_KV + I_O + 64 * I_G + 32 * I_D;
    for (int it = gw; it < NITEMS; it += NGW) {
        int r = it;
        if (r < I_IN) { const int kb = r / 61, nb = r % 61; transpose_item(F.in[2], NIN, F.in[1], (bf16*)(ws + WS_WI), 1024, kb * 64, nb * 32, nb * 32, scr, lane, nb == 60); continue; } r -= I_IN;
        if (r < I_Q) { const int kb = r / 24, nb = r % 24; transpose_item(F.in[5], 768, F.in[4], (bf16*)(ws + WS_WQKV), 256, kb * 64, nb * 32, nb * 32, scr, lane, nb % 3 == 2); continue; } r -= I_Q;
        if (r < I_KV) { const int kb = r / 32, nb = r % 32; transpose_item(F.in[7], 1024, F.in[6], (bf16*)(ws + WS_WQKV), 256, kb * 64, nb * 32, 768 + nb * 32, scr, lane); continue; } r -= I_KV;
        if (r < I_O) { const int kb = r / 32, nb = r % 32; transpose_item(F.in[10], 1024, nullptr, (bf16*)(ws + WS_WO), 1024, kb * 64, nb * 32, nb * 32, scr, lane); continue; } r -= I_O;
        if (r < 64 * I_G) { const int mtx = r / I_G, q = r % I_G, e = mtx >> 1, kind = mtx & 1, kb = q / 8, nb = q % 8;
            const float* W = (kind ? F.in[17] : F.in[16]) + (size_t)e * 1024 * 256; const int n0 = nb * 32;
            transpose_item(W, 256, F.in[11], (bf16*)(ws + WS_WGU) + (size_t)e * 512 * 1024, 1024, kb * 64, n0, 256 * (n0 >> 7) + kind * 128 + (n0 & 127), scr, lane); continue; } r -= 64 * I_G;
        { const int e = r / I_D, q = r % I_D, kb = q / 32, nb = q % 32;
            transpose_item(F.in[18] + (size_t)e * 256 * 1024, 1024, nullptr, (bf16*)(ws + WS_WD) + (size_t)e * 1024 * 256, 256, kb * 64, nb * 32, nb * 32, scr, lane); }
    }
    const size_t gt = (size_t)F.vcu * 512 + F.tid, NGT = (size_t)F.G * 512;
    for (size_t i = gt; i < (size_t)96 * 1024 / 8; i += NGT) ((u32x4*)((bf16*)(ws + WS_WI) + (size_t)1952 * 1024))[i] = (u32x4){0, 0, 0, 0};
    for (size_t i = gt; i < (size_t)1024 * 16; i += NGT) { const size_t row = i >> 4, c = i & 15; *(u32x4*)((bf16*)(ws + WS_WQKV) + (768 + row) * 256 + 128 + c * 8) = (u32x4){0, 0, 0, 0}; }
    { const float* __restrict__ xin = F.in[0]; bf16* __restrict__ XBp = (bf16*)(ws + WS_XB); float* __restrict__ rs0 = (float*)(ws + WS_RS0);
    for (int m0 = gw * 2; m0 < T; m0 += NGW * 2) {
        f32x4 v[2][4];
#pragma unroll
        for (int q = 0; q < 2; ++q)
#pragma unroll
            for (int j = 0; j < 4; ++j) v[q][j] = *((const f32x4*)(xin + (size_t)(m0 + q) * D) + lane + 64 * j);
#pragma unroll
        for (int q = 0; q < 2; ++q) { float s = 0.f;
#pragma unroll
            for (int j = 0; j < 4; ++j) s += sq4(v[q][j]);
            s = wave_sum(s);
            u32x2* o8 = (u32x2*)(XBp + (size_t)(m0 + q) * D) + lane;
#pragma unroll
            for (int j = 0; j < 4; ++j) { u32x2 o; o.x = pk2(v[q][j].x, v[q][j].y); o.y = pk2(v[q][j].z, v[q][j].w); o8[64 * j] = o; }
            if (lane == 0) rs0[m0 + q] = rsqrtf(s * (1.f / D) + EPS); }
    } }
    for (size_t i = gt; i < (size_t)48 * 1024; i += NGT) { const int c = (int)(i >> 10), k = (int)(i & 1023);
        float w = 0.f; if (c < 4) w = F.in[12][k * 4 + c] * F.in[11][k]; else if (c < 36) w = F.in[14][k * 32 + c - 4] * F.in[11][k];
        const bf16 hi = f2bf(w); const bf16 lo = f2bf(w - bf2f(hi));
        ((bf16*)(ws + WS_WR))[i] = hi; ((bf16*)(ws + WS_WR))[(size_t)48 * 1024 + i] = lo; }
    for (size_t i = gt; i < (size_t)SEQ * 16; i += NGT) { const int s = (int)(i >> 4), f = (int)(i & 15);
        const float inv = (float)pow(10000.0, -(double)f / 16.0); const float ang = (float)s * inv;
        float2 cs; cs.x = (float)cos((double)ang); cs.y = (float)sin((double)ang); ((float2*)(ws + WS_ROPE))[i] = cs; }
    for (size_t i = gt; i < (size_t)3 * 8 * 132; i += NGT) { const int p = (int)(i / (8 * 132)), h = (int)((i / 132) % 8), jj = (int)(i % 132);
        float val = 0.f;
        if (jj <= 128) { const int dil = (p == 0) ? 1 : (p == 1) ? 4 : 16; const int rel = (jj - 64) * dil; const int n = rel < 0 ? -rel : rel;
            int large = 8 + (int)(log((double)(n > 1 ? n : 1) / 8.0) / log(128.0) * 8.0); if (large > 15) large = 15;
            const int bucket = (rel > 0 ? 16 : 0) + (n < 8 ? n : large);
            val = F.in[3][bucket * 8 + h] * LOG2E; }
        ((float*)(ws + WS_BT))[i] = val; }
}

__device__ __forceinline__ void p_attnA_naive(const Frame& F, bf16* OA, float* LSE) {
    unsigned char* ws = F.ws;
    const bf16* QA = (const bf16*)(ws + WS_QA); const bf16* KA = (const bf16*)(ws + WS_KA); const bf16* VA = (const bf16*)(ws + WS_VA);
    const float* BT = (const float*)(ws + WS_BT);
    for (int idx = F.vcu * 512 + F.tid; idx < T * 8; idx += F.G * 512) {
        const int s = idx & (SEQ - 1), h = (idx >> 11) & 7, b = idx >> 14;
        float q[64], o[64];
        const size_t t = (size_t)b * SEQ + s;
#pragma unroll
        for (int i = 0; i < 64; ++i) { q[i] = bf2f(QA[t * 512 + h * 64 + i]); o[i] = 0.f; }
        float m = -1e30f, l = 0.f;
        for (int p = 0; p < 3; ++p) { const int dil = (p == 0) ? 1 : (p == 1) ? 4 : 16;
            for (int j = -64; j <= 64; ++j) { const int pos = s + j * dil; if (pos < 0 || pos >= SEQ) continue;
                const bf16* kp = KA + ((size_t)b * SEQ + pos) * 512 + h * 64; const bf16* vp = VA + ((size_t)b * SEQ + pos) * 512 + h * 64;
                float sc = BT[(p * 8 + h) * 132 + j + 64];
#pragma unroll
                for (int i = 0; i < 64; ++i) sc += q[i] * bf2f(kp[i]);
                const float mn = fmaxf(m, sc), al = exp2f(m - mn), pe = exp2f(sc - mn);
                l = l * al + pe; m = mn;
#pragma unroll
                for (int i = 0; i < 64; ++i) o[i] = o[i] * al + pe * bf2f(vp[i]);
            } }
        const float il = 1.f / l;
#pragma unroll
        for (int i = 0; i < 64; ++i) OA[t * 512 + h * 64 + i] = f2bf(o[i] * il);
        LSE[t * 8 + h] = m + log2f(l);
    }
}
__device__ __forceinline__ void p_attnB_naive(const Frame& F) {
    unsigned char* ws = F.ws;
    const bf16* QB = (const bf16*)(ws + WS_QB); const bf16* KB = (const bf16*)(ws + WS_KB); const bf16* VB = (const bf16*)(ws + WS_VB); const bf16* KR = (const bf16*)(ws + WS_KR);
    for (int idx = F.vcu * 512 + F.tid; idx < T * 8; idx += F.G * 512) {
        const int s = idx & (SEQ - 1), h = (idx >> 11) & 7, b = idx >> 14;
        float q[96], o[64];
        const size_t t = (size_t)b * SEQ + s;
#pragma unroll
        for (int i = 0; i < 96; ++i) q[i] = bf2f(QB[t * 768 + h * 96 + i]);
#pragma unroll
        for (int i = 0; i < 64; ++i) o[i] = 0.f;
        float m = -1e30f, l = 0.f;
        for (int key = 0; key < SEQ; ++key) { const size_t tk = (size_t)b * SEQ + key;
            const bf16* kp = KB + tk * 512 + h * 64; const bf16* rp = KR + tk * 32; const bf16* vp = VB + tk * 512 + h * 64;
            float sc = 0.f;
#pragma unroll
            for (int i = 0; i < 64; ++i) sc += q[i] * bf2f(kp[i]);
#pragma unroll
            for (int i = 0; i < 32; ++i) sc += q[64 + i] * bf2f(rp[i]);
            const float mn = fmaxf(m, sc), al = exp2f(m - mn), pe = exp2f(sc - mn);
            l = l * al + pe; m = mn;
#pragma unroll
            for (int i = 0; i < 64; ++i) o[i] = o[i] * al + pe * bf2f(vp[i]);
        }
        const float il = 1.f / l;
#pragma unroll
        for (int i = 0; i < 64; ++i) ((bf16*)(ws + WS_OB))[t * 512 + h * 64 + i] = f2bf(o[i] * il);
    }
}

typedef float f32x16 __attribute__((ext_vector_type(16)));
typedef short s16x4 __attribute__((ext_vector_type(4)));
typedef short v4i16_t __attribute__((ext_vector_type(4)));
__device__ __forceinline__ s16x4 vtr(const LAS unsigned char* p) { return __builtin_bit_cast(s16x4, __builtin_amdgcn_ds_read_tr16_b64_v4i16((LAS v4i16_t*)p)); }
__device__ __forceinline__ int crow(int r, int hi) { return (r & 3) + 8 * (r >> 2) + 4 * hi; }
#define ATT_WAIT_BAR() asm volatile("s_waitcnt vmcnt(0) lgkmcnt(0)\n\ts_barrier" ::: "memory")
#define GLDS16(src, dst) __builtin_amdgcn_global_load_lds((const unsigned*)(src), (LAS unsigned*)(dst), 16, 0, 0)

template <int NS>
__device__ __forceinline__ void sm_update(f32x16 (&p)[NS], float& m, float& l, f32x16& o0, f32x16& o1, bf16x8 (&pf)[2 * NS]) {
    float mx = p[0][0];
#pragma unroll
    for (int s = 0; s < NS; ++s)
#pragma unroll
        for (int r = 0; r < 16; ++r) mx = fmaxf(mx, p[s][r]);
    { auto rr = __builtin_amdgcn_permlane32_swap(__float_as_uint(mx), __float_as_uint(mx), false, false); mx = fmaxf(__uint_as_float(rr[0]), __uint_as_float(rr[1])); }
    const float mn = fmaxf(m, mx); const float al = __builtin_amdgcn_exp2f(m - mn); m = mn;
    float sum = 0.f;
#pragma unroll
    for (int s = 0; s < NS; ++s)
#pragma unroll
        for (int r = 0; r < 16; ++r) { p[s][r] = __builtin_amdgcn_exp2f(p[s][r] - mn); sum += p[s][r]; }
    l = l * al + sum;
#pragma unroll
    for (int r = 0; r < 16; ++r) { o0[r] *= al; o1[r] *= al; }
#pragma unroll
    for (int s = 0; s < NS; ++s)
#pragma unroll
        for (int k = 0; k < 2; ++k) { u32x4 w; w.x = cvtpk(p[s][8 * k + 0], p[s][8 * k + 1]); w.y = cvtpk(p[s][8 * k + 2], p[s][8 * k + 3]); w.z = cvtpk(p[s][8 * k + 4], p[s][8 * k + 5]); w.w = cvtpk(p[s][8 * k + 6], p[s][8 * k + 7]);
            pf[2 * s + k] = __builtin_bit_cast(bf16x8, w); }
}
__device__ __forceinline__ void pv_step(f32x16& o0, f32x16& o1, const LAS unsigned char* vp, int dstride, bf16x8 pfk) {
    const s16x4 a0 = vtr(vp), a1 = vtr(vp + 512), b0 = vtr(vp + dstride), b1 = vtr(vp + dstride + 512);
    const bf16x8 v0 = (bf16x8){a0[0], a0[1], a0[2], a0[3], a1[0], a1[1], a1[2], a1[3]};
    const bf16x8 v1 = (bf16x8){b0[0], b0[1], b0[2], b0[3], b1[0], b1[1], b1[2], b1[3]};
    o0 = __builtin_amdgcn_mfma_f32_32x32x16_bf16(v0, pfk, o0, 0, 0, 0);
    o1 = __builtin_amdgcn_mfma_f32_32x32x16_bf16(v1, pfk, o1, 0, 0, 0);
}
__device__ __forceinline__ void store_o(bf16* orow, const f32x16& o0, const f32x16& o1, float il, int hi) {
#pragma unroll
    for (int g = 0; g < 4; ++g) {
        u32x2 w0, w1; w0.x = cvtpk(o0[4 * g] * il, o0[4 * g + 1] * il); w0.y = cvtpk(o0[4 * g + 2] * il, o0[4 * g + 3] * il);
        w1.x = cvtpk(o1[4 * g] * il, o1[4 * g + 1] * il); w1.y = cvtpk(o1[4 * g + 2] * il, o1[4 * g + 3] * il);
        *(u32x2*)(orow + 8 * g + 4 * hi) = w0; *(u32x2*)(orow + 32 + 8 * g + 4 * hi) = w1; }
}

constexpr int B_KBUF = 12288, B_VBUF = 8192, B_VOFF = 2 * B_KBUF;
__device__ __forceinline__ void attnB_unit(const Frame& F, int b, int head, int qb) {
    unsigned char* ws = F.ws; LAS unsigned char* lds = F.lds;
    const int lane = F.lane, wave = F.wave, r32 = lane & 31, hi = lane >> 5;
    const bf16* QB = (const bf16*)(ws + WS_QB); const bf16* KB = (const bf16*)(ws + WS_KB); const bf16* VB = (const bf16*)(ws + WS_VB); const bf16* KR = (const bf16*)(ws + WS_KR);
    const size_t t0 = (size_t)b * SEQ;
    const size_t tq = t0 + qb * 256 + wave * 32 + r32;
    bf16x8 qf[6];
#pragma unroll
    for (int ks = 0; ks < 6; ++ks) qf[ks] = *(const bf16x8*)(QB + tq * 768 + head * 96 + ks * 16 + hi * 8);
    const bf16* ksrc = KB + (t0 + lane) * 512 + head * 64 + wave * 8;
    const bf16* rsrc = KR + (t0 + lane) * 32 + (wave & 3) * 8;
    const bf16* vsrc = VB + (t0 + 16 * (wave & 3) + (lane >> 2)) * 512 + head * 64 + (wave >> 2) * 32 + (lane & 3) * 8;
#define B_ISSUE(kt, buf) do { GLDS16(ksrc + (size_t)(kt) * 64 * 512, lds + (buf) * B_KBUF + wave * 1024); \
        if (wave < 4) GLDS16(rsrc + (size_t)(kt) * 64 * 32, lds + (buf) * B_KBUF + (8 + wave) * 1024); \
        GLDS16(vsrc + (size_t)(kt) * 64 * 512, lds + B_VOFF + (buf) * B_VBUF + wave * 1024); } while (0)
    float m = -1e30f, l = 0.f; f32x16 o0, o1;
#pragma unroll
    for (int r = 0; r < 16; ++r) { o0[r] = 0.f; o1[r] = 0.f; }
    const int kfo = hi * 1024 + r32 * 16;
    const int vbo = ((lane >> 4) & 1) * 32 + (lane & 3) * 8 + (4 * hi + ((lane & 15) >> 2)) * 64;
    B_ISSUE(0, 0);
    for (int kt = 0; kt < SEQ / 64; ++kt) {
        const int buf = kt & 1;
        ATT_WAIT_BAR();
        if (kt + 1 < SEQ / 64) B_ISSUE(kt + 1, buf ^ 1);
        const LAS unsigned char* kb = lds + buf * B_KBUF + kfo; const LAS unsigned char* vb = lds + B_VOFF + buf * B_VBUF + vbo;
        f32x16 p[2];
#pragma unroll
        for (int r = 0; r < 16; ++r) { p[0][r] = 0.f; p[1][r] = 0.f; }
#pragma unroll
        for (int ks = 0; ks < 6; ++ks) {
            const bf16x8 k0 = *(const LAS bf16x8*)(kb + ks * 2048), k1 = *(const LAS bf16x8*)(kb + ks * 2048 + 512);
            p[0] = __builtin_amdgcn_mfma_f32_32x32x16_bf16(k0, qf[ks], p[0], 0, 0, 0);
            p[1] = __builtin_amdgcn_mfma_f32_32x32x16_bf16(k1, qf[ks], p[1], 0, 0, 0);
        }
        bf16x8 pf[4];
        sm_update<2>(p, m, l, o0, o1, pf);
#pragma unroll
        for (int s = 0; s < 4; ++s) pv_step(o0, o1, vb + s * 1024, 4096, pf[s]);
    }
#undef B_ISSUE
    { auto rr = __builtin_amdgcn_permlane32_swap(__float_as_uint(l), __float_as_uint(l), false, false); l = __uint_as_float(rr[0]) + __uint_as_float(rr[1]); }
    store_o((bf16*)(ws + WS_OB) + tq * 512 + head * 64, o0, o1, 1.f / l, hi);
}
__device__ __forceinline__ void p_attnB(const Frame& F) {
    for (int i = 0; i < 4; ++i) { const int u = F.vcu * 4 + i; if (u >= BATCH * 8 * 8) break; const int bh = u >> 3, qb = u & 7; attnB_unit(F, bh >> 3, bh & 7, qb); }
    ATT_WAIT_BAR();
}

constexpr int A_NSL = 384, A_VOFF = 8 * A_NSL * 16, A_TAB = A_VOFF + 2 * A_NSL * 64;
__device__ __forceinline__ void attnA_unit(const Frame& F, int b, int head, int pat, int g, bf16* OA, float* LSE) {
    unsigned char* ws = F.ws; LAS unsigned char* lds = F.lds;
    const int lane = F.lane, wave = F.wave, r32 = lane & 31, hi = lane >> 5;
    const bf16* QA = (const bf16*)(ws + WS_QA); const bf16* KA = (const bf16*)(ws + WS_KA); const bf16* VA = (const bf16*)(ws + WS_VA);
    const int dil = (pat == 0) ? 1 : (pat == 1) ? 4 : 16, L = SEQ / dil;
    const int nslots = (pat == 2) ? 256 : 384;
    const size_t t0 = (size_t)b * SEQ;
#define A_POS(s, pos) do { int kn_; if (pat == 2) { kn_ = (s) & 127; pos = 2 * g + ((s) >> 7) + 16 * kn_; } \
        else if (pat == 1) { kn_ = 256 * (g & 1) - 64 + (s); kn_ = kn_ < 0 ? 0 : (kn_ > 511 ? 511 : kn_); pos = (g >> 1) + 4 * kn_; } \
        else { kn_ = 256 * g - 64 + (s); kn_ = kn_ < 0 ? 0 : (kn_ > 2047 ? 2047 : kn_); pos = kn_; } } while (0)
    for (int kp = wave; kp < 8 * (nslots / 64); kp += 8) { const int sg = kp >> 3; int pos; A_POS(64 * sg + lane, pos);
        GLDS16(KA + (t0 + pos) * 512 + head * 64 + wave * 8, lds + wave * (A_NSL * 16) + sg * 1024); }
    { const int nvg = nslots / 16;
        for (int vp = wave; vp < 2 * nvg; vp += 8) { const int d0 = vp / nvg, vg = vp - d0 * nvg; int pos; A_POS(16 * vg + (lane >> 2), pos);
            GLDS16(VA + (t0 + pos) * 512 + head * 64 + d0 * 32 + (lane & 3) * 8, lds + A_VOFF + d0 * (A_NSL * 64) + vg * 1024); } }
#undef A_POS
    LAS float* tab = (LAS float*)(lds + A_TAB);
    if (F.tid < 192) { const int idx = F.tid - 32; tab[F.tid] = (idx >= 0 && idx <= 128) ? ((const float*)(ws + WS_BT))[(pat * 8 + head) * 132 + idx] : -INFINITY; }
    int c, n0, hb, wstart;
    if (pat == 2) { c = 2 * g + (wave >> 2); n0 = 32 * (wave & 3); hb = 128 * (wave >> 2); wstart = 0; }
    else if (pat == 1) { c = g >> 1; n0 = 256 * (g & 1) + 32 * wave; hb = 0; wstart = 256 * (g & 1) - 64; }
    else { c = 0; n0 = 256 * g + 32 * wave; hb = 0; wstart = 256 * g - 64; }
    const size_t tq = t0 + c + dil * (n0 + r32);
    bf16x8 qf[4];
#pragma unroll
    for (int ks = 0; ks < 4; ++ks) qf[ks] = *(const bf16x8*)(QA + tq * 512 + head * 64 + ks * 16 + hi * 8);
    float m = -1e30f, l = 0.f; f32x16 o0, o1;
#pragma unroll
    for (int r = 0; r < 16; ++r) { o0[r] = 0.f; o1[r] = 0.f; }
    const int vbo = ((lane >> 4) & 1) * 32 + (lane & 3) * 8 + (4 * hi + ((lane & 15) >> 2)) * 64;
    ATT_WAIT_BAR();
#pragma unroll 1
    for (int i = 0; i < 5; ++i) {
        const int kt0 = n0 - 64 + 32 * i; if (kt0 < 0 || kt0 >= L) continue;
        const int slot0 = hb + kt0 - wstart;
        const LAS unsigned char* kb = lds + hi * (A_NSL * 16) + (slot0 + r32) * 16;
        f32x16 p[1];
#pragma unroll
        for (int r = 0; r < 16; ++r) p[0][r] = 0.f;
#pragma unroll
        for (int ks = 0; ks < 4; ++ks) { const bf16x8 kf = *(const LAS bf16x8*)(kb + ks * 2 * (A_NSL * 16)); p[0] = __builtin_amdgcn_mfma_f32_32x32x16_bf16(kf, qf[ks], p[0], 0, 0, 0); }
        const LAS float* tb = tab + (32 * i + 32 + 4 * hi - r32);
#pragma unroll
        for (int r = 0; r < 16; ++r) p[0][r] += tb[(r & 3) + 8 * (r >> 2)];
        bf16x8 pf[2];
        sm_update<1>(p, m, l, o0, o1, pf);
        const LAS unsigned char* vb = lds + A_VOFF + slot0 * 64 + vbo;
#pragma unroll
        for (int s = 0; s < 2; ++s) pv_step(o0, o1, vb + s * 1024, A_NSL * 64, pf[s]);
    }
    { auto rr = __builtin_amdgcn_permlane32_swap(__float_as_uint(l), __float_as_uint(l), false, false); l = __uint_as_float(rr[0]) + __uint_as_float(rr[1]); }
    store_o(OA + ((size_t)pat * T + tq) * 512 + head * 64, o0, o1, 1.f / l, hi);
    if (hi == 0) LSE[((size_t)pat * T + tq) * 8 + head] = m + __builtin_amdgcn_logf(l);
    ATT_WAIT_BAR();
}
__device__ __forceinline__ void p_attnA(const Frame& F, bf16* OA, float* LSE) {
    const int bh = F.vcu >> 1;
    if (bh >= BATCH * 8) return;
    for (int k = 0; k < 12; ++k) { const int u = 2 * k + (F.vcu & 1); attnA_unit(F, bh >> 3, bh & 7, u >> 3, u & 7, OA, LSE); }
}


template <int NP>
__device__ __forceinline__ void p_mixnorm(const Frame& F, const bf16* __restrict__ OA, const float* __restrict__ LSE) {
    unsigned char* ws = F.ws; const int lane = F.lane;
    const bf16* __restrict__ OBp = (const bf16*)(ws + WS_OB); bf16* __restrict__ MIX = (bf16*)(ws + WS_MIX);
    float ga[8], gb[8];
#pragma unroll
    for (int i = 0; i < 8; ++i) { ga[i] = F.in[8][lane * 8 + i]; gb[i] = F.in[9][lane * 8 + i]; }
    const int head = lane >> 3;
    for (int m0 = (F.vcu * NWAVES + F.wave) * 2; m0 < T; m0 += F.G * NWAVES * 2) {
        u32x4 pa[2][NP], pb[2]; float w[2][NP];
#pragma unroll
        for (int q = 0; q < 2; ++q) { const int m = m0 + q;
#pragma unroll
            for (int p = 0; p < NP; ++p) { pa[q][p] = *(const u32x4*)(OA + ((size_t)p * T + m) * 512 + lane * 8); w[q][p] = LSE[((size_t)p * T + m) * 8 + head]; }
            pb[q] = *(const u32x4*)(OBp + (size_t)m * 512 + lane * 8); }
#pragma unroll
        for (int q = 0; q < 2; ++q) { const int m = m0 + q; float a[8], mx = -1e30f;
#pragma unroll
            for (int p = 0; p < NP; ++p) mx = fmaxf(mx, w[q][p]);
            float wsum = 0.f;
#pragma unroll
            for (int p = 0; p < NP; ++p) { w[q][p] = exp2f(w[q][p] - mx); wsum += w[q][p]; }
            const float iw = 1.f / wsum;
#pragma unroll
            for (int i = 0; i < 8; ++i) a[i] = 0.f;
#pragma unroll
            for (int p = 0; p < NP; ++p) { float t8[8]; unpack8(pa[q][p], t8); const float ww = w[q][p] * iw;
#pragma unroll
                for (int i = 0; i < 8; ++i) a[i] += ww * t8[i]; }
            float bv[8]; unpack8(pb[q], bv);
            float sa = 0.f, sb = 0.f;
#pragma unroll
            for (int i = 0; i < 8; ++i) { sa += a[i] * a[i]; sb += bv[i] * bv[i]; }
            sa = wave_sum(sa); sb = wave_sum(sb);
            const float ra = rsqrtf(sa * (1.f / 512.f) + EPS), rb = rsqrtf(sb * (1.f / 512.f) + EPS);
            u32x4 oa, ob;
            oa.x = pk2(a[0] * ra * ga[0], a[1] * ra * ga[1]); oa.y = pk2(a[2] * ra * ga[2], a[3] * ra * ga[3]); oa.z = pk2(a[4] * ra * ga[4], a[5] * ra * ga[5]); oa.w = pk2(a[6] * ra * ga[6], a[7] * ra * ga[7]);
            ob.x = pk2(bv[0] * rb * gb[0], bv[1] * rb * gb[1]); ob.y = pk2(bv[2] * rb * gb[2], bv[3] * rb * gb[3]); ob.z = pk2(bv[4] * rb * gb[4], bv[5] * rb * gb[5]); ob.w = pk2(bv[6] * rb * gb[6], bv[7] * rb * gb[7]);
            bf16* mix = MIX + (size_t)m * 1024;
            *(u32x4*)(mix + lane * 8) = oa; *(u32x4*)(mix + 512 + lane * 8) = ob; }
    }
}
typedef float f32x4r __attribute__((ext_vector_type(4)));
__device__ __forceinline__ void p_router(const Frame& F) {
    unsigned char* ws = F.ws; const int lane = F.lane, wave = F.wave;
    LAS float* lg = (LAS float*)(F.lds + wave * (16 * 52 * 4));
    LAS int* cnt_l = (LAS int*)(F.lds + 32768); LAS int* base_l = cnt_l + 32;
    const bf16* X1 = (const bf16*)(ws + WS_X1); const bf16* WR = (const bf16*)(ws + WS_WR);
    const float* brg = F.in[13]; const float* bre = F.in[15];
    int* counts = (int*)(ws + WS_CTL) + CW_COUNTS; const float* ssq1 = (const float*)(ws + CTL_SSQ1);
    if (F.tid < 32) cnt_l[F.tid] = 0;
    __syncthreads();
    for (int unit = F.vcu; unit < T / 128; unit += F.G) {
        const int tok0 = unit * 128 + wave * 16;
        f32x4 acc[3];
#pragma unroll
        for (int ct = 0; ct < 3; ++ct) acc[ct] = (f32x4){0.f, 0.f, 0.f, 0.f};
        const bf16* arow = X1 + (size_t)(tok0 + (lane & 15)) * 1024 + (lane >> 4) * 8;
        const bf16* brow = WR + (size_t)(lane & 15) * 1024 + (lane >> 4) * 8;
#pragma unroll 4
        for (int kk = 0; kk < 32; ++kk) {
            const bf16x8 a = *(const bf16x8*)(arow + kk * 32);
#pragma unroll
            for (int ct = 0; ct < 3; ++ct) {
                const bf16x8 bh = *(const bf16x8*)(brow + (size_t)(ct * 16) * 1024 + kk * 32), bl = *(const bf16x8*)(brow + (size_t)(48 + ct * 16) * 1024 + kk * 32);
                acc[ct] = __builtin_amdgcn_mfma_f32_16x16x32_bf16(a, bh, acc[ct], 0, 0, 0);
                acc[ct] = __builtin_amdgcn_mfma_f32_16x16x32_bf16(a, bl, acc[ct], 0, 0, 0);
            }
        }
#pragma unroll
        for (int ct = 0; ct < 3; ++ct)
#pragma unroll
            for (int j = 0; j < 4; ++j) lg[(4 * (lane >> 4) + j) * 52 + ct * 16 + (lane & 15)] = acc[ct][j];
        LDS_WAIT();
        int e1 = 0, e2 = 0, q1 = 0, q2 = 0; float g1 = 0.f, g2 = 0.f; const int m = tok0 + lane;
        if (lane < 16) {
            const float rs = rsqrtf(ssq1[m] * (1.f / D) + EPS);
            const LAS float* L = lg + lane * 52;
            int gi = 0; float gm = L[0] * rs + brg[0];
            float gl1 = L[1] * rs + brg[1], gl2 = L[2] * rs + brg[2], gl3 = L[3] * rs + brg[3]; const float gl0 = gm;
            if (gl1 > gm) { gm = gl1; gi = 1; } if (gl2 > gm) { gm = gl2; gi = 2; } if (gl3 > gm) { gm = gl3; gi = 3; }
            const float gs = __expf(gl0 - gm) + __expf(gl1 - gm) + __expf(gl2 - gm) + __expf(gl3 - gm);
            const float ggate = 1.f / gs;
            const LAS float* EL = L + 4 + gi * 8; const float* eb = bre + gi * 8;
            int i1 = 0; float m1 = EL[0] * rs + eb[0];
            for (int i = 1; i < 8; ++i) { const float v = EL[i] * rs + eb[i]; if (v > m1) { m1 = v; i1 = i; } }
            int i2 = -1; float m2 = -3.0e38f;
            for (int i = 0; i < 8; ++i) { const float v = EL[i] * rs + eb[i]; if (i != i1 && v > m2) { m2 = v; i2 = i; } }
            const float p2 = __expf(m2 - m1); g1 = ggate / (1.f + p2); g2 = ggate * p2 / (1.f + p2);
            e1 = gi * 8 + i1; e2 = gi * 8 + i2;
            q1 = __hip_atomic_fetch_add(cnt_l + e1, 1, __ATOMIC_RELAXED, __HIP_MEMORY_SCOPE_WORKGROUP);
            q2 = __hip_atomic_fetch_add(cnt_l + e2, 1, __ATOMIC_RELAXED, __HIP_MEMORY_SCOPE_WORKGROUP);
        }
        __syncthreads();
        if (F.tid < 32) { const int c = cnt_l[F.tid]; base_l[F.tid] = c ? atomicAdd(&counts[F.tid], c) : 0; }
        __syncthreads();
        if (lane < 16) {
            const int p1 = base_l[e1] + q1, pp2 = base_l[e2] + q2;
            ((int*)(ws + WS_TOK))[e1 * CAP + p1] = m; ((int*)(ws + WS_TOK))[e2 * CAP + pp2] = m;
            ((float*)(ws + WS_GATE))[e1 * CAP + p1] = g1; ((float*)(ws + WS_GATE))[e2 * CAP + pp2] = g2;
            ((int*)(ws + WS_AE))[m * 2] = e1; ((int*)(ws + WS_AE))[m * 2 + 1] = e2; ((int*)(ws + WS_APOS))[m * 2] = p1; ((int*)(ws + WS_APOS))[m * 2 + 1] = pp2;
        }
        __syncthreads();
        if (F.tid < 32) cnt_l[F.tid] = 0;
        __syncthreads();
    }
}
__device__ __forceinline__ void moe_tables(const Frame& F) {
    LAS int* pst = (LAS int*)(F.lds + MOE_OFF); LAS int* cnt = pst + 40;
    const int* counts = (const int*)(F.ws + WS_CTL) + CW_COUNTS;
    __syncthreads();
    if (F.tid < NE) cnt[F.tid] = counts[F.tid];
    __syncthreads();
    if (F.tid == 0) { int acc = 0; for (int e = 0; e < NE; ++e) { pst[e] = acc; acc += (cnt[e] + 255) >> 8; } pst[NE] = acc; }
    __syncthreads();
}
__device__ __forceinline__ void p_final(const Frame& F) {
    unsigned char* ws = F.ws; const int lane = F.lane; const float* __restrict__ gfin = F.in[19];
    const LAS int* pst = (const LAS int*)(F.lds + MOE_OFF);
    const int* __restrict__ AE = (const int*)(ws + WS_AE); const int* __restrict__ AP = (const int*)(ws + WS_APOS);
    const bf16* __restrict__ X1 = (const bf16*)(ws + WS_X1); const bf16* __restrict__ YB = (const bf16*)(ws + WS_YB);
    float* __restrict__ out = F.out;
    f32x4 g4[4];
#pragma unroll
    for (int j = 0; j < 2; ++j) { g4[2 * j] = *((const f32x4*)gfin + 2 * lane + 128 * j); g4[2 * j + 1] = *((const f32x4*)gfin + 2 * lane + 128 * j + 1); }
    for (int m0 = (F.vcu * NWAVES + F.wave) * 2; m0 < T; m0 += F.G * NWAVES * 2) {
        u32x4 xa[2][2], ya[2][2], yb[2][2];
#pragma unroll
        for (int q = 0; q < 2; ++q) { const int m = m0 + q;
            const int e1 = AE[m * 2], e2 = AE[m * 2 + 1];
            const int r1 = AP[m * 2] + pst[e1] * 256, r2 = AP[m * 2 + 1] + pst[e2] * 256;
#pragma unroll
            for (int j = 0; j < 2; ++j) { xa[q][j] = *((const u32x4*)(X1 + (size_t)m * 1024) + lane + 64 * j); ya[q][j] = *((const u32x4*)(YB + (size_t)r1 * 1024) + lane + 64 * j); yb[q][j] = *((const u32x4*)(YB + (size_t)r2 * 1024) + lane + 64 * j); } }
#pragma unroll
        for (int q = 0; q < 2; ++q) { const int m = m0 + q; float v[2][8]; float s = 0.f;
#pragma unroll
            for (int j = 0; j < 2; ++j) { float a[8], b[8], c[8]; unpack8(xa[q][j], a); unpack8(ya[q][j], b); unpack8(yb[q][j], c);
#pragma unroll
                for (int i = 0; i < 8; ++i) { v[j][i] = a[i] + b[i] + c[i]; s += v[j][i] * v[j][i]; } }
            s = wave_sum(s); const float rs = rsqrtf(s * (1.f / D) + EPS);
#pragma unroll
            for (int j = 0; j < 2; ++j) { f32x4 o0, o1;
                o0.x = v[j][0] * rs * g4[2 * j].x; o0.y = v[j][1] * rs * g4[2 * j].y; o0.z = v[j][2] * rs * g4[2 * j].z; o0.w = v[j][3] * rs * g4[2 * j].w;
                o1.x = v[j][4] * rs * g4[2 * j + 1].x; o1.y = v[j][5] * rs * g4[2 * j + 1].y; o1.z = v[j][6] * rs * g4[2 * j + 1].z; o1.w = v[j][7] * rs * g4[2 * j + 1].w;
                f32x4* op = (f32x4*)(out + (size_t)m * D) + 2 * lane + 128 * j; op[0] = o0; op[1] = o1; } }
    }
}

__global__ void __launch_bounds__(NWAVES * 64, 2) mk_fwd(Args args) {
    extern __shared__ __attribute__((aligned(16))) unsigned char lds_raw[];
    Frame F;
    F.lds = (LAS unsigned char*)lds_raw;
    F.tid = threadIdx.x; F.lane = F.tid & 63; F.wave = __builtin_amdgcn_readfirstlane(F.tid >> 6);
    F.G = gridDim.x; { const int bx = blockIdx.x; F.vcu = (F.G % 8 == 0) ? (bx % 8) * (F.G / 8) + bx / 8 : bx; }
    F.in = args.in; F.out = args.out; F.ws = args.ws;
    unsigned char* ws = args.ws;
    for (int u = F.tid; u < (LDS_BYTES - LDSCTL_OFF) / 4; u += NWAVES * 64) ((LAS unsigned*)(F.lds + LDSCTL_OFF))[u] = 0u;
    __syncthreads();
#if MK_SPLIT
#define GRID_BAR() do { } while (0)
#else
    volatile LAS unsigned* MISC = (volatile LAS unsigned*)(F.lds + MISC_OFF);
    XcdBarrier bar = xcd_barrier_post((unsigned*)(ws + WS_CTL) + CW_BAR, MISC + 8);
#define GRID_BAR() xcd_barrier(bar)
#endif
    const int lo = args.ph_lo, hi = args.ph_hi;
#ifndef PH_MASK
#define PH_MASK 0x3ff
#endif
#define IN(k) (((PH_MASK >> (k)) & 1) && lo <= (k) && (k) < hi)
#define BOTH(k) (IN(k) && IN((k) + 1))
    bf16* OA = (bf16*)args.out; float* LSE = (float*)(ws + WS_LSE);
    const LAS int* pst = (const LAS int*)(F.lds + MOE_OFF); const LAS int* cnt = pst + 40;

    if (IN(0)) { p_prologue(F); if (BOTH(0)) GRID_BAR(); }
    if (IN(1)) {
        PlainSched S; S.so.init(T, NINP, F.G, (int)blockIdx.x); S.A = (const bf16*)(ws + WS_XB); S.Bt = (const bf16*)(ws + WS_WI); S.lda = 1024; S.ldb = 1024; S.acol_pn = 1 << 30; S.acol_off = 0;
        EpiInProj E{ws};
        pg8::gemm_phase<EpiInProj, PlainSched, true>(F.lds, 1024, 1024, S, E);
        if (BOTH(1)) GRID_BAR();
    }
    if (IN(2)) {
        PlainSched S; S.so.init(T, 768 + 1024, F.G, (int)blockIdx.x); S.A = (const bf16*)(ws + WS_LAT); S.Bt = (const bf16*)(ws + WS_WQKV); S.lda = 512; S.ldb = 256; S.acol_pn = 3; S.acol_off = 256;
        EpiUps E{ws};
        pg8::gemm_phase<EpiUps, PlainSched, true>(F.lds, 256, 256, S, E);
        if (BOTH(2)) GRID_BAR();
    }
#ifndef ATTN_A_NAIVE
#define ATTN_A_NAIVE 0
#endif
#ifndef ATTN_B_NAIVE
#define ATTN_B_NAIVE 0
#endif
    if (IN(3)) {
        if (!(args.flags & 2)) { if (ATTN_A_NAIVE) p_attnA_naive(F, OA, LSE); else p_attnA(F, OA, LSE); }
        if (!(args.flags & 1)) { if (ATTN_B_NAIVE) p_attnB_naive(F); else p_attnB(F); }
        if (BOTH(3)) GRID_BAR(); }
    if (IN(4)) { if (ATTN_A_NAIVE) p_mixnorm<1>(F, OA, LSE); else p_mixnorm<3>(F, OA, LSE); if (BOTH(4)) GRID_BAR(); }
    if (IN(5)) {
        PlainSched S; S.so.init(T, 1024, F.G, (int)blockIdx.x); S.A = (const bf16*)(ws + WS_MIX); S.Bt = (const bf16*)(ws + WS_WO); S.lda = 1024; S.ldb = 1024; S.acol_pn = 1 << 30; S.acol_off = 0;
        EpiOut E{ws};
        pg8::gemm_phase<EpiOut, PlainSched, true>(F.lds, 1024, 1024, S, E);
        if (BOTH(5)) GRID_BAR();
    }
    if (IN(6)) { p_router(F); if (BOTH(6)) GRID_BAR(); }
    if (IN(7)) {
        moe_tables(F);
        MoeSched S; S.G = F.G; S.c = (int)blockIdx.x; S.NT = 2; S.npanels = pst[NE]; S.pst = pst; S.cnt = cnt; S.toks = (const int*)(ws + WS_TOK);
        S.A = (const bf16*)(ws + WS_X1); S.Bt = (const bf16*)(ws + WS_WGU); S.lda = 1024; S.ldb = 1024; S.bstride = (size_t)512 * 1024; S.gather = true;
        EpiGateUp E{ws, cnt};
        pg8::gemm_phase<EpiGateUp, MoeSched, true>(F.lds, 1024, 1024, S, E);
        if (BOTH(7)) GRID_BAR();
    }
    if (IN(8)) {
        moe_tables(F);
        MoeSched S; S.G = F.G; S.c = (int)blockIdx.x; S.NT = 4; S.npanels = pst[NE]; S.pst = pst; S.cnt = cnt; S.toks = (const int*)(ws + WS_TOK);
        S.A = (const bf16*)(ws + WS_HB); S.Bt = (const bf16*)(ws + WS_WD); S.lda = 256; S.ldb = 256; S.bstride = (size_t)1024 * 256; S.gather = false;
        EpiDown E{ws, cnt};
        pg8::gemm_phase<EpiDown, MoeSched, true>(F.lds, 256, 256, S, E);
        if (BOTH(8)) GRID_BAR();
    }
    if (IN(9)) { moe_tables(F); p_final(F); }
#undef IN
#undef BOTH
}
}

extern "C" void kernel_launch(void* const* d_in, const int* in_sizes, int n_in, void* d_out, int out_size, void* d_ws, size_t ws_size, hipStream_t stream) {
    static int grid = 0;
    if (grid == 0) {
        if (n_in != 20 || ws_size < WS_END || out_size != T * D) { fprintf(stderr, "kernel_launch: unexpected shapes (n_in %d, ws %zu, out %d)\n", n_in, ws_size, out_size); grid = -1; return; }
        int dev = 0, cus = 0, per_cu = 0;
        if (hipGetDevice(&dev) != hipSuccess || hipDeviceGetAttribute(&cus, hipDeviceAttributeMultiprocessorCount, dev) != hipSuccess) { grid = -1; return; }
        if (hipFuncSetAttribute((const void*)mk_fwd, hipFuncAttributeMaxDynamicSharedMemorySize, LDS_BYTES) != hipSuccess) { fprintf(stderr, "kernel_launch: hipFuncSetAttribute failed\n"); grid = -1; return; }
        if (hipOccupancyMaxActiveBlocksPerMultiprocessor(&per_cu, (const void*)mk_fwd, NWAVES * 64, LDS_BYTES) != hipSuccess || per_cu < 1) { fprintf(stderr, "kernel_launch: occupancy query says %d\n", per_cu); }
        (void)hipGetLastError();
        grid = cus;
    }
    if (grid < 0) return;
    (void)hipMemsetAsync((char*)d_ws + WS_CTL, 0, CTL_BYTES, stream);
    Args a{};
    for (int i = 0; i < 20; ++i) a.in[i] = (const float*)d_in[i];
    a.out = (float*)d_out; a.ws = (unsigned char*)d_ws;
#if MK_SPLIT
    for (int p = 0; p < NPHASE; ++p) { a.ph_lo = p; a.ph_hi = p + 1; hipLaunchKernelGGL(mk_fwd, dim3(grid), dim3(NWAVES * 64), LDS_BYTES, stream, a); }
#else
#ifndef PROBE_PREFIX
#define PROBE_PREFIX -1
#endif
#ifndef PROBE_FLAGS
#define PROBE_FLAGS 0
#endif
    if (PROBE_PREFIX >= 0) {
        a.ph_lo = 0; a.ph_hi = PROBE_PREFIX + 1; a.flags = PROBE_FLAGS;
        hipLaunchKernelGGL(mk_fwd, dim3(grid), dim3(NWAVES * 64), LDS_BYTES, stream, a);
        (void)hipMemsetAsync((char*)d_ws + WS_CTL, 0, CTL_BYTES, stream);
    }
    a.ph_lo = 0; a.ph_hi = NPHASE; a.flags = 0;
    hipLaunchKernelGGL(mk_fwd, dim3(grid), dim3(NWAVES * 64), LDS_BYTES, stream, a);
#endif
}
```

```cpp
#include <hip/hip_runtime.h>
#include <stdint.h>
#include <stdio.h>

#ifndef MK_SPLIT
#define MK_SPLIT 0
#endif

#define LAS __attribute__((address_space(3)))
#define GAS __attribute__((address_space(1)))

namespace {
typedef unsigned short bf16;
typedef short bf16x8 __attribute__((ext_vector_type(8)));
typedef float f32x4 __attribute__((ext_vector_type(4)));
typedef unsigned u32x4 __attribute__((ext_vector_type(4)));
typedef unsigned u32x2 __attribute__((ext_vector_type(2)));

constexpr int D = 1024, BATCH = 16, SEQ = 2048, T = BATCH * SEQ;
constexpr int NIN = 1952, NINP = 2048;
constexpr int NE = 32, CAP = 32768;
constexpr float EPS = 1e-6f;
constexpr float LOG2E = 1.4426950408889634f;
constexpr float QS_A = 0.125f * LOG2E;
constexpr float QS_B = 0.10206207261596577f * LOG2E;
constexpr int NWAVES = 8;
constexpr int NPHASE = 10;

constexpr size_t MiB = 1u << 20;
constexpr size_t WS_CTL = 0;
constexpr size_t CTL_BYTES = 1 * MiB;
constexpr int CW_COUNTS = 64;
constexpr int CW_BAR = 4096;
constexpr size_t CTL_SSQQ = 128 * 1024, CTL_SSQKV = 256 * 1024, CTL_SSQ1 = 384 * 1024;
constexpr size_t WS_RS0 = 2 * MiB;
constexpr size_t WS_ROPE = WS_RS0 + 512 * 1024;
constexpr size_t WS_BT = WS_ROPE + 256 * 1024;
constexpr size_t WS_AE = 3 * MiB;
constexpr size_t WS_APOS = WS_AE + 256 * 1024;
constexpr size_t WS_LSE = 4 * MiB;
constexpr size_t WS_WR = 7 * MiB;
constexpr size_t WS_WI = 8 * MiB;
constexpr size_t WS_WQKV = 12 * MiB;
constexpr size_t WS_WO = 13 * MiB;
constexpr size_t WS_WGU = 16 * MiB;
constexpr size_t WS_WD = 48 * MiB;
constexpr size_t WS_XB = 64 * MiB;
constexpr size_t WS_QA = 128 * MiB, WS_KA = 160 * MiB, WS_VA = 192 * MiB;
constexpr size_t WS_LAT = 224 * MiB;
constexpr size_t WS_QB = 256 * MiB;
constexpr size_t WS_KB = 304 * MiB, WS_VB = 336 * MiB, WS_OB = 368 * MiB;
constexpr size_t WS_MIX = 400 * MiB;
constexpr size_t WS_KR = 464 * MiB;
constexpr size_t WS_TOK = 466 * MiB;
constexpr size_t WS_GATE = 470 * MiB;
constexpr size_t WS_END = 474 * MiB;
constexpr size_t WS_X1 = 128 * MiB;
constexpr size_t WS_HB = 192 * MiB;
constexpr size_t WS_YB = 256 * MiB;

constexpr int RING_BYTES = 131072;
constexpr int LDSCTL_OFF = RING_BYTES;
constexpr int MISC_OFF = LDSCTL_OFF + 320;
constexpr int MOE_OFF = LDSCTL_OFF + 1024;
constexpr int LDS_BYTES = 147456;

__device__ __forceinline__ float bf2f(bf16 b) { return __uint_as_float(((unsigned)b) << 16); }
__device__ __forceinline__ bf16 f2bf(float f) { unsigned u = __float_as_uint(f); u += 0x7fffu + ((u >> 16) & 1u); return (bf16)(u >> 16); }
typedef float f32x2_t __attribute__((ext_vector_type(2))); typedef __bf16 bf16x2_t __attribute__((ext_vector_type(2)));
__device__ __forceinline__ unsigned cvtpk(float lo, float hi) { f32x2_t v = {lo, hi}; bf16x2_t b = __builtin_convertvector(v, bf16x2_t); return __builtin_bit_cast(unsigned, b); }
__device__ __forceinline__ unsigned pk2(float lo, float hi) { return cvtpk(lo, hi); }
__device__ __forceinline__ float wave_sum(float v) {
#pragma unroll
    for (int o = 1; o < 64; o <<= 1) v += __shfl_xor(v, o);
    return v;
}
__device__ __forceinline__ void unpack8(u32x4 v, float (&a)[8]) {
    a[0] = __uint_as_float(v.x << 16); a[1] = __uint_as_float(v.x & 0xffff0000u); a[2] = __uint_as_float(v.y << 16); a[3] = __uint_as_float(v.y & 0xffff0000u);
    a[4] = __uint_as_float(v.z << 16); a[5] = __uint_as_float(v.z & 0xffff0000u); a[6] = __uint_as_float(v.w << 16); a[7] = __uint_as_float(v.w & 0xffff0000u); }
#define LDS_WAIT() asm volatile("s_waitcnt lgkmcnt(0)" ::: "memory")

#define XB_TMO      128
#define XB_XCNT(j)  (256  + 64 * (j))
#define XB_XSUB(j)  (1280 + 64 * (j))
#define XB_XGEN(j)  (2304 + 64 * (j))
#define XB_TOP      3328
#define XB_TOPGEN   3392
#define XCD_BAR_WORDS 3456
#define XB_SPIN_CAP (1u << 18)
__device__ __forceinline__ unsigned xb_ld(unsigned* p)              { return __hip_atomic_load(p, __ATOMIC_RELAXED, __HIP_MEMORY_SCOPE_AGENT); }
__device__ __forceinline__ unsigned xb_add(unsigned* p, unsigned v) { return __hip_atomic_fetch_add(p, v, __ATOMIC_RELAXED, __HIP_MEMORY_SCOPE_AGENT); }
__device__ __forceinline__ unsigned xb_xcc_id() { return (unsigned)__builtin_amdgcn_s_getreg((3 << 11) | 20) & 0xFu; }
#define XB_SPIN(cond, bar) do { unsigned _sp = 0; while (cond) { __builtin_amdgcn_s_sleep(1); \
    if ((++_sp & 255u) == 0u) { if (xb_ld(&(bar)[XB_TMO])) break; if (_sp > XB_SPIN_CAP) { atomicAdd(&(bar)[XB_TMO], 1u); break; } } } } while (0)
struct XcdBarrier { unsigned* bar; unsigned x; volatile LAS unsigned* st; };
__device__ __forceinline__ XcdBarrier xcd_barrier_post(unsigned* bar, volatile LAS unsigned* st) {
    XcdBarrier b; b.bar = bar; b.x = xb_xcc_id(); b.st = st;
    if (threadIdx.x == 0) (void)xb_add(&bar[XB_XCNT(b.x)], 1u);
    return b;
}
__device__ __forceinline__ void xcd_barrier_complete(unsigned* bar, unsigned x, unsigned& nloc, unsigned& nx) {
    const unsigned G = gridDim.x * gridDim.y * gridDim.z;
    unsigned sum, cnt, mine, sp = 0u;
    for (;;) {
        sum = 0u; cnt = 0u; mine = 0u;
#pragma unroll
        for (unsigned j = 0; j < 16; ++j) { const unsigned c = xb_ld(&bar[XB_XCNT(j)]); sum += c; cnt += (c > 0u) ? 1u : 0u; mine = (j == x) ? c : mine; }
        if (sum == G) break;
        __builtin_amdgcn_s_sleep(1);
        if ((++sp & 255u) == 0u) { if (xb_ld(&bar[XB_TMO])) break; if (sp > XB_SPIN_CAP) { atomicAdd(&bar[XB_TMO], 1u); break; } }
    }
    nloc = mine > 0u ? mine : 1u; nx = cnt > 0u ? cnt : 1u;
}
__device__ __forceinline__ void xcd_barrier(const XcdBarrier& b) {
    asm volatile("s_waitcnt vmcnt(0)" ::: "memory");
    __syncthreads();
    if (threadIdx.x == 0) {
        unsigned* bar = b.bar;
        __builtin_amdgcn_s_waitcnt(0);
        unsigned nloc = b.st[0], nx = b.st[1];
        if (nloc == 0u) { xcd_barrier_complete(bar, b.x, nloc, nx); b.st[0] = nloc; b.st[1] = nx; }
        const unsigned old = xb_add(&bar[XB_XSUB(b.x)], 1u);
        const unsigned gen = old / nloc;
        if (old + 1u == (gen + 1u) * nloc) {
            __builtin_amdgcn_fence(__ATOMIC_RELEASE, "agent");
            asm volatile("s_waitcnt vmcnt(0)" ::: "memory");
            const unsigned og = xb_add(&bar[XB_TOP], 1u);
            const unsigned tg = og / nx;
            if (og + 1u == (tg + 1u) * nx) xb_add(&bar[XB_TOPGEN], 1u);
            else XB_SPIN(xb_ld(&bar[XB_TOPGEN]) == tg, bar);
            __builtin_amdgcn_fence(__ATOMIC_ACQUIRE, "agent");
            xb_add(&bar[XB_XGEN(b.x)], 1u);
            asm volatile("s_waitcnt vmcnt(0)" ::: "memory");
        } else {
            XB_SPIN(xb_ld(&bar[XB_XGEN(b.x)]) == gen, bar);
            __builtin_amdgcn_fence(__ATOMIC_ACQUIRE, "agent");
            asm volatile("s_waitcnt vmcnt(0)" ::: "memory");
        }
    }
    __syncthreads();
}

namespace pg8 {
constexpr int BM = 256, BK = 64, HALF = 128, HTB = HALF * BK * 2, STAGE_BYTES = 8 * HTB, NXCD = 8, WGM = 8;
__device__ __forceinline__ int lds_byte(int r, int c) { const int st = (r >> 4) * 2 + (c >> 5), rr = r & 15, cc = c & 31, ob = rr * 64 + cc * 2; return st * 1024 + (ob ^ (((ob >> 9) & 1) << 5)); }
__device__ __forceinline__ void stage_rc(int b, int& R, int& C) { const int st = b / 1024, sb = b % 1024, swz = sb ^ (((sb >> 9) & 1) << 5); R = (st >> 1) * 16 + swz / 64; C = (st & 1) * 32 + (swz % 64) / 2; }
__device__ __forceinline__ int perm32(int rho) { const int n = rho >> 4, i = rho & 15; return 8 * (i >> 2) + 4 * n + (i & 3); }
struct Unit { int pm, pn, e, lr0; };
struct StaticOrder {
    int nM, nN, nwg, G, c;
    __device__ void init(int M, int N, int G_, int c_) { nM = M / BM; nN = N / BM; nwg = nM * nN; G = G_; c = c_; }
    __device__ bool next(int i, Unit& u) const {
        const long L = (long)i * G + c; if (L >= nwg) return false;
        int wgid = (int)L; { const int q = nwg / NXCD, r = nwg % NXCD, xcd = wgid % NXCD, off = wgid / NXCD; wgid = (xcd < r ? xcd * (q + 1) : r * (q + 1) + (xcd - r) * q) + off; }
        const int nig = WGM * nN, gid = wgid / nig, fm = gid * WGM, gsz = (nM - fm) < WGM ? (nM - fm) : WGM;
        u.pm = fm + ((wgid % nig) % gsz); u.pn = (wgid % nig) / gsz; u.e = 0; u.lr0 = 0; return true;
    }
};

template <class Epi, class Sched, bool ALIGN_EPI>
__device__ __forceinline__ void gemm_phase(LAS unsigned char* lds, const int K, const int ldb, const Sched& S, const Epi& E) {
    const int tid = threadIdx.x, wid = __builtin_amdgcn_readfirstlane(tid >> 6), lane = tid & 63, wr = wid >> 2, wc = wid & 3, fr = lane & 15, fq = lane >> 4;
    const int nt = K / BK;
    int Rr[2], Cc[2]; unsigned voffB[2];
#pragma unroll
    for (int i = 0; i < 2; ++i) { stage_rc(tid * 16 + i * 8192, Rr[i], Cc[i]); const int Rb = (Rr[i] & ~31) + perm32(Rr[i] & 31); voffB[i] = (unsigned)(Rb * ldb + Cc[i]) * 2u; }
    const size_t kstep = (size_t)(BK * 2);
    const size_t hstepB = (size_t)HALF * ldb * 2;
    const unsigned ldsw = (unsigned)wid * 1024u;
    const int aoff = lds_byte(wr * 64 + fr, fq * 8), boff = lds_byte(wc * 32 + fr, fq * 8);
#define PG8_SA(b, h) (((b) * 2 + (h)) * HTB)
#define PG8_SB(b, h) ((4 + (b) * 2 + (h)) * HTB)
#define PG8_STAGE(bufoff, gbase, voff) do { _Pragma("unroll") for (int _i = 0; _i < 2; ++_i) \
        __builtin_amdgcn_global_load_lds((const unsigned*)((const char*)(gbase) + (voff)[_i]), (LAS unsigned*)(lds + (bufoff) + ldsw + _i * 8192), 16, 0, 0); } while (0)
#define PG8_LDA(dst, b, h) do { _Pragma("unroll") for (int m = 0; m < 4; ++m) _Pragma("unroll") for (int k = 0; k < 2; ++k) dst[m][k] = *(const LAS bf16x8*)(lds + PG8_SA(b, h) + aoff + m * 2048 + k * 1024); } while (0)
#define PG8_LDB(dst, b, h) do { _Pragma("unroll") for (int n = 0; n < 2; ++n) _Pragma("unroll") for (int k = 0; k < 2; ++k) dst[n][k] = *(const LAS bf16x8*)(lds + PG8_SB(b, h) + boff + n * 2048 + k * 1024); } while (0)
#define PG8_MMA(ai, bj, At, Bt) do { __builtin_amdgcn_s_setprio(1); _Pragma("unroll") for (int m = 0; m < 4; ++m) _Pragma("unroll") for (int n = 0; n < 2; ++n) _Pragma("unroll") for (int k = 0; k < 2; ++k) \
        acc[ai][bj][m][n] = __builtin_amdgcn_mfma_f32_16x16x32_bf16(Bt[n][k], At[m][k], acc[ai][bj][m][n], 0, 0, 0); __builtin_amdgcn_s_setprio(0); } while (0)
#define PG8_WAIT_V(n) asm volatile("s_waitcnt vmcnt(" #n ")" ::: "memory")
#define PG8_WAIT_L(n) asm volatile("s_waitcnt lgkmcnt(" #n ")" ::: "memory")
#define PG8_BAR __builtin_amdgcn_s_barrier()
#define PG8_SCHED __builtin_amdgcn_sched_barrier(0)
    Unit cur, nxt; int ui = 0;
    if (!S.next(0, cur)) return;
    f32x4 acc[2][2][4][2];
#pragma unroll
    for (int a = 0; a < 2; ++a)
#pragma unroll
        for (int b = 0; b < 2; ++b)
#pragma unroll
            for (int m = 0; m < 4; ++m)
#pragma unroll
                for (int n = 0; n < 2; ++n) acc[a][b][m][n] = (f32x4){0.f, 0.f, 0.f, 0.f};
    bf16x8 At[4][2], B0[2][2], B1[2][2];
    const char* cA = S.a_base(cur); const char* cB = S.b_base(cur);
    unsigned vAc[2][2], vAn[2][2], v2[2][2];
    S.a_offs(cur, Rr, Cc, vAc);
    PG8_STAGE(PG8_SB(0, 0), cB, voffB); PG8_STAGE(PG8_SB(0, 1), cB + hstepB, voffB); PG8_STAGE(PG8_SA(0, 0), cA, vAc[0]); PG8_STAGE(PG8_SA(0, 1), cA, vAc[1]);
    if (wr == 1) PG8_BAR;
    PG8_WAIT_V(2); PG8_BAR;
    PG8_STAGE(PG8_SB(1, 0), cB + kstep, voffB); PG8_STAGE(PG8_SA(1, 0), cA + kstep, vAc[0]); PG8_STAGE(PG8_SB(1, 1), cB + hstepB + kstep, voffB);
    PG8_WAIT_V(6); PG8_BAR;
    for (;;) {
        const bool has_next = S.next(ui + 1, nxt);
        const char* nA = has_next ? S.a_base(nxt) : cA; const char* nB = has_next ? S.b_base(nxt) : cB;
        if (has_next) S.a_offs(nxt, Rr, Cc, vAn);
        else {
#pragma unroll
            for (int h = 0; h < 2; ++h)
#pragma unroll
                for (int i = 0; i < 2; ++i) vAn[h][i] = vAc[h][i]; }
#pragma unroll 1
        for (int t = 0; t < nt; t += 2) {
            const bool last = (t == nt - 2);
            const char* a1 = cA + (size_t)(t + 1) * kstep;
            const char* a2 = last ? nA : cA + (size_t)(t + 2) * kstep; const char* b2 = last ? nB : cB + (size_t)(t + 2) * kstep;
            const char* a3 = a2 + kstep; const char* b3 = b2 + kstep;
#pragma unroll
            for (int h = 0; h < 2; ++h)
#pragma unroll
                for (int i = 0; i < 2; ++i) v2[h][i] = last ? vAn[h][i] : vAc[h][i];
            PG8_LDB(B0, 0, 0); PG8_LDB(B1, 0, 1); PG8_SCHED; PG8_LDA(At, 0, 0); PG8_STAGE(PG8_SA(1, 1), a1, vAc[1]);
            PG8_WAIT_V(8); PG8_WAIT_L(0); PG8_BAR; PG8_MMA(0, 0, At, B0); PG8_MMA(0, 1, At, B1); PG8_BAR; PG8_SCHED;
            PG8_LDA(At, 0, 1); PG8_STAGE(PG8_SB(0, 0), b2, voffB); PG8_STAGE(PG8_SB(0, 1), b2 + hstepB, voffB); PG8_STAGE(PG8_SA(0, 0), a2, v2[0]);
            PG8_WAIT_V(8); PG8_WAIT_L(0); PG8_BAR; PG8_MMA(1, 0, At, B0); PG8_MMA(1, 1, At, B1); PG8_BAR; PG8_SCHED;
            PG8_LDB(B0, 1, 0); PG8_LDB(B1, 1, 1); PG8_SCHED; PG8_LDA(At, 1, 0); PG8_STAGE(PG8_SA(0, 1), a2, v2[1]);
            PG8_WAIT_V(8); PG8_WAIT_L(0); PG8_BAR; PG8_MMA(0, 0, At, B0); PG8_MMA(0, 1, At, B1); PG8_BAR; PG8_SCHED;
            PG8_LDA(At, 1, 1); PG8_STAGE(PG8_SB(1, 0), b3, voffB); PG8_STAGE(PG8_SB(1, 1), b3 + hstepB, voffB); PG8_STAGE(PG8_SA(1, 0), a3, v2[0]);
            PG8_WAIT_V(8); PG8_WAIT_L(0); PG8_BAR; PG8_MMA(1, 0, At, B0); PG8_MMA(1, 1, At, B1); PG8_BAR; PG8_SCHED;
        }
        if constexpr (ALIGN_EPI) { if (wr == 0) PG8_BAR; }
        E(acc, cur, wr, wc, fr, fq);
        if (!has_next) break;
#pragma unroll
        for (int a = 0; a < 2; ++a)
#pragma unroll
            for (int b = 0; b < 2; ++b)
#pragma unroll
                for (int m = 0; m < 4; ++m)
#pragma unroll
                    for (int n = 0; n < 2; ++n) acc[a][b][m][n] = (f32x4){0.f, 0.f, 0.f, 0.f};
        cur = nxt; cA = nA; cB = nB; ++ui;
#pragma unroll
        for (int h = 0; h < 2; ++h)
#pragma unroll
            for (int i = 0; i < 2; ++i) vAc[h][i] = vAn[h][i];
        if constexpr (ALIGN_EPI) { if (wr == 1) PG8_BAR; }
    }
    PG8_WAIT_V(0);
    if constexpr (!ALIGN_EPI) { if (wr == 0) PG8_BAR; }
    PG8_BAR;
#undef PG8_SA
#undef PG8_SB
#undef PG8_STAGE
#undef PG8_LDA
#undef PG8_LDB
#undef PG8_MMA
#undef PG8_WAIT_V
#undef PG8_WAIT_L
#undef PG8_BAR
#undef PG8_SCHED
}
}
using pg8::Unit;

struct PlainSched {
    pg8::StaticOrder so; const bf16* A; const bf16* Bt; int lda, ldb; int acol_pn, acol_off;
    __device__ __forceinline__ bool next(int i, Unit& u) const { return so.next(i, u); }
    __device__ __forceinline__ const char* a_base(const Unit& u) const { return (const char*)(A + (size_t)u.pm * 256 * lda + (u.pn >= acol_pn ? acol_off : 0)); }
    __device__ __forceinline__ const char* b_base(const Unit& u) const { return (const char*)(Bt + (size_t)u.pn * 256 * ldb); }
    __device__ __forceinline__ void a_offs(const Unit&, const int (&R)[2], const int (&C)[2], unsigned (&v)[2][2]) const {
#pragma unroll
        for (int h = 0; h < 2; ++h)
#pragma unroll
            for (int i = 0; i < 2; ++i) v[h][i] = (unsigned)((h * 128 + R[i]) * lda + C[i]) * 2u; }
};
struct MoeSched {
    int G, c, NT, npanels; const LAS int* pst; const LAS int* cnt; const int* toks; const bf16* A; const bf16* Bt; int lda, ldb; size_t bstride; bool gather;
    __device__ __forceinline__ bool next(int i, Unit& u) const {
        const int L = i * G + c; if (L >= npanels * NT) return false;
        u.pm = L / NT; u.pn = L % NT; int e = 0;
#pragma unroll 1
        for (int q = 1; q < NE; ++q) e = (pst[q] <= u.pm) ? q : e;
        u.e = e; u.lr0 = (u.pm - pst[e]) * 256; return true; }
    __device__ __forceinline__ const char* a_base(const Unit& u) const { return gather ? (const char*)A : (const char*)(A + (size_t)u.pm * 256 * lda); }
    __device__ __forceinline__ const char* b_base(const Unit& u) const { return (const char*)(Bt + (size_t)u.e * bstride + (size_t)u.pn * 256 * ldb); }
    __device__ __forceinline__ void a_offs(const Unit& u, const int (&R)[2], const int (&C)[2], unsigned (&v)[2][2]) const {
        const int ce = cnt[u.e];
#pragma unroll
        for (int h = 0; h < 2; ++h)
#pragma unroll
            for (int i = 0; i < 2; ++i) {
                if (gather) { const int lrow = u.lr0 + h * 128 + R[i]; const int tok = lrow < ce ? toks[u.e * CAP + lrow] : 0; v[h][i] = (unsigned)(tok * lda + C[i]) * 2u; }
                else v[h][i] = (unsigned)((h * 128 + R[i]) * lda + C[i]) * 2u; } }
};

__device__ __forceinline__ void st8(bf16* p, f32x4 a, f32x4 b) { u32x4 o; o.x = pk2(a.x, a.y); o.y = pk2(a.z, a.w); o.z = pk2(b.x, b.y); o.w = pk2(b.z, b.w); *(u32x4*)p = o; }
__device__ __forceinline__ void st4(bf16* p, f32x4 v) { u32x2 o; o.x = pk2(v.x, v.y); o.y = pk2(v.z, v.w); *(u32x2*)p = o; }
__device__ __forceinline__ float sq4(f32x4 v) { return (v.x * v.x + v.y * v.y) + (v.z * v.z + v.w * v.w); }

struct EpiInProj {
    unsigned char* ws;
    __device__ __forceinline__ void operator()(const f32x4 (&acc)[2][2][4][2], const Unit& u, int wr, int wc, int fr, int fq) const {
        const float* rs0 = (const float*)(ws + WS_RS0);
        const int reg = u.pn >> 1;
        bf16* dst = (bf16*)(ws + (reg == 0 ? WS_QA : reg == 1 ? WS_KA : reg == 2 ? WS_VA : WS_LAT));
        const float qs = (reg == 0) ? QS_A : 1.f;
#pragma unroll
        for (int ai = 0; ai < 2; ++ai)
#pragma unroll
            for (int m = 0; m < 4; ++m) {
                const int row = u.pm * 256 + ai * 128 + wr * 64 + m * 16 + fr;
                const float rs = rs0[row]; const float sc = rs * qs;
                float ssq = 0.f;
#pragma unroll
                for (int bj = 0; bj < 2; ++bj) {
                    const int lc = (u.pn & 1) * 256 + bj * 128 + wc * 32 + fq * 8;
                    const f32x4 v0 = acc[ai][bj][m][0] * sc, v1 = acc[ai][bj][m][1] * sc;
                    st8(dst + (size_t)row * 512 + lc, v0, v1);
                    if (u.pn == 6 || (u.pn == 7 && bj == 0)) ssq += sq4(v0) + sq4(v1);
                }
                if (u.pn >= 6) {
                    ssq += __shfl_xor(ssq, 16); ssq += __shfl_xor(ssq, 32);
                    if (fq == 0) atomicAdd((float*)(ws + (u.pn == 6 ? CTL_SSQQ : CTL_SSQKV)) + row, ssq);
                    if (u.pn == 7 && wc == 0) {
                        const f32x4 x1 = acc[ai][1][m][0] * rs, x2 = acc[ai][1][m][1] * rs;
                        const float2* cs = (const float2*)(ws + WS_ROPE) + (row & (SEQ - 1)) * 16 + fq * 4;
                        f32x4 y1, y2;
#pragma unroll
                        for (int j = 0; j < 4; ++j) { const float2 c = cs[j]; y1[j] = x1[j] * c.x - x2[j] * c.y; y2[j] = x1[j] * c.y + x2[j] * c.x; }
                        bf16* kr = (bf16*)(ws + WS_KR) + (size_t)row * 32 + fq * 4;
                        st4(kr, y1); st4(kr + 16, y2);
                    }
                }
            }
    }
};
struct EpiUps {
    unsigned char* ws;
    __device__ __forceinline__ void operator()(const f32x4 (&acc)[2][2][4][2], const Unit& u, int wr, int wc, int fr, int fq) const {
        const bool isq = u.pn < 3;
        const float* ssq = (const float*)(ws + (isq ? CTL_SSQQ : CTL_SSQKV));
#pragma unroll
        for (int ai = 0; ai < 2; ++ai)
#pragma unroll
            for (int m = 0; m < 4; ++m) {
                const int row = u.pm * 256 + ai * 128 + wr * 64 + m * 16 + fr;
                const float rs = rsqrtf(ssq[row] * (isq ? (1.f / 256.f) : (1.f / 128.f)) + EPS) * (isq ? QS_B : 1.f);
#pragma unroll
                for (int bj = 0; bj < 2; ++bj) {
                    if (isq) {
                        const int cg = u.pn * 8 + bj * 4 + wc;
                        bf16* q = (bf16*)(ws + WS_QB) + (size_t)row * 768 + cg * 32;
                        f32x4 a = acc[ai][bj][m][0] * rs, b = acc[ai][bj][m][1] * rs;
                        if (cg % 3 == 2) {
                            const float2* cs = (const float2*)(ws + WS_ROPE) + (row & (SEQ - 1)) * 16 + fq * 4;
                            f32x4 y1, y2;
#pragma unroll
                            for (int j = 0; j < 4; ++j) { const float2 c = cs[j]; y1[j] = a[j] * c.x - b[j] * c.y; y2[j] = a[j] * c.y + b[j] * c.x; }
                            st4(q + fq * 4, y1); st4(q + 16 + fq * 4, y2);
                        } else st8(q + fq * 8, a, b);
                    } else {
                        const int head = (u.pn - 3) * 2 + bj;
                        bf16* dst = (bf16*)(ws + (wc < 2 ? WS_KB : WS_VB)) + (size_t)row * 512 + head * 64 + (wc & 1) * 32 + fq * 8;
                        st8(dst, acc[ai][bj][m][0] * rs, acc[ai][bj][m][1] * rs);
                    }
                }
            }
    }
};
struct EpiOut {
    unsigned char* ws;
    __device__ __forceinline__ void operator()(const f32x4 (&acc)[2][2][4][2], const Unit& u, int wr, int wc, int fr, int fq) const {
        const bf16* xb = (const bf16*)(ws + WS_XB); bf16* x1 = (bf16*)(ws + WS_X1);
#pragma unroll
        for (int ai = 0; ai < 2; ++ai)
#pragma unroll
            for (int m = 0; m < 4; ++m) {
                const int row = u.pm * 256 + ai * 128 + wr * 64 + m * 16 + fr; float ssq = 0.f;
#pragma unroll
                for (int bj = 0; bj < 2; ++bj) {
                    const size_t o = (size_t)row * 1024 + u.pn * 256 + bj * 128 + wc * 32 + fq * 8;
                    float xv[8]; unpack8(*(const u32x4*)(xb + o), xv);
                    f32x4 v0 = acc[ai][bj][m][0], v1 = acc[ai][bj][m][1];
                    v0.x += xv[0]; v0.y += xv[1]; v0.z += xv[2]; v0.w += xv[3]; v1.x += xv[4]; v1.y += xv[5]; v1.z += xv[6]; v1.w += xv[7];
                    st8(x1 + o, v0, v1); ssq += sq4(v0) + sq4(v1);
                }
                ssq += __shfl_xor(ssq, 16); ssq += __shfl_xor(ssq, 32);
                if (fq == 0) atomicAdd((float*)(ws + CTL_SSQ1) + row, ssq);
            }
    }
};
struct EpiGateUp {
    unsigned char* ws; const LAS int* cnt;
    __device__ __forceinline__ void operator()(const f32x4 (&acc)[2][2][4][2], const Unit& u, int wr, int wc, int fr, int fq) const {
        const int ce = cnt[u.e]; const int* toks = (const int*)(ws + WS_TOK) + u.e * CAP; const float* ssq1 = (const float*)(ws + CTL_SSQ1);
#pragma unroll
        for (int ai = 0; ai < 2; ++ai)
#pragma unroll
            for (int m = 0; m < 4; ++m) {
                const int lr = ai * 128 + wr * 64 + m * 16 + fr; const int lrow = u.lr0 + lr;
                const int tok = lrow < ce ? toks[lrow] : 0;
                const float rs = rsqrtf(ssq1[tok] * (1.f / D) + EPS);
                bf16* dst = (bf16*)(ws + WS_HB) + (size_t)(u.pm * 256 + lr) * 256 + u.pn * 128 + wc * 32 + fq * 8;
                f32x4 h[2];
#pragma unroll
                for (int n = 0; n < 2; ++n) { const f32x4 g = acc[ai][0][m][n] * rs, up = acc[ai][1][m][n] * rs;
#pragma unroll
                    for (int j = 0; j < 4; ++j) h[n][j] = g[j] / (1.f + __expf(-g[j])) * up[j]; }
                st8(dst, h[0], h[1]);
            }
    }
};
struct EpiDown {
    unsigned char* ws; const LAS int* cnt;
    __device__ __forceinline__ void operator()(const f32x4 (&acc)[2][2][4][2], const Unit& u, int wr, int wc, int fr, int fq) const {
        const int ce = cnt[u.e]; const float* gates = (const float*)(ws + WS_GATE) + u.e * CAP;
#pragma unroll
        for (int ai = 0; ai < 2; ++ai)
#pragma unroll
            for (int m = 0; m < 4; ++m) {
                const int lr = ai * 128 + wr * 64 + m * 16 + fr; const int lrow = u.lr0 + lr;
                const float gt = lrow < ce ? gates[lrow] : 0.f;
                bf16* dst = (bf16*)(ws + WS_YB) + (size_t)(u.pm * 256 + lr) * 1024 + u.pn * 256 + wc * 32 + fq * 8;
#pragma unroll
                for (int bj = 0; bj < 2; ++bj) st8(dst + bj * 128, acc[ai][bj][m][0] * gt, acc[ai][bj][m][1] * gt);
            }
    }
};

struct Args { const float* in[20]; float* out; unsigned char* ws; int ph_lo, ph_hi, flags, pad; };
struct Frame { LAS unsigned char* lds; int tid, lane, wave, vcu, G; const float* const* in; float* out; unsigned char* ws; };

__device__ __forceinline__ void transpose_item(const float* W, int ldw, const float* gain, bf16* WT, int ldwt, int k0, int n0, int dstrow0, LAS float* scr, int lane, bool ropeperm = false) {
#pragma unroll 8
    for (int i = 0; i < 32; ++i) { const int kk = 2 * i + (lane >> 5); float v = W[(size_t)(k0 + kk) * ldw + n0 + (lane & 31)]; if (gain) v *= gain[k0 + kk]; scr[kk * 33 + (lane & 31)] = v; }
    LDS_WAIT();
    const int c = lane & 7;
#pragma unroll
    for (int j = 0; j < 4; ++j) { const int n = (lane >> 3) + 8 * j; const LAS float* s = scr + (8 * c) * 33 + n;
        u32x4 o; o.x = pk2(s[0 * 33], s[1 * 33]); o.y = pk2(s[2 * 33], s[3 * 33]); o.z = pk2(s[4 * 33], s[5 * 33]); o.w = pk2(s[6 * 33], s[7 * 33]);
        const int dn = ropeperm ? (8 * ((n & 15) >> 2) + 4 * (n >> 4) + (n & 3)) : n;
        *(u32x4*)(WT + (size_t)(dstrow0 + dn) * ldwt + k0 + 8 * c) = o; }
    LDS_WAIT();
}

__device__ __forceinline__ void p_prologue(const Frame& F) {
    unsigned char* ws = F.ws; const int lane = F.lane;
    LAS float* scr = (LAS float*)(F.lds + F.wave * 16384);
    const int gw = F.vcu * NWAVES + F.wave, NGW = F.G * NWAVES;
    constexpr int I_IN = 16 * 61, I_Q = 4 * 24, I_KV = 2 * 32, I_O = 16 * 32, I_G = 16 * 8, I_D = 4 * 32;
    constexpr int NITEMS = I_IN + I_Q + I_KV + I_O + 64 * I_G + 32 * I_D;
    for (int it = gw; it < NITEMS; it += NGW) {
        int r = it;
        if (r < I_IN) { const int kb = r / 61, nb = r % 61; transpose_item(F.in[2], NIN, F.in[1], (bf16*)(ws + WS_WI), 1024, kb * 64, nb * 32, nb * 32, scr, lane, nb == 60); continue; } r -= I_IN;
        if (r < I_Q) { const int kb = r / 24, nb = r % 24; transpose_item(F.in[5], 768, F.in[4], (bf16*)(ws + WS_WQKV), 256, kb * 64, nb * 32, nb * 32, scr, lane, nb % 3 == 2); continue; } r -= I_Q;
        if (r < I_KV) { const int kb = r / 32, nb = r % 32; transpose_item(F.in[7], 1024, F.in[6], (bf16*)(ws + WS_WQKV), 256, kb * 64, nb * 32, 768 + nb * 32, scr, lane); continue; } r -= I_KV;
        if (r < I_O) { const int kb = r / 32, nb = r % 32; transpose_item(F.in[10], 1024, nullptr, (bf16*)(ws + WS_WO), 1024, kb * 64, nb * 32, nb * 32, scr, lane); continue; } r -= I_O;
        if (r < 64 * I_G) { const int mtx = r / I_G, q = r % I_G, e = mtx >> 1, kind = mtx & 1, kb = q / 8, nb = q % 8;
            const float* W = (kind ? F.in[17] : F.in[16]) + (size_t)e * 1024 * 256; const int n0 = nb * 32;
            transpose_item(W, 256, F.in[11], (bf16*)(ws + WS_WGU) + (size_t)e * 512 * 1024, 1024, kb * 64, n0, 256 * (n0 >> 7) + kind * 128 + (n0 & 127), scr, lane); continue; } r -= 64 * I_G;
        { const int e = r / I_D, q = r % I_D, kb = q / 32, nb = q % 32;
            transpose_item(F.in[18] + (size_t)e * 256 * 1024, 1024, nullptr, (bf16*)(ws + WS_WD) + (size_t)e * 1024 * 256, 256, kb * 64, nb * 32, nb * 32, scr, lane); }
    }
    const size_t gt = (size_t)F.vcu * 512 + F.tid, NGT = (size_t)F.G * 512;
    for (size_t i = gt; i < (size_t)96 * 1024 / 8; i += NGT) ((u32x4*)((bf16*)(ws + WS_WI) + (size_t)1952 * 1024))[i] = (u32x4){0, 0, 0, 0};
    for (size_t i = gt; i < (size_t)1024 * 16; i += NGT) { const size_t row = i >> 4, c = i & 15; *(u32x4*)((bf16*)(ws + WS_WQKV) + (768 + row) * 256 + 128 + c * 8) = (u32x4){0, 0, 0, 0}; }
    { const float* __restrict__ xin = F.in[0]; bf16* __restrict__ XBp = (bf16*)(ws + WS_XB); float* __restrict__ rs0 = (float*)(ws + WS_RS0);
    for (int m0 = gw * 2; m0 < T; m0 += NGW * 2) {
        f32x4 v[2][4];
#pragma unroll
        for (int q = 0; q < 2; ++q)
#pragma unroll
            for (int j = 0; j < 4; ++j) v[q][j] = *((const f32x4*)(xin + (size_t)(m0 + q) * D) + lane + 64 * j);
#pragma unroll
        for (int q = 0; q < 2; ++q) { float s = 0.f;
#pragma unroll
            for (int j = 0; j < 4; ++j) s += sq4(v[q][j]);
            s = wave_sum(s);
            u32x2* o8 = (u32x2*)(XBp + (size_t)(m0 + q) * D) + lane;
#pragma unroll
            for (int j = 0; j < 4; ++j) { u32x2 o; o.x = pk2(v[q][j].x, v[q][j].y); o.y = pk2(v[q][j].z, v[q][j].w); o8[64 * j] = o; }
            if (lane == 0) rs0[m0 + q] = rsqrtf(s * (1.f / D) + EPS); }
    } }
    for (size_t i = gt; i < (size_t)48 * 1024; i += NGT) { const int c = (int)(i >> 10), k = (int)(i & 1023);
        float w = 0.f; if (c < 4) w = F.in[12][k * 4 + c] * F.in[11][k]; else if (c < 36) w = F.in[14][k * 32 + c - 4] * F.in[11][k];
        const bf16 hi = f2bf(w); const bf16 lo = f2bf(w - bf2f(hi));
        ((bf16*)(ws + WS_WR))[i] = hi; ((bf16*)(ws + WS_WR))[(size_t)48 * 1024 + i] = lo; }
    for (size_t i = gt; i < (size_t)SEQ * 16; i += NGT) { const int s = (int)(i >> 4), f = (int)(i & 15);
        const float inv = (float)pow(10000.0, -(double)f / 16.0); const float ang = (float)s * inv;
        float2 cs; cs.x = (float)cos((double)ang); cs.y = (float)sin((double)ang); ((float2*)(ws + WS_ROPE))[i] = cs; }
    for (size_t i = gt; i < (size_t)3 * 8 * 132; i += NGT) { const int p = (int)(i / (8 * 132)), h = (int)((i / 132) % 8), jj = (int)(i % 132);
        float val = 0.f;
        if (jj <= 128) { const int dil = (p == 0) ? 1 : (p == 1) ? 4 : 16; const int rel = (jj - 64) * dil; const int n = rel < 0 ? -rel : rel;
            int large = 8 + (int)(log((double)(n > 1 ? n : 1) / 8.0) / log(128.0) * 8.0); if (large > 15) large = 15;
            const int bucket = (rel > 0 ? 16 : 0) + (n < 8 ? n : large);
            val = F.in[3][bucket * 8 + h] * LOG2E; }
        ((float*)(ws + WS_BT))[i] = val; }
}

__device__ __forceinline__ void p_attnA_naive(const Frame& F, bf16* OA, float* LSE) {
    unsigned char* ws = F.ws;
    const bf16* QA = (const bf16*)(ws + WS_QA); const bf16* KA = (const bf16*)(ws + WS_KA); const bf16* VA = (const bf16*)(ws + WS_VA);
    const float* BT = (const float*)(ws + WS_BT);
    for (int idx = F.vcu * 512 + F.tid; idx < T * 8; idx += F.G * 512) {
        const int s = idx & (SEQ - 1), h = (idx >> 11) & 7, b = idx >> 14;
        float q[64], o[64];
        const size_t t = (size_t)b * SEQ + s;
#pragma unroll
        for (int i = 0; i < 64; ++i) { q[i] = bf2f(QA[t * 512 + h * 64 + i]); o[i] = 0.f; }
        float m = -1e30f, l = 0.f;
        for (int p = 0; p < 3; ++p) { const int dil = (p == 0) ? 1 : (p == 1) ? 4 : 16;
            for (int j = -64; j <= 64; ++j) { const int pos = s + j * dil; if (pos < 0 || pos >= SEQ) continue;
                const bf16* kp = KA + ((size_t)b * SEQ + pos) * 512 + h * 64; const bf16* vp = VA + ((size_t)b * SEQ + pos) * 512 + h * 64;
                float sc = BT[(p * 8 + h) * 132 + j + 64];
#pragma unroll
                for (int i = 0; i < 64; ++i) sc += q[i] * bf2f(kp[i]);
                const float mn = fmaxf(m, sc), al = exp2f(m - mn), pe = exp2f(sc - mn);
                l = l * al + pe; m = mn;
#pragma unroll
                for (int i = 0; i < 64; ++i) o[i] = o[i] * al + pe * bf2f(vp[i]);
            } }
        const float il = 1.f / l;
#pragma unroll
        for (int i = 0; i < 64; ++i) OA[t * 512 + h * 64 + i] = f2bf(o[i] * il);
        LSE[t * 8 + h] = m + log2f(l);
    }
}
__device__ __forceinline__ void p_attnB_naive(const Frame& F) {
    unsigned char* ws = F.ws;
    const bf16* QB = (const bf16*)(ws + WS_QB); const bf16* KB = (const bf16*)(ws + WS_KB); const bf16* VB = (const bf16*)(ws + WS_VB); const bf16* KR = (const bf16*)(ws + WS_KR);
    for (int idx = F.vcu * 512 + F.tid; idx < T * 8; idx += F.G * 512) {
        const int s = idx & (SEQ - 1), h = (idx >> 11) & 7, b = idx >> 14;
        float q[96], o[64];
        const size_t t = (size_t)b * SEQ + s;
#pragma unroll
        for (int i = 0; i < 96; ++i) q[i] = bf2f(QB[t * 768 + h * 96 + i]);
#pragma unroll
        for (int i = 0; i < 64; ++i) o[i] = 0.f;
        float m = -1e30f, l = 0.f;
        for (int key = 0; key < SEQ; ++key) { const size_t tk = (size_t)b * SEQ + key;
            const bf16* kp = KB + tk * 512 + h * 64; const bf16* rp = KR + tk * 32; const bf16* vp = VB + tk * 512 + h * 64;
            float sc = 0.f;
#pragma unroll
            for (int i = 0; i < 64; ++i) sc += q[i] * bf2f(kp[i]);
#pragma unroll
            for (int i = 0; i < 32; ++i) sc += q[64 + i] * bf2f(rp[i]);
            const float mn = fmaxf(m, sc), al = exp2f(m - mn), pe = exp2f(sc - mn);
            l = l * al + pe; m = mn;
#pragma unroll
            for (int i = 0; i < 64; ++i) o[i] = o[i] * al + pe * bf2f(vp[i]);
        }
        const float il = 1.f / l;
#pragma unroll
        for (int i = 0; i < 64; ++i) ((bf16*)(ws + WS_OB))[t * 512 + h * 64 + i] = f2bf(o[i] * il);
    }
}

typedef float f32x16 __attribute__((ext_vector_type(16)));
typedef short s16x4 __attribute__((ext_vector_type(4)));
typedef short v4i16_t __attribute__((ext_vector_type(4)));
__device__ __forceinline__ s16x4 vtr(const LAS unsigned char* p) { return __builtin_bit_cast(s16x4, __builtin_amdgcn_ds_read_tr16_b64_v4i16((LAS v4i16_t*)p)); }
__device__ __forceinline__ int crow(int r, int hi) { return (r & 3) + 8 * (r >> 2) + 4 * hi; }
#define ATT_WAIT_BAR() asm volatile("s_waitcnt vmcnt(0) lgkmcnt(0)\n\ts_barrier" ::: "memory")
#define GLDS16(src, dst) __builtin_amdgcn_global_load_lds((const unsigned*)(src), (LAS unsigned*)(dst), 16, 0, 0)
__device__ __forceinline__ void glds16_asm(const void* gsrc, LAS unsigned char* dst) { unsigned keep; const unsigned d = (unsigned)__builtin_amdgcn_readfirstlane((int)(unsigned)(size_t)dst);
    asm volatile("s_mov_b32 %0, m0\n\ts_mov_b32 m0, %2\n\ts_nop 0\n\tglobal_load_lds_dwordx4 %1, off\n\ts_mov_b32 m0, %0" : "=&s"(keep) : "v"(gsrc), "s"(d) : "memory"); }

template <int NS>
__device__ __forceinline__ void sm_update(f32x16 (&p)[NS], float& m, float& l, f32x16& o0, f32x16& o1, bf16x8 (&pf)[2 * NS]) {
    float mx = p[0][0];
#pragma unroll
    for (int s = 0; s < NS; ++s)
#pragma unroll
        for (int r = 0; r < 16; ++r) mx = fmaxf(mx, p[s][r]);
    { auto rr = __builtin_amdgcn_permlane32_swap(__float_as_uint(mx), __float_as_uint(mx), false, false); mx = fmaxf(__uint_as_float(rr[0]), __uint_as_float(rr[1])); }
    const float mn = fmaxf(m, mx); const float al = __builtin_amdgcn_exp2f(m - mn); m = mn;
    float sum = 0.f;
#pragma unroll
    for (int s = 0; s < NS; ++s)
#pragma unroll
        for (int r = 0; r < 16; ++r) { p[s][r] = __builtin_amdgcn_exp2f(p[s][r] - mn); sum += p[s][r]; }
    l = l * al + sum;
#pragma unroll
    for (int r = 0; r < 16; ++r) { o0[r] *= al; o1[r] *= al; }
#pragma unroll
    for (int s = 0; s < NS; ++s)
#pragma unroll
        for (int k = 0; k < 2; ++k) { u32x4 w; w.x = cvtpk(p[s][8 * k + 0], p[s][8 * k + 1]); w.y = cvtpk(p[s][8 * k + 2], p[s][8 * k + 3]); w.z = cvtpk(p[s][8 * k + 4], p[s][8 * k + 5]); w.w = cvtpk(p[s][8 * k + 6], p[s][8 * k + 7]);
            pf[2 * s + k] = __builtin_bit_cast(bf16x8, w); }
}
__device__ __forceinline__ void pv_step(f32x16& o0, f32x16& o1, const LAS unsigned char* vp, int dstride, bf16x8 pfk) {
    const s16x4 a0 = vtr(vp), a1 = vtr(vp + 512), b0 = vtr(vp + dstride), b1 = vtr(vp + dstride + 512);
    const bf16x8 v0 = (bf16x8){a0[0], a0[1], a0[2], a0[3], a1[0], a1[1], a1[2], a1[3]};
    const bf16x8 v1 = (bf16x8){b0[0], b0[1], b0[2], b0[3], b1[0], b1[1], b1[2], b1[3]};
    o0 = __builtin_amdgcn_mfma_f32_32x32x16_bf16(v0, pfk, o0, 0, 0, 0);
    o1 = __builtin_amdgcn_mfma_f32_32x32x16_bf16(v1, pfk, o1, 0, 0, 0);
}
__device__ __forceinline__ void store_o(bf16* orow, const f32x16& o0, const f32x16& o1, float il, int hi) {
#pragma unroll
    for (int g = 0; g < 4; ++g) {
        u32x2 w0, w1; w0.x = cvtpk(o0[4 * g] * il, o0[4 * g + 1] * il); w0.y = cvtpk(o0[4 * g + 2] * il, o0[4 * g + 3] * il);
        w1.x = cvtpk(o1[4 * g] * il, o1[4 * g + 1] * il); w1.y = cvtpk(o1[4 * g + 2] * il, o1[4 * g + 3] * il);
        *(u32x2*)(orow + 8 * g + 4 * hi) = w0; *(u32x2*)(orow + 32 + 8 * g + 4 * hi) = w1; }
}


template <class RowPtr>
__device__ __forceinline__ void store_o_staged(LAS unsigned char* stg, const f32x16& o0, const f32x16& o1, float il, int lane, const RowPtr& rowptr) {
    const int r32 = lane & 31, hi = lane >> 5;
#pragma unroll
    for (int d0 = 0; d0 < 2; ++d0) {
        const f32x16& o = d0 ? o1 : o0;
#pragma unroll
        for (int g = 0; g < 4; ++g) { u32x2 w; w.x = cvtpk(o[4 * g] * il, o[4 * g + 1] * il); w.y = cvtpk(o[4 * g + 2] * il, o[4 * g + 3] * il);
            *(LAS u32x2*)(stg + r32 * 64 + ((g ^ ((r32 >> 1) & 3)) * 16) + hi * 8) = w; }
        LDS_WAIT();
#pragma unroll
        for (int j = 0; j < 2; ++j) { const int row = 16 * j + (lane >> 2), c = lane & 3;
            const u32x4 v = *(const LAS u32x4*)(stg + row * 64 + ((c ^ ((row >> 1) & 3)) * 16));
            *(u32x4*)(rowptr(row) + d0 * 32 + c * 8) = v; }
        LDS_WAIT();
    }
}

constexpr int B_KBUF = 12288, B_VBUF = 8192, B_VOFF = 3 * B_KBUF;
constexpr float B_THR = 8.f;
#define SBAR() __builtin_amdgcn_sched_barrier(0)
__device__ __forceinline__ void attnB_unit(const Frame& F, int b, int head, int qb) {
    unsigned char* ws = F.ws; LAS unsigned char* lds = F.lds;
    const int lane = F.lane, wave = F.wave, r32 = lane & 31, hi = lane >> 5;
    const bf16* QB = (const bf16*)(ws + WS_QB); const bf16* KB = (const bf16*)(ws + WS_KB); const bf16* VB = (const bf16*)(ws + WS_VB); const bf16* KR = (const bf16*)(ws + WS_KR);
    const size_t t0 = (size_t)b * SEQ;
    const size_t tq = t0 + qb * 256 + wave * 32 + r32;
    const int kr8 = 8 * wave + (lane >> 3), kr16 = 16 * (wave & 3) + (lane >> 2);
    const bf16* ksrc = KB + (t0 + kr8) * 512 + head * 64 + (((lane & 7) ^ ((kr8 >> 1) & 7)) * 8);
    const bf16* rsrc = KR + (t0 + kr16) * 32 + (((lane & 3) ^ ((kr16 >> 2) & 3)) * 8);
    const bf16* vsrc = VB + (t0 + kr8) * 512 + head * 64 + (((lane & 7) ^ (((kr8 >> 1) & 1) << 2)) * 8);
#define B_ISSUE_K(kt, boff) do { glds16_asm(ksrc + (size_t)(kt) * 64 * 512, lds + (boff) + wave * 1024); \
        glds16_asm(rsrc + (size_t)(kt) * 64 * 32, lds + (boff) + 8192 + (wave & 3) * 1024); } while (0)
#define B_ISSUE_V(kt, boff) glds16_asm(vsrc + (size_t)(kt) * 64 * 512, lds + B_VOFF + (boff) + wave * 1024)
    B_ISSUE_K(0, 0); B_ISSUE_V(0, 0); B_ISSUE_K(1, B_KBUF); B_ISSUE_V(1, B_VBUF); B_ISSUE_K(2, 2 * B_KBUF);
    bf16x8 qf[6];
#pragma unroll
    for (int ks = 0; ks < 6; ++ks) qf[ks] = *(const bf16x8*)(QB + tq * 768 + head * 96 + ks * 16 + hi * 8);
    float mref, l = 0.f; f32x16 o0, o1, negm;
#pragma unroll
    for (int r = 0; r < 16; ++r) { o0[r] = 0.f; o1[r] = 0.f; }
    int kad[6];
#pragma unroll
    for (int ks = 0; ks < 4; ++ks) kad[ks] = r32 * 128 + (((2 * ks + hi) ^ ((r32 >> 1) & 7)) * 16);
#pragma unroll
    for (int j = 0; j < 2; ++j) kad[4 + j] = 8192 + r32 * 64 + (((2 * j + hi) ^ ((r32 >> 2) & 3)) * 16);
    const int vq = (lane & 15) >> 2;
    const int vbo0 = (4 * hi + vq) * 128 + (((((lane >> 4) & 1) * 2 + ((lane & 3) >> 1)) ^ (((vq >> 1) & 1) << 2)) * 16) + (lane & 1) * 8;
    constexpr int NT = SEQ / 64;
    f32x16 pA0, pA1, pB0, pB1;
    ATT_WAIT_BAR();
    {
        const LAS unsigned char* kb = lds;
#pragma unroll
        for (int r = 0; r < 16; ++r) { pA0[r] = 0.f; pA1[r] = 0.f; }
#pragma unroll
        for (int ks = 0; ks < 6; ++ks) {
            const bf16x8 k0 = *(const LAS bf16x8*)(kb + kad[ks]), k1 = *(const LAS bf16x8*)(kb + kad[ks] + (ks < 4 ? 4096 : 2048));
            pA0 = __builtin_amdgcn_mfma_f32_32x32x16_bf16(k0, qf[ks], pA0, 0, 0, 0);
            pA1 = __builtin_amdgcn_mfma_f32_32x32x16_bf16(k1, qf[ks], pA1, 0, 0, 0);
        }
        float mx = pA0[0];
#pragma unroll
        for (int r = 0; r < 16; ++r) mx = fmaxf(mx, fmaxf(pA0[r], pA1[r]));
        { auto rr = __builtin_amdgcn_permlane32_swap(__float_as_uint(mx), __float_as_uint(mx), false, false); mx = fmaxf(__uint_as_float(rr[0]), __uint_as_float(rr[1])); }
        mref = mx;
#pragma unroll
        for (int r = 0; r < 16; ++r) { negm[r] = -mref; pA0[r] = __builtin_amdgcn_exp2f(pA0[r] - mref); pA1[r] = __builtin_amdgcn_exp2f(pA1[r] - mref); }
    }
    ATT_WAIT_BAR();
    bool resc = false; float fres = 1.f;
#define B_PIN(x) asm volatile("" : "+v"(x))
#define B_GAPA(MF, A0, A1, A2, WI, WA, WB, WC, WD, KRD) do { MF; sacc += A0; sacc += A1; sacc += A2; B_PIN(sacc); pw_[WI] = cvtpk(WA, WB); pw_[WI + 1] = cvtpk(WC, WD); B_PIN(pw_[WI]); B_PIN(pw_[WI + 1]); KRD; SBAR(); } while (0)
#define B_GAPA0(MF, A0, A1, A2) do { MF; sacc += A0; sacc += A1; sacc += A2; B_PIN(sacc); SBAR(); } while (0)
#define B_KRD(i_) kf_[i_] = *(const LAS bf16x8*)(kb_ + kad[(i_) >> 1] + (((i_) & 1) ? (((i_) >> 1) < 4 ? 4096 : 2048) : 0))
#define B_EX4(X, B) do { X[B] = __builtin_amdgcn_exp2f(X[B]); X[B + 1] = __builtin_amdgcn_exp2f(X[B + 1]); X[B + 2] = __builtin_amdgcn_exp2f(X[B + 2]); X[B + 3] = __builtin_amdgcn_exp2f(X[B + 3]); B_PIN(X); } while (0)
#define B_STEP(PA0, PA1, PB0, PB1, t, HASN) do { \
      \
    const int krd_ = (i3 == 2 ? 0 : i3 + 1) * B_KBUF, kwr_ = i3 * B_KBUF, vrd_ = i3 * B_VBUF, vwr_ = (i3 == 0 ? 2 : i3 - 1) * B_VBUF; \
    if ((t) + 3 < NT) B_ISSUE_K((t) + 3, kwr_); \
    if ((t) + 2 < NT) B_ISSUE_V((t) + 2, vwr_); \
    unsigned pw_[16]; float sacc = 0.f; \
    if (HASN) { \
        const LAS unsigned char* kb_ = lds + krd_; bf16x8 kf_[12]; \
        B_KRD(0); B_KRD(1); B_KRD(2); B_KRD(3); \
        SBAR(); \
        B_GAPA(PB0 = __builtin_amdgcn_mfma_f32_32x32x16_bf16(kf_[0], qf[0], negm, 0, 0, 0), PA0[0], PA0[1], PA0[2],    0, PA0[0], PA0[1], PA0[2], PA0[3],     B_KRD(4)); \
        B_GAPA(PB1 = __builtin_amdgcn_mfma_f32_32x32x16_bf16(kf_[1], qf[0], negm, 0, 0, 0), PA0[3], PA0[4], PA0[5],    2, PA0[4], PA0[5], PA0[6], PA0[7],     B_KRD(5)); \
        B_GAPA(PB0 = __builtin_amdgcn_mfma_f32_32x32x16_bf16(kf_[2], qf[1], PB0, 0, 0, 0),  PA0[6], PA0[7], PA0[8],    4, PA0[8], PA0[9], PA0[10], PA0[11],   B_KRD(6)); \
        B_GAPA(PB1 = __builtin_amdgcn_mfma_f32_32x32x16_bf16(kf_[3], qf[1], PB1, 0, 0, 0),  PA0[9], PA0[10], PA0[11],  6, PA0[12], PA0[13], PA0[14], PA0[15], B_KRD(7)); \
        B_GAPA(PB0 = __builtin_amdgcn_mfma_f32_32x32x16_bf16(kf_[4], qf[2], PB0, 0, 0, 0),  PA0[12], PA0[13], PA0[14], 8, PA1[0], PA1[1], PA1[2], PA1[3],     B_KRD(8)); \
        B_GAPA(PB1 = __builtin_amdgcn_mfma_f32_32x32x16_bf16(kf_[5], qf[2], PB1, 0, 0, 0),  PA0[15], PA1[0], PA1[1],   10, PA1[4], PA1[5], PA1[6], PA1[7],    B_KRD(9)); \
        B_GAPA(PB0 = __builtin_amdgcn_mfma_f32_32x32x16_bf16(kf_[6], qf[3], PB0, 0, 0, 0),  PA1[2], PA1[3], PA1[4],    12, PA1[8], PA1[9], PA1[10], PA1[11],  B_KRD(10)); \
        B_GAPA(PB1 = __builtin_amdgcn_mfma_f32_32x32x16_bf16(kf_[7], qf[3], PB1, 0, 0, 0),  PA1[5], PA1[6], PA1[7],    14, PA1[12], PA1[13], PA1[14], PA1[15], B_KRD(11)); \
        B_GAPA0(PB0 = __builtin_amdgcn_mfma_f32_32x32x16_bf16(kf_[8], qf[4], PB0, 0, 0, 0),  PA1[8], PA1[9], PA1[10]); \
        B_GAPA0(PB1 = __builtin_amdgcn_mfma_f32_32x32x16_bf16(kf_[9], qf[4], PB1, 0, 0, 0),  PA1[11], PA1[12], PA1[13]); \
        B_GAPA0(PB0 = __builtin_amdgcn_mfma_f32_32x32x16_bf16(kf_[10], qf[5], PB0, 0, 0, 0), PA1[14], PA1[15], 0.f); \
        PB1 = __builtin_amdgcn_mfma_f32_32x32x16_bf16(kf_[11], qf[5], PB1, 0, 0, 0); SBAR(); \
    } else { \
        _Pragma("unroll") for (int r = 0; r < 16; ++r) sacc += PA0[r] + PA1[r]; \
        _Pragma("unroll") for (int i_ = 0; i_ < 8; ++i_) { pw_[i_] = cvtpk(PA0[2 * i_], PA0[2 * i_ + 1]); pw_[8 + i_] = cvtpk(PA1[2 * i_], PA1[2 * i_ + 1]); } \
    } \
    l += sacc; \
    resc = false; \
    if (HASN) { \
        float mx_ = PB0[0]; \
        _Pragma("unroll") for (int r = 0; r < 16; ++r) mx_ = fmaxf(mx_, fmaxf(PB0[r], PB1[r])); \
        { auto rr = __builtin_amdgcn_permlane32_swap(__float_as_uint(mx_), __float_as_uint(mx_), false, false); mx_ = fmaxf(__uint_as_float(rr[0]), __uint_as_float(rr[1])); } \
        if (__builtin_expect(__any(mx_ > B_THR), 0)) { const float dl_ = fmaxf(mx_, 0.f); mref += dl_; \
            _Pragma("unroll") for (int r = 0; r < 16; ++r) { PB0[r] -= dl_; PB1[r] -= dl_; negm[r] = -mref; } \
            fres = __builtin_amdgcn_exp2f(-dl_); resc = true; } \
    } \
    SBAR(); \
    { const LAS unsigned char* vb_ = lds + B_VOFF + vrd_ + vbo0; const LAS unsigned char* vc_ = lds + B_VOFF + vrd_ + (vbo0 ^ 64); \
      const bf16x8 pf0_ = __builtin_bit_cast(bf16x8, ((u32x4){pw_[0], pw_[1], pw_[2], pw_[3]})), pf1_ = __builtin_bit_cast(bf16x8, ((u32x4){pw_[4], pw_[5], pw_[6], pw_[7]})), pf2_ = __builtin_bit_cast(bf16x8, ((u32x4){pw_[8], pw_[9], pw_[10], pw_[11]})), pf3_ = __builtin_bit_cast(bf16x8, ((u32x4){pw_[12], pw_[13], pw_[14], pw_[15]})); \
      s16x4 a0_ = vtr(vb_), a1_ = vtr(vb_ + 1024), b0_ = vtr(vc_), b1_ = vtr(vc_ + 1024), c0_, c1_, d0_, d1_; \
        \
      c0_ = vtr(vb_ + 2048); c1_ = vtr(vb_ + 2048 + 1024); d0_ = vtr(vc_ + 2048); d1_ = vtr(vc_ + 2048 + 1024); \
      o0 = __builtin_amdgcn_mfma_f32_32x32x16_bf16(((bf16x8){a0_[0], a0_[1], a0_[2], a0_[3], a1_[0], a1_[1], a1_[2], a1_[3]}), pf0_, o0, 0, 0, 0); if (HASN) B_EX4(PB0, 0); SBAR(); \
      o1 = __builtin_amdgcn_mfma_f32_32x32x16_bf16(((bf16x8){b0_[0], b0_[1], b0_[2], b0_[3], b1_[0], b1_[1], b1_[2], b1_[3]}), pf0_, o1, 0, 0, 0); if (HASN) B_EX4(PB0, 4); SBAR(); \
        \
      a0_ = vtr(vb_ + 4096); a1_ = vtr(vb_ + 4096 + 1024); b0_ = vtr(vc_ + 4096); b1_ = vtr(vc_ + 4096 + 1024); \
      o0 = __builtin_amdgcn_mfma_f32_32x32x16_bf16(((bf16x8){c0_[0], c0_[1], c0_[2], c0_[3], c1_[0], c1_[1], c1_[2], c1_[3]}), pf1_, o0, 0, 0, 0); if (HASN) B_EX4(PB0, 8); SBAR(); \
      o1 = __builtin_amdgcn_mfma_f32_32x32x16_bf16(((bf16x8){d0_[0], d0_[1], d0_[2], d0_[3], d1_[0], d1_[1], d1_[2], d1_[3]}), pf1_, o1, 0, 0, 0); if (HASN) B_EX4(PB0, 12); SBAR(); \
        \
      c0_ = vtr(vb_ + 6144); c1_ = vtr(vb_ + 6144 + 1024); d0_ = vtr(vc_ + 6144); d1_ = vtr(vc_ + 6144 + 1024); \
      o0 = __builtin_amdgcn_mfma_f32_32x32x16_bf16(((bf16x8){a0_[0], a0_[1], a0_[2], a0_[3], a1_[0], a1_[1], a1_[2], a1_[3]}), pf2_, o0, 0, 0, 0); if (HASN) B_EX4(PB1, 0); SBAR(); \
      o1 = __builtin_amdgcn_mfma_f32_32x32x16_bf16(((bf16x8){b0_[0], b0_[1], b0_[2], b0_[3], b1_[0], b1_[1], b1_[2], b1_[3]}), pf2_, o1, 0, 0, 0); if (HASN) B_EX4(PB1, 4); SBAR(); \
        \
      o0 = __builtin_amdgcn_mfma_f32_32x32x16_bf16(((bf16x8){c0_[0], c0_[1], c0_[2], c0_[3], c1_[0], c1_[1], c1_[2], c1_[3]}), pf3_, o0, 0, 0, 0); if (HASN) B_EX4(PB1, 8); SBAR(); \
      o1 = __builtin_amdgcn_mfma_f32_32x32x16_bf16(((bf16x8){d0_[0], d0_[1], d0_[2], d0_[3], d1_[0], d1_[1], d1_[2], d1_[3]}), pf3_, o1, 0, 0, 0); if (HASN) B_EX4(PB1, 12); SBAR(); \
    } \
    if (resc) { l *= fres; _Pragma("unroll") for (int r = 0; r < 16; ++r) { o0[r] *= fres; o1[r] *= fres; } } \
    i3 = (i3 == 2) ? 0 : i3 + 1; \
    } while (0)
#define B_WAIT3() asm volatile("s_waitcnt vmcnt(3) lgkmcnt(0)\n\ts_barrier" ::: "memory")
#define B_WAIT1() asm volatile("s_waitcnt vmcnt(1) lgkmcnt(0)\n\ts_barrier" ::: "memory")
    int i3 = 0;
    for (int t = 0; t + 4 < NT; t += 2) {
        B_STEP(pA0, pA1, pB0, pB1, t, true);     B_WAIT3();
        B_STEP(pB0, pB1, pA0, pA1, t + 1, true); B_WAIT3();
    }
    B_STEP(pA0, pA1, pB0, pB1, NT - 4, true);  B_WAIT3();
    B_STEP(pB0, pB1, pA0, pA1, NT - 3, true);  B_WAIT1();
    B_STEP(pA0, pA1, pB0, pB1, NT - 2, true);  ATT_WAIT_BAR();
    B_STEP(pB0, pB1, pA0, pA1, NT - 1, false);
#undef B_WAIT3
#undef B_WAIT1
#undef B_STEP
#undef B_GAPA
#undef B_GAPA0
#undef B_KRD
#undef B_PIN
#undef B_EX4
#undef B_ISSUE_K
#undef B_ISSUE_V
    { auto rr = __builtin_amdgcn_permlane32_swap(__float_as_uint(l), __float_as_uint(l), false, false); l = __uint_as_float(rr[0]) + __uint_as_float(rr[1]); }
    { bf16* obase = (bf16*)(ws + WS_OB) + (t0 + qb * 256 + wave * 32) * 512 + head * 64;
      store_o_staged(lds + B_VOFF + 3 * B_VBUF + wave * 2048, o0, o1, 1.f / l, lane, [=](int row) { return obase + (size_t)row * 512; }); }
    ATT_WAIT_BAR();
}
__device__ __forceinline__ void p_attnB(const Frame& F) {
    for (int i = 0; i < 4; ++i) { const int u = F.vcu * 4 + i; if (u >= BATCH * 8 * 8) break; const int bh = u >> 3, qb = u & 7; attnB_unit(F, bh >> 3, bh & 7, qb); }
}

constexpr int A_NSL = 384, A_KOFF = 0, A_VOFF = A_NSL * 128, A_TAB = 2 * A_NSL * 128, A_OST = A_TAB + 2048;
struct AGeo { int b, head, pat, g, dil, L, nslots; };
__device__ __forceinline__ AGeo a_geo(int vcu, int k) { AGeo q; const int bh = vcu >> 1, u = 2 * k + (vcu & 1); q.b = bh >> 3; q.head = bh & 7; q.pat = u >> 3; q.g = u & 7;
    q.dil = (q.pat == 0) ? 1 : (q.pat == 1) ? 4 : 16; q.L = SEQ / q.dil; q.nslots = (q.pat == 2) ? 256 : 384; return q; }
__device__ __forceinline__ int a_pos(const AGeo& q, int s) {
    if (q.pat == 2) return 2 * q.g + (s >> 7) + 16 * (s & 127);
    if (q.pat == 1) { int kn = 256 * (q.g & 1) - 64 + s; kn = kn < 0 ? 0 : (kn > 511 ? 511 : kn); return (q.g >> 1) + 4 * kn; }
    int kn = 256 * q.g - 64 + s; return kn < 0 ? 0 : (kn > 2047 ? 2047 : kn); }
__device__ __forceinline__ void a_issue(const Frame& F, const AGeo& q, bool isv) {
    const bf16* src = (const bf16*)(F.ws + (isv ? WS_VA : WS_KA)) + (size_t)q.b * SEQ * 512 + q.head * 64;
    const int np = q.nslots >> 3;
    for (int p = F.wave; p < np; p += 8) { const int slot = 8 * p + (F.lane >> 3);
        const int c = (F.lane & 7) ^ (isv ? (((slot >> 1) & 1) << 2) : ((slot >> 1) & 7));
        glds16_asm(src + (size_t)a_pos(q, slot) * 512 + c * 8, F.lds + (isv ? A_VOFF : A_KOFF) + p * 1024); }
}
__device__ __forceinline__ void a_wave_geo(const AGeo& q, int wave, int& c, int& n0, int& hb, int& wstart) {
    if (q.pat == 2) { c = 2 * q.g + (wave >> 2); n0 = 32 * (wave & 3); hb = 128 * (wave >> 2); wstart = 0; }
    else if (q.pat == 1) { c = q.g >> 1; n0 = 256 * (q.g & 1) + 32 * wave; hb = 0; wstart = 256 * (q.g & 1) - 64; }
    else { c = 0; n0 = 256 * q.g + 32 * wave; hb = 0; wstart = 256 * q.g - 64; } }
__device__ __forceinline__ void a_load_q(const Frame& F, const AGeo& q, bf16x8 (&qf)[4]) {
    int c, n0, hb, wstart; a_wave_geo(q, F.wave, c, n0, hb, wstart);
    const size_t tq = (size_t)q.b * SEQ + c + q.dil * (n0 + (F.lane & 31));
    const bf16* QA = (const bf16*)(F.ws + WS_QA);
#pragma unroll
    for (int ks = 0; ks < 4; ++ks) qf[ks] = *(const bf16x8*)(QA + tq * 512 + q.head * 64 + ks * 16 + (F.lane >> 5) * 8);
}
__device__ __forceinline__ void a_write_tab(const Frame& F, const AGeo& q, int tsel) {
    LAS float* tab = (LAS float*)(F.lds + A_TAB) + tsel * 192;
    if (F.tid < 192) { const int idx = F.tid - 32; tab[F.tid] = (idx >= 0 && idx <= 128) ? ((const float*)(F.ws + WS_BT))[(q.pat * 8 + q.head) * 132 + idx] : -INFINITY; }
}
__device__ __forceinline__ void p_attnA(const Frame& F, bf16* OA, float* LSE) {
    if ((F.vcu >> 1) >= BATCH * 8) return;
    LAS unsigned char* lds = F.lds;
    const int lane = F.lane, wave = F.wave, r32 = lane & 31, hi = lane >> 5;
    int kad[4];
#pragma unroll
    for (int ks = 0; ks < 4; ++ks) kad[ks] = r32 * 128 + (((2 * ks + hi) ^ ((r32 >> 1) & 7)) * 16);
    const int vq = (lane & 15) >> 2;
    const int vbo0 = (4 * hi + vq) * 128 + (((((lane >> 4) & 1) * 2 + ((lane & 3) >> 1)) ^ (((vq >> 1) & 1) << 2)) * 16) + (lane & 1) * 8;
    constexpr int NU = 12;
    AGeo q = a_geo(F.vcu, 0);
    a_issue(F, q, false); a_issue(F, q, true); a_write_tab(F, q, 0);
    bf16x8 qf[4]; a_load_q(F, q, qf);
    ATT_WAIT_BAR();
#pragma unroll 1
    for (int k = 0; k < NU; ++k) {
        int c, n0, hb, wstart; a_wave_geo(q, wave, c, n0, hb, wstart);
        const LAS float* tb = (const LAS float*)(lds + A_TAB) + (k & 1) * 192 + (32 + 4 * hi - r32);
        f32x16 p[5]; bool val[5];
#pragma unroll
        for (int i = 0; i < 5; ++i) {
            const int kt0 = n0 - 64 + 32 * i; val[i] = (kt0 >= 0 && kt0 < q.L);
            if (val[i]) {
                const LAS unsigned char* kb = lds + A_KOFF + (hb + kt0 - wstart) * 128;
#pragma unroll
                for (int r = 0; r < 16; ++r) p[i][r] = 0.f;
#pragma unroll
                for (int ks = 0; ks < 4; ++ks) { const bf16x8 kf = *(const LAS bf16x8*)(kb + kad[ks]); p[i] = __builtin_amdgcn_mfma_f32_32x32x16_bf16(kf, qf[ks], p[i], 0, 0, 0); }
#pragma unroll
                for (int r = 0; r < 16; ++r) p[i][r] += tb[32 * i + (r & 3) + 8 * (r >> 2)];
            } else {
#pragma unroll
                for (int r = 0; r < 16; ++r) p[i][r] = -INFINITY;
            }
        }
        ATT_WAIT_BAR();
        AGeo qn = q; bf16x8 qfn[4];
        if (k + 1 < NU) { qn = a_geo(F.vcu, k + 1); a_issue(F, qn, false); a_load_q(F, qn, qfn); a_write_tab(F, qn, (k + 1) & 1); }
        float mx = p[0][0];
#pragma unroll
        for (int i = 0; i < 5; ++i)
#pragma unroll
            for (int r = 0; r < 16; ++r) mx = fmaxf(mx, p[i][r]);
        { auto rr = __builtin_amdgcn_permlane32_swap(__float_as_uint(mx), __float_as_uint(mx), false, false); mx = fmaxf(__uint_as_float(rr[0]), __uint_as_float(rr[1])); }
        float l = 0.f; f32x16 o0, o1;
#pragma unroll
        for (int r = 0; r < 16; ++r) { o0[r] = 0.f; o1[r] = 0.f; }
#pragma unroll
        for (int i = 0; i < 5; ++i) {
            if (val[i]) {
#pragma unroll
                for (int r = 0; r < 16; ++r) { p[i][r] = __builtin_amdgcn_exp2f(p[i][r] - mx); l += p[i][r]; }
                const int kt0 = n0 - 64 + 32 * i;
                const LAS unsigned char* vb = lds + A_VOFF + (hb + kt0 - wstart) * 128;
#pragma unroll
                for (int s2 = 0; s2 < 2; ++s2) {
                    u32x4 w; w.x = cvtpk(p[i][8 * s2 + 0], p[i][8 * s2 + 1]); w.y = cvtpk(p[i][8 * s2 + 2], p[i][8 * s2 + 3]); w.z = cvtpk(p[i][8 * s2 + 4], p[i][8 * s2 + 5]); w.w = cvtpk(p[i][8 * s2 + 6], p[i][8 * s2 + 7]);
                    const bf16x8 pf = __builtin_bit_cast(bf16x8, w);
                    const LAS unsigned char* v0p = vb + s2 * 2048 + vbo0; const LAS unsigned char* v1p = vb + s2 * 2048 + (vbo0 ^ 64);
                    const s16x4 a0 = vtr(v0p), a1 = vtr(v0p + 1024), b0 = vtr(v1p), b1 = vtr(v1p + 1024);
                    o0 = __builtin_amdgcn_mfma_f32_32x32x16_bf16(((bf16x8){a0[0], a0[1], a0[2], a0[3], a1[0], a1[1], a1[2], a1[3]}), pf, o0, 0, 0, 0);
                    o1 = __builtin_amdgcn_mfma_f32_32x32x16_bf16(((bf16x8){b0[0], b0[1], b0[2], b0[3], b1[0], b1[1], b1[2], b1[3]}), pf, o1, 0, 0, 0);
                }
            }
        }
        { auto rr = __builtin_amdgcn_permlane32_swap(__float_as_uint(l), __float_as_uint(l), false, false); l = __uint_as_float(rr[0]) + __uint_as_float(rr[1]); }
        const size_t tq0 = (size_t)q.pat * T + (size_t)q.b * SEQ + c + q.dil * n0;
        { bf16* obase = OA + tq0 * 512 + q.head * 64; const int rstride = q.dil * 512;
          store_o_staged(lds + A_OST + wave * 2048, o0, o1, 1.f / l, lane, [=](int row) { return obase + (size_t)row * rstride; }); }
        if (hi == 0) LSE[(tq0 + q.dil * r32) * 8 + q.head] = mx + __builtin_amdgcn_logf(l);
        ATT_WAIT_BAR();
        if (k + 1 < NU) { a_issue(F, qn, true);
#pragma unroll
            for (int ks = 0; ks < 4; ++ks) qf[ks] = qfn[ks];
            q = qn; }
    }
}
template <int NP>
__device__ __forceinline__ void p_mixnorm(const Frame& F, const bf16* __restrict__ OA, const float* __restrict__ LSE) {
    unsigned char* ws = F.ws; const int lane = F.lane;
    const bf16* __restrict__ OBp = (const bf16*)(ws + WS_OB); bf16* __restrict__ MIX = (bf16*)(ws + WS_MIX);
    float ga[8], gb[8];
#pragma unroll
    for (int i = 0; i < 8; ++i) { ga[i] = F.in[8][lane * 8 + i]; gb[i] = F.in[9][lane * 8 + i]; }
    const int head = lane >> 3;
    for (int m0 = (F.vcu * NWAVES + F.wave) * 2; m0 < T; m0 += F.G * NWAVES * 2) {
        u32x4 pa[2][NP], pb[2]; float w[2][NP];
#pragma unroll
        for (int q = 0; q < 2; ++q) { const int m = m0 + q;
#pragma unroll
            for (int p = 0; p < NP; ++p) { pa[q][p] = *(const u32x4*)(OA + ((size_t)p * T + m) * 512 + lane * 8); w[q][p] = LSE[((size_t)p * T + m) * 8 + head]; }
            pb[q] = *(const u32x4*)(OBp + (size_t)m * 512 + lane * 8); }
#pragma unroll
        for (int q = 0; q < 2; ++q) { const int m = m0 + q; float a[8], mx = -1e30f;
#pragma unroll
            for (int p = 0; p < NP; ++p) mx = fmaxf(mx, w[q][p]);
            float wsum = 0.f;
#pragma unroll
            for (int p = 0; p < NP; ++p) { w[q][p] = exp2f(w[q][p] - mx); wsum += w[q][p]; }
            const float iw = 1.f / wsum;
#pragma unroll
            for (int i = 0; i < 8; ++i) a[i] = 0.f;
#pragma unroll
            for (int p = 0; p < NP; ++p) { float t8[8]; unpack8(pa[q][p], t8); const float ww = w[q][p] * iw;
#pragma unroll
                for (int i = 0; i < 8; ++i) a[i] += ww * t8[i]; }
            float bv[8]; unpack8(pb[q], bv);
            float sa = 0.f, sb = 0.f;
#pragma unroll
            for (int i = 0; i < 8; ++i) { sa += a[i] * a[i]; sb += bv[i] * bv[i]; }
            sa = wave_sum(sa); sb = wave_sum(sb);
            const float ra = rsqrtf(sa * (1.f / 512.f) + EPS), rb = rsqrtf(sb * (1.f / 512.f) + EPS);
            u32x4 oa, ob;
            oa.x = pk2(a[0] * ra * ga[0], a[1] * ra * ga[1]); oa.y = pk2(a[2] * ra * ga[2], a[3] * ra * ga[3]); oa.z = pk2(a[4] * ra * ga[4], a[5] * ra * ga[5]); oa.w = pk2(a[6] * ra * ga[6], a[7] * ra * ga[7]);
            ob.x = pk2(bv[0] * rb * gb[0], bv[1] * rb * gb[1]); ob.y = pk2(bv[2] * rb * gb[2], bv[3] * rb * gb[3]); ob.z = pk2(bv[4] * rb * gb[4], bv[5] * rb * gb[5]); ob.w = pk2(bv[6] * rb * gb[6], bv[7] * rb * gb[7]);
            bf16* mix = MIX + (size_t)m * 1024;
            *(u32x4*)(mix + lane * 8) = oa; *(u32x4*)(mix + 512 + lane * 8) = ob; }
    }
}
typedef float f32x4r __attribute__((ext_vector_type(4)));
__device__ __forceinline__ void p_router(const Frame& F) {
    unsigned char* ws = F.ws; const int lane = F.lane, wave = F.wave;
    LAS float* lg = (LAS float*)(F.lds + wave * (16 * 52 * 4));
    LAS int* cnt_l = (LAS int*)(F.lds + 32768); LAS int* base_l = cnt_l + 32;
    const bf16* X1 = (const bf16*)(ws + WS_X1); const bf16* WR = (const bf16*)(ws + WS_WR);
    const float* brg = F.in[13]; const float* bre = F.in[15];
    int* counts = (int*)(ws + WS_CTL) + CW_COUNTS; const float* ssq1 = (const float*)(ws + CTL_SSQ1);
    if (F.tid < 32) cnt_l[F.tid] = 0;
    __syncthreads();
    for (int unit = F.vcu; unit < T / 128; unit += F.G) {
        const int tok0 = unit * 128 + wave * 16;
        f32x4 acc[3];
#pragma unroll
        for (int ct = 0; ct < 3; ++ct) acc[ct] = (f32x4){0.f, 0.f, 0.f, 0.f};
        const bf16* arow = X1 + (size_t)(tok0 + (lane & 15)) * 1024 + (lane >> 4) * 8;
        const bf16* brow = WR + (size_t)(lane & 15) * 1024 + (lane >> 4) * 8;
#pragma unroll 4
        for (int kk = 0; kk < 32; ++kk) {
            const bf16x8 a = *(const bf16x8*)(arow + kk * 32);
#pragma unroll
            for (int ct = 0; ct < 3; ++ct) {
                const bf16x8 bh = *(const bf16x8*)(brow + (size_t)(ct * 16) * 1024 + kk * 32), bl = *(const bf16x8*)(brow + (size_t)(48 + ct * 16) * 1024 + kk * 32);
                acc[ct] = __builtin_amdgcn_mfma_f32_16x16x32_bf16(a, bh, acc[ct], 0, 0, 0);
                acc[ct] = __builtin_amdgcn_mfma_f32_16x16x32_bf16(a, bl, acc[ct], 0, 0, 0);
            }
        }
#pragma unroll
        for (int ct = 0; ct < 3; ++ct)
#pragma unroll
            for (int j = 0; j < 4; ++j) lg[(4 * (lane >> 4) + j) * 52 + ct * 16 + (lane & 15)] = acc[ct][j];
        LDS_WAIT();
        int e1 = 0, e2 = 0, q1 = 0, q2 = 0; float g1 = 0.f, g2 = 0.f; const int m = tok0 + lane;
        if (lane < 16) {
            const float rs = rsqrtf(ssq1[m] * (1.f / D) + EPS);
            const LAS float* L = lg + lane * 52;
            int gi = 0; float gm = L[0] * rs + brg[0];
            float gl1 = L[1] * rs + brg[1], gl2 = L[2] * rs + brg[2], gl3 = L[3] * rs + brg[3]; const float gl0 = gm;
            if (gl1 > gm) { gm = gl1; gi = 1; } if (gl2 > gm) { gm = gl2; gi = 2; } if (gl3 > gm) { gm = gl3; gi = 3; }
            const float gs = __expf(gl0 - gm) + __expf(gl1 - gm) + __expf(gl2 - gm) + __expf(gl3 - gm);
            const float ggate = 1.f / gs;
            const LAS float* EL = L + 4 + gi * 8; const float* eb = bre + gi * 8;
            int i1 = 0; float m1 = EL[0] * rs + eb[0];
            for (int i = 1; i < 8; ++i) { const float v = EL[i] * rs + eb[i]; if (v > m1) { m1 = v; i1 = i; } }
            int i2 = -1; float m2 = -3.0e38f;
            for (int i = 0; i < 8; ++i) { const float v = EL[i] * rs + eb[i]; if (i != i1 && v > m2) { m2 = v; i2 = i; } }
            const float p2 = __expf(m2 - m1); g1 = ggate / (1.f + p2); g2 = ggate * p2 / (1.f + p2);
            e1 = gi * 8 + i1; e2 = gi * 8 + i2;
            q1 = __hip_atomic_fetch_add(cnt_l + e1, 1, __ATOMIC_RELAXED, __HIP_MEMORY_SCOPE_WORKGROUP);
            q2 = __hip_atomic_fetch_add(cnt_l + e2, 1, __ATOMIC_RELAXED, __HIP_MEMORY_SCOPE_WORKGROUP);
        }
        __syncthreads();
        if (F.tid < 32) { const int c = cnt_l[F.tid]; base_l[F.tid] = c ? atomicAdd(&counts[F.tid], c) : 0; }
        __syncthreads();
        if (lane < 16) {
            const int p1 = base_l[e1] + q1, pp2 = base_l[e2] + q2;
            ((int*)(ws + WS_TOK))[e1 * CAP + p1] = m; ((int*)(ws + WS_TOK))[e2 * CAP + pp2] = m;
            ((float*)(ws + WS_GATE))[e1 * CAP + p1] = g1; ((float*)(ws + WS_GATE))[e2 * CAP + pp2] = g2;
            ((int*)(ws + WS_AE))[m * 2] = e1; ((int*)(ws + WS_AE))[m * 2 + 1] = e2; ((int*)(ws + WS_APOS))[m * 2] = p1; ((int*)(ws + WS_APOS))[m * 2 + 1] = pp2;
        }
        __syncthreads();
        if (F.tid < 32) cnt_l[F.tid] = 0;
        __syncthreads();
    }
}
__device__ __forceinline__ void moe_tables(const Frame& F) {
    LAS int* pst = (LAS int*)(F.lds + MOE_OFF); LAS int* cnt = pst + 40;
    const int* counts = (const int*)(F.ws + WS_CTL) + CW_COUNTS;
    __syncthreads();
    if (F.tid < NE) cnt[F.tid] = counts[F.tid];
    __syncthreads();
    if (F.tid == 0) { int acc = 0; for (int e = 0; e < NE; ++e) { pst[e] = acc; acc += (cnt[e] + 255) >> 8; } pst[NE] = acc; }
    __syncthreads();
}
__device__ __forceinline__ void p_final(const Frame& F) {
    unsigned char* ws = F.ws; const int lane = F.lane; const float* __restrict__ gfin = F.in[19];
    const LAS int* pst = (const LAS int*)(F.lds + MOE_OFF);
    const int* __restrict__ AE = (const int*)(ws + WS_AE); const int* __restrict__ AP = (const int*)(ws + WS_APOS);
    const bf16* __restrict__ X1 = (const bf16*)(ws + WS_X1); const bf16* __restrict__ YB = (const bf16*)(ws + WS_YB);
    float* __restrict__ out = F.out;
    f32x4 g4[4];
#pragma unroll
    for (int j = 0; j < 2; ++j) { g4[2 * j] = *((const f32x4*)gfin + 2 * lane + 128 * j); g4[2 * j + 1] = *((const f32x4*)gfin + 2 * lane + 128 * j + 1); }
    for (int m0 = (F.vcu * NWAVES + F.wave) * 2; m0 < T; m0 += F.G * NWAVES * 2) {
        u32x4 xa[2][2], ya[2][2], yb[2][2];
#pragma unroll
        for (int q = 0; q < 2; ++q) { const int m = m0 + q;
            const int e1 = AE[m * 2], e2 = AE[m * 2 + 1];
            const int r1 = AP[m * 2] + pst[e1] * 256, r2 = AP[m * 2 + 1] + pst[e2] * 256;
#pragma unroll
            for (int j = 0; j < 2; ++j) { xa[q][j] = *((const u32x4*)(X1 + (size_t)m * 1024) + lane + 64 * j); ya[q][j] = *((const u32x4*)(YB + (size_t)r1 * 1024) + lane + 64 * j); yb[q][j] = *((const u32x4*)(YB + (size_t)r2 * 1024) + lane + 64 * j); } }
#pragma unroll
        for (int q = 0; q < 2; ++q) { const int m = m0 + q; float v[2][8]; float s = 0.f;
#pragma unroll
            for (int j = 0; j < 2; ++j) { float a[8], b[8], c[8]; unpack8(xa[q][j], a); unpack8(ya[q][j], b); unpack8(yb[q][j], c);
#pragma unroll
                for (int i = 0; i < 8; ++i) { v[j][i] = a[i] + b[i] + c[i]; s += v[j][i] * v[j][i]; } }
            s = wave_sum(s); const float rs = rsqrtf(s * (1.f / D) + EPS);
#pragma unroll
            for (int j = 0; j < 2; ++j) { f32x4 o0, o1;
                o0.x = v[j][0] * rs * g4[2 * j].x; o0.y = v[j][1] * rs * g4[2 * j].y; o0.z = v[j][2] * rs * g4[2 * j].z; o0.w = v[j][3] * rs * g4[2 * j].w;
                o1.x = v[j][4] * rs * g4[2 * j + 1].x; o1.y = v[j][5] * rs * g4[2 * j + 1].y; o1.z = v[j][6] * rs * g4[2 * j + 1].z; o1.w = v[j][7] * rs * g4[2 * j + 1].w;
                f32x4* op = (f32x4*)(out + (size_t)m * D) + 2 * lane + 128 * j; op[0] = o0; op[1] = o1; } }
    }
}

__global__ void __launch_bounds__(NWAVES * 64, 2) mk_fwd(Args args) {
    extern __shared__ __attribute__((aligned(16))) unsigned char lds_raw[];
    Frame F;
    F.lds = (LAS unsigned char*)lds_raw;
    F.tid = threadIdx.x; F.lane = F.tid & 63; F.wave = __builtin_amdgcn_readfirstlane(F.tid >> 6);
    F.G = gridDim.x; { const int bx = blockIdx.x; F.vcu = (F.G % 8 == 0) ? (bx % 8) * (F.G / 8) + bx / 8 : bx; }
    F.in = args.in; F.out = args.out; F.ws = args.ws;
    unsigned char* ws = args.ws;
    for (int u = F.tid; u < (LDS_BYTES - LDSCTL_OFF) / 4; u += NWAVES * 64) ((LAS unsigned*)(F.lds + LDSCTL_OFF))[u] = 0u;
    __syncthreads();
#if MK_SPLIT
#define GRID_BAR() do { } while (0)
#else
    volatile LAS unsigned* MISC = (volatile LAS unsigned*)(F.lds + MISC_OFF);
    XcdBarrier bar = xcd_barrier_post((unsigned*)(ws + WS_CTL) + CW_BAR, MISC + 8);
#define GRID_BAR() xcd_barrier(bar)
#endif
    const int lo = args.ph_lo, hi = args.ph_hi;
#ifndef PH_MASK
#define PH_MASK 0x3ff
#endif
#define IN(k) (((PH_MASK >> (k)) & 1) && lo <= (k) && (k) < hi)
#define BOTH(k) (IN(k) && IN((k) + 1))
    bf16* OA = (bf16*)args.out; float* LSE = (float*)(ws + WS_LSE);
    const LAS int* pst = (const LAS int*)(F.lds + MOE_OFF); const LAS int* cnt = pst + 40;

    if (IN(0)) { p_prologue(F); if (BOTH(0)) GRID_BAR(); }
    if (IN(1)) {
        PlainSched S; S.so.init(T, NINP, F.G, (int)blockIdx.x); S.A = (const bf16*)(ws + WS_XB); S.Bt = (const bf16*)(ws + WS_WI); S.lda = 1024; S.ldb = 1024; S.acol_pn = 1 << 30; S.acol_off = 0;
        EpiInProj E{ws};
        pg8::gemm_phase<EpiInProj, PlainSched, true>(F.lds, 1024, 1024, S, E);
        if (BOTH(1)) GRID_BAR();
    }
    if (IN(2)) {
        PlainSched S; S.so.init(T, 768 + 1024, F.G, (int)blockIdx.x); S.A = (const bf16*)(ws + WS_LAT); S.Bt = (const bf16*)(ws + WS_WQKV); S.lda = 512; S.ldb = 256; S.acol_pn = 3; S.acol_off = 256;
        EpiUps E{ws};
        pg8::gemm_phase<EpiUps, PlainSched, true>(F.lds, 256, 256, S, E);
        if (BOTH(2)) GRID_BAR();
    }
#ifndef ATTN_A_NAIVE
#define ATTN_A_NAIVE 0
#endif
#ifndef ATTN_B_NAIVE
#define ATTN_B_NAIVE 0
#endif
    if (IN(3)) {
        if (!(args.flags & 2)) { if (ATTN_A_NAIVE) p_attnA_naive(F, OA, LSE); else p_attnA(F, OA, LSE); }
        if (!(args.flags & 1)) { if (ATTN_B_NAIVE) p_attnB_naive(F); else p_attnB(F); }
        if (BOTH(3)) GRID_BAR(); }
    if (IN(4)) { if (ATTN_A_NAIVE) p_mixnorm<1>(F, OA, LSE); else p_mixnorm<3>(F, OA, LSE); if (BOTH(4)) GRID_BAR(); }
    if (IN(5)) {
        PlainSched S; S.so.init(T, 1024, F.G, (int)blockIdx.x); S.A = (const bf16*)(ws + WS_MIX); S.Bt = (const bf16*)(ws + WS_WO); S.lda = 1024; S.ldb = 1024; S.acol_pn = 1 << 30; S.acol_off = 0;
        EpiOut E{ws};
        pg8::gemm_phase<EpiOut, PlainSched, true>(F.lds, 1024, 1024, S, E);
        if (BOTH(5)) GRID_BAR();
    }
    if (IN(6)) { p_router(F); if (BOTH(6)) GRID_BAR(); }
    if (IN(7)) {
        moe_tables(F);
        MoeSched S; S.G = F.G; S.c = (int)blockIdx.x; S.NT = 2; S.npanels = pst[NE]; S.pst = pst; S.cnt = cnt; S.toks = (const int*)(ws + WS_TOK);
        S.A = (const bf16*)(ws + WS_X1); S.Bt = (const bf16*)(ws + WS_WGU); S.lda = 1024; S.ldb = 1024; S.bstride = (size_t)512 * 1024; S.gather = true;
        EpiGateUp E{ws, cnt};
        pg8::gemm_phase<EpiGateUp, MoeSched, true>(F.lds, 1024, 1024, S, E);
        if (BOTH(7)) GRID_BAR();
    }
    if (IN(8)) {
        moe_tables(F);
        MoeSched S; S.G = F.G; S.c = (int)blockIdx.x; S.NT = 4; S.npanels = pst[NE]; S.pst = pst; S.cnt = cnt; S.toks = (const int*)(ws + WS_TOK);
        S.A = (const bf16*)(ws + WS_HB); S.Bt = (const bf16*)(ws + WS_WD); S.lda = 256; S.ldb = 256; S.bstride = (size_t)1024 * 256; S.gather = false;
        EpiDown E{ws, cnt};
        pg8::gemm_phase<EpiDown, MoeSched, true>(F.lds, 256, 256, S, E);
        if (BOTH(8)) GRID_BAR();
    }
    if (IN(9)) { moe_tables(F); p_final(F); }
#undef IN
#undef BOTH
}
}

extern "C" void kernel_launch(void* const* d_in, const int* in_sizes, int n_in, void* d_out, int out_size, void* d_ws, size_t ws_size, hipStream_t stream) {
    static int grid = 0;
    if (grid == 0) {
        if (n_in != 20 || ws_size < WS_END || out_size != T * D) { fprintf(stderr, "kernel_launch: unexpected shapes (n_in %d, ws %zu, out %d)\n", n_in, ws_size, out_size); grid = -1; return; }
        int dev = 0, cus = 0, per_cu = 0;
        if (hipGetDevice(&dev) != hipSuccess || hipDeviceGetAttribute(&cus, hipDeviceAttributeMultiprocessorCount, dev) != hipSuccess) { grid = -1; return; }
        if (hipFuncSetAttribute((const void*)mk_fwd, hipFuncAttributeMaxDynamicSharedMemorySize, LDS_BYTES) != hipSuccess) { fprintf(stderr, "kernel_launch: hipFuncSetAttribute failed\n"); grid = -1; return; }
        if (hipOccupancyMaxActiveBlocksPerMultiprocessor(&per_cu, (const void*)mk_fwd, NWAVES * 64, LDS_BYTES) != hipSuccess || per_cu < 1) { fprintf(stderr, "kernel_launch: occupancy query says %d\n", per_cu); }
        (void)hipGetLastError();
        grid = cus;
    }
    if (grid < 0) return;
    (void)hipMemsetAsync((char*)d_ws + WS_CTL, 0, CTL_BYTES, stream);
    Args a{};
    for (int i = 0; i < 20; ++i) a.in[i] = (const float*)d_in[i];
    a.out = (float*)d_out; a.ws = (unsigned char*)d_ws;
#if MK_SPLIT
    for (int p = 0; p < NPHASE; ++p) { a.ph_lo = p; a.ph_hi = p + 1; hipLaunchKernelGGL(mk_fwd, dim3(grid), dim3(NWAVES * 64), LDS_BYTES, stream, a); }
#else
#ifndef PROBE_PREFIX
#define PROBE_PREFIX -1
#endif
#ifndef PROBE_FLAGS
#define PROBE_FLAGS 0
#endif
    if (PROBE_PREFIX >= 0) {
        a.ph_lo = 0; a.ph_hi = PROBE_PREFIX + 1; a.flags = PROBE_FLAGS;
        hipLaunchKernelGGL(mk_fwd, dim3(grid), dim3(NWAVES * 64), LDS_BYTES, stream, a);
        (void)hipMemsetAsync((char*)d_ws + WS_CTL, 0, CTL_BYTES, stream);
    }
    a.ph_lo = 0; a.ph_hi = NPHASE; a.flags = 0;
    hipLaunchKernelGGL(mk_fwd, dim3(grid), dim3(NWAVES * 64), LDS_BYTES, stream, a);
#endif
}
```

```cpp
#include <hip/hip_runtime.h>
#include <stdint.h>
#include <stdio.h>

#ifndef PROBE_ABL
#define PROBE_ABL 0
#endif
#ifndef MK_SPLIT
#define MK_SPLIT 0
#endif

#define LAS __attribute__((address_space(3)))
#define GAS __attribute__((address_space(1)))

namespace {
typedef unsigned short bf16;
typedef short bf16x8 __attribute__((ext_vector_type(8)));
typedef float f32x4 __attribute__((ext_vector_type(4)));
typedef unsigned u32x4 __attribute__((ext_vector_type(4)));
typedef unsigned u32x2 __attribute__((ext_vector_type(2)));

constexpr int D = 1024, BATCH = 16, SEQ = 2048, T = BATCH * SEQ;
constexpr int NIN = 1952, NINP = 2048;
constexpr int NE = 32, CAP = 32768;
constexpr float EPS = 1e-6f;
constexpr float LOG2E = 1.4426950408889634f;
constexpr float QS_A = 0.125f * LOG2E;
constexpr float QS_B = 0.10206207261596577f * LOG2E;
constexpr int NWAVES = 8;
constexpr int NPHASE = 10;

constexpr size_t MiB = 1u << 20;
constexpr size_t WS_CTL = 0;
constexpr size_t CTL_BYTES = 1 * MiB;
constexpr int CW_COUNTS = 64;
constexpr int CW_BAR = 4096;
constexpr size_t CTL_SSQQ = 128 * 1024, CTL_SSQKV = 256 * 1024, CTL_SSQ1 = 384 * 1024;
constexpr size_t WS_RS0 = 2 * MiB;
constexpr size_t WS_ROPE = WS_RS0 + 512 * 1024;
constexpr size_t WS_BT = WS_ROPE + 256 * 1024;
constexpr size_t WS_BIMG = WS_BT + 16 * 1024;
constexpr size_t WS_AE = 3 * MiB;
constexpr size_t WS_APOS = WS_AE + 256 * 1024;
constexpr size_t WS_LSE = 4 * MiB;
constexpr size_t WS_WR = 7 * MiB;
constexpr size_t WS_WI = 8 * MiB;
constexpr size_t WS_WQKV = 12 * MiB;
constexpr size_t WS_WO = 13 * MiB;
constexpr size_t WS_WGU = 16 * MiB;
constexpr size_t WS_WD = 48 * MiB;
constexpr size_t WS_XB = 64 * MiB;
constexpr size_t WS_QA = 128 * MiB, WS_KA = 160 * MiB, WS_VA = 192 * MiB;
constexpr size_t WS_LAT = 224 * MiB;
constexpr size_t WS_QB = 256 * MiB;
constexpr size_t WS_KB = 304 * MiB, WS_VB = 336 * MiB, WS_OB = 368 * MiB;
constexpr size_t WS_MIX = 400 * MiB;
constexpr size_t WS_KR = 464 * MiB;
constexpr size_t WS_TOK = 466 * MiB;
constexpr size_t WS_GATE = 470 * MiB;
constexpr size_t WS_END = 474 * MiB;
constexpr size_t WS_X1 = 128 * MiB;
constexpr size_t WS_HB = 192 * MiB;
constexpr size_t WS_YB = 256 * MiB;

constexpr int RING_BYTES = 131072;
constexpr int LDSCTL_OFF = RING_BYTES;
constexpr int MISC_OFF = LDSCTL_OFF + 320;
constexpr int MOE_OFF = LDSCTL_OFF + 1024;
constexpr int LDS_BYTES = 147456;

__device__ __forceinline__ float bf2f(bf16 b) { return __uint_as_float(((unsigned)b) << 16); }
__device__ __forceinline__ bf16 f2bf(float f) { unsigned u = __float_as_uint(f); u += 0x7fffu + ((u >> 16) & 1u); return (bf16)(u >> 16); }
typedef float f32x2_t __attribute__((ext_vector_type(2))); typedef __bf16 bf16x2_t __attribute__((ext_vector_type(2)));
__device__ __forceinline__ unsigned cvtpk(float lo, float hi) { f32x2_t v = {lo, hi}; bf16x2_t b = __builtin_convertvector(v, bf16x2_t); return __builtin_bit_cast(unsigned, b); }
__device__ __forceinline__ unsigned pk2(float lo, float hi) { return cvtpk(lo, hi); }
__device__ __forceinline__ float wave_sum(float v) {
#pragma unroll
    for (int o = 1; o < 64; o <<= 1) v += __shfl_xor(v, o);
    return v;
}
__device__ __forceinline__ void unpack8(u32x4 v, float (&a)[8]) {
    a[0] = __uint_as_float(v.x << 16); a[1] = __uint_as_float(v.x & 0xffff0000u); a[2] = __uint_as_float(v.y << 16); a[3] = __uint_as_float(v.y & 0xffff0000u);
    a[4] = __uint_as_float(v.z << 16); a[5] = __uint_as_float(v.z & 0xffff0000u); a[6] = __uint_as_float(v.w << 16); a[7] = __uint_as_float(v.w & 0xffff0000u); }
#define LDS_WAIT() asm volatile("s_waitcnt lgkmcnt(0)" ::: "memory")

#define XB_TMO      128
#define XB_XCNT(j)  (256  + 64 * (j))
#define XB_XSUB(j)  (1280 + 64 * (j))
#define XB_XGEN(j)  (2304 + 64 * (j))
#define XB_TOP      3328
#define XB_TOPGEN   3392
#define XCD_BAR_WORDS 3456
#define XB_SPIN_CAP (1u << 18)
__device__ __forceinline__ unsigned xb_ld(unsigned* p)              { return __hip_atomic_load(p, __ATOMIC_RELAXED, __HIP_MEMORY_SCOPE_AGENT); }
__device__ __forceinline__ unsigned xb_add(unsigned* p, unsigned v) { return __hip_atomic_fetch_add(p, v, __ATOMIC_RELAXED, __HIP_MEMORY_SCOPE_AGENT); }
__device__ __forceinline__ unsigned xb_xcc_id() { return (unsigned)__builtin_amdgcn_s_getreg((3 << 11) | 20) & 0xFu; }
#define XB_SPIN(cond, bar) do { unsigned _sp = 0; while (cond) { __builtin_amdgcn_s_sleep(1); \
    if ((++_sp & 255u) == 0u) { if (xb_ld(&(bar)[XB_TMO])) break; if (_sp > XB_SPIN_CAP) { atomicAdd(&(bar)[XB_TMO], 1u); break; } } } } while (0)
struct XcdBarrier { unsigned* bar; unsigned x; volatile LAS unsigned* st; };
__device__ __forceinline__ XcdBarrier xcd_barrier_post(unsigned* bar, volatile LAS unsigned* st) {
    XcdBarrier b; b.bar = bar; b.x = xb_xcc_id(); b.st = st;
    if (threadIdx.x == 0) (void)xb_add(&bar[XB_XCNT(b.x)], 1u);
    return b;
}
__device__ __forceinline__ void xcd_barrier_complete(unsigned* bar, unsigned x, unsigned& nloc, unsigned& nx) {
    const unsigned G = gridDim.x * gridDim.y * gridDim.z;
    unsigned sum, cnt, mine, sp = 0u;
    for (;;) {
        sum = 0u; cnt = 0u; mine = 0u;
#pragma unroll
        for (unsigned j = 0; j < 16; ++j) { const unsigned c = xb_ld(&bar[XB_XCNT(j)]); sum += c; cnt += (c > 0u) ? 1u : 0u; mine = (j == x) ? c : mine; }
        if (sum == G) break;
        __builtin_amdgcn_s_sleep(1);
        if ((++sp & 255u) == 0u) { if (xb_ld(&bar[XB_TMO])) break; if (sp > XB_SPIN_CAP) { atomicAdd(&bar[XB_TMO], 1u); break; } }
    }
    nloc = mine > 0u ? mine : 1u; nx = cnt > 0u ? cnt : 1u;
}
__device__ __forceinline__ void xcd_barrier(const XcdBarrier& b) {
    asm volatile("s_waitcnt vmcnt(0)" ::: "memory");
    __syncthreads();
    if (threadIdx.x == 0) {
        unsigned* bar = b.bar;
        __builtin_amdgcn_s_waitcnt(0);
        unsigned nloc = b.st[0], nx = b.st[1];
        if (nloc == 0u) { xcd_barrier_complete(bar, b.x, nloc, nx); b.st[0] = nloc; b.st[1] = nx; }
        const unsigned old = xb_add(&bar[XB_XSUB(b.x)], 1u);
        const unsigned gen = old / nloc;
        if (old + 1u == (gen + 1u) * nloc) {
            __builtin_amdgcn_fence(__ATOMIC_RELEASE, "agent");
            asm volatile("s_waitcnt vmcnt(0)" ::: "memory");
            const unsigned og = xb_add(&bar[XB_TOP], 1u);
            const unsigned tg = og / nx;
            if (og + 1u == (tg + 1u) * nx) xb_add(&bar[XB_TOPGEN], 1u);
            else XB_SPIN(xb_ld(&bar[XB_TOPGEN]) == tg, bar);
            __builtin_amdgcn_fence(__ATOMIC_ACQUIRE, "agent");
            xb_add(&bar[XB_XGEN(b.x)], 1u);
            asm volatile("s_waitcnt vmcnt(0)" ::: "memory");
        } else {
            XB_SPIN(xb_ld(&bar[XB_XGEN(b.x)]) == gen, bar);
            __builtin_amdgcn_fence(__ATOMIC_ACQUIRE, "agent");
            asm volatile("s_waitcnt vmcnt(0)" ::: "memory");
        }
    }
    __syncthreads();
}

namespace pg8 {
constexpr int BM = 256, BK = 64, HALF = 128, HTB = HALF * BK * 2, STAGE_BYTES = 8 * HTB, NXCD = 8, WGM = 8;
__device__ __forceinline__ int lds_byte(int r, int c) { const int st = (r >> 4) * 2 + (c >> 5), rr = r & 15, cc = c & 31, ob = rr * 64 + cc * 2; return st * 1024 + (ob ^ (((ob >> 9) & 1) << 5)); }
__device__ __forceinline__ void stage_rc(int b, int& R, int& C) { const int st = b / 1024, sb = b % 1024, swz = sb ^ (((sb >> 9) & 1) << 5); R = (st >> 1) * 16 + swz / 64; C = (st & 1) * 32 + (swz % 64) / 2; }
__device__ __forceinline__ int perm32(int rho) { const int n = rho >> 4, i = rho & 15; return 8 * (i >> 2) + 4 * n + (i & 3); }
struct Unit { int pm, pn, e, lr0, half; };
struct StaticOrder {
    int nM, nN, nwg, G, c;
    __device__ void init(int M, int N, int G_, int c_) { nM = M / BM; nN = N / BM; nwg = nM * nN; G = G_; c = c_; }
    __device__ bool next(int i, Unit& u) const {
        const long L = (long)i * G + c; if (L >= nwg) return false;
        int wgid = (int)L; { const int q = nwg / NXCD, r = nwg % NXCD, xcd = wgid % NXCD, off = wgid / NXCD; wgid = (xcd < r ? xcd * (q + 1) : r * (q + 1) + (xcd - r) * q) + off; }
        const int nig = WGM * nN, gid = wgid / nig, fm = gid * WGM, gsz = (nM - fm) < WGM ? (nM - fm) : WGM;
        u.pm = fm + ((wgid % nig) % gsz); u.pn = (wgid % nig) / gsz; u.e = 0; u.lr0 = 0; u.half = 0; return true;
    }
};

template <class Epi, class Sched, bool ALIGN_EPI, bool HALFM = false>
__device__ __forceinline__ void gemm_phase(LAS unsigned char* lds, const int K, const int ldb, const Sched& S, const Epi& E, const bool nomma = false, const bool nostage = false) {
    const int tid = threadIdx.x, wid = __builtin_amdgcn_readfirstlane(tid >> 6), lane = tid & 63, wr = wid >> 2, wc = wid & 3, fr = lane & 15, fq = lane >> 4;
    const int nt = K / BK;
    int Rr[2], Cc[2]; unsigned voffB[2];
#pragma unroll
    for (int i = 0; i < 2; ++i) { stage_rc(tid * 16 + i * 8192, Rr[i], Cc[i]); const int Rb = (Rr[i] & ~31) + perm32(Rr[i] & 31); voffB[i] = (unsigned)(Rb * ldb + Cc[i]) * 2u; }
    const size_t kstep = (size_t)(BK * 2);
    const size_t hstepB = (size_t)HALF * ldb * 2;
    const unsigned ldsw = (unsigned)wid * 1024u;
    const int aoff = lds_byte(wr * 64 + fr, fq * 8), boff = lds_byte(wc * 32 + fr, fq * 8);
#define PG8_SA(b, h) (((b) * 2 + (h)) * HTB)
#define PG8_SB(b, h) ((4 + (b) * 2 + (h)) * HTB)
#define PG8_STAGE(bufoff, gbase, voff) do { if (nostage) break; _Pragma("unroll") for (int _i = 0; _i < 2; ++_i) \
        __builtin_amdgcn_global_load_lds((const unsigned*)((const char*)(gbase) + (voff)[_i]), (LAS unsigned*)(lds + (bufoff) + ldsw + _i * 8192), 16, 0, 0); } while (0)
#define PG8_LDA(dst, b, h) do { _Pragma("unroll") for (int m = 0; m < 4; ++m) _Pragma("unroll") for (int k = 0; k < 2; ++k) dst[m][k] = *(const LAS bf16x8*)(lds + PG8_SA(b, h) + aoff + m * 2048 + k * 1024); } while (0)
#define PG8_LDB(dst, b, h) do { _Pragma("unroll") for (int n = 0; n < 2; ++n) _Pragma("unroll") for (int k = 0; k < 2; ++k) dst[n][k] = *(const LAS bf16x8*)(lds + PG8_SB(b, h) + boff + n * 2048 + k * 1024); } while (0)
#define PG8_MMA(ai, bj, At, Bt) do { if (nomma) { asm volatile("" :: "v"(At[0][0]), "v"(At[3][1]), "v"(Bt[0][0]), "v"(Bt[1][1])); break; } __builtin_amdgcn_s_setprio(1); _Pragma("unroll") for (int m = 0; m < 4; ++m) _Pragma("unroll") for (int n = 0; n < 2; ++n) _Pragma("unroll") for (int k = 0; k < 2; ++k) \
        acc[ai][bj][m][n] = __builtin_amdgcn_mfma_f32_16x16x32_bf16(Bt[n][k], At[m][k], acc[ai][bj][m][n], 0, 0, 0); __builtin_amdgcn_s_setprio(0); } while (0)
#define PG8_WAIT_V(n) asm volatile("s_waitcnt vmcnt(" #n ")" ::: "memory")
#define PG8_WAIT_L(n) asm volatile("s_waitcnt lgkmcnt(" #n ")" ::: "memory")
#define PG8_BAR __builtin_amdgcn_s_barrier()
#define PG8_SCHED __builtin_amdgcn_sched_barrier(0)
    Unit cur, nxt; int ui = 0;
    if (!S.next(0, cur)) return;
    f32x4 acc[2][2][4][2];
#pragma unroll
    for (int a = 0; a < 2; ++a)
#pragma unroll
        for (int b = 0; b < 2; ++b)
#pragma unroll
            for (int m = 0; m < 4; ++m)
#pragma unroll
                for (int n = 0; n < 2; ++n) acc[a][b][m][n] = (f32x4){0.f, 0.f, 0.f, 0.f};
    bf16x8 At[4][2], B0[2][2], B1[2][2];
    const char* cA = S.a_base(cur); const char* cB = S.b_base(cur);
    unsigned vAc[2][2], vAn[2][2], v2[2][2];
    S.a_offs(cur, Rr, Cc, vAc);
    PG8_STAGE(PG8_SB(0, 0), cB, voffB); PG8_STAGE(PG8_SB(0, 1), cB + hstepB, voffB); PG8_STAGE(PG8_SA(0, 0), cA, vAc[0]); PG8_STAGE(PG8_SA(0, 1), cA, vAc[1]);
    if (wr == 1) PG8_BAR;
    PG8_WAIT_V(2); PG8_BAR;
    PG8_STAGE(PG8_SB(1, 0), cB + kstep, voffB); PG8_STAGE(PG8_SA(1, 0), cA + kstep, vAc[0]); PG8_STAGE(PG8_SB(1, 1), cB + hstepB + kstep, voffB);
    PG8_WAIT_V(6); PG8_BAR;
    for (;;) {
        const bool has_next = S.next(ui + 1, nxt);
        const char* nA = has_next ? S.a_base(nxt) : cA; const char* nB = has_next ? S.b_base(nxt) : cB;
        if (has_next) S.a_offs(nxt, Rr, Cc, vAn);
        else {
#pragma unroll
            for (int h = 0; h < 2; ++h)
#pragma unroll
                for (int i = 0; i < 2; ++i) vAn[h][i] = vAc[h][i]; }
#pragma unroll 1
        for (int t = 0; t < nt; t += 2) {
            const bool last = (t == nt - 2);
            const char* a1 = cA + (size_t)(t + 1) * kstep;
            const char* a2 = last ? nA : cA + (size_t)(t + 2) * kstep; const char* b2 = last ? nB : cB + (size_t)(t + 2) * kstep;
            const char* a3 = a2 + kstep; const char* b3 = b2 + kstep;
#pragma unroll
            for (int h = 0; h < 2; ++h)
#pragma unroll
                for (int i = 0; i < 2; ++i) v2[h][i] = last ? vAn[h][i] : vAc[h][i];
            PG8_LDB(B0, 0, 0); PG8_LDB(B1, 0, 1); PG8_SCHED; PG8_LDA(At, 0, 0); PG8_STAGE(PG8_SA(1, 1), a1, vAc[1]);
            PG8_WAIT_V(8); PG8_WAIT_L(0); PG8_BAR; PG8_MMA(0, 0, At, B0); PG8_MMA(0, 1, At, B1); PG8_BAR; PG8_SCHED;
            if constexpr (!HALFM) { PG8_LDA(At, 0, 1); } PG8_STAGE(PG8_SB(0, 0), b2, voffB); PG8_STAGE(PG8_SB(0, 1), b2 + hstepB, voffB); PG8_STAGE(PG8_SA(0, 0), a2, v2[0]);
            PG8_WAIT_V(8); PG8_WAIT_L(0); PG8_BAR; if constexpr (!HALFM) { PG8_MMA(1, 0, At, B0); PG8_MMA(1, 1, At, B1); } PG8_BAR; PG8_SCHED;
            PG8_LDB(B0, 1, 0); PG8_LDB(B1, 1, 1); PG8_SCHED; PG8_LDA(At, 1, 0); PG8_STAGE(PG8_SA(0, 1), a2, v2[1]);
            PG8_WAIT_V(8); PG8_WAIT_L(0); PG8_BAR; PG8_MMA(0, 0, At, B0); PG8_MMA(0, 1, At, B1); PG8_BAR; PG8_SCHED;
            if constexpr (!HALFM) { PG8_LDA(At, 1, 1); } PG8_STAGE(PG8_SB(1, 0), b3, voffB); PG8_STAGE(PG8_SB(1, 1), b3 + hstepB, voffB); PG8_STAGE(PG8_SA(1, 0), a3, v2[0]);
            PG8_WAIT_V(8); PG8_WAIT_L(0); PG8_BAR; if constexpr (!HALFM) { PG8_MMA(1, 0, At, B0); PG8_MMA(1, 1, At, B1); } PG8_BAR; PG8_SCHED;
        }
        if constexpr (ALIGN_EPI) { if (wr == 0) PG8_BAR; }
        if constexpr (!HALFM) cur.half = 0; else cur.half = (cur.half == 2) ? 2 : 1;
        E(acc, cur, wr, wc, fr, fq);
        if (!has_next) break;
#pragma unroll
        for (int a = 0; a < 2; ++a)
#pragma unroll
            for (int b = 0; b < 2; ++b)
#pragma unroll
                for (int m = 0; m < 4; ++m)
#pragma unroll
                    for (int n = 0; n < 2; ++n) acc[a][b][m][n] = (f32x4){0.f, 0.f, 0.f, 0.f};
        cur = nxt; cA = nA; cB = nB; ++ui;
#pragma unroll
        for (int h = 0; h < 2; ++h)
#pragma unroll
            for (int i = 0; i < 2; ++i) vAc[h][i] = vAn[h][i];
        if constexpr (ALIGN_EPI) { if (wr == 1) PG8_BAR; }
    }
    PG8_WAIT_V(0);
    if constexpr (!ALIGN_EPI) { if (wr == 0) PG8_BAR; }
    PG8_BAR;
#undef PG8_SA
#undef PG8_SB
#undef PG8_STAGE
#undef PG8_LDA
#undef PG8_LDB
#undef PG8_MMA
#undef PG8_WAIT_V
#undef PG8_WAIT_L
#undef PG8_BAR
#undef PG8_SCHED
}
}
using pg8::Unit;

struct PlainSched {
    pg8::StaticOrder so; const bf16* A; const bf16* Bt; int lda, ldb; int acol_pn, acol_off;
    __device__ __forceinline__ bool next(int i, Unit& u) const { return so.next(i, u); }
    __device__ __forceinline__ const char* a_base(const Unit& u) const { return (const char*)(A + (size_t)u.pm * 256 * lda + (u.pn >= acol_pn ? acol_off : 0)); }
    __device__ __forceinline__ const char* b_base(const Unit& u) const { return (const char*)(Bt + (size_t)u.pn * 256 * ldb); }
    __device__ __forceinline__ void a_offs(const Unit&, const int (&R)[2], const int (&C)[2], unsigned (&v)[2][2]) const {
#pragma unroll
        for (int h = 0; h < 2; ++h)
#pragma unroll
            for (int i = 0; i < 2; ++i) v[h][i] = (unsigned)((h * 128 + R[i]) * lda + C[i]) * 2u; }
};
struct PairSched {
    int pm, pn0; const bf16* A; const bf16* Bt; int lda, ldb;
    __device__ __forceinline__ bool next(int i, Unit& u) const { if (i >= 2) return false; u.pm = pm; u.pn = pn0 + i; u.e = 0; u.lr0 = 0; u.half = 0; return true; }
    __device__ __forceinline__ const char* a_base(const Unit& u) const { return (const char*)(A + (size_t)u.pm * 256 * lda); }
    __device__ __forceinline__ const char* b_base(const Unit& u) const { return (const char*)(Bt + (size_t)u.pn * 256 * ldb); }
    __device__ __forceinline__ void a_offs(const Unit&, const int (&R)[2], const int (&C)[2], unsigned (&v)[2][2]) const {
#pragma unroll
        for (int h = 0; h < 2; ++h)
#pragma unroll
            for (int i = 0; i < 2; ++i) v[h][i] = (unsigned)((h * 128 + R[i]) * lda + C[i]) * 2u; }
};
struct MoeSched {
    int G, c, NT, npanels; const LAS int* pst; const LAS int* cnt; const int* toks; const bf16* A; const bf16* Bt; int lda, ldb; size_t bstride; bool gather; int mode;
    __device__ __forceinline__ int rem() const { return (npanels * NT) % G; }
    __device__ __forceinline__ bool split() const { const int r = rem(); return r > 0 && 2 * r <= G; }
    __device__ __forceinline__ int tail_wgs() const { return split() ? 2 * rem() : rem(); }
    __device__ __forceinline__ bool next(int i, Unit& u) const {
        const int nu = npanels * NT, full = nu - rem(); int L;
        if (mode == 0) { L = i * G + c; if (L >= (split() ? full : nu)) return false; u.half = 0; }
        else { if (i > 0 || !split() || c >= 2 * rem()) return false; L = full + (c >> 1); u.half = 1 + (c & 1); }
        u.pm = L / NT; u.pn = L % NT; int e = 0;
#pragma unroll 1
        for (int q = 1; q < NE; ++q) e = (pst[q] <= u.pm) ? q : e;
        u.e = e; u.lr0 = (u.pm - pst[e]) * 256; return true; }
    __device__ __forceinline__ const char* a_base(const Unit& u) const { return gather ? (const char*)A : (const char*)(A + (size_t)u.pm * 256 * lda); }
    __device__ __forceinline__ const char* b_base(const Unit& u) const { return (const char*)(Bt + (size_t)u.e * bstride + (size_t)u.pn * 256 * ldb); }
    __device__ __forceinline__ void a_offs(const Unit& u, const int (&R)[2], const int (&C)[2], unsigned (&v)[2][2]) const {
        const int ce = cnt[u.e];
#pragma unroll
        for (int h = 0; h < 2; ++h)
#pragma unroll
            for (int i = 0; i < 2; ++i) {
                const int hh = (u.half == 2) ? 1 : h;
                if (gather) { const int lrow = u.lr0 + hh * 128 + R[i]; const int tok = toks[u.e * CAP + (lrow < ce ? lrow : 0)]; v[h][i] = (unsigned)(tok * lda + C[i]) * 2u; }
                else v[h][i] = (unsigned)((hh * 128 + R[i]) * lda + C[i]) * 2u; } }
};

#ifndef ST8_SC1
#define ST8_SC1 0
#endif
__device__ __forceinline__ void st8(bf16* p, f32x4 a, f32x4 b) { u32x4 o; o.x = pk2(a.x, a.y); o.y = pk2(a.z, a.w); o.z = pk2(b.x, b.y); o.w = pk2(b.z, b.w);
    if (ST8_SC1) asm volatile("global_store_dwordx4 %0, %1, off sc1\n\ts_nop 1" :: "v"(p), "v"(o) : "memory"); else *(u32x4*)p = o; }
__device__ __forceinline__ void st4(bf16* p, f32x4 v) { u32x2 o; o.x = pk2(v.x, v.y); o.y = pk2(v.z, v.w); *(u32x2*)p = o; }
__device__ __forceinline__ float sq4(f32x4 v) { return (v.x * v.x + v.y * v.y) + (v.z * v.z + v.w * v.w); }

struct EpiInProj {
    unsigned char* ws;
    __device__ __forceinline__ void operator()(const f32x4 (&acc)[2][2][4][2], const Unit& u, int wr, int wc, int fr, int fq) const {
        const float* __restrict__ rs0 = (const float*)(ws + WS_RS0);
        const int reg = u.pn >> 1;
        bf16* __restrict__ dst = (bf16*)(ws + (reg == 0 ? WS_QA : reg == 1 ? WS_KA : reg == 2 ? WS_VA : WS_LAT));
        const float qs = (reg == 0) ? QS_A : 1.f;
        const int row0 = u.pm * 256 + wr * 64 + fr;
        float rsv[2][4];
#pragma unroll
        for (int ai = 0; ai < 2; ++ai)
#pragma unroll
            for (int m = 0; m < 4; ++m) rsv[ai][m] = rs0[row0 + ai * 128 + m * 16];
        const bool isrope = (u.pn == 7 && wc == 0);
        float2 csv[2][4][4];
        if (isrope) {
#pragma unroll
            for (int ai = 0; ai < 2; ++ai)
#pragma unroll
                for (int m = 0; m < 4; ++m) { const float2* cs = (const float2*)(ws + WS_ROPE) + ((row0 + ai * 128 + m * 16) & (SEQ - 1)) * 16 + fq * 4;
#pragma unroll
                    for (int j = 0; j < 4; ++j) csv[ai][m][j] = cs[j]; }
        }
#pragma unroll
        for (int ai = 0; ai < 2; ++ai)
#pragma unroll
            for (int m = 0; m < 4; ++m) {
                const int row = row0 + ai * 128 + m * 16;
                const float rs = rsv[ai][m]; const float sc = rs * qs;
                float ssq = 0.f;
#pragma unroll
                for (int bj = 0; bj < 2; ++bj) {
                    const int lc = (u.pn & 1) * 256 + bj * 128 + wc * 32 + fq * 8;
                    const f32x4 v0 = acc[ai][bj][m][0] * sc, v1 = acc[ai][bj][m][1] * sc;
                    st8(dst + (size_t)row * 512 + lc, v0, v1);
                    if (u.pn == 6 || (u.pn == 7 && bj == 0)) ssq += sq4(v0) + sq4(v1);
                }
                if (u.pn >= 6) {
                    ssq += __shfl_xor(ssq, 16); ssq += __shfl_xor(ssq, 32);
                    if (fq == 0) atomicAdd((float*)(ws + (u.pn == 6 ? CTL_SSQQ : CTL_SSQKV)) + row, ssq);
                    if (isrope) {
                        const f32x4 x1 = acc[ai][1][m][0] * rs, x2 = acc[ai][1][m][1] * rs;
                        f32x4 y1, y2;
#pragma unroll
                        for (int j = 0; j < 4; ++j) { const float2 c = csv[ai][m][j]; y1[j] = x1[j] * c.x - x2[j] * c.y; y2[j] = x1[j] * c.y + x2[j] * c.x; }
                        bf16* kr = (bf16*)(ws + WS_KR) + (size_t)row * 32 + fq * 4;
                        st4(kr, y1); st4(kr + 16, y2);
                    }
                }
            }
    }
};
struct EpiUps {
    unsigned char* ws;
    __device__ __forceinline__ void operator()(const f32x4 (&acc)[2][2][4][2], const Unit& u, int wr, int wc, int fr, int fq) const {
        const bool isq = u.pn < 3;
        const float* __restrict__ ssq = (const float*)(ws + (isq ? CTL_SSQQ : CTL_SSQKV));
        const int row0 = u.pm * 256 + wr * 64 + fr;
        float sv[2][4];
#pragma unroll
        for (int ai = 0; ai < 2; ++ai)
#pragma unroll
            for (int m = 0; m < 4; ++m) sv[ai][m] = ssq[row0 + ai * 128 + m * 16];
        const bool rope0 = isq && ((u.pn * 8 + wc) % 3 == 2), rope1 = isq && ((u.pn * 8 + 4 + wc) % 3 == 2);
        float2 csv[2][4][4];
        if (rope0 || rope1) {
#pragma unroll
            for (int ai = 0; ai < 2; ++ai)
#pragma unroll
                for (int m = 0; m < 4; ++m) { const float2* cs = (const float2*)(ws + WS_ROPE) + ((row0 + ai * 128 + m * 16) & (SEQ - 1)) * 16 + fq * 4;
#pragma unroll
                    for (int j = 0; j < 4; ++j) csv[ai][m][j] = cs[j]; }
        }
#pragma unroll
        for (int ai = 0; ai < 2; ++ai)
#pragma unroll
            for (int m = 0; m < 4; ++m) {
                const int row = row0 + ai * 128 + m * 16;
                const float rs = rsqrtf(sv[ai][m] * (isq ? (1.f / 256.f) : (1.f / 128.f)) + EPS) * (isq ? QS_B : 1.f);
#pragma unroll
                for (int bj = 0; bj < 2; ++bj) {
                    if (isq) {
                        const int cg = u.pn * 8 + bj * 4 + wc;
                        bf16* q = (bf16*)(ws + WS_QB) + (size_t)row * 768 + cg * 32;
                        f32x4 a = acc[ai][bj][m][0] * rs, b = acc[ai][bj][m][1] * rs;
                        if (bj ? rope1 : rope0) {
                            f32x4 y1, y2;
#pragma unroll
                            for (int j = 0; j < 4; ++j) { const float2 c = csv[ai][m][j]; y1[j] = a[j] * c.x - b[j] * c.y; y2[j] = a[j] * c.y + b[j] * c.x; }
                            st4(q + fq * 4, y1); st4(q + 16 + fq * 4, y2);
                        } else st8(q + fq * 8, a, b);
                    } else {
                        const int head = (u.pn - 3) * 2 + bj;
                        bf16* dst = (bf16*)(ws + (wc < 2 ? WS_KB : WS_VB)) + (size_t)row * 512 + head * 64 + (wc & 1) * 32 + fq * 8;
                        st8(dst, acc[ai][bj][m][0] * rs, acc[ai][bj][m][1] * rs);
                    }
                }
            }
    }
};
struct EpiOut {
    unsigned char* ws; int gabl;
    __device__ __forceinline__ void operator()(const f32x4 (&acc)[2][2][4][2], const Unit& u, int wr, int wc, int fr, int fq) const {
        const bf16* __restrict__ xb = (const bf16*)(ws + WS_XB); bf16* __restrict__ x1 = (bf16*)(ws + WS_X1);
        int pm_ = u.pm; asm volatile("" : "+s"(pm_));
        const int row0 = pm_ * 256 + wr * 64 + fr; const int col0 = u.pn * 256 + wc * 32 + fq * 8;
        u32x4 xv[4][2], pk[4][2]; float sq[4];
#define EO_LOAD(ai) _Pragma("unroll") for (int m = 0; m < 4; ++m) _Pragma("unroll") for (int bj = 0; bj < 2; ++bj) \
            xv[m][bj] = (gabl & 1) ? (u32x4){0u, 0u, 0u, 0u} : *(const u32x4*)(xb + (size_t)(row0 + (ai) * 128 + m * 16) * 1024 + col0 + bj * 128)
#define EO_PACK(ai) _Pragma("unroll") for (int m = 0; m < 4; ++m) { float ssq = 0.f; _Pragma("unroll") for (int bj = 0; bj < 2; ++bj) { float t8[8]; unpack8(xv[m][bj], t8); \
                f32x4 v0 = acc[ai][bj][m][0], v1 = acc[ai][bj][m][1]; \
                v0.x += t8[0]; v0.y += t8[1]; v0.z += t8[2]; v0.w += t8[3]; v1.x += t8[4]; v1.y += t8[5]; v1.z += t8[6]; v1.w += t8[7]; \
                pk[m][bj].x = pk2(v0.x, v0.y); pk[m][bj].y = pk2(v0.z, v0.w); pk[m][bj].z = pk2(v1.x, v1.y); pk[m][bj].w = pk2(v1.z, v1.w); ssq += sq4(v0) + sq4(v1); } \
            ssq += __shfl_xor(ssq, 16); ssq += __shfl_xor(ssq, 32); sq[m] = ssq; }
#define EO_STORE(ai) _Pragma("unroll") for (int m = 0; m < 4; ++m) { const int row = row0 + (ai) * 128 + m * 16; \
            _Pragma("unroll") for (int bj = 0; bj < 2; ++bj) { if (!(gabl & 2)) *(u32x4*)(x1 + (size_t)row * 1024 + col0 + bj * 128) = pk[m][bj]; else asm volatile("" :: "v"(pk[m][bj])); } \
            if (fq == 0 && !(gabl & 4)) atomicAdd((float*)(ws + CTL_SSQ1) + row, sq[m]); else asm volatile("" :: "v"(sq[m])); }
        EO_LOAD(0); EO_PACK(0); EO_LOAD(1); EO_STORE(0); EO_PACK(1); EO_STORE(1);
#undef EO_LOAD
#undef EO_PACK
#undef EO_STORE
    }
};
struct EpiGateUp {
    unsigned char* ws; const LAS int* cnt;
    __device__ __forceinline__ void operator()(const f32x4 (&acc)[2][2][4][2], const Unit& u, int wr, int wc, int fr, int fq) const {
        const int ce = cnt[u.e]; const int* __restrict__ toks = (const int*)(ws + WS_TOK) + u.e * CAP; const float* __restrict__ ssq1 = (const float*)(ws + CTL_SSQ1);
        const int lr0 = wr * 64 + fr + (u.half == 2 ? 128 : 0);
        int tk[2][4]; float sv[2][4];
#pragma unroll
        for (int ai = 0; ai < 2; ++ai)
#pragma unroll
            for (int m = 0; m < 4; ++m) { const int lrow = u.lr0 + lr0 + ai * 128 + m * 16; tk[ai][m] = toks[lrow < ce ? lrow : 0]; }
#pragma unroll
        for (int ai = 0; ai < 2; ++ai)
#pragma unroll
            for (int m = 0; m < 4; ++m) sv[ai][m] = ssq1[tk[ai][m]];
#pragma unroll
        for (int ai = 0; ai < 2; ++ai)
#pragma unroll
            for (int m = 0; m < 4; ++m) {
                if (ai == 1 && u.half) continue;
                const int lr = lr0 + ai * 128 + m * 16;
                const float rs = rsqrtf(sv[ai][m] * (1.f / D) + EPS);
                bf16* dst = (bf16*)(ws + WS_HB) + (size_t)(u.pm * 256 + lr) * 256 + u.pn * 128 + wc * 32 + fq * 8;
                f32x4 h[2];
#pragma unroll
                for (int n = 0; n < 2; ++n) { const f32x4 g = acc[ai][0][m][n] * rs, up = acc[ai][1][m][n] * rs;
#pragma unroll
                    for (int j = 0; j < 4; ++j) h[n][j] = g[j] / (1.f + __expf(-g[j])) * up[j]; }
                st8(dst, h[0], h[1]);
            }
    }
};
struct EpiDown {
    unsigned char* ws; const LAS int* cnt; int gabl;
    __device__ __forceinline__ void operator()(const f32x4 (&acc)[2][2][4][2], const Unit& u, int wr, int wc, int fr, int fq) const {
        const int ce = cnt[u.e]; const float* __restrict__ gates = (const float*)(ws + WS_GATE) + u.e * CAP;
        const int lr0 = wr * 64 + fr + (u.half == 2 ? 128 : 0);
        float gv[2][4];
#pragma unroll
        for (int ai = 0; ai < 2; ++ai)
#pragma unroll
            for (int m = 0; m < 4; ++m) { const int lrow = u.lr0 + lr0 + ai * 128 + m * 16; const float g = gates[lrow < ce ? lrow : 0]; gv[ai][m] = lrow < ce ? g : 0.f; }
#pragma unroll
        for (int ai = 0; ai < 2; ++ai)
#pragma unroll
            for (int m = 0; m < 4; ++m) {
                if (ai == 1 && u.half) continue;
                const int lr = lr0 + ai * 128 + m * 16;
                const float gt = gv[ai][m];
                bf16* dst = (bf16*)(ws + WS_YB) + (size_t)(u.pm * 256 + lr) * 1024 + u.pn * 256 + wc * 32 + fq * 8;
#pragma unroll
                for (int bj = 0; bj < 2; ++bj) { if (!(gabl & 1)) st8(dst + bj * 128, acc[ai][bj][m][0] * gt, acc[ai][bj][m][1] * gt); else asm volatile("" :: "v"(acc[ai][bj][m][0] * gt), "v"(acc[ai][bj][m][1] * gt)); }
            }
    }
};

struct Args { const float* in[20]; float* out; unsigned char* ws; int ph_lo, ph_hi, flags, pad; };
struct Frame { LAS unsigned char* lds; int tid, lane, wave, vcu, G; const float* const* in; float* out; unsigned char* ws; int pflags; };

__device__ __forceinline__ void transpose_item(const float* W, int ldw, const float* gain, bf16* WT, int ldwt, int k0, int n0, int dstrow0, LAS float* scr, int lane, bool ropeperm = false) {
    f32x4 v[8];
#pragma unroll
    for (int i = 0; i < 8; ++i) v[i] = *(const f32x4*)(W + (size_t)(k0 + 8 * i + (lane >> 3)) * ldw + n0 + 4 * (lane & 7));
#pragma unroll
    for (int i = 0; i < 8; ++i) { const int kk = 8 * i + (lane >> 3); const float g = gain ? gain[k0 + kk] : 1.f; LAS float* d = scr + kk * 33 + 4 * (lane & 7);
        d[0] = v[i].x * g; d[1] = v[i].y * g; d[2] = v[i].z * g; d[3] = v[i].w * g; }
    LDS_WAIT();
    const int c = lane & 7;
#pragma unroll
    for (int j = 0; j < 4; ++j) { const int n = (lane >> 3) + 8 * j; const LAS float* s = scr + (8 * c) * 33 + n;
        u32x4 o; o.x = pk2(s[0 * 33], s[1 * 33]); o.y = pk2(s[2 * 33], s[3 * 33]); o.z = pk2(s[4 * 33], s[5 * 33]); o.w = pk2(s[6 * 33], s[7 * 33]);
        const int dn = ropeperm ? (8 * ((n & 15) >> 2) + 4 * (n >> 4) + (n & 3)) : n;
        *(u32x4*)(WT + (size_t)(dstrow0 + dn) * ldwt + k0 + 8 * c) = o; }
    LDS_WAIT();
}

struct XItem { const float* W; const float* gain; bf16* WT; int ldw, ldwt, k0, n0, dstrow0; };
__device__ __forceinline__ XItem xitem_decode(const Frame& F, int kind, int r) {
    unsigned char* ws = F.ws; XItem t; constexpr int I_G = 16 * 8, I_D = 4 * 32;
    if (kind == 0) { const int mtx = r / I_G, q = r % I_G, e = mtx >> 1, gu = mtx & 1, kb = q / 8, nb = q % 8; const int n0 = nb * 32;
        t.W = (gu ? F.in[17] : F.in[16]) + (size_t)e * 1024 * 256; t.ldw = 256; t.gain = F.in[11]; t.WT = (bf16*)(ws + WS_WGU) + (size_t)e * 512 * 1024; t.ldwt = 1024; t.k0 = kb * 64; t.n0 = n0;
        t.dstrow0 = 256 * (n0 >> 7) + gu * 128 + (n0 & 127); }
    else { const int e = r / I_D, q = r % I_D, kb = q / 32, nb = q % 32;
        t.W = F.in[18] + (size_t)e * 256 * 1024; t.ldw = 1024; t.gain = nullptr; t.WT = (bf16*)(ws + WS_WD) + (size_t)e * 1024 * 256; t.ldwt = 256; t.k0 = kb * 64; t.n0 = nb * 32; t.dstrow0 = nb * 32; }
    return t;
}
__device__ __forceinline__ void xitem_load(const XItem& t, f32x4 (&v)[8], int lane) {
#pragma unroll
    for (int i = 0; i < 8; ++i) v[i] = *(const f32x4*)(t.W + (size_t)(t.k0 + 8 * i + (lane >> 3)) * t.ldw + t.n0 + 4 * (lane & 7));
}
__device__ __forceinline__ void xitem_store(const XItem& t, const f32x4 (&v)[8], LAS float* scr, int lane) {
#pragma unroll
    for (int i = 0; i < 8; ++i) { const int kk = 8 * i + (lane >> 3); const float g = t.gain ? t.gain[t.k0 + kk] : 1.f; LAS float* d = scr + kk * 33 + 4 * (lane & 7);
        d[0] = v[i].x * g; d[1] = v[i].y * g; d[2] = v[i].z * g; d[3] = v[i].w * g; }
    LDS_WAIT();
    const int c = lane & 7;
#pragma unroll
    for (int j = 0; j < 4; ++j) { const int n = (lane >> 3) + 8 * j; const LAS float* s = scr + (8 * c) * 33 + n;
        u32x4 o; o.x = pk2(s[0 * 33], s[1 * 33]); o.y = pk2(s[2 * 33], s[3 * 33]); o.z = pk2(s[4 * 33], s[5 * 33]); o.w = pk2(s[6 * 33], s[7 * 33]);
        *(u32x4*)(t.WT + (size_t)(t.dstrow0 + n) * t.ldwt + t.k0 + 8 * c) = o; }
    LDS_WAIT();
}
__device__ __forceinline__ void p_convert_experts(const Frame& F, int kind, int wid, int nw) {
    const int lane = F.lane; LAS float* scr = (LAS float*)(F.lds + F.wave * 16384);
    const int nitems = kind == 0 ? 64 * 16 * 8 : 32 * 4 * 32;
    if (wid >= nitems) return;
    XItem cur = xitem_decode(F, kind, wid); f32x4 v[8], vn[8]; xitem_load(cur, v, lane);
    for (int r = wid; r < nitems; r += nw) {
        const bool more = (r + nw < nitems); XItem nxt = cur;
        if (more) { nxt = xitem_decode(F, kind, r + nw); xitem_load(nxt, vn, lane); }
        xitem_store(cur, v, scr, lane);
        if (more) { cur = nxt;
#pragma unroll
            for (int i = 0; i < 8; ++i) v[i] = vn[i]; }
    }
}
__device__ __forceinline__ void p_prologue(const Frame& F) {
    unsigned char* ws = F.ws; const int lane = F.lane;
    LAS float* scr = (LAS float*)(F.lds + F.wave * 16384);
    const int gw = F.vcu * NWAVES + F.wave, NGW = F.G * NWAVES;
    constexpr int I_IN = 16 * 61, I_Q = 4 * 24, I_KV = 2 * 32, I_O = 16 * 32;
    constexpr int NITEMS = I_IN + I_Q + I_KV + I_O;
    for (int it = gw; it < NITEMS; it += NGW) {
        if (F.pflags & 128) break;
        int r = it;
        if (r < I_IN) { const int kb = r / 61, nb = r % 61; transpose_item(F.in[2], NIN, F.in[1], (bf16*)(ws + WS_WI), 1024, kb * 64, nb * 32, nb * 32, scr, lane, nb == 60); continue; } r -= I_IN;
        if (r < I_Q) { const int kb = r / 24, nb = r % 24; transpose_item(F.in[5], 768, F.in[4], (bf16*)(ws + WS_WQKV), 256, kb * 64, nb * 32, nb * 32, scr, lane, nb % 3 == 2); continue; } r -= I_Q;
        if (r < I_KV) { const int kb = r / 32, nb = r % 32; transpose_item(F.in[7], 1024, F.in[6], (bf16*)(ws + WS_WQKV), 256, kb * 64, nb * 32, 768 + nb * 32, scr, lane); continue; } r -= I_KV;
        { const int kb = r / 32, nb = r % 32; transpose_item(F.in[10], 1024, nullptr, (bf16*)(ws + WS_WO), 1024, kb * 64, nb * 32, nb * 32, scr, lane); }
    }
    const size_t gt = (size_t)F.vcu * 512 + F.tid, NGT = (size_t)F.G * 512;
    for (size_t i = gt; i < (size_t)96 * 1024 / 8; i += NGT) ((u32x4*)((bf16*)(ws + WS_WI) + (size_t)1952 * 1024))[i] = (u32x4){0, 0, 0, 0};
    for (size_t i = gt; i < (size_t)1024 * 16; i += NGT) { const size_t row = i >> 4, c = i & 15; *(u32x4*)((bf16*)(ws + WS_WQKV) + (768 + row) * 256 + 128 + c * 8) = (u32x4){0, 0, 0, 0}; }
    { const float* __restrict__ xin = F.in[0]; bf16* __restrict__ XBp = (bf16*)(ws + WS_XB); float* __restrict__ rs0 = (float*)(ws + WS_RS0);
    for (int m0 = gw * 4; m0 < T; m0 += NGW * 4) {
        if (F.pflags & 256) break;
        f32x4 v[4][4];
#pragma unroll
        for (int q = 0; q < 4; ++q)
#pragma unroll
            for (int j = 0; j < 4; ++j) v[q][j] = *((const f32x4*)(xin + (size_t)(m0 + q) * D) + lane + 64 * j);
#pragma unroll
        for (int q = 0; q < 4; ++q) { float s = 0.f;
#pragma unroll
            for (int j = 0; j < 4; ++j) s += sq4(v[q][j]);
            s = wave_sum(s);
            u32x2* o8 = (u32x2*)(XBp + (size_t)(m0 + q) * D) + lane;
#pragma unroll
            for (int j = 0; j < 4; ++j) { u32x2 o; o.x = pk2(v[q][j].x, v[q][j].y); o.y = pk2(v[q][j].z, v[q][j].w); o8[64 * j] = o; }
            if (lane == 0) rs0[m0 + q] = rsqrtf(s * (1.f / D) + EPS); }
    } }
    for (size_t i = gt; i < (size_t)48 * 1024; i += NGT) { const int c = (int)(i >> 10), k = (int)(i & 1023);
        float w = 0.f; if (c < 4) w = F.in[12][k * 4 + c] * F.in[11][k]; else if (c < 36) w = F.in[14][k * 32 + c - 4] * F.in[11][k];
        const bf16 hi = f2bf(w); const bf16 lo = f2bf(w - bf2f(hi));
        ((bf16*)(ws + WS_WR))[i] = hi; ((bf16*)(ws + WS_WR))[(size_t)48 * 1024 + i] = lo; }
    for (size_t i = gt; i < (size_t)SEQ * 16; i += NGT) { const int s = (int)(i >> 4), f = (int)(i & 15);
        const float inv = (float)pow(10000.0, -(double)f / 16.0); const float ang = (float)s * inv;
        float2 cs; cs.x = (float)cos((double)ang); cs.y = (float)sin((double)ang); ((float2*)(ws + WS_ROPE))[i] = cs; }
    for (size_t i = gt; i < (size_t)24 * 2048; i += NGT) { const int ph = (int)(i >> 11), e = (int)(i & 2047), p = ph >> 3, h = ph & 7;
        float val = 0.f;
        if (e < 1600) { const int m = e / 200, x = e - m * 200, y = x + m, t = 191 - y;
            val = -30000.f;
            if (y <= 191 && t >= 32 && t <= 160) { const int dil = (p == 0) ? 1 : (p == 1) ? 4 : 16; const int rel = (t - 96) * dil; const int n = rel < 0 ? -rel : rel;
                int large = 8 + (int)(log((double)(n > 1 ? n : 1) / 8.0) / log(128.0) * 8.0); if (large > 15) large = 15;
                const int bucket = (rel > 0 ? 16 : 0) + (n < 8 ? n : large);
                val = F.in[3][bucket * 8 + h] * LOG2E; } }
        ((bf16*)(ws + WS_BIMG))[i] = f2bf(val); }
    for (size_t i = gt; i < (size_t)3 * 8 * 132; i += NGT) { const int p = (int)(i / (8 * 132)), h = (int)((i / 132) % 8), jj = (int)(i % 132);
        float val = 0.f;
        if (jj <= 128) { const int dil = (p == 0) ? 1 : (p == 1) ? 4 : 16; const int rel = (jj - 64) * dil; const int n = rel < 0 ? -rel : rel;
            int large = 8 + (int)(log((double)(n > 1 ? n : 1) / 8.0) / log(128.0) * 8.0); if (large > 15) large = 15;
            const int bucket = (rel > 0 ? 16 : 0) + (n < 8 ? n : large);
            val = F.in[3][bucket * 8 + h] * LOG2E; }
        ((float*)(ws + WS_BT))[i] = val; }
}

__device__ __forceinline__ void p_attnA_naive(const Frame& F, bf16* OA, float* LSE) {
    unsigned char* ws = F.ws;
    const bf16* QA = (const bf16*)(ws + WS_QA); const bf16* KA = (const bf16*)(ws + WS_KA); const bf16* VA = (const bf16*)(ws + WS_VA);
    const float* BT = (const float*)(ws + WS_BT);
    for (int idx = F.vcu * 512 + F.tid; idx < T * 8; idx += F.G * 512) {
        const int s = idx & (SEQ - 1), h = (idx >> 11) & 7, b = idx >> 14;
        float q[64], o[64];
        const size_t t = (size_t)b * SEQ + s;
#pragma unroll
        for (int i = 0; i < 64; ++i) { q[i] = bf2f(QA[t * 512 + h * 64 + i]); o[i] = 0.f; }
        float m = -1e30f, l = 0.f;
        for (int p = 0; p < 3; ++p) { const int dil = (p == 0) ? 1 : (p == 1) ? 4 : 16;
            for (int j = -64; j <= 64; ++j) { const int pos = s + j * dil; if (pos < 0 || pos >= SEQ) continue;
                const bf16* kp = KA + ((size_t)b * SEQ + pos) * 512 + h * 64; const bf16* vp = VA + ((size_t)b * SEQ + pos) * 512 + h * 64;
                float sc = BT[(p * 8 + h) * 132 + j + 64];
#pragma unroll
                for (int i = 0; i < 64; ++i) sc += q[i] * bf2f(kp[i]);
                const float mn = fmaxf(m, sc), al = exp2f(m - mn), pe = exp2f(sc - mn);
                l = l * al + pe; m = mn;
#pragma unroll
                for (int i = 0; i < 64; ++i) o[i] = o[i] * al + pe * bf2f(vp[i]);
            } }
        const float il = 1.f / l;
#pragma unroll
        for (int i = 0; i < 64; ++i) OA[t * 512 + h * 64 + i] = f2bf(o[i] * il);
        LSE[t * 8 + h] = m + log2f(l);
    }
}
__device__ __forceinline__ void p_attnB_naive(const Frame& F) {
    unsigned char* ws = F.ws;
    const bf16* QB = (const bf16*)(ws + WS_QB); const bf16* KB = (const bf16*)(ws + WS_KB); const bf16* VB = (const bf16*)(ws + WS_VB); const bf16* KR = (const bf16*)(ws + WS_KR);
    for (int idx = F.vcu * 512 + F.tid; idx < T * 8; idx += F.G * 512) {
        const int s = idx & (SEQ - 1), h = (idx >> 11) & 7, b = idx >> 14;
        float q[96], o[64];
        const size_t t = (size_t)b * SEQ + s;
#pragma unroll
        for (int i = 0; i < 96; ++i) q[i] = bf2f(QB[t * 768 + h * 96 + i]);
#pragma unroll
        for (int i = 0; i < 64; ++i) o[i] = 0.f;
        float m = -1e30f, l = 0.f;
        for (int key = 0; key < SEQ; ++key) { const size_t tk = (size_t)b * SEQ + key;
            const bf16* kp = KB + tk * 512 + h * 64; const bf16* rp = KR + tk * 32; const bf16* vp = VB + tk * 512 + h * 64;
            float sc = 0.f;
#pragma unroll
            for (int i = 0; i < 64; ++i) sc += q[i] * bf2f(kp[i]);
#pragma unroll
            for (int i = 0; i < 32; ++i) sc += q[64 + i] * bf2f(rp[i]);
            const float mn = fmaxf(m, sc), al = exp2f(m - mn), pe = exp2f(sc - mn);
            l = l * al + pe; m = mn;
#pragma unroll
            for (int i = 0; i < 64; ++i) o[i] = o[i] * al + pe * bf2f(vp[i]);
        }
        const float il = 1.f / l;
#pragma unroll
        for (int i = 0; i < 64; ++i) ((bf16*)(ws + WS_OB))[t * 512 + h * 64 + i] = f2bf(o[i] * il);
    }
}

typedef float f32x16 __attribute__((ext_vector_type(16)));
typedef short s16x4 __attribute__((ext_vector_type(4)));
typedef short v4i16_t __attribute__((ext_vector_type(4)));
__device__ __forceinline__ s16x4 vtr(const LAS unsigned char* p) { return __builtin_bit_cast(s16x4, __builtin_amdgcn_ds_read_tr16_b64_v4i16((LAS v4i16_t*)p)); }
__device__ __forceinline__ int crow(int r, int hi) { return (r & 3) + 8 * (r >> 2) + 4 * hi; }
__device__ __forceinline__ float max3f(float a, float b, float c) { float r; asm("v_max3_f32 %0, %1, %2, %3" : "=v"(r) : "v"(a), "v"(b), "v"(c)); return r; }
__device__ __forceinline__ float max2f(float a, float b) { float r; asm("v_max_f32_e32 %0, %1, %2" : "=v"(r) : "v"(a), "v"(b)); return r; }
__device__ __forceinline__ float rowmax32(const f32x16& p0, const f32x16& p1) {
    float a = max3f(p0[0], p0[1], p1[0]), b = max3f(p0[2], p0[3], p1[1]); a = max3f(a, p1[2], p1[3]);
#pragma unroll
    for (int r = 4; r < 16; r += 4) { a = max3f(a, p0[r], p0[r + 1]); b = max3f(b, p0[r + 2], p0[r + 3]); a = max3f(a, p1[r], p1[r + 1]); b = max3f(b, p1[r + 2], p1[r + 3]); }
    const float m = max2f(a, b);
    auto rr = __builtin_amdgcn_permlane32_swap(__float_as_uint(m), __float_as_uint(m), false, false);
    return max2f(__uint_as_float(rr[0]), __uint_as_float(rr[1]));
}
#define ATT_WAIT_BAR() asm volatile("s_waitcnt vmcnt(0) lgkmcnt(0)\n\ts_barrier" ::: "memory")
#define GLDS16(src, dst) __builtin_amdgcn_global_load_lds((const unsigned*)(src), (LAS unsigned*)(dst), 16, 0, 0)
__device__ __forceinline__ void glds16_asm(const void* gsrc, LAS unsigned char* dst) { unsigned keep; const unsigned d = (unsigned)__builtin_amdgcn_readfirstlane((int)(unsigned)(size_t)dst);
    asm volatile("s_mov_b32 %0, m0\n\ts_mov_b32 m0, %2\n\ts_nop 0\n\tglobal_load_lds_dwordx4 %1, off\n\ts_mov_b32 m0, %0" : "=&s"(keep) : "v"(gsrc), "s"(d) : "memory"); }

template <int NS>
__device__ __forceinline__ void sm_update(f32x16 (&p)[NS], float& m, float& l, f32x16& o0, f32x16& o1, bf16x8 (&pf)[2 * NS]) {
    float mx = p[0][0];
#pragma unroll
    for (int s = 0; s < NS; ++s)
#pragma unroll
        for (int r = 0; r < 16; ++r) mx = fmaxf(mx, p[s][r]);
    { auto rr = __builtin_amdgcn_permlane32_swap(__float_as_uint(mx), __float_as_uint(mx), false, false); mx = fmaxf(__uint_as_float(rr[0]), __uint_as_float(rr[1])); }
    const float mn = fmaxf(m, mx); const float al = __builtin_amdgcn_exp2f(m - mn); m = mn;
    float sum = 0.f;
#pragma unroll
    for (int s = 0; s < NS; ++s)
#pragma unroll
        for (int r = 0; r < 16; ++r) { p[s][r] = __builtin_amdgcn_exp2f(p[s][r] - mn); sum += p[s][r]; }
    l = l * al + sum;
#pragma unroll
    for (int r = 0; r < 16; ++r) { o0[r] *= al; o1[r] *= al; }
#pragma unroll
    for (int s = 0; s < NS; ++s)
#pragma unroll
        for (int k = 0; k < 2; ++k) { u32x4 w; w.x = cvtpk(p[s][8 * k + 0], p[s][8 * k + 1]); w.y = cvtpk(p[s][8 * k + 2], p[s][8 * k + 3]); w.z = cvtpk(p[s][8 * k + 4], p[s][8 * k + 5]); w.w = cvtpk(p[s][8 * k + 6], p[s][8 * k + 7]);
            pf[2 * s + k] = __builtin_bit_cast(bf16x8, w); }
}
__device__ __forceinline__ void pv_step(f32x16& o0, f32x16& o1, const LAS unsigned char* vp, int dstride, bf16x8 pfk) {
    const s16x4 a0 = vtr(vp), a1 = vtr(vp + 512), b0 = vtr(vp + dstride), b1 = vtr(vp + dstride + 512);
    const bf16x8 v0 = (bf16x8){a0[0], a0[1], a0[2], a0[3], a1[0], a1[1], a1[2], a1[3]};
    const bf16x8 v1 = (bf16x8){b0[0], b0[1], b0[2], b0[3], b1[0], b1[1], b1[2], b1[3]};
    o0 = __builtin_amdgcn_mfma_f32_32x32x16_bf16(v0, pfk, o0, 0, 0, 0);
    o1 = __builtin_amdgcn_mfma_f32_32x32x16_bf16(v1, pfk, o1, 0, 0, 0);
}
__device__ __forceinline__ void store_o(bf16* orow, const f32x16& o0, const f32x16& o1, float il, int hi) {
#pragma unroll
    for (int g = 0; g < 4; ++g) {
        u32x2 w0, w1; w0.x = cvtpk(o0[4 * g] * il, o0[4 * g + 1] * il); w0.y = cvtpk(o0[4 * g + 2] * il, o0[4 * g + 3] * il);
        w1.x = cvtpk(o1[4 * g] * il, o1[4 * g + 1] * il); w1.y = cvtpk(o1[4 * g + 2] * il, o1[4 * g + 3] * il);
        *(u32x2*)(orow + 8 * g + 4 * hi) = w0; *(u32x2*)(orow + 32 + 8 * g + 4 * hi) = w1; }
}


template <class RowPtr>
__device__ __forceinline__ void store_o_staged(LAS unsigned char* stg, const f32x16& o0, const f32x16& o1, float il, int lane, const RowPtr& rowptr) {
    const int r32 = lane & 31, hi = lane >> 5;
#pragma unroll
    for (int d0 = 0; d0 < 2; ++d0) {
        const f32x16& o = d0 ? o1 : o0;
#pragma unroll
        for (int g = 0; g < 4; ++g) { u32x2 w; w.x = cvtpk(o[4 * g] * il, o[4 * g + 1] * il); w.y = cvtpk(o[4 * g + 2] * il, o[4 * g + 3] * il);
            *(LAS u32x2*)(stg + r32 * 64 + ((g ^ ((r32 >> 1) & 3)) * 16) + hi * 8) = w; }
        LDS_WAIT();
#pragma unroll
        for (int j = 0; j < 2; ++j) { const int row = 16 * j + (lane >> 2), c = lane & 3;
            const u32x4 v = *(const LAS u32x4*)(stg + row * 64 + ((c ^ ((row >> 1) & 3)) * 16));
            *(u32x4*)(rowptr(row) + d0 * 32 + c * 8) = v; }
        LDS_WAIT();
    }
}

constexpr int B_KBUF = 12288, B_VBUF = 8192, B_VOFF = 3 * B_KBUF;
constexpr float B_THR = 40.f;
#define SBAR() __builtin_amdgcn_sched_barrier(0)
template <int ABL>
__device__ __forceinline__ void attnB_unit(const Frame& F, int b, int head, int qb) {
    unsigned char* ws = F.ws; LAS unsigned char* lds = F.lds;
    const int lane = F.lane, wave = F.wave, r32 = lane & 31, hi = lane >> 5;
    const bf16* QB = (const bf16*)(ws + WS_QB); const bf16* KB = (const bf16*)(ws + WS_KB); const bf16* VB = (const bf16*)(ws + WS_VB); const bf16* KR = (const bf16*)(ws + WS_KR);
    const size_t t0 = (size_t)b * SEQ;
    const size_t tq = t0 + qb * 256 + wave * 32 + r32;
    const int kr8 = 8 * wave + (lane >> 3), kr16 = 16 * (wave & 3) + (lane >> 2);
    const bf16* ksrc = KB + (t0 + kr8) * 512 + head * 64 + (((lane & 7) ^ ((kr8 >> 1) & 7)) * 8);
    const bf16* rsrc = KR + (t0 + kr16) * 32 + (((lane & 3) ^ ((kr16 >> 2) & 3)) * 8);
    const bf16* vsrc = VB + (t0 + kr8) * 512 + head * 64 + (((lane & 7) ^ (((kr8 >> 1) & 1) << 2)) * 8);
#define B_ISSUE_K(kt, boff) do { if (ABL & 2) break; glds16_asm(ksrc + (size_t)(kt) * 64 * 512, lds + (boff) + wave * 1024); \
        glds16_asm(rsrc + (size_t)(kt) * 64 * 32, lds + (boff) + 8192 + (wave & 3) * 1024); } while (0)
#define B_ISSUE_V(kt, boff) do { if (!(ABL & 2)) glds16_asm(vsrc + (size_t)(kt) * 64 * 512, lds + B_VOFF + (boff) + wave * 1024); } while (0)
    B_ISSUE_K(0, 0); B_ISSUE_V(0, 0); B_ISSUE_K(1, B_KBUF); B_ISSUE_V(1, B_VBUF); B_ISSUE_K(2, 2 * B_KBUF);
    bf16x8 qf[6];
#pragma unroll
    for (int ks = 0; ks < 6; ++ks) qf[ks] = *(const bf16x8*)(QB + tq * 768 + head * 96 + ks * 16 + hi * 8);
    float mref; f32x16 o0, o1, o2, negm;
#pragma unroll
    for (int r = 0; r < 16; ++r) { o0[r] = 0.f; o1[r] = 0.f; o2[r] = 0.f; }
    const bf16x8 onesf = (bf16x8){(short)0x3F80, (short)0x3F80, (short)0x3F80, (short)0x3F80, (short)0x3F80, (short)0x3F80, (short)0x3F80, (short)0x3F80};
    int kad[6];
#pragma unroll
    for (int ks = 0; ks < 4; ++ks) kad[ks] = r32 * 128 + (((2 * ks + hi) ^ ((r32 >> 1) & 7)) * 16);
#pragma unroll
    for (int j = 0; j < 2; ++j) kad[4 + j] = 8192 + r32 * 64 + (((2 * j + hi) ^ ((r32 >> 2) & 3)) * 16);
    const int vq = (lane & 15) >> 2;
    const int vbo0 = (4 * hi + vq) * 128 + (((((lane >> 4) & 1) * 2 + ((lane & 3) >> 1)) ^ (((vq >> 1) & 1) << 2)) * 16) + (lane & 1) * 8;
    constexpr int NT = SEQ / 64;
    f32x16 pA0, pA1, pB0, pB1;
    ATT_WAIT_BAR();
    {
        const LAS unsigned char* kb = lds;
#pragma unroll
        for (int r = 0; r < 16; ++r) { pA0[r] = 0.f; pA1[r] = 0.f; }
#pragma unroll
        for (int ks = 0; ks < 6; ++ks) {
            const bf16x8 k0 = *(const LAS bf16x8*)(kb + kad[ks]), k1 = *(const LAS bf16x8*)(kb + kad[ks] + (ks < 4 ? 4096 : 2048));
            pA0 = __builtin_amdgcn_mfma_f32_32x32x16_bf16(k0, qf[ks], pA0, 0, 0, 0);
            pA1 = __builtin_amdgcn_mfma_f32_32x32x16_bf16(k1, qf[ks], pA1, 0, 0, 0);
        }
        asm volatile("s_nop 15" : "+v"(pA0), "+v"(pA1));
        const float mx = rowmax32(pA0, pA1);
        mref = mx;
#pragma unroll
        for (int r = 0; r < 16; ++r) { negm[r] = -mref; pA0[r] = __builtin_amdgcn_exp2f(pA0[r] - mref); pA1[r] = __builtin_amdgcn_exp2f(pA1[r] - mref); }
    }
    ATT_WAIT_BAR();
    bool resc = false; float fres = 1.f;
#define B_PIN(x) asm volatile("" : "+v"(x))
#define B_GAPA(MF, A0, A1, A2, WI, WA, WB, WC, WD, KRD) do { MF; pw_[WI] = cvtpk(WA, WB); pw_[WI + 1] = cvtpk(WC, WD); B_PIN(pw_[WI]); B_PIN(pw_[WI + 1]); KRD; SBAR(); } while (0)
#define B_GAPA0(MF, A0, A1, A2) do { MF; SBAR(); } while (0)
#define B_KRD(i_) kf_[i_] = *(const LAS bf16x8*)(kb_ + kad[(i_) >> 1] + (((i_) & 1) ? (((i_) >> 1) < 4 ? 4096 : 2048) : 0))
#define B_EX4(X, B) do { X[B] = __builtin_amdgcn_exp2f(X[B]); X[B + 1] = __builtin_amdgcn_exp2f(X[B + 1]); X[B + 2] = __builtin_amdgcn_exp2f(X[B + 2]); X[B + 3] = __builtin_amdgcn_exp2f(X[B + 3]); B_PIN(X); } while (0)
#define B_EX4C(X, B) do { if (!(ABL & 1)) B_EX4(X, B); } while (0)
#define B_MFQ(D, A, Bq, C) D = (ABL & 8) ? (C) : __builtin_amdgcn_mfma_f32_32x32x16_bf16(A, Bq, C, 0, 0, 0)
#define B_MFQ0(D, A, Bq, C) do { if (ABL & 8) D = (C); else asm volatile("v_mfma_f32_32x32x16_bf16 %0, %1, %2, %3" : "=&v"(D) : "v"(A), "v"(Bq), "v"(C)); } while (0)
#define B_MFP(D, A, Bq) do { if (!(ABL & 16)) D = __builtin_amdgcn_mfma_f32_32x32x16_bf16(A, Bq, D, 0, 0, 0); else { asm volatile("" :: "v"(A), "v"(Bq)); } } while (0)
#define B_STEP(PA0, PA1, PB0, PB1, t, HASN) do { \
      \
    const int krd_ = (i3 == 2 ? 0 : i3 + 1) * B_KBUF, kwr_ = i3 * B_KBUF, vrd_ = i3 * B_VBUF, vwr_ = (i3 == 0 ? 2 : i3 - 1) * B_VBUF; \
    if ((t) + 3 < NT) B_ISSUE_K((t) + 3, kwr_); \
    if ((t) + 2 < NT) B_ISSUE_V((t) + 2, vwr_); \
    unsigned pw_[16]; \
    if (HASN) { \
        const LAS unsigned char* kb_ = lds + krd_; bf16x8 kf_[12]; \
        B_KRD(0); B_KRD(1); B_KRD(2); B_KRD(3); \
        SBAR(); \
        B_GAPA(B_MFQ0(PB0, kf_[0], qf[0], negm), PA0[0], PA0[1], PA0[2],    0, PA0[0], PA0[1], PA0[2], PA0[3],     B_KRD(4)); \
        B_GAPA(B_MFQ0(PB1, kf_[1], qf[0], negm), PA0[3], PA0[4], PA0[5],    2, PA0[4], PA0[5], PA0[6], PA0[7],     B_KRD(5)); \
        B_GAPA(B_MFQ(PB0, kf_[2], qf[1], PB0),  PA0[6], PA0[7], PA0[8],    4, PA0[8], PA0[9], PA0[10], PA0[11],   B_KRD(6)); \
        B_GAPA(B_MFQ(PB1, kf_[3], qf[1], PB1),  PA0[9], PA0[10], PA0[11],  6, PA0[12], PA0[13], PA0[14], PA0[15], B_KRD(7)); \
        B_GAPA(B_MFQ(PB0, kf_[4], qf[2], PB0),  PA0[12], PA0[13], PA0[14], 8, PA1[0], PA1[1], PA1[2], PA1[3],     B_KRD(8)); \
        B_GAPA(B_MFQ(PB1, kf_[5], qf[2], PB1),  PA0[15], PA1[0], PA1[1],   10, PA1[4], PA1[5], PA1[6], PA1[7],    B_KRD(9)); \
        B_GAPA(B_MFQ(PB0, kf_[6], qf[3], PB0),  PA1[2], PA1[3], PA1[4],    12, PA1[8], PA1[9], PA1[10], PA1[11],  B_KRD(10)); \
        B_GAPA(B_MFQ(PB1, kf_[7], qf[3], PB1),  PA1[5], PA1[6], PA1[7],    14, PA1[12], PA1[13], PA1[14], PA1[15], B_KRD(11)); \
        B_GAPA0(B_MFQ(PB0, kf_[8], qf[4], PB0),  PA1[8], PA1[9], PA1[10]); \
        B_GAPA0(B_MFQ(PB1, kf_[9], qf[4], PB1),  PA1[11], PA1[12], PA1[13]); \
        B_GAPA0(B_MFQ(PB0, kf_[10], qf[5], PB0), PA1[14], PA1[15], 0.f); \
        B_MFQ(PB1, kf_[11], qf[5], PB1); SBAR(); \
    } else { \
        _Pragma("unroll") for (int i_ = 0; i_ < 8; ++i_) { pw_[i_] = cvtpk(PA0[2 * i_], PA0[2 * i_ + 1]); pw_[8 + i_] = cvtpk(PA1[2 * i_], PA1[2 * i_ + 1]); } \
    } \
    resc = false; \
    if (HASN) { \
        asm volatile("s_nop 15" : "+v"(PB0), "+v"(PB1)); \
        const float mx_ = rowmax32(PB0, PB1); \
        if (__builtin_expect(__any(mx_ > B_THR), 0)) { const float dl_ = fmaxf(mx_, 0.f); mref += dl_; \
            _Pragma("unroll") for (int r = 0; r < 16; ++r) { PB0[r] -= dl_; PB1[r] -= dl_; negm[r] = -mref; } \
            fres = __builtin_amdgcn_exp2f(-dl_); resc = true; } \
    } \
    SBAR(); \
    { const LAS unsigned char* vb_ = lds + B_VOFF + vrd_ + vbo0; const LAS unsigned char* vc_ = lds + B_VOFF + vrd_ + (vbo0 ^ 64); \
      const bf16x8 pf0_ = __builtin_bit_cast(bf16x8, ((u32x4){pw_[0], pw_[1], pw_[2], pw_[3]})), pf1_ = __builtin_bit_cast(bf16x8, ((u32x4){pw_[4], pw_[5], pw_[6], pw_[7]})), pf2_ = __builtin_bit_cast(bf16x8, ((u32x4){pw_[8], pw_[9], pw_[10], pw_[11]})), pf3_ = __builtin_bit_cast(bf16x8, ((u32x4){pw_[12], pw_[13], pw_[14], pw_[15]})); \
      s16x4 a0_ = vtr(vb_), a1_ = vtr(vb_ + 1024), b0_ = vtr(vc_), b1_ = vtr(vc_ + 1024), c0_, c1_, d0_, d1_; \
        \
      c0_ = vtr(vb_ + 2048); c1_ = vtr(vb_ + 2048 + 1024); d0_ = vtr(vc_ + 2048); d1_ = vtr(vc_ + 2048 + 1024); \
      B_MFP(o0, ((bf16x8){a0_[0], a0_[1], a0_[2], a0_[3], a1_[0], a1_[1], a1_[2], a1_[3]}), pf0_); if (HASN) B_EX4C(PB0, 0); SBAR(); \
      B_MFP(o1, ((bf16x8){b0_[0], b0_[1], b0_[2], b0_[3], b1_[0], b1_[1], b1_[2], b1_[3]}), pf0_); if (HASN) B_EX4C(PB0, 4); SBAR(); \
      B_MFP(o2, onesf, pf0_); SBAR(); \
        \
      a0_ = vtr(vb_ + 4096); a1_ = vtr(vb_ + 4096 + 1024); b0_ = vtr(vc_ + 4096); b1_ = vtr(vc_ + 4096 + 1024); \
      B_MFP(o0, ((bf16x8){c0_[0], c0_[1], c0_[2], c0_[3], c1_[0], c1_[1], c1_[2], c1_[3]}), pf1_); if (HASN) B_EX4C(PB0, 8); SBAR(); \
      B_MFP(o1, ((bf16x8){d0_[0], d0_[1], d0_[2], d0_[3], d1_[0], d1_[1], d1_[2], d1_[3]}), pf1_); if (HASN) B_EX4C(PB0, 12); SBAR(); \
      B_MFP(o2, onesf, pf1_); SBAR(); \
        \
      c0_ = vtr(vb_ + 6144); c1_ = vtr(vb_ + 6144 + 1024); d0_ = vtr(vc_ + 6144); d1_ = vtr(vc_ + 6144 + 1024); \
      B_MFP(o0, ((bf16x8){a0_[0], a0_[1], a0_[2], a0_[3], a1_[0], a1_[1], a1_[2], a1_[3]}), pf2_); if (HASN) B_EX4C(PB1, 0); SBAR(); \
      B_MFP(o1, ((bf16x8){b0_[0], b0_[1], b0_[2], b0_[3], b1_[0], b1_[1], b1_[2], b1_[3]}), pf2_); if (HASN) B_EX4C(PB1, 4); SBAR(); \
      B_MFP(o2, onesf, pf2_); SBAR(); \
        \
      B_MFP(o0, ((bf16x8){c0_[0], c0_[1], c0_[2], c0_[3], c1_[0], c1_[1], c1_[2], c1_[3]}), pf3_); if (HASN) B_EX4C(PB1, 8); SBAR(); \
      B_MFP(o1, ((bf16x8){d0_[0], d0_[1], d0_[2], d0_[3], d1_[0], d1_[1], d1_[2], d1_[3]}), pf3_); if (HASN) B_EX4C(PB1, 12); SBAR(); \
      B_MFP(o2, onesf, pf3_); SBAR(); \
    } \
    if (resc) { o2[0] *= fres; _Pragma("unroll") for (int r = 0; r < 16; ++r) { o0[r] *= fres; o1[r] *= fres; } } \
    i3 = (i3 == 2) ? 0 : i3 + 1; \
    } while (0)
#define B_WAIT3() do { if (ABL & 4) asm volatile("s_waitcnt vmcnt(3) lgkmcnt(0)" ::: "memory"); else asm volatile("s_waitcnt vmcnt(3) lgkmcnt(0)\n\ts_barrier" ::: "memory"); } while (0)
#define B_WAIT1() asm volatile("s_waitcnt vmcnt(1) lgkmcnt(0)\n\ts_barrier" ::: "memory")
    int i3 = 0;
    for (int t = 0; t + 4 < NT; t += 2) {
        B_STEP(pA0, pA1, pB0, pB1, t, true);     B_WAIT3();
        B_STEP(pB0, pB1, pA0, pA1, t + 1, true); B_WAIT3();
    }
    B_STEP(pA0, pA1, pB0, pB1, NT - 4, true);  B_WAIT3();
    B_STEP(pB0, pB1, pA0, pA1, NT - 3, true);  B_WAIT1();
    B_STEP(pA0, pA1, pB0, pB1, NT - 2, true);  ATT_WAIT_BAR();
    B_STEP(pB0, pB1, pA0, pA1, NT - 1, false);
#undef B_WAIT3
#undef B_WAIT1
#undef B_STEP
#undef B_MFQ
#undef B_MFQ0
#undef B_MFP
#undef B_EX4C
#undef B_GAPA
#undef B_GAPA0
#undef B_KRD
#undef B_PIN
#undef B_EX4
#undef B_ISSUE_K
#undef B_ISSUE_V
    const float l = o2[0];
    { bf16* obase = (bf16*)(ws + WS_OB) + (t0 + qb * 256 + wave * 32) * 512 + head * 64;
      store_o_staged(lds + B_VOFF + 3 * B_VBUF + wave * 2048, o0, o1, 1.f / l, lane, [=](int row) { return obase + (size_t)row * 512; }); }
    ATT_WAIT_BAR();
}
__device__ __forceinline__ void p_attnB(const Frame& F, bool abl) {
    if (F.G == 256) {
        const int x = F.vcu >> 5, j = F.vcu & 31;
        for (int r = 0; r < 4; ++r) { const int bh = 16 * x + 4 * r + (j >> 3); { if (PROBE_ABL != 0 && abl) attnB_unit<PROBE_ABL>(F, bh >> 3, bh & 7, j & 7); else attnB_unit<0>(F, bh >> 3, bh & 7, j & 7); } }
    } else {
        for (int u = F.vcu; u < BATCH * 8 * 8; u += F.G) { const int bh = u >> 3; attnB_unit<0>(F, bh >> 3, bh & 7, u & 7); }
    }
}

constexpr int A_NSL = 384, A_KOFF = 0, A_VOFF = A_NSL * 128, A_TAB = 2 * A_NSL * 128, A_TABB = 4096, A_OST = A_TAB + 2 * A_TABB;
constexpr float A_NEG = -30000.f;
struct AGeo { int b, head, pat, g, dil, L, nslots; };
__device__ __forceinline__ AGeo a_geo(int vcu, int k) { AGeo q;
    const int x = vcu >> 5, j = vcu & 31, bh = 16 * x + 4 * (k / 3) + (j >> 3); q.b = bh >> 3; q.head = bh & 7; q.pat = k % 3; q.g = j & 7;
    q.dil = (q.pat == 0) ? 1 : (q.pat == 1) ? 4 : 16; q.L = SEQ / q.dil; q.nslots = (q.pat == 2) ? 256 : 384; return q; }
__device__ __forceinline__ int a_pos(const AGeo& q, int s) {
    if (q.pat == 2) return 2 * q.g + (s >> 7) + 16 * (s & 127);
    if (q.pat == 1) { int kn = 256 * (q.g & 1) - 64 + s; kn = kn < 0 ? 0 : (kn > 511 ? 511 : kn); return (q.g >> 1) + 4 * kn; }
    int kn = 256 * q.g - 64 + s; return kn < 0 ? 0 : (kn > 2047 ? 2047 : kn); }
__device__ __forceinline__ void glds16_s(const void* sbase, unsigned voff, LAS unsigned char* dst) { unsigned keep; const unsigned d = (unsigned)__builtin_amdgcn_readfirstlane((int)(unsigned)(size_t)dst);
    asm volatile("s_mov_b32 %0, m0\n\ts_mov_b32 m0, %3\n\ts_nop 0\n\tglobal_load_lds_dwordx4 %1, %2\n\ts_mov_b32 m0, %0" : "=&s"(keep) : "v"(voff), "s"(sbase), "s"(d) : "memory"); }
__device__ __forceinline__ void a_issue(const Frame& F, const AGeo& q, bool isv) {
    const unsigned char* src = F.ws + (isv ? WS_VA : WS_KA) + ((size_t)q.b * SEQ * 512 + q.head * 64) * 2;
    const int s0 = 8 * F.wave + (F.lane >> 3);
    const unsigned coff = (unsigned)((F.lane & 7) ^ (isv ? (((s0 >> 1) & 1) << 2) : ((s0 >> 1) & 7))) * 16u;
    LAS unsigned char* dst = F.lds + (isv ? A_VOFF : A_KOFF) + F.wave * 1024;
    if (q.pat == 2) {
        const unsigned o0 = (unsigned)(2 * q.g + 16 * s0) * 1024u + coff;
        glds16_s(src, o0, dst); glds16_s(src, o0 + 1024u * 1024u, dst + 8192); glds16_s(src, o0 + 1024u, dst + 16384); glds16_s(src, o0 + 1025u * 1024u, dst + 24576);
    } else {
        const int hi = q.pat == 1 ? 511 : 2047, sh = q.pat == 1 ? 12 : 10;
        const unsigned cb = (q.pat == 1 ? (unsigned)(q.g >> 1) * 1024u : 0u) + coff;
        const int w0 = (q.pat == 1 ? 256 * (q.g & 1) : 256 * q.g) - 64 + s0;
#pragma unroll
        for (int i = 0; i < 6; ++i) { int kn = w0 + 64 * i; kn = kn < 0 ? 0 : (kn > hi ? hi : kn); glds16_s(src, cb + ((unsigned)kn << sh), dst + i * 8192); }
    }
}
__device__ __forceinline__ void a_wave_geo(const AGeo& q, int wave, int& c, int& n0, int& hb, int& wstart) {
    if (q.pat == 2) { c = 2 * q.g + (wave >> 2); n0 = 32 * (wave & 3); hb = 128 * (wave >> 2); wstart = 0; }
    else if (q.pat == 1) { c = q.g >> 1; n0 = 256 * (q.g & 1) + 32 * wave; hb = 0; wstart = 256 * (q.g & 1) - 64; }
    else { c = 0; n0 = 256 * q.g + 32 * wave; hb = 0; wstart = 256 * q.g - 64; } }
__device__ __forceinline__ void a_load_q(const Frame& F, const AGeo& q, bf16x8 (&qf)[4]) {
    int c, n0, hb, wstart; a_wave_geo(q, F.wave, c, n0, hb, wstart);
    const size_t tq = (size_t)q.b * SEQ + c + q.dil * (n0 + (F.lane & 31));
    const bf16* QA = (const bf16*)(F.ws + WS_QA);
#pragma unroll
    for (int ks = 0; ks < 4; ++ks) qf[ks] = *(const bf16x8*)(QA + tq * 512 + q.head * 64 + ks * 16 + (F.lane >> 5) * 8);
}
__device__ __forceinline__ void a_write_tab(const Frame& F, const AGeo& q, int tsel) {
    if (F.wave < 4) glds16_asm((const bf16*)(F.ws + WS_BIMG) + (size_t)(q.pat * 8 + q.head) * 2048 + F.wave * 512 + F.lane * 8, F.lds + A_TAB + tsel * A_TABB + F.wave * 1024);
}
__device__ __forceinline__ f32x16 mfma_dc(bf16x8 a, bf16x8 b, const f32x16& c) { f32x16 d; asm volatile("v_mfma_f32_32x32x16_bf16 %0, %1, %2, %3" : "=&v"(d) : "v"(a), "v"(b), "v"(c)); return d; }
template <int ABL>
__device__ __forceinline__ void p_attnA(const Frame& F, bf16* OA, float* LSE) {
    if (F.vcu >= 256) return;
    LAS unsigned char* lds = F.lds;
    const int lane = F.lane, wave = F.wave, r32 = lane & 31, hi = lane >> 5;
    int kad[4];
#pragma unroll
    for (int ks = 0; ks < 4; ++ks) kad[ks] = r32 * 128 + (((2 * ks + hi) ^ ((r32 >> 1) & 7)) * 16);
    const int vq = (lane & 15) >> 2;
    const int vbo0 = (4 * hi + vq) * 128 + (((((lane >> 4) & 1) * 2 + ((lane & 3) >> 1)) ^ (((vq >> 1) & 1) << 2)) * 16) + (lane & 1) * 8;
    const int bm = (7 - r32) & 7;
    const int bbo = bm * 400 + (159 - 128 - r32 + 8 * hi - bm) * 2;
    bf16x8 idn[2];
#pragma unroll
    for (int s2 = 0; s2 < 2; ++s2)
#pragma unroll
        for (int j = 0; j < 8; ++j) idn[s2][j] = (16 * s2 + 8 * hi + j == r32) ? (short)0x3F80 : (short)0;
    constexpr int NU = 12;
    const bf16x8 onesf = (bf16x8){(short)0x3F80, (short)0x3F80, (short)0x3F80, (short)0x3F80, (short)0x3F80, (short)0x3F80, (short)0x3F80, (short)0x3F80};
    AGeo q = a_geo(F.vcu, 0);
    if (!(ABL & 2)) { a_issue(F, q, false); a_issue(F, q, true); } a_write_tab(F, q, 0);
    bf16x8 qf[4]; a_load_q(F, q, qf);
    ATT_WAIT_BAR();
#pragma unroll 1
    for (int k = 0; k < NU; ++k) {
        int c, n0, hb, wstart; a_wave_geo(q, wave, c, n0, hb, wstart);
        const LAS unsigned char* tbb = lds + A_TAB + (k & 1) * A_TABB + bbo;
        f32x16 p[5]; bool val[5]; float mref; f32x16 negm;
        {   const LAS unsigned char* kb = lds + A_KOFF + (hb + n0 - wstart) * 128;
#pragma unroll
            for (int r = 0; r < 16; ++r) p[2][r] = 0.f;
#pragma unroll
            for (int ks = 0; ks < 4; ++ks) { const bf16x8 kf = *(const LAS bf16x8*)(kb + kad[ks]); if (!(ABL & 8)) p[2] = __builtin_amdgcn_mfma_f32_32x32x16_bf16(kf, qf[ks], p[2], 0, 0, 0); else asm volatile("" :: "v"(kf)); }
#pragma unroll
            for (int s2 = 0; s2 < 2; ++s2) { const bf16x8 bfr = *(const LAS bf16x8*)(tbb + (16 * s2 + 32 * 2) * 2); if (!(ABL & 8)) p[2] = __builtin_amdgcn_mfma_f32_32x32x16_bf16(bfr, idn[s2], p[2], 0, 0, 0); else asm volatile("" :: "v"(bfr)); }
            asm volatile("s_nop 15" : "+v"(p[2]));
            float a = max3f(p[2][0], p[2][1], p[2][2]), b2 = max3f(p[2][3], p[2][4], p[2][5]);
            a = max3f(a, p[2][6], p[2][7]); b2 = max3f(b2, p[2][8], p[2][9]); a = max3f(a, p[2][10], p[2][11]); b2 = max3f(b2, p[2][12], p[2][13]); a = max3f(a, p[2][14], p[2][15]);
            float mx = max2f(a, b2);
            { auto rr = __builtin_amdgcn_permlane32_swap(__float_as_uint(mx), __float_as_uint(mx), false, false); mx = max2f(__uint_as_float(rr[0]), __uint_as_float(rr[1])); }
            mref = mx;
#pragma unroll
            for (int r = 0; r < 16; ++r) { negm[r] = -mref; p[2][r] -= mref; }
            val[2] = true;
        }
#pragma unroll
        for (int i = 0; i < 5; ++i) {
            if (i == 2) continue;
            const int kt0 = n0 - 64 + 32 * i; val[i] = (kt0 >= 0 && kt0 < q.L);
            if (val[i]) {
                const LAS unsigned char* kb = lds + A_KOFF + (hb + kt0 - wstart) * 128;
                { const bf16x8 kf = *(const LAS bf16x8*)(kb + kad[0]); if (!(ABL & 8)) p[i] = mfma_dc(kf, qf[0], negm); else { p[i] = negm; asm volatile("" :: "v"(kf)); } }
#pragma unroll
                for (int ks = 1; ks < 4; ++ks) { const bf16x8 kf = *(const LAS bf16x8*)(kb + kad[ks]); if (!(ABL & 8)) p[i] = __builtin_amdgcn_mfma_f32_32x32x16_bf16(kf, qf[ks], p[i], 0, 0, 0); else asm volatile("" :: "v"(kf)); }
#pragma unroll
                for (int s2 = 0; s2 < 2; ++s2) { const bf16x8 bfr = *(const LAS bf16x8*)(tbb + (16 * s2 + 32 * (4 - i)) * 2); if (!(ABL & 8)) p[i] = __builtin_amdgcn_mfma_f32_32x32x16_bf16(bfr, idn[s2], p[i], 0, 0, 0); else asm volatile("" :: "v"(bfr)); }
            }
        }
        if (ABL & 4) asm volatile("s_waitcnt vmcnt(0) lgkmcnt(0)" ::: "memory"); else ATT_WAIT_BAR();
        AGeo qn = q; bf16x8 qfn[4];
        if (k + 1 < NU) { qn = a_geo(F.vcu, k + 1); if (!(ABL & 64)) a_write_tab(F, qn, (k + 1) & 1); a_load_q(F, qn, qfn); if (!(ABL & 2)) a_issue(F, qn, false); }
        f32x16 o0, o1, o2;
#pragma unroll
        for (int r = 0; r < 16; ++r) { o0[r] = 0.f; o1[r] = 0.f; o2[r] = 0.f; }
#pragma unroll
        for (int i = 0; i < 5; ++i) {
            if (val[i]) {
#pragma unroll
                for (int r = 0; r < 16; ++r) { if (!(ABL & 1)) p[i][r] = __builtin_amdgcn_exp2f(p[i][r]); }
                const int kt0 = n0 - 64 + 32 * i;
                const LAS unsigned char* vb = lds + A_VOFF + (hb + kt0 - wstart) * 128;
#pragma unroll
                for (int s2 = 0; s2 < 2; ++s2) {
                    u32x4 w; w.x = cvtpk(p[i][8 * s2 + 0], p[i][8 * s2 + 1]); w.y = cvtpk(p[i][8 * s2 + 2], p[i][8 * s2 + 3]); w.z = cvtpk(p[i][8 * s2 + 4], p[i][8 * s2 + 5]); w.w = cvtpk(p[i][8 * s2 + 6], p[i][8 * s2 + 7]);
                    const bf16x8 pf = __builtin_bit_cast(bf16x8, w);
                    const LAS unsigned char* v0p = vb + s2 * 2048 + vbo0; const LAS unsigned char* v1p = vb + s2 * 2048 + (vbo0 ^ 64);
                    if (!(ABL & 16)) {
                    const s16x4 a0 = vtr(v0p), a1 = vtr(v0p + 1024), b0 = vtr(v1p), b1 = vtr(v1p + 1024);
                    o0 = __builtin_amdgcn_mfma_f32_32x32x16_bf16(((bf16x8){a0[0], a0[1], a0[2], a0[3], a1[0], a1[1], a1[2], a1[3]}), pf, o0, 0, 0, 0);
                    o1 = __builtin_amdgcn_mfma_f32_32x32x16_bf16(((bf16x8){b0[0], b0[1], b0[2], b0[3], b1[0], b1[1], b1[2], b1[3]}), pf, o1, 0, 0, 0);
                    o2 = __builtin_amdgcn_mfma_f32_32x32x16_bf16(onesf, pf, o2, 0, 0, 0);
                    } else asm volatile("" :: "v"(pf));
                }
            }
        }
        const float l = o2[0];
        const size_t tq0 = (size_t)q.pat * T + (size_t)q.b * SEQ + c + q.dil * n0;
        if (!(ABL & 32)) { bf16* obase = OA + tq0 * 512 + q.head * 64; const int rstride = q.dil * 512;
          store_o_staged(lds + A_OST + wave * 2048, o0, o1, 1.f / l, lane, [=](int row) { return obase + (size_t)row * rstride; }); }
        if (!(ABL & 32)) { if (hi == 0) LSE[(tq0 + q.dil * r32) * 8 + q.head] = mref + __builtin_amdgcn_logf(l); } else asm volatile("" :: "v"(l), "v"(o0), "v"(o1));
        if (ABL & 4) asm volatile("s_waitcnt vmcnt(5) lgkmcnt(0)" ::: "memory"); else asm volatile("s_waitcnt vmcnt(5) lgkmcnt(0)\n\ts_barrier" ::: "memory");
        if (k + 1 < NU) { if (!(ABL & 2)) a_issue(F, qn, true);
#pragma unroll
            for (int ks = 0; ks < 4; ++ks) qf[ks] = qfn[ks];
            q = qn; }
    }
}
constexpr int MQ = 4;
template <int NP>
__device__ __forceinline__ void p_mixnorm(const Frame& F, const bf16* __restrict__ OA, const float* __restrict__ LSE, int row0, int nrows, int wid, int nw) {
    unsigned char* ws = F.ws; const int lane = F.lane;
    const bf16* __restrict__ OBp = (const bf16*)(ws + WS_OB); bf16* __restrict__ MIX = (bf16*)(ws + WS_MIX);
    float ga[8], gb[8];
#pragma unroll
    for (int i = 0; i < 8; ++i) { ga[i] = F.in[8][lane * 8 + i]; gb[i] = F.in[9][lane * 8 + i]; }
    const int head = lane >> 3;
    for (int m0 = row0 + wid * MQ; m0 < row0 + nrows; m0 += nw * MQ) {
        u32x4 pa[MQ][NP], pb[MQ]; float w[MQ][NP];
#pragma unroll
        for (int q = 0; q < MQ; ++q) { const int m = m0 + q;
#pragma unroll
            for (int p = 0; p < NP; ++p) { pa[q][p] = *(const u32x4*)(OA + ((size_t)p * T + m) * 512 + lane * 8); w[q][p] = LSE[((size_t)p * T + m) * 8 + head]; }
            pb[q] = *(const u32x4*)(OBp + (size_t)m * 512 + lane * 8); }
#pragma unroll
        for (int q = 0; q < MQ; ++q) { const int m = m0 + q; float a[8], mx = -1e30f;
#pragma unroll
            for (int p = 0; p < NP; ++p) mx = fmaxf(mx, w[q][p]);
            float wsum = 0.f;
#pragma unroll
            for (int p = 0; p < NP; ++p) { w[q][p] = exp2f(w[q][p] - mx); wsum += w[q][p]; }
            const float iw = 1.f / wsum;
#pragma unroll
            for (int i = 0; i < 8; ++i) a[i] = 0.f;
#pragma unroll
            for (int p = 0; p < NP; ++p) { float t8[8]; unpack8(pa[q][p], t8); const float ww = w[q][p] * iw;
#pragma unroll
                for (int i = 0; i < 8; ++i) a[i] += ww * t8[i]; }
            float bv[8]; unpack8(pb[q], bv);
            float sa = 0.f, sb = 0.f;
#pragma unroll
            for (int i = 0; i < 8; ++i) { sa += a[i] * a[i]; sb += bv[i] * bv[i]; }
            sa = wave_sum(sa); sb = wave_sum(sb);
            const float ra = rsqrtf(sa * (1.f / 512.f) + EPS), rb = rsqrtf(sb * (1.f / 512.f) + EPS);
            u32x4 oa, ob;
            oa.x = pk2(a[0] * ra * ga[0], a[1] * ra * ga[1]); oa.y = pk2(a[2] * ra * ga[2], a[3] * ra * ga[3]); oa.z = pk2(a[4] * ra * ga[4], a[5] * ra * ga[5]); oa.w = pk2(a[6] * ra * ga[6], a[7] * ra * ga[7]);
            ob.x = pk2(bv[0] * rb * gb[0], bv[1] * rb * gb[1]); ob.y = pk2(bv[2] * rb * gb[2], bv[3] * rb * gb[3]); ob.z = pk2(bv[4] * rb * gb[4], bv[5] * rb * gb[5]); ob.w = pk2(bv[6] * rb * gb[6], bv[7] * rb * gb[7]);
            bf16* mix = MIX + (size_t)m * 1024;
            *(u32x4*)(mix + lane * 8) = oa; *(u32x4*)(mix + 512 + lane * 8) = ob; }
    }
}
constexpr int R_BUF = 96 * 512, R_LG = 2 * R_BUF, R_CNT = R_LG + 8 * 16 * 52 * 4;
__device__ __forceinline__ void p_router(const Frame& F) {
    unsigned char* ws = F.ws; const int lane = F.lane, wave = F.wave; LAS unsigned char* lds = F.lds;
    LAS float* lg = (LAS float*)(lds + R_LG + wave * (16 * 52 * 4));
    LAS int* cnt_l = (LAS int*)(lds + R_CNT); LAS int* base_l = cnt_l + 32;
    const bf16* X1 = (const bf16*)(ws + WS_X1); const bf16* WR = (const bf16*)(ws + WS_WR);
    const float* brg = F.in[13]; const float* bre = F.in[15];
    int* counts = (int*)(ws + WS_CTL) + CW_COUNTS; const float* ssq1 = (const float*)(ws + CTL_SSQ1);
    if (F.tid < 32) cnt_l[F.tid] = 0;
#define R_ISSUE(kc, buf) do { _Pragma("unroll") for (int i_ = 0; i_ < 6; ++i_) { const int p_ = wave + 8 * i_, row_ = 2 * p_ + (lane >> 5); \
        glds16_asm(WR + (size_t)row_ * 1024 + (kc) * 256 + (((lane & 31) ^ (row_ & 15)) * 8), lds + (buf) * R_BUF + p_ * 1024); } } while (0)
    const int col = lane & 15, kq = lane >> 4;
    for (int unit = F.vcu; unit < T / 128; unit += F.G) {
        const int tok0 = unit * 128 + wave * 16;
        f32x4 acc[3];
#pragma unroll
        for (int ct = 0; ct < 3; ++ct) acc[ct] = (f32x4){0.f, 0.f, 0.f, 0.f};
        const bf16* arow = X1 + (size_t)(tok0 + col) * 1024 + kq * 8;
        ATT_WAIT_BAR();
        R_ISSUE(0, 0);
#pragma unroll 1
        for (int kc = 0; kc < 4; ++kc) {
            bf16x8 af[8];
#pragma unroll
            for (int kk = 0; kk < 8; ++kk) af[kk] = *(const bf16x8*)(arow + kc * 256 + kk * 32);
            if (kc + 1 < 4) { R_ISSUE(kc + 1, (kc + 1) & 1); asm volatile("s_waitcnt vmcnt(6) lgkmcnt(0)\n\ts_barrier" ::: "memory"); }
            else ATT_WAIT_BAR();
            const LAS unsigned char* wb = lds + (kc & 1) * R_BUF;
#pragma unroll
            for (int kk = 0; kk < 8; ++kk) {
#pragma unroll
                for (int ct = 0; ct < 3; ++ct) {
                    const int rh = ct * 16 + col, rl = 48 + ct * 16 + col, c16 = kk * 4 + kq;
                    const bf16x8 bh = *(const LAS bf16x8*)(wb + rh * 512 + ((c16 ^ (rh & 15)) * 16)), bl = *(const LAS bf16x8*)(wb + rl * 512 + ((c16 ^ (rl & 15)) * 16));
                    acc[ct] = __builtin_amdgcn_mfma_f32_16x16x32_bf16(af[kk], bh, acc[ct], 0, 0, 0);
                    acc[ct] = __builtin_amdgcn_mfma_f32_16x16x32_bf16(af[kk], bl, acc[ct], 0, 0, 0);
                }
            }
            if (kc + 1 < 4) asm volatile("s_waitcnt lgkmcnt(0)\n\ts_barrier" ::: "memory");
            if (kc + 2 < 4) {   }
        }
#pragma unroll
        for (int ct = 0; ct < 3; ++ct)
#pragma unroll
            for (int j = 0; j < 4; ++j) lg[(4 * (lane >> 4) + j) * 52 + ct * 16 + (lane & 15)] = acc[ct][j];
        LDS_WAIT();
        int e1 = 0, e2 = 0, q1 = 0, q2 = 0; float g1 = 0.f, g2 = 0.f; const int m = tok0 + lane;
        if (lane < 16) {
            const float rs = rsqrtf(ssq1[m] * (1.f / D) + EPS);
            const LAS float* L = lg + lane * 52;
            int gi = 0; float gm = L[0] * rs + brg[0];
            float gl1 = L[1] * rs + brg[1], gl2 = L[2] * rs + brg[2], gl3 = L[3] * rs + brg[3]; const float gl0 = gm;
            if (gl1 > gm) { gm = gl1; gi = 1; } if (gl2 > gm) { gm = gl2; gi = 2; } if (gl3 > gm) { gm = gl3; gi = 3; }
            const float gs = __expf(gl0 - gm) + __expf(gl1 - gm) + __expf(gl2 - gm) + __expf(gl3 - gm);
            const float ggate = 1.f / gs;
            const LAS float* EL = L + 4 + gi * 8; const float* eb = bre + gi * 8;
            int i1 = 0; float m1 = EL[0] * rs + eb[0];
            for (int i = 1; i < 8; ++i) { const float v = EL[i] * rs + eb[i]; if (v > m1) { m1 = v; i1 = i; } }
            int i2 = -1; float m2 = -3.0e38f;
            for (int i = 0; i < 8; ++i) { const float v = EL[i] * rs + eb[i]; if (i != i1 && v > m2) { m2 = v; i2 = i; } }
            const float p2 = __expf(m2 - m1); g1 = ggate / (1.f + p2); g2 = ggate * p2 / (1.f + p2);
            e1 = gi * 8 + i1; e2 = gi * 8 + i2;
            q1 = __hip_atomic_fetch_add(cnt_l + e1, 1, __ATOMIC_RELAXED, __HIP_MEMORY_SCOPE_WORKGROUP);
            q2 = __hip_atomic_fetch_add(cnt_l + e2, 1, __ATOMIC_RELAXED, __HIP_MEMORY_SCOPE_WORKGROUP);
        }
        __syncthreads();
        if (F.tid < 32) { const int c = cnt_l[F.tid]; base_l[F.tid] = c ? atomicAdd(&counts[F.tid], c) : 0; }
        __syncthreads();
        if (lane < 16) {
            const int p1 = base_l[e1] + q1, pp2 = base_l[e2] + q2;
            ((int*)(ws + WS_TOK))[e1 * CAP + p1] = m; ((int*)(ws + WS_TOK))[e2 * CAP + pp2] = m;
            ((float*)(ws + WS_GATE))[e1 * CAP + p1] = g1; ((float*)(ws + WS_GATE))[e2 * CAP + pp2] = g2;
            ((int*)(ws + WS_AE))[m * 2] = e1; ((int*)(ws + WS_AE))[m * 2 + 1] = e2; ((int*)(ws + WS_APOS))[m * 2] = p1; ((int*)(ws + WS_APOS))[m * 2 + 1] = pp2;
        }
        __syncthreads();
        if (F.tid < 32) cnt_l[F.tid] = 0;
        __syncthreads();
    }
#undef R_ISSUE
}
__device__ __forceinline__ void moe_tables(const Frame& F) {
    LAS int* pst = (LAS int*)(F.lds + MOE_OFF); LAS int* cnt = pst + 40;
    const int* counts = (const int*)(F.ws + WS_CTL) + CW_COUNTS;
    __syncthreads();
    if (F.tid < NE) cnt[F.tid] = counts[F.tid];
    __syncthreads();
    if (F.tid == 0) { int acc = 0; for (int e = 0; e < NE; ++e) { pst[e] = acc; acc += (cnt[e] + 255) >> 8; } pst[NE] = acc; }
    __syncthreads();
}
constexpr int FQ = 2;
__device__ __forceinline__ void p_final(const Frame& F) {
    unsigned char* ws = F.ws; const int lane = F.lane; const float* __restrict__ gfin = F.in[19];
    const LAS int* pst = (const LAS int*)(F.lds + MOE_OFF);
    const int* __restrict__ AE = (const int*)(ws + WS_AE); const int* __restrict__ AP = (const int*)(ws + WS_APOS);
    const bf16* __restrict__ X1 = (const bf16*)(ws + WS_X1); const bf16* __restrict__ YB = (const bf16*)(ws + WS_YB);
    float* __restrict__ out = F.out;
    f32x4 g4[4];
#pragma unroll
    for (int j = 0; j < 2; ++j) { g4[2 * j] = *((const f32x4*)gfin + 2 * lane + 128 * j); g4[2 * j + 1] = *((const f32x4*)gfin + 2 * lane + 128 * j + 1); }
    const int step = F.G * NWAVES * FQ;
    int m0 = (F.vcu * NWAVES + F.wave) * FQ;
    if (m0 >= T) return;
    u32x2 ie[FQ], ip[FQ];
    u32x4 xa[FQ][2], ya[FQ][2], yb[FQ][2], xn[FQ][2], yan[FQ][2], ybn[FQ][2];
#define FIN_IDX(mm) do { _Pragma("unroll") for (int q = 0; q < FQ; ++q) { ie[q] = *(const u32x2*)(AE + ((mm) + q) * 2); ip[q] = *(const u32x2*)(AP + ((mm) + q) * 2); } } while (0)
#define FIN_ROWS(mm, XA, YA, YB_) do { _Pragma("unroll") for (int q = 0; q < FQ; ++q) { const int m = (mm) + q; \
        const int r1 = (int)ip[q].x + pst[ie[q].x] * 256, r2 = (int)ip[q].y + pst[ie[q].y] * 256; \
        _Pragma("unroll") for (int j = 0; j < 2; ++j) { XA[q][j] = *((const u32x4*)(X1 + (size_t)m * 1024) + lane + 64 * j); YA[q][j] = *((const u32x4*)(YB + (size_t)r1 * 1024) + lane + 64 * j); YB_[q][j] = *((const u32x4*)(YB + (size_t)r2 * 1024) + lane + 64 * j); } } } while (0)
    FIN_IDX(m0); FIN_ROWS(m0, xa, ya, yb);
    if (m0 + step < T) FIN_IDX(m0 + step);
    for (; m0 < T; m0 += step) {
        const bool more = (m0 + step < T);
        if (more) { FIN_ROWS(m0 + step, xn, yan, ybn); if (m0 + 2 * step < T) FIN_IDX(m0 + 2 * step); }
#pragma unroll
        for (int q = 0; q < FQ; ++q) { const int m = m0 + q; float v[2][8]; float s = 0.f;
#pragma unroll
            for (int j = 0; j < 2; ++j) { float a[8], b[8], c[8]; unpack8(xa[q][j], a); unpack8(ya[q][j], b); unpack8(yb[q][j], c);
#pragma unroll
                for (int i = 0; i < 8; ++i) { v[j][i] = a[i] + b[i] + c[i]; s += v[j][i] * v[j][i]; } }
            s = wave_sum(s); const float rs = rsqrtf(s * (1.f / D) + EPS);
#pragma unroll
            for (int j = 0; j < 2; ++j) { f32x4 o0, o1;
                o0.x = v[j][0] * rs * g4[2 * j].x; o0.y = v[j][1] * rs * g4[2 * j].y; o0.z = v[j][2] * rs * g4[2 * j].z; o0.w = v[j][3] * rs * g4[2 * j].w;
                o1.x = v[j][4] * rs * g4[2 * j + 1].x; o1.y = v[j][5] * rs * g4[2 * j + 1].y; o1.z = v[j][6] * rs * g4[2 * j + 1].z; o1.w = v[j][7] * rs * g4[2 * j + 1].w;
                f32x4* op = (f32x4*)(out + (size_t)m * D) + 2 * lane + 128 * j; op[0] = o0; op[1] = o1; } }
        if (more) {
#pragma unroll
            for (int q = 0; q < FQ; ++q)
#pragma unroll
                for (int j = 0; j < 2; ++j) { xa[q][j] = xn[q][j]; ya[q][j] = yan[q][j]; yb[q][j] = ybn[q][j]; } }
    }
#undef FIN_IDX
#undef FIN_ROWS
}

__global__ void __launch_bounds__(NWAVES * 64, 2) mk_fwd(Args args) {
    extern __shared__ __attribute__((aligned(16))) unsigned char lds_raw[];
    Frame F;
    F.lds = (LAS unsigned char*)lds_raw;
    F.tid = threadIdx.x; F.lane = F.tid & 63; F.wave = __builtin_amdgcn_readfirstlane(F.tid >> 6);
    F.G = gridDim.x; { const int bx = blockIdx.x; F.vcu = (F.G % 8 == 0) ? (bx % 8) * (F.G / 8) + bx / 8 : bx; }
    F.in = args.in; F.out = args.out; F.ws = args.ws; F.pflags = args.flags;
    unsigned char* ws = args.ws;
    for (int u = F.tid; u < (LDS_BYTES - LDSCTL_OFF) / 4; u += NWAVES * 64) ((LAS unsigned*)(F.lds + LDSCTL_OFF))[u] = 0u;
    __syncthreads();
#if MK_SPLIT
#define GRID_BAR() do { } while (0)
#else
    volatile LAS unsigned* MISC = (volatile LAS unsigned*)(F.lds + MISC_OFF);
    XcdBarrier bar = xcd_barrier_post((unsigned*)(ws + WS_CTL) + CW_BAR, MISC + 8);
#define GRID_BAR() xcd_barrier(bar)
#endif
#ifndef SLACK_PCT
#define SLACK_PCT 0
#endif
#define STAGGER_SLACK(n_units, t_unit_ticks, myid) do { const int nu_ = (n_units), rounds_ = (nu_ + F.G - 1) / F.G; const int mine_ = (nu_ - (myid) + F.G - 1) / F.G; \
        if (SLACK_PCT > 0 && mine_ < rounds_) { const unsigned long long t0_ = __builtin_amdgcn_s_memrealtime(); \
            const unsigned long long d_ = (unsigned long long)(t_unit_ticks) * SLACK_PCT / 100 * (unsigned)((F.vcu * 37) & 63) / 64; \
            while (__builtin_amdgcn_s_memrealtime() - t0_ < d_) __builtin_amdgcn_s_sleep(8); } } while (0)
    const int lo = args.ph_lo, hi = args.ph_hi;
#ifndef PH_MASK
#define PH_MASK 0x3ff
#endif
#define IN(k) (((PH_MASK >> (k)) & 1) && lo <= (k) && (k) < hi)
#define BOTH(k) (IN(k) && IN((k) + 1))
    bf16* OA = (bf16*)args.out; float* LSE = (float*)(ws + WS_LSE);
    const LAS int* pst = (const LAS int*)(F.lds + MOE_OFF); const LAS int* cnt = pst + 40;

#ifndef ATTN_A_NAIVE
#define ATTN_A_NAIVE 0
#endif
    static_assert(ATTN_A_NAIVE == 0, "the naive mixer-A body writes one partial; the fused merge expects three");
#ifndef ATTN_B_NAIVE
#define ATTN_B_NAIVE 0
#endif
    if (IN(0)) { p_prologue(F); if (BOTH(0)) GRID_BAR(); }
    if (IN(1)) {
        PlainSched S; S.so.init(T, NINP, F.G, (int)blockIdx.x); S.A = (const bf16*)(ws + WS_XB); S.Bt = (const bf16*)(ws + WS_WI); S.lda = 1024; S.ldb = 1024; S.acol_pn = 1 << 30; S.acol_off = 0;
        EpiInProj E{ws};
        pg8::gemm_phase<EpiInProj, PlainSched, true>(F.lds, 1024, 1024, S, E);
        if (BOTH(1)) GRID_BAR();
    }
    if (IN(2)) {
        PlainSched S; S.so.init(T, 768 + 1024, F.G, (int)blockIdx.x); S.A = (const bf16*)(ws + WS_LAT); S.Bt = (const bf16*)(ws + WS_WQKV); S.lda = 512; S.ldb = 256; S.acol_pn = 3; S.acol_off = 256;
        EpiUps E{ws};
        STAGGER_SLACK(896, 1500, (int)blockIdx.x);
        pg8::gemm_phase<EpiUps, PlainSched, true>(F.lds, 256, 256, S, E);
        if (!(args.flags & 2)) { if (ATTN_A_NAIVE) p_attnA_naive(F, OA, LSE); else if (PROBE_ABL != 0 && (args.flags & 8)) p_attnA<PROBE_ABL>(F, OA, LSE); else p_attnA<0>(F, OA, LSE); }
        { const int r_ = S.so.nwg % F.G, c_ = (int)blockIdx.x;
          if (r_ == 0) p_convert_experts(F, 0, c_ * NWAVES + F.wave, F.G * NWAVES); else if (c_ >= r_) p_convert_experts(F, 0, (c_ - r_) * NWAVES + F.wave, (F.G - r_) * NWAVES); }
        if (BOTH(2)) GRID_BAR();
    }
    if (IN(3)) {
        if (!(args.flags & 1)) { if (ATTN_B_NAIVE) p_attnB_naive(F); else p_attnB(F, (args.flags & 4) != 0); }
        if (BOTH(3)) GRID_BAR(); }
    if (IN(4)) { p_mixnorm<3>(F, OA, LSE, 0, T, F.vcu * NWAVES + F.wave, F.G * NWAVES); if (BOTH(4)) GRID_BAR(); }
    if (IN(5)) {
        EpiOut E{ws, (args.flags >> 9) & 7};
        PlainSched S; S.so.init(T, 1024, F.G, (int)blockIdx.x); S.A = (const bf16*)(ws + WS_MIX); S.Bt = (const bf16*)(ws + WS_WO); S.lda = 1024; S.ldb = 1024; S.acol_pn = 1 << 30; S.acol_off = 0;
        pg8::gemm_phase<EpiOut, PlainSched, true>(F.lds, 1024, 1024, S, E, (args.flags & 4096) != 0, (args.flags & 8192) != 0);
        if (BOTH(5)) GRID_BAR();
    }
    if (IN(6)) { p_router(F); if (BOTH(6)) GRID_BAR(); }
    if (IN(7)) {
        moe_tables(F);
        MoeSched S; S.G = F.G; S.c = F.vcu;      S.NT = 2; S.npanels = pst[NE]; S.pst = pst; S.cnt = cnt; S.toks = (const int*)(ws + WS_TOK);
        S.A = (const bf16*)(ws + WS_X1); S.Bt = (const bf16*)(ws + WS_WGU); S.lda = 1024; S.ldb = 1024; S.bstride = (size_t)512 * 1024; S.gather = true; S.mode = 0;
        EpiGateUp E{ws, cnt};
        STAGGER_SLACK(pst[NE] * 2, 2700, F.vcu);
        pg8::gemm_phase<EpiGateUp, MoeSched, true>(F.lds, 1024, 1024, S, E);
        S.mode = 1; pg8::gemm_phase<EpiGateUp, MoeSched, true, true>(F.lds, 1024, 1024, S, E);
        { const int r_ = S.tail_wgs(), c_ = F.vcu;
          if (r_ == 0) p_convert_experts(F, 1, c_ * NWAVES + F.wave, F.G * NWAVES); else if (c_ >= r_) p_convert_experts(F, 1, (c_ - r_) * NWAVES + F.wave, (F.G - r_) * NWAVES); }
        if (BOTH(7)) GRID_BAR();
    }
    if (IN(8)) {
        moe_tables(F);
        MoeSched S; S.G = F.G; S.c = F.vcu;      S.NT = 4; S.npanels = pst[NE]; S.pst = pst; S.cnt = cnt; S.toks = (const int*)(ws + WS_TOK);
        S.A = (const bf16*)(ws + WS_HB); S.Bt = (const bf16*)(ws + WS_WD); S.lda = 256; S.ldb = 256; S.bstride = (size_t)1024 * 256; S.gather = false; S.mode = 0;
        EpiDown E{ws, cnt, (args.flags >> 4) & 3};
        STAGGER_SLACK(pst[NE] * 4, 1400, F.vcu);
        pg8::gemm_phase<EpiDown, MoeSched, true>(F.lds, 256, 256, S, E, (args.flags & 32) != 0, (args.flags & 64) != 0);
        S.mode = 1; pg8::gemm_phase<EpiDown, MoeSched, true, true>(F.lds, 256, 256, S, E);
        if (BOTH(8)) GRID_BAR();
    }
    if (IN(9)) { moe_tables(F); p_final(F); }
#undef IN
#undef BOTH
}
}

extern "C" void kernel_launch(void* const* d_in, const int* in_sizes, int n_in, void* d_out, int out_size, void* d_ws, size_t ws_size, hipStream_t stream) {
    static int grid = 0;
    if (grid == 0) {
        if (n_in != 20 || ws_size < WS_END || out_size != T * D) { fprintf(stderr, "kernel_launch: unexpected shapes (n_in %d, ws %zu, out %d)\n", n_in, ws_size, out_size); grid = -1; return; }
        int dev = 0, cus = 0, per_cu = 0;
        if (hipGetDevice(&dev) != hipSuccess || hipDeviceGetAttribute(&cus, hipDeviceAttributeMultiprocessorCount, dev) != hipSuccess) { grid = -1; return; }
        if (hipFuncSetAttribute((const void*)mk_fwd, hipFuncAttributeMaxDynamicSharedMemorySize, LDS_BYTES) != hipSuccess) { fprintf(stderr, "kernel_launch: hipFuncSetAttribute failed\n"); grid = -1; return; }
        if (hipOccupancyMaxActiveBlocksPerMultiprocessor(&per_cu, (const void*)mk_fwd, NWAVES * 64, LDS_BYTES) != hipSuccess || per_cu < 1) { fprintf(stderr, "kernel_launch: occupancy query says %d\n", per_cu); }
        (void)hipGetLastError();
        if (cus < 256) { fprintf(stderr, "kernel_launch: this kernel's unit maps are written for a 256-workgroup grid, one workgroup per CU; the device has %d CUs; nothing launched\n", cus); grid = -1; return; }
        grid = 256;
    }
    if (grid < 0) return;
    (void)hipMemsetAsync((char*)d_ws + WS_CTL, 0, CTL_BYTES, stream);
    Args a{};
    for (int i = 0; i < 20; ++i) a.in[i] = (const float*)d_in[i];
    a.out = (float*)d_out; a.ws = (unsigned char*)d_ws;
#if MK_SPLIT
    for (int p = 0; p < NPHASE; ++p) { a.ph_lo = p; a.ph_hi = p + 1; hipLaunchKernelGGL(mk_fwd, dim3(grid), dim3(NWAVES * 64), LDS_BYTES, stream, a); }
#else
#ifndef PROBE_PREFIX
#define PROBE_PREFIX -1
#endif
#ifndef PROBE_FLAGS
#define PROBE_FLAGS 0
#endif
    if (PROBE_PREFIX >= 0) {
        a.ph_lo = 0; a.ph_hi = PROBE_PREFIX + 1; a.flags = PROBE_FLAGS;
        hipLaunchKernelGGL(mk_fwd, dim3(grid), dim3(NWAVES * 64), LDS_BYTES, stream, a);
        (void)hipMemsetAsync((char*)d_ws + WS_CTL, 0, CTL_BYTES, stream);
    }
    a.ph_lo = 0; a.ph_hi = NPHASE; a.flags = 0;
    hipLaunchKernelGGL(mk_fwd, dim3(grid), dim3(NWAVES * 64), LDS_BYTES, stream, a);
#endif
}
```

```cpp
#include <hip/hip_runtime.h>
#include <stdint.h>
#include <stdio.h>

#ifndef PROBE_ABL
#define PROBE_ABL 0
#endif
#ifndef MK_SPLIT
#define MK_SPLIT 0
#endif

#define LAS __attribute__((address_space(3)))
#define GAS __attribute__((address_space(1)))

namespace {
typedef unsigned short bf16;
typedef short bf16x8 __attribute__((ext_vector_type(8)));
typedef float f32x4 __attribute__((ext_vector_type(4)));
typedef unsigned u32x4 __attribute__((ext_vector_type(4)));
typedef unsigned u32x2 __attribute__((ext_vector_type(2)));

constexpr int D = 1024, BATCH = 16, SEQ = 2048, T = BATCH * SEQ;
constexpr int NIN = 1952, NINP = 2048;
constexpr int NE = 32, CAP = 32768;
constexpr float EPS = 1e-6f;
constexpr float LOG2E = 1.4426950408889634f;
constexpr float QS_A = 0.125f * LOG2E;
constexpr float QS_B = 0.10206207261596577f * LOG2E;
constexpr int NWAVES = 8;
constexpr int NPHASE = 10;

constexpr size_t MiB = 1u << 20;
constexpr size_t WS_CTL = 0;
constexpr size_t CTL_BYTES = 1 * MiB;
constexpr int CW_COUNTS = 64;
constexpr int CW_BAR = 4096;
constexpr size_t CTL_SSQQ = 128 * 1024, CTL_SSQKV = 256 * 1024, CTL_SSQ1 = 384 * 1024;
constexpr size_t WS_RS0 = 2 * MiB;
constexpr size_t WS_ROPE = WS_RS0 + 512 * 1024;
constexpr size_t WS_BT = WS_ROPE + 256 * 1024;
constexpr size_t WS_BIMG = WS_BT + 16 * 1024;
constexpr size_t WS_AE = 3 * MiB;
constexpr size_t WS_APOS = WS_AE + 256 * 1024;
constexpr size_t WS_LSE = 4 * MiB;
constexpr size_t WS_WR = 7 * MiB;
constexpr size_t WS_WI = 8 * MiB;
constexpr size_t WS_WQKV = 12 * MiB;
constexpr size_t WS_WO = 13 * MiB;
constexpr size_t WS_WGU = 16 * MiB;
constexpr size_t WS_WD = 48 * MiB;
constexpr size_t WS_XB = 64 * MiB;
constexpr size_t WS_QA = 128 * MiB, WS_KA = 160 * MiB, WS_VA = 192 * MiB;
constexpr size_t WS_LAT = 224 * MiB;
constexpr size_t WS_QB = 256 * MiB;
constexpr size_t WS_KB = 304 * MiB, WS_VB = 336 * MiB, WS_OB = 368 * MiB;
constexpr size_t WS_MIX = 400 * MiB;
constexpr size_t WS_KR = 464 * MiB;
constexpr size_t WS_TOK = 466 * MiB;
constexpr size_t WS_GATE = 470 * MiB;
constexpr size_t WS_END = 474 * MiB;
constexpr size_t WS_X1 = 128 * MiB;
constexpr size_t WS_HB = 192 * MiB;
constexpr size_t WS_YB = 256 * MiB;

constexpr int RING_BYTES = 131072;
constexpr int LDSCTL_OFF = RING_BYTES;
constexpr int MISC_OFF = LDSCTL_OFF + 320;
constexpr int MOE_OFF = LDSCTL_OFF + 1024;
constexpr int LDS_BYTES = 147456;

__device__ __forceinline__ float bf2f(bf16 b) { return __uint_as_float(((unsigned)b) << 16); }
__device__ __forceinline__ bf16 f2bf(float f) { unsigned u = __float_as_uint(f); u += 0x7fffu + ((u >> 16) & 1u); return (bf16)(u >> 16); }
typedef float f32x2_t __attribute__((ext_vector_type(2))); typedef __bf16 bf16x2_t __attribute__((ext_vector_type(2)));
__device__ __forceinline__ unsigned cvtpk(float lo, float hi) { f32x2_t v = {lo, hi}; bf16x2_t b = __builtin_convertvector(v, bf16x2_t); return __builtin_bit_cast(unsigned, b); }
__device__ __forceinline__ unsigned pk2(float lo, float hi) { return cvtpk(lo, hi); }
__device__ __forceinline__ float wave_sum(float v) {
#pragma unroll
    for (int o = 1; o < 64; o <<= 1) v += __shfl_xor(v, o);
    return v;
}
__device__ __forceinline__ void unpack8(u32x4 v, float (&a)[8]) {
    a[0] = __uint_as_float(v.x << 16); a[1] = __uint_as_float(v.x & 0xffff0000u); a[2] = __uint_as_float(v.y << 16); a[3] = __uint_as_float(v.y & 0xffff0000u);
    a[4] = __uint_as_float(v.z << 16); a[5] = __uint_as_float(v.z & 0xffff0000u); a[6] = __uint_as_float(v.w << 16); a[7] = __uint_as_float(v.w & 0xffff0000u); }
#define LDS_WAIT() asm volatile("s_waitcnt lgkmcnt(0)" ::: "memory")

#define XB_TMO      128
#define XB_XCNT(j)  (256  + 64 * (j))
#define XB_XSUB(j)  (1280 + 64 * (j))
#define XB_XGEN(j)  (2304 + 64 * (j))
#define XB_TOP      3328
#define XB_TOPGEN   3392
#define XCD_BAR_WORDS 3456
#define XB_SPIN_CAP (1u << 18)
__device__ __forceinline__ unsigned xb_ld(unsigned* p)              { return __hip_atomic_load(p, __ATOMIC_RELAXED, __HIP_MEMORY_SCOPE_AGENT); }
__device__ __forceinline__ unsigned xb_add(unsigned* p, unsigned v) { return __hip_atomic_fetch_add(p, v, __ATOMIC_RELAXED, __HIP_MEMORY_SCOPE_AGENT); }
__device__ __forceinline__ unsigned xb_xcc_id() { return (unsigned)__builtin_amdgcn_s_getreg((3 << 11) | 20) & 0xFu; }
#define XB_SPIN(cond, bar) do { unsigned _sp = 0; while (cond) { __builtin_amdgcn_s_sleep(1); \
    if ((++_sp & 255u) == 0u) { if (xb_ld(&(bar)[XB_TMO])) break; if (_sp > XB_SPIN_CAP) { atomicAdd(&(bar)[XB_TMO], 1u); break; } } } } while (0)
struct XcdBarrier { unsigned* bar; unsigned x; volatile LAS unsigned* st; };
__device__ __forceinline__ XcdBarrier xcd_barrier_post(unsigned* bar, volatile LAS unsigned* st) {
    XcdBarrier b; b.bar = bar; b.x = xb_xcc_id(); b.st = st;
    if (threadIdx.x == 0) (void)xb_add(&bar[XB_XCNT(b.x)], 1u);
    return b;
}
__device__ __forceinline__ void xcd_barrier_complete(unsigned* bar, unsigned x, unsigned& nloc, unsigned& nx) {
    const unsigned G = gridDim.x * gridDim.y * gridDim.z;
    unsigned sum, cnt, mine, sp = 0u;
    for (;;) {
        sum = 0u; cnt = 0u; mine = 0u;
#pragma unroll
        for (unsigned j = 0; j < 16; ++j) { const unsigned c = xb_ld(&bar[XB_XCNT(j)]); sum += c; cnt += (c > 0u) ? 1u : 0u; mine = (j == x) ? c : mine; }
        if (sum == G) break;
        __builtin_amdgcn_s_sleep(1);
        if ((++sp & 255u) == 0u) { if (xb_ld(&bar[XB_TMO])) break; if (sp > XB_SPIN_CAP) { atomicAdd(&bar[XB_TMO], 1u); break; } }
    }
    nloc = mine > 0u ? mine : 1u; nx = cnt > 0u ? cnt : 1u;
}
__device__ __forceinline__ void xcd_barrier(const XcdBarrier& b) {
    asm volatile("s_waitcnt vmcnt(0)" ::: "memory");
    __syncthreads();
    if (threadIdx.x == 0) {
        unsigned* bar = b.bar;
        __builtin_amdgcn_s_waitcnt(0);
        unsigned nloc = b.st[0], nx = b.st[1];
        if (nloc == 0u) { xcd_barrier_complete(bar, b.x, nloc, nx); b.st[0] = nloc; b.st[1] = nx; }
        const unsigned old = xb_add(&bar[XB_XSUB(b.x)], 1u);
        const unsigned gen = old / nloc;
        if (old + 1u == (gen + 1u) * nloc) {
            __builtin_amdgcn_fence(__ATOMIC_RELEASE, "agent");
            asm volatile("s_waitcnt vmcnt(0)" ::: "memory");
            const unsigned og = xb_add(&bar[XB_TOP], 1u);
            const unsigned tg = og / nx;
            if (og + 1u == (tg + 1u) * nx) xb_add(&bar[XB_TOPGEN], 1u);
            else XB_SPIN(xb_ld(&bar[XB_TOPGEN]) == tg, bar);
            __builtin_amdgcn_fence(__ATOMIC_ACQUIRE, "agent");
            xb_add(&bar[XB_XGEN(b.x)], 1u);
            asm volatile("s_waitcnt vmcnt(0)" ::: "memory");
        } else {
            XB_SPIN(xb_ld(&bar[XB_XGEN(b.x)]) == gen, bar);
            __builtin_amdgcn_fence(__ATOMIC_ACQUIRE, "agent");
            asm volatile("s_waitcnt vmcnt(0)" ::: "memory");
        }
    }
    __syncthreads();
}

namespace pg8 {
constexpr int BM = 256, BK = 64, HALF = 128, HTB = HALF * BK * 2, STAGE_BYTES = 8 * HTB, NXCD = 8, WGM = 8;
__device__ __forceinline__ int lds_byte(int r, int c) { const int st = (r >> 4) * 2 + (c >> 5), rr = r & 15, cc = c & 31, ob = rr * 64 + cc * 2; return st * 1024 + (ob ^ (((ob >> 9) & 1) << 5)); }
__device__ __forceinline__ void stage_rc(int b, int& R, int& C) { const int st = b / 1024, sb = b % 1024, swz = sb ^ (((sb >> 9) & 1) << 5); R = (st >> 1) * 16 + swz / 64; C = (st & 1) * 32 + (swz % 64) / 2; }
__device__ __forceinline__ int perm32(int rho) { const int n = rho >> 4, i = rho & 15; return 8 * (i >> 2) + 4 * n + (i & 3); }
struct Unit { int pm, pn, e, lr0, half; };
struct StaticOrder {
    int nM, nN, nwg, G, c;
    __device__ void init(int M, int N, int G_, int c_) { nM = M / BM; nN = N / BM; nwg = nM * nN; G = G_; c = c_; }
    __device__ bool next(int i, Unit& u) const {
        const long L = (long)i * G + c; if (L >= nwg) return false;
        int wgid = (int)L; { const int q = nwg / NXCD, r = nwg % NXCD, xcd = wgid % NXCD, off = wgid / NXCD; wgid = (xcd < r ? xcd * (q + 1) : r * (q + 1) + (xcd - r) * q) + off; }
        const int nig = WGM * nN, gid = wgid / nig, fm = gid * WGM, gsz = (nM - fm) < WGM ? (nM - fm) : WGM;
        u.pm = fm + ((wgid % nig) % gsz); u.pn = (wgid % nig) / gsz; u.e = 0; u.lr0 = 0; u.half = 0; return true;
    }
};

template <class Epi, class Sched, bool ALIGN_EPI, bool HALFM = false>
__device__ __forceinline__ void gemm_phase(LAS unsigned char* lds, const int K, const int ldb, const Sched& S, const Epi& E, const bool nomma = false, const bool nostage = false) {
    const int tid = threadIdx.x, wid = __builtin_amdgcn_readfirstlane(tid >> 6), lane = tid & 63, wr = wid >> 2, wc = wid & 3, fr = lane & 15, fq = lane >> 4;
    const int nt = K / BK;
    int Rr[2], Cc[2]; unsigned voffB[2];
#pragma unroll
    for (int i = 0; i < 2; ++i) { stage_rc(tid * 16 + i * 8192, Rr[i], Cc[i]); const int Rb = (Rr[i] & ~31) + perm32(Rr[i] & 31); voffB[i] = (unsigned)(Rb * ldb + Cc[i]) * 2u; }
    const size_t kstep = (size_t)(BK * 2);
    const size_t hstepB = (size_t)HALF * ldb * 2;
    const unsigned ldsw = (unsigned)wid * 1024u;
    const int aoff = lds_byte(wr * 64 + fr, fq * 8), boff = lds_byte(wc * 32 + fr, fq * 8);
#define PG8_SA(b, h) (((b) * 2 + (h)) * HTB)
#define PG8_SB(b, h) ((4 + (b) * 2 + (h)) * HTB)
#define PG8_STAGE(bufoff, gbase, voff) do { if (nostage) break; _Pragma("unroll") for (int _i = 0; _i < 2; ++_i) \
        __builtin_amdgcn_global_load_lds((const unsigned*)((const char*)(gbase) + (voff)[_i]), (LAS unsigned*)(lds + (bufoff) + ldsw + _i * 8192), 16, 0, 0); } while (0)
#define PG8_LDA(dst, b, h) do { _Pragma("unroll") for (int m = 0; m < 4; ++m) _Pragma("unroll") for (int k = 0; k < 2; ++k) dst[m][k] = *(const LAS bf16x8*)(lds + PG8_SA(b, h) + aoff + m * 2048 + k * 1024); } while (0)
#define PG8_LDB(dst, b, h) do { _Pragma("unroll") for (int n = 0; n < 2; ++n) _Pragma("unroll") for (int k = 0; k < 2; ++k) dst[n][k] = *(const LAS bf16x8*)(lds + PG8_SB(b, h) + boff + n * 2048 + k * 1024); } while (0)
#define PG8_MMA(ai, bj, At, Bt) do { if (nomma) { asm volatile("" :: "v"(At[0][0]), "v"(At[3][1]), "v"(Bt[0][0]), "v"(Bt[1][1])); break; } __builtin_amdgcn_s_setprio(1); _Pragma("unroll") for (int m = 0; m < 4; ++m) _Pragma("unroll") for (int n = 0; n < 2; ++n) _Pragma("unroll") for (int k = 0; k < 2; ++k) \
        acc[ai][bj][m][n] = __builtin_amdgcn_mfma_f32_16x16x32_bf16(Bt[n][k], At[m][k], acc[ai][bj][m][n], 0, 0, 0); __builtin_amdgcn_s_setprio(0); } while (0)
#define PG8_WAIT_V(n) asm volatile("s_waitcnt vmcnt(" #n ")" ::: "memory")
#define PG8_WAIT_L(n) asm volatile("s_waitcnt lgkmcnt(" #n ")" ::: "memory")
#define PG8_BAR __builtin_amdgcn_s_barrier()
#define PG8_SCHED __builtin_amdgcn_sched_barrier(0)
    Unit cur, nxt; int ui = 0;
    if (!S.next(0, cur)) return;
    f32x4 acc[2][2][4][2];
#pragma unroll
    for (int a = 0; a < 2; ++a)
#pragma unroll
        for (int b = 0; b < 2; ++b)
#pragma unroll
            for (int m = 0; m < 4; ++m)
#pragma unroll
                for (int n = 0; n < 2; ++n) acc[a][b][m][n] = (f32x4){0.f, 0.f, 0.f, 0.f};
    bf16x8 At[4][2], B0[2][2], B1[2][2];
    const char* cA = S.a_base(cur); const char* cB = S.b_base(cur);
    unsigned vAc[2][2], vAn[2][2], v2[2][2];
    S.a_offs(cur, Rr, Cc, vAc);
    PG8_STAGE(PG8_SB(0, 0), cB, voffB); PG8_STAGE(PG8_SB(0, 1), cB + hstepB, voffB); PG8_STAGE(PG8_SA(0, 0), cA, vAc[0]); PG8_STAGE(PG8_SA(0, 1), cA, vAc[1]);
    if (wr == 1) PG8_BAR;
    PG8_WAIT_V(2); PG8_BAR;
    PG8_STAGE(PG8_SB(1, 0), cB + kstep, voffB); PG8_STAGE(PG8_SA(1, 0), cA + kstep, vAc[0]); PG8_STAGE(PG8_SB(1, 1), cB + hstepB + kstep, voffB);
    PG8_WAIT_V(6); PG8_BAR;
    for (;;) {
        const bool has_next = S.next(ui + 1, nxt);
        const char* nA = has_next ? S.a_base(nxt) : cA; const char* nB = has_next ? S.b_base(nxt) : cB;
        if (has_next) S.a_offs(nxt, Rr, Cc, vAn);
        else {
#pragma unroll
            for (int h = 0; h < 2; ++h)
#pragma unroll
                for (int i = 0; i < 2; ++i) vAn[h][i] = vAc[h][i]; }
#pragma unroll 1
        for (int t = 0; t < nt; t += 2) {
            const bool last = (t == nt - 2);
            const char* a1 = cA + (size_t)(t + 1) * kstep;
            const char* a2 = last ? nA : cA + (size_t)(t + 2) * kstep; const char* b2 = last ? nB : cB + (size_t)(t + 2) * kstep;
            const char* a3 = a2 + kstep; const char* b3 = b2 + kstep;
#pragma unroll
            for (int h = 0; h < 2; ++h)
#pragma unroll
                for (int i = 0; i < 2; ++i) v2[h][i] = last ? vAn[h][i] : vAc[h][i];
            PG8_LDB(B0, 0, 0); PG8_LDB(B1, 0, 1); PG8_SCHED; PG8_LDA(At, 0, 0); PG8_STAGE(PG8_SA(1, 1), a1, vAc[1]);
            PG8_WAIT_V(8); PG8_WAIT_L(0); PG8_BAR; PG8_MMA(0, 0, At, B0); PG8_MMA(0, 1, At, B1); PG8_BAR; PG8_SCHED;
            if constexpr (!HALFM) { PG8_LDA(At, 0, 1); } PG8_STAGE(PG8_SB(0, 0), b2, voffB); PG8_STAGE(PG8_SB(0, 1), b2 + hstepB, voffB); PG8_STAGE(PG8_SA(0, 0), a2, v2[0]);
            PG8_WAIT_V(8); PG8_WAIT_L(0); PG8_BAR; if constexpr (!HALFM) { PG8_MMA(1, 0, At, B0); PG8_MMA(1, 1, At, B1); } PG8_BAR; PG8_SCHED;
            PG8_LDB(B0, 1, 0); PG8_LDB(B1, 1, 1); PG8_SCHED; PG8_LDA(At, 1, 0); PG8_STAGE(PG8_SA(0, 1), a2, v2[1]);
            PG8_WAIT_V(8); PG8_WAIT_L(0); PG8_BAR; PG8_MMA(0, 0, At, B0); PG8_MMA(0, 1, At, B1); PG8_BAR; PG8_SCHED;
            if constexpr (!HALFM) { PG8_LDA(At, 1, 1); } PG8_STAGE(PG8_SB(1, 0), b3, voffB); PG8_STAGE(PG8_SB(1, 1), b3 + hstepB, voffB); PG8_STAGE(PG8_SA(1, 0), a3, v2[0]);
            PG8_WAIT_V(8); PG8_WAIT_L(0); PG8_BAR; if constexpr (!HALFM) { PG8_MMA(1, 0, At, B0); PG8_MMA(1, 1, At, B1); } PG8_BAR; PG8_SCHED;
        }
        if constexpr (ALIGN_EPI) { if (wr == 0) PG8_BAR; }
        if constexpr (!HALFM) cur.half = 0; else cur.half = (cur.half == 2) ? 2 : 1;
        E(acc, cur, wr, wc, fr, fq);
        if (!has_next) break;
#pragma unroll
        for (int a = 0; a < 2; ++a)
#pragma unroll
            for (int b = 0; b < 2; ++b)
#pragma unroll
                for (int m = 0; m < 4; ++m)
#pragma unroll
                    for (int n = 0; n < 2; ++n) acc[a][b][m][n] = (f32x4){0.f, 0.f, 0.f, 0.f};
        cur = nxt; cA = nA; cB = nB; ++ui;
#pragma unroll
        for (int h = 0; h < 2; ++h)
#pragma unroll
            for (int i = 0; i < 2; ++i) vAc[h][i] = vAn[h][i];
        if constexpr (ALIGN_EPI) { if (wr == 1) PG8_BAR; }
    }
    PG8_WAIT_V(0);
    if constexpr (!ALIGN_EPI) { if (wr == 0) PG8_BAR; }
    PG8_BAR;
#undef PG8_SA
#undef PG8_SB
#undef PG8_STAGE
#undef PG8_LDA
#undef PG8_LDB
#undef PG8_MMA
#undef PG8_WAIT_V
#undef PG8_WAIT_L
#undef PG8_BAR
#undef PG8_SCHED
}
}
using pg8::Unit;

struct PlainSched {
    pg8::StaticOrder so; const bf16* A; const bf16* Bt; int lda, ldb; int acol_pn, acol_off;
    __device__ __forceinline__ bool next(int i, Unit& u) const { return so.next(i, u); }
    __device__ __forceinline__ const char* a_base(const Unit& u) const { return (const char*)(A + (size_t)u.pm * 256 * lda + (u.pn >= acol_pn ? acol_off : 0)); }
    __device__ __forceinline__ const char* b_base(const Unit& u) const { return (const char*)(Bt + (size_t)u.pn * 256 * ldb); }
    __device__ __forceinline__ void a_offs(const Unit&, const int (&R)[2], const int (&C)[2], unsigned (&v)[2][2]) const {
#pragma unroll
        for (int h = 0; h < 2; ++h)
#pragma unroll
            for (int i = 0; i < 2; ++i) v[h][i] = (unsigned)((h * 128 + R[i]) * lda + C[i]) * 2u; }
};
struct PairSched {
    int pm, pn0; const bf16* A; const bf16* Bt; int lda, ldb;
    __device__ __forceinline__ bool next(int i, Unit& u) const { if (i >= 2) return false; u.pm = pm; u.pn = pn0 + i; u.e = 0; u.lr0 = 0; u.half = 0; return true; }
    __device__ __forceinline__ const char* a_base(const Unit& u) const { return (const char*)(A + (size_t)u.pm * 256 * lda); }
    __device__ __forceinline__ const char* b_base(const Unit& u) const { return (const char*)(Bt + (size_t)u.pn * 256 * ldb); }
    __device__ __forceinline__ void a_offs(const Unit&, const int (&R)[2], const int (&C)[2], unsigned (&v)[2][2]) const {
#pragma unroll
        for (int h = 0; h < 2; ++h)
#pragma unroll
            for (int i = 0; i < 2; ++i) v[h][i] = (unsigned)((h * 128 + R[i]) * lda + C[i]) * 2u; }
};
struct MoeSched {
    int G, c, NT, npanels; const LAS int* pst; const LAS int* cnt; const int* toks; const bf16* A; const bf16* Bt; int lda, ldb; size_t bstride; bool gather; int mode;
    __device__ __forceinline__ int rem() const { return (npanels * NT) % G; }
    __device__ __forceinline__ bool split() const { const int r = rem(); return r > 0 && 2 * r <= G; }
    __device__ __forceinline__ int tail_wgs() const { return split() ? 2 * rem() : rem(); }
    __device__ __forceinline__ bool next(int i, Unit& u) const {
        const int nu = npanels * NT, full = nu - rem(); int L;
        if (mode == 0) { L = i * G + c; if (L >= (split() ? full : nu)) return false; u.half = 0; }
        else { if (i > 0 || !split() || c >= 2 * rem()) return false; L = full + (c >> 1); u.half = 1 + (c & 1); }
        u.pm = L / NT; u.pn = L % NT; int e = 0;
#pragma unroll 1
        for (int q = 1; q < NE; ++q) e = (pst[q] <= u.pm) ? q : e;
        u.e = e; u.lr0 = (u.pm - pst[e]) * 256; return true; }
    __device__ __forceinline__ const char* a_base(const Unit& u) const { return gather ? (const char*)A : (const char*)(A + (size_t)u.pm * 256 * lda); }
    __device__ __forceinline__ const char* b_base(const Unit& u) const { return (const char*)(Bt + (size_t)u.e * bstride + (size_t)u.pn * 256 * ldb); }
    __device__ __forceinline__ void a_offs(const Unit& u, const int (&R)[2], const int (&C)[2], unsigned (&v)[2][2]) const {
        const int ce = cnt[u.e];
#pragma unroll
        for (int h = 0; h < 2; ++h)
#pragma unroll
            for (int i = 0; i < 2; ++i) {
                const int hh = (u.half == 2) ? 1 : h;
                if (gather) { const int lrow = u.lr0 + hh * 128 + R[i]; const int tok = toks[u.e * CAP + (lrow < ce ? lrow : 0)]; v[h][i] = (unsigned)(tok * lda + C[i]) * 2u; }
                else v[h][i] = (unsigned)((hh * 128 + R[i]) * lda + C[i]) * 2u; } }
};

#ifndef ST8_SC1
#define ST8_SC1 0
#endif
__device__ __forceinline__ void st8(bf16* p, f32x4 a, f32x4 b) { u32x4 o; o.x = pk2(a.x, a.y); o.y = pk2(a.z, a.w); o.z = pk2(b.x, b.y); o.w = pk2(b.z, b.w);
    if (ST8_SC1) asm volatile("global_store_dwordx4 %0, %1, off sc1\n\ts_nop 1" :: "v"(p), "v"(o) : "memory"); else *(u32x4*)p = o; }
__device__ __forceinline__ void st4(bf16* p, f32x4 v) { u32x2 o; o.x = pk2(v.x, v.y); o.y = pk2(v.z, v.w); *(u32x2*)p = o; }
__device__ __forceinline__ float sq4(f32x4 v) { return (v.x * v.x + v.y * v.y) + (v.z * v.z + v.w * v.w); }

struct EpiInProj {
    unsigned char* ws;
    __device__ __forceinline__ void operator()(const f32x4 (&acc)[2][2][4][2], const Unit& u, int wr, int wc, int fr, int fq) const {
        const float* __restrict__ rs0 = (const float*)(ws + WS_RS0);
        const int reg = u.pn >> 1;
        bf16* __restrict__ dst = (bf16*)(ws + (reg == 0 ? WS_QA : reg == 1 ? WS_KA : reg == 2 ? WS_VA : WS_LAT));
        const float qs = (reg == 0) ? QS_A : 1.f;
        const int row0 = u.pm * 256 + wr * 64 + fr;
        float rsv[2][4];
#pragma unroll
        for (int ai = 0; ai < 2; ++ai)
#pragma unroll
            for (int m = 0; m < 4; ++m) rsv[ai][m] = rs0[row0 + ai * 128 + m * 16];
        const bool isrope = (u.pn == 7 && wc == 0);
        float2 csv[2][4][4];
        if (isrope) {
#pragma unroll
            for (int ai = 0; ai < 2; ++ai)
#pragma unroll
                for (int m = 0; m < 4; ++m) { const float2* cs = (const float2*)(ws + WS_ROPE) + ((row0 + ai * 128 + m * 16) & (SEQ - 1)) * 16 + fq * 4;
#pragma unroll
                    for (int j = 0; j < 4; ++j) csv[ai][m][j] = cs[j]; }
        }
#pragma unroll
        for (int ai = 0; ai < 2; ++ai)
#pragma unroll
            for (int m = 0; m < 4; ++m) {
                const int row = row0 + ai * 128 + m * 16;
                const float rs = rsv[ai][m]; const float sc = rs * qs;
                float ssq = 0.f;
#pragma unroll
                for (int bj = 0; bj < 2; ++bj) {
                    const int lc = (u.pn & 1) * 256 + bj * 128 + wc * 32 + fq * 8;
                    const f32x4 v0 = acc[ai][bj][m][0] * sc, v1 = acc[ai][bj][m][1] * sc;
                    st8(dst + (size_t)row * 512 + lc, v0, v1);
                    if (u.pn == 6 || (u.pn == 7 && bj == 0)) ssq += sq4(v0) + sq4(v1);
                }
                if (u.pn >= 6) {
                    ssq += __shfl_xor(ssq, 16); ssq += __shfl_xor(ssq, 32);
                    if (fq == 0) atomicAdd((float*)(ws + (u.pn == 6 ? CTL_SSQQ : CTL_SSQKV)) + row, ssq);
                    if (isrope) {
                        const f32x4 x1 = acc[ai][1][m][0] * rs, x2 = acc[ai][1][m][1] * rs;
                        f32x4 y1, y2;
#pragma unroll
                        for (int j = 0; j < 4; ++j) { const float2 c = csv[ai][m][j]; y1[j] = x1[j] * c.x - x2[j] * c.y; y2[j] = x1[j] * c.y + x2[j] * c.x; }
                        bf16* kr = (bf16*)(ws + WS_KR) + (size_t)row * 32 + fq * 4;
                        st4(kr, y1); st4(kr + 16, y2);
                    }
                }
            }
    }
};
struct EpiUps {
    unsigned char* ws;
    __device__ __forceinline__ void operator()(const f32x4 (&acc)[2][2][4][2], const Unit& u, int wr, int wc, int fr, int fq) const {
        const bool isq = u.pn < 3;
        const float* __restrict__ ssq = (const float*)(ws + (isq ? CTL_SSQQ : CTL_SSQKV));
        const int row0 = u.pm * 256 + wr * 64 + fr;
        float sv[2][4];
#pragma unroll
        for (int ai = 0; ai < 2; ++ai)
#pragma unroll
            for (int m = 0; m < 4; ++m) sv[ai][m] = ssq[row0 + ai * 128 + m * 16];
        const bool rope0 = isq && ((u.pn * 8 + wc) % 3 == 2), rope1 = isq && ((u.pn * 8 + 4 + wc) % 3 == 2);
        float2 csv[2][4][4];
        if (rope0 || rope1) {
#pragma unroll
            for (int ai = 0; ai < 2; ++ai)
#pragma unroll
                for (int m = 0; m < 4; ++m) { const float2* cs = (const float2*)(ws + WS_ROPE) + ((row0 + ai * 128 + m * 16) & (SEQ - 1)) * 16 + fq * 4;
#pragma unroll
                    for (int j = 0; j < 4; ++j) csv[ai][m][j] = cs[j]; }
        }
#pragma unroll
        for (int ai = 0; ai < 2; ++ai)
#pragma unroll
            for (int m = 0; m < 4; ++m) {
                const int row = row0 + ai * 128 + m * 16;
                const float rs = rsqrtf(sv[ai][m] * (isq ? (1.f / 256.f) : (1.f / 128.f)) + EPS) * (isq ? QS_B : 1.f);
#pragma unroll
                for (int bj = 0; bj < 2; ++bj) {
                    if (isq) {
                        const int cg = u.pn * 8 + bj * 4 + wc;
                        bf16* q = (bf16*)(ws + WS_QB) + (size_t)row * 768 + cg * 32;
                        f32x4 a = acc[ai][bj][m][0] * rs, b = acc[ai][bj][m][1] * rs;
                        if (bj ? rope1 : rope0) {
                            f32x4 y1, y2;
#pragma unroll
                            for (int j = 0; j < 4; ++j) { const float2 c = csv[ai][m][j]; y1[j] = a[j] * c.x - b[j] * c.y; y2[j] = a[j] * c.y + b[j] * c.x; }
                            st4(q + fq * 4, y1); st4(q + 16 + fq * 4, y2);
                        } else st8(q + fq * 8, a, b);
                    } else {
                        const int head = (u.pn - 3) * 2 + bj;
                        bf16* dst = (bf16*)(ws + (wc < 2 ? WS_KB : WS_VB)) + (size_t)row * 512 + head * 64 + (wc & 1) * 32 + fq * 8;
                        st8(dst, acc[ai][bj][m][0] * rs, acc[ai][bj][m][1] * rs);
                    }
                }
            }
    }
};
struct EpiOut {
    unsigned char* ws; int gabl;
    __device__ __forceinline__ void operator()(const f32x4 (&acc)[2][2][4][2], const Unit& u, int wr, int wc, int fr, int fq) const {
        const bf16* __restrict__ xb = (const bf16*)(ws + WS_XB); bf16* __restrict__ x1 = (bf16*)(ws + WS_X1);
        int pm_ = u.pm; asm volatile("" : "+s"(pm_));
        const int row0 = pm_ * 256 + wr * 64 + fr; const int col0 = u.pn * 256 + wc * 32 + fq * 8;
        u32x4 xv[4][2], pk[4][2]; float sq[4];
#define EO_LOAD(ai) _Pragma("unroll") for (int m = 0; m < 4; ++m) _Pragma("unroll") for (int bj = 0; bj < 2; ++bj) \
            xv[m][bj] = (gabl & 1) ? (u32x4){0u, 0u, 0u, 0u} : *(const u32x4*)(xb + (size_t)(row0 + (ai) * 128 + m * 16) * 1024 + col0 + bj * 128)
#define EO_PACK(ai) _Pragma("unroll") for (int m = 0; m < 4; ++m) { float ssq = 0.f; _Pragma("unroll") for (int bj = 0; bj < 2; ++bj) { float t8[8]; unpack8(xv[m][bj], t8); \
                f32x4 v0 = acc[ai][bj][m][0], v1 = acc[ai][bj][m][1]; \
                v0.x += t8[0]; v0.y += t8[1]; v0.z += t8[2]; v0.w += t8[3]; v1.x += t8[4]; v1.y += t8[5]; v1.z += t8[6]; v1.w += t8[7]; \
                pk[m][bj].x = pk2(v0.x, v0.y); pk[m][bj].y = pk2(v0.z, v0.w); pk[m][bj].z = pk2(v1.x, v1.y); pk[m][bj].w = pk2(v1.z, v1.w); ssq += sq4(v0) + sq4(v1); } \
            ssq += __shfl_xor(ssq, 16); ssq += __shfl_xor(ssq, 32); sq[m] = ssq; }
#define EO_STORE(ai) _Pragma("unroll") for (int m = 0; m < 4; ++m) { const int row = row0 + (ai) * 128 + m * 16; \
            _Pragma("unroll") for (int bj = 0; bj < 2; ++bj) { if (!(gabl & 2)) *(u32x4*)(x1 + (size_t)row * 1024 + col0 + bj * 128) = pk[m][bj]; else asm volatile("" :: "v"(pk[m][bj])); } \
            if (fq == 0 && !(gabl & 4)) atomicAdd((float*)(ws + CTL_SSQ1) + row, sq[m]); else asm volatile("" :: "v"(sq[m])); }
        EO_LOAD(0); EO_PACK(0); EO_LOAD(1); EO_STORE(0); EO_PACK(1); EO_STORE(1);
#undef EO_LOAD
#undef EO_PACK
#undef EO_STORE
    }
};
struct EpiGateUp {
    unsigned char* ws; const LAS int* cnt;
    __device__ __forceinline__ void operator()(const f32x4 (&acc)[2][2][4][2], const Unit& u, int wr, int wc, int fr, int fq) const {
        const int ce = cnt[u.e]; const int* __restrict__ toks = (const int*)(ws + WS_TOK) + u.e * CAP; const float* __restrict__ ssq1 = (const float*)(ws + CTL_SSQ1);
        const int lr0 = wr * 64 + fr + (u.half == 2 ? 128 : 0);
        int tk[2][4]; float sv[2][4];
#pragma unroll
        for (int ai = 0; ai < 2; ++ai)
#pragma unroll
            for (int m = 0; m < 4; ++m) { const int lrow = u.lr0 + lr0 + ai * 128 + m * 16; tk[ai][m] = toks[lrow < ce ? lrow : 0]; }
#pragma unroll
        for (int ai = 0; ai < 2; ++ai)
#pragma unroll
            for (int m = 0; m < 4; ++m) sv[ai][m] = ssq1[tk[ai][m]];
#pragma unroll
        for (int ai = 0; ai < 2; ++ai)
#pragma unroll
            for (int m = 0; m < 4; ++m) {
                if (ai == 1 && u.half) continue;
                const int lr = lr0 + ai * 128 + m * 16;
                const float rs = rsqrtf(sv[ai][m] * (1.f / D) + EPS);
                bf16* dst = (bf16*)(ws + WS_HB) + (size_t)(u.pm * 256 + lr) * 256 + u.pn * 128 + wc * 32 + fq * 8;
                f32x4 h[2];
#pragma unroll
                for (int n = 0; n < 2; ++n) { const f32x4 g = acc[ai][0][m][n] * rs, up = acc[ai][1][m][n] * rs;
#pragma unroll
                    for (int j = 0; j < 4; ++j) h[n][j] = g[j] / (1.f + __expf(-g[j])) * up[j]; }
                st8(dst, h[0], h[1]);
            }
    }
};
struct EpiDown {
    unsigned char* ws; const LAS int* cnt; int gabl;
    __device__ __forceinline__ void operator()(const f32x4 (&acc)[2][2][4][2], const Unit& u, int wr, int wc, int fr, int fq) const {
        const int ce = cnt[u.e]; const float* __restrict__ gates = (const float*)(ws + WS_GATE) + u.e * CAP;
        const int lr0 = wr * 64 + fr + (u.half == 2 ? 128 : 0);
        float gv[2][4];
#pragma unroll
        for (int ai = 0; ai < 2; ++ai)
#pragma unroll
            for (int m = 0; m < 4; ++m) { const int lrow = u.lr0 + lr0 + ai * 128 + m * 16; const float g = gates[lrow < ce ? lrow : 0]; gv[ai][m] = lrow < ce ? g : 0.f; }
#pragma unroll
        for (int ai = 0; ai < 2; ++ai)
#pragma unroll
            for (int m = 0; m < 4; ++m) {
                if (ai == 1 && u.half) continue;
                const int lr = lr0 + ai * 128 + m * 16;
                const float gt = gv[ai][m];
                bf16* dst = (bf16*)(ws + WS_YB) + (size_t)(u.pm * 256 + lr) * 1024 + u.pn * 256 + wc * 32 + fq * 8;
#pragma unroll
                for (int bj = 0; bj < 2; ++bj) { if (!(gabl & 1)) st8(dst + bj * 128, acc[ai][bj][m][0] * gt, acc[ai][bj][m][1] * gt); else asm volatile("" :: "v"(acc[ai][bj][m][0] * gt), "v"(acc[ai][bj][m][1] * gt)); }
            }
    }
};

struct Args { const float* in[20]; float* out; unsigned char* ws; int ph_lo, ph_hi, flags, pad; };
struct Frame { LAS unsigned char* lds; int tid, lane, wave, vcu, G; const float* const* in; float* out; unsigned char* ws; int pflags; };

__device__ __forceinline__ void transpose_item(const float* W, int ldw, const float* gain, bf16* WT, int ldwt, int k0, int n0, int dstrow0, LAS float* scr, int lane, bool ropeperm = false) {
    f32x4 v[8];
#pragma unroll
    for (int i = 0; i < 8; ++i) v[i] = *(const f32x4*)(W + (size_t)(k0 + 8 * i + (lane >> 3)) * ldw + n0 + 4 * (lane & 7));
#pragma unroll
    for (int i = 0; i < 8; ++i) { const int kk = 8 * i + (lane >> 3); const float g = gain ? gain[k0 + kk] : 1.f; LAS float* d = scr + kk * 33 + 4 * (lane & 7);
        d[0] = v[i].x * g; d[1] = v[i].y * g; d[2] = v[i].z * g; d[3] = v[i].w * g; }
    LDS_WAIT();
    const int c = lane & 7;
#pragma unroll
    for (int j = 0; j < 4; ++j) { const int n = (lane >> 3) + 8 * j; const LAS float* s = scr + (8 * c) * 33 + n;
        u32x4 o; o.x = pk2(s[0 * 33], s[1 * 33]); o.y = pk2(s[2 * 33], s[3 * 33]); o.z = pk2(s[4 * 33], s[5 * 33]); o.w = pk2(s[6 * 33], s[7 * 33]);
        const int dn = ropeperm ? (8 * ((n & 15) >> 2) + 4 * (n >> 4) + (n & 3)) : n;
        *(u32x4*)(WT + (size_t)(dstrow0 + dn) * ldwt + k0 + 8 * c) = o; }
    LDS_WAIT();
}

struct XItem { const float* W; const float* gain; bf16* WT; int ldw, ldwt, k0, n0, dstrow0; };
__device__ __forceinline__ XItem xitem_decode(const Frame& F, int kind, int r) {
    unsigned char* ws = F.ws; XItem t; constexpr int I_G = 16 * 8, I_D = 4 * 32;
    if (kind == 0) { const int mtx = r / I_G, q = r % I_G, e = mtx >> 1, gu = mtx & 1, kb = q / 8, nb = q % 8; const int n0 = nb * 32;
        t.W = (gu ? F.in[17] : F.in[16]) + (size_t)e * 1024 * 256; t.ldw = 256; t.gain = F.in[11]; t.WT = (bf16*)(ws + WS_WGU) + (size_t)e * 512 * 1024; t.ldwt = 1024; t.k0 = kb * 64; t.n0 = n0;
        t.dstrow0 = 256 * (n0 >> 7) + gu * 128 + (n0 & 127); }
    else { const int e = r / I_D, q = r % I_D, kb = q / 32, nb = q % 32;
        t.W = F.in[18] + (size_t)e * 256 * 1024; t.ldw = 1024; t.gain = nullptr; t.WT = (bf16*)(ws + WS_WD) + (size_t)e * 1024 * 256; t.ldwt = 256; t.k0 = kb * 64; t.n0 = nb * 32; t.dstrow0 = nb * 32; }
    return t;
}
__device__ __forceinline__ void xitem_load(const XItem& t, f32x4 (&v)[8], int lane) {
#pragma unroll
    for (int i = 0; i < 8; ++i) v[i] = *(const f32x4*)(t.W + (size_t)(t.k0 + 8 * i + (lane >> 3)) * t.ldw + t.n0 + 4 * (lane & 7));
}
__device__ __forceinline__ void xitem_store(const XItem& t, const f32x4 (&v)[8], LAS float* scr, int lane) {
#pragma unroll
    for (int i = 0; i < 8; ++i) { const int kk = 8 * i + (lane >> 3); const float g = t.gain ? t.gain[t.k0 + kk] : 1.f; LAS float* d = scr + kk * 33 + 4 * (lane & 7);
        d[0] = v[i].x * g; d[1] = v[i].y * g; d[2] = v[i].z * g; d[3] = v[i].w * g; }
    LDS_WAIT();
    const int c = lane & 7;
#pragma unroll
    for (int j = 0; j < 4; ++j) { const int n = (lane >> 3) + 8 * j; const LAS float* s = scr + (8 * c) * 33 + n;
        u32x4 o; o.x = pk2(s[0 * 33], s[1 * 33]); o.y = pk2(s[2 * 33], s[3 * 33]); o.z = pk2(s[4 * 33], s[5 * 33]); o.w = pk2(s[6 * 33], s[7 * 33]);
        *(u32x4*)(t.WT + (size_t)(t.dstrow0 + n) * t.ldwt + t.k0 + 8 * c) = o; }
    LDS_WAIT();
}
__device__ __forceinline__ void p_convert_experts(const Frame& F, int kind, int wid, int nw) {
    const int lane = F.lane; LAS float* scr = (LAS float*)(F.lds + F.wave * 16384);
    const int nitems = kind == 0 ? 64 * 16 * 8 : 32 * 4 * 32;
    if (wid >= nitems) return;
    XItem cur = xitem_decode(F, kind, wid); f32x4 v[8], vn[8]; xitem_load(cur, v, lane);
    for (int r = wid; r < nitems; r += nw) {
        const bool more = (r + nw < nitems); XItem nxt = cur;
        if (more) { nxt = xitem_decode(F, kind, r + nw); xitem_load(nxt, vn, lane); }
        xitem_store(cur, v, scr, lane);
        if (more) { cur = nxt;
#pragma unroll
            for (int i = 0; i < 8; ++i) v[i] = vn[i]; }
    }
}
__device__ __forceinline__ void p_prologue(const Frame& F) {
    unsigned char* ws = F.ws; const int lane = F.lane;
    LAS float* scr = (LAS float*)(F.lds + F.wave * 16384);
    const int gw = F.vcu * NWAVES + F.wave, NGW = F.G * NWAVES;
    constexpr int I_IN = 16 * 61, I_Q = 4 * 24, I_KV = 2 * 32, I_O = 16 * 32;
    constexpr int NITEMS = I_IN + I_Q + I_KV + I_O;
    for (int it = gw; it < NITEMS; it += NGW) {
        if (F.pflags & 128) break;
        int r = it;
        if (r < I_IN) { const int kb = r / 61, nb = r % 61; transpose_item(F.in[2], NIN, F.in[1], (bf16*)(ws + WS_WI), 1024, kb * 64, nb * 32, nb * 32, scr, lane, nb == 60); continue; } r -= I_IN;
        if (r < I_Q) { const int kb = r / 24, nb = r % 24; transpose_item(F.in[5], 768, F.in[4], (bf16*)(ws + WS_WQKV), 256, kb * 64, nb * 32, nb * 32, scr, lane, nb % 3 == 2); continue; } r -= I_Q;
        if (r < I_KV) { const int kb = r / 32, nb = r % 32; transpose_item(F.in[7], 1024, F.in[6], (bf16*)(ws + WS_WQKV), 256, kb * 64, nb * 32, 768 + nb * 32, scr, lane); continue; } r -= I_KV;
        { const int kb = r / 32, nb = r % 32; transpose_item(F.in[10], 1024, nullptr, (bf16*)(ws + WS_WO), 1024, kb * 64, nb * 32, nb * 32, scr, lane); }
    }
    const size_t gt = (size_t)F.vcu * 512 + F.tid, NGT = (size_t)F.G * 512;
    for (size_t i = gt; i < (size_t)96 * 1024 / 8; i += NGT) ((u32x4*)((bf16*)(ws + WS_WI) + (size_t)1952 * 1024))[i] = (u32x4){0, 0, 0, 0};
    for (size_t i = gt; i < (size_t)1024 * 16; i += NGT) { const size_t row = i >> 4, c = i & 15; *(u32x4*)((bf16*)(ws + WS_WQKV) + (768 + row) * 256 + 128 + c * 8) = (u32x4){0, 0, 0, 0}; }
    { const float* __restrict__ xin = F.in[0]; bf16* __restrict__ XBp = (bf16*)(ws + WS_XB); float* __restrict__ rs0 = (float*)(ws + WS_RS0);
    for (int m0 = gw * 4; m0 < T; m0 += NGW * 4) {
        if (F.pflags & 256) break;
        f32x4 v[4][4];
#pragma unroll
        for (int q = 0; q < 4; ++q)
#pragma unroll
            for (int j = 0; j < 4; ++j) v[q][j] = *((const f32x4*)(xin + (size_t)(m0 + q) * D) + lane + 64 * j);
#pragma unroll
        for (int q = 0; q < 4; ++q) { float s = 0.f;
#pragma unroll
            for (int j = 0; j < 4; ++j) s += sq4(v[q][j]);
            s = wave_sum(s);
            u32x2* o8 = (u32x2*)(XBp + (size_t)(m0 + q) * D) + lane;
#pragma unroll
            for (int j = 0; j < 4; ++j) { u32x2 o; o.x = pk2(v[q][j].x, v[q][j].y); o.y = pk2(v[q][j].z, v[q][j].w); o8[64 * j] = o; }
            if (lane == 0) rs0[m0 + q] = rsqrtf(s * (1.f / D) + EPS); }
    } }
    for (size_t i = gt; i < (size_t)48 * 1024; i += NGT) { const int c = (int)(i >> 10), k = (int)(i & 1023);
        float w = 0.f; if (c < 4) w = F.in[12][k * 4 + c] * F.in[11][k]; else if (c < 36) w = F.in[14][k * 32 + c - 4] * F.in[11][k];
        const bf16 hi = f2bf(w); const bf16 lo = f2bf(w - bf2f(hi));
        ((bf16*)(ws + WS_WR))[i] = hi; ((bf16*)(ws + WS_WR))[(size_t)48 * 1024 + i] = lo; }
    for (size_t i = gt; i < (size_t)SEQ * 16; i += NGT) { const int s = (int)(i >> 4), f = (int)(i & 15);
        const float inv = (float)pow(10000.0, -(double)f / 16.0); const float ang = (float)s * inv;
        float2 cs; cs.x = (float)cos((double)ang); cs.y = (float)sin((double)ang); ((float2*)(ws + WS_ROPE))[i] = cs; }
    for (size_t i = gt; i < (size_t)24 * 2048; i += NGT) { const int ph = (int)(i >> 11), e = (int)(i & 2047), p = ph >> 3, h = ph & 7;
        float val = 0.f;
        if (e < 1600) { const int m = e / 200, x = e - m * 200, y = x + m, t = 191 - y;
            val = -30000.f;
            if (y <= 191 && t >= 32 && t <= 160) { const int dil = (p == 0) ? 1 : (p == 1) ? 4 : 16; const int rel = (t - 96) * dil; const int n = rel < 0 ? -rel : rel;
                int large = 8 + (int)(log((double)(n > 1 ? n : 1) / 8.0) / log(128.0) * 8.0); if (large > 15) large = 15;
                const int bucket = (rel > 0 ? 16 : 0) + (n < 8 ? n : large);
                val = F.in[3][bucket * 8 + h] * LOG2E; } }
        ((bf16*)(ws + WS_BIMG))[i] = f2bf(val); }
    for (size_t i = gt; i < (size_t)3 * 8 * 132; i += NGT) { const int p = (int)(i / (8 * 132)), h = (int)((i / 132) % 8), jj = (int)(i % 132);
        float val = 0.f;
        if (jj <= 128) { const int dil = (p == 0) ? 1 : (p == 1) ? 4 : 16; const int rel = (jj - 64) * dil; const int n = rel < 0 ? -rel : rel;
            int large = 8 + (int)(log((double)(n > 1 ? n : 1) / 8.0) / log(128.0) * 8.0); if (large > 15) large = 15;
            const int bucket = (rel > 0 ? 16 : 0) + (n < 8 ? n : large);
            val = F.in[3][bucket * 8 + h] * LOG2E; }
        ((float*)(ws + WS_BT))[i] = val; }
}

__device__ __forceinline__ void p_attnA_naive(const Frame& F, bf16* OA, float* LSE) {
    unsigned char* ws = F.ws;
    const bf16* QA = (const bf16*)(ws + WS_QA); const bf16* KA = (const bf16*)(ws + WS_KA); const bf16* VA = (const bf16*)(ws + WS_VA);
    const float* BT = (const float*)(ws + WS_BT);
    for (int idx = F.vcu * 512 + F.tid; idx < T * 8; idx += F.G * 512) {
        const int s = idx & (SEQ - 1), h = (idx >> 11) & 7, b = idx >> 14;
        float q[64], o[64];
        const size_t t = (size_t)b * SEQ + s;
#pragma unroll
        for (int i = 0; i < 64; ++i) { q[i] = bf2f(QA[t * 512 + h * 64 + i]); o[i] = 0.f; }
        float m = -1e30f, l = 0.f;
        for (int p = 0; p < 3; ++p) { const int dil = (p == 0) ? 1 : (p == 1) ? 4 : 16;
            for (int j = -64; j <= 64; ++j) { const int pos = s + j * dil; if (pos < 0 || pos >= SEQ) continue;
                const bf16* kp = KA + ((size_t)b * SEQ + pos) * 512 + h * 64; const bf16* vp = VA + ((size_t)b * SEQ + pos) * 512 + h * 64;
                float sc = BT[(p * 8 + h) * 132 + j + 64];
#pragma unroll
                for (int i = 0; i < 64; ++i) sc += q[i] * bf2f(kp[i]);
                const float mn = fmaxf(m, sc), al = exp2f(m - mn), pe = exp2f(sc - mn);
                l = l * al + pe; m = mn;
#pragma unroll
                for (int i = 0; i < 64; ++i) o[i] = o[i] * al + pe * bf2f(vp[i]);
            } }
        const float il = 1.f / l;
#pragma unroll
        for (int i = 0; i < 64; ++i) OA[t * 512 + h * 64 + i] = f2bf(o[i] * il);
        LSE[t * 8 + h] = m + log2f(l);
    }
}
__device__ __forceinline__ void p_attnB_naive(const Frame& F) {
    unsigned char* ws = F.ws;
    const bf16* QB = (const bf16*)(ws + WS_QB); const bf16* KB = (const bf16*)(ws + WS_KB); const bf16* VB = (const bf16*)(ws + WS_VB); const bf16* KR = (const bf16*)(ws + WS_KR);
    for (int idx = F.vcu * 512 + F.tid; idx < T * 8; idx += F.G * 512) {
        const int s = idx & (SEQ - 1), h = (idx >> 11) & 7, b = idx >> 14;
        float q[96], o[64];
        const size_t t = (size_t)b * SEQ + s;
#pragma unroll
        for (int i = 0; i < 96; ++i) q[i] = bf2f(QB[t * 768 + h * 96 + i]);
#pragma unroll
        for (int i = 0; i < 64; ++i) o[i] = 0.f;
        float m = -1e30f, l = 0.f;
        for (int key = 0; key < SEQ; ++key) { const size_t tk = (size_t)b * SEQ + key;
            const bf16* kp = KB + tk * 512 + h * 64; const bf16* rp = KR + tk * 32; const bf16* vp = VB + tk * 512 + h * 64;
            float sc = 0.f;
#pragma unroll
            for (int i = 0; i < 64; ++i) sc += q[i] * bf2f(kp[i]);
#pragma unroll
            for (int i = 0; i < 32; ++i) sc += q[64 + i] * bf2f(rp[i]);
            const float mn = fmaxf(m, sc), al = exp2f(m - mn), pe = exp2f(sc - mn);
            l = l * al + pe; m = mn;
#pragma unroll
            for (int i = 0; i < 64; ++i) o[i] = o[i] * al + pe * bf2f(vp[i]);
        }
        const float il = 1.f / l;
#pragma unroll
        for (int i = 0; i < 64; ++i) ((bf16*)(ws + WS_OB))[t * 512 + h * 64 + i] = f2bf(o[i] * il);
    }
}

typedef float f32x16 __attribute__((ext_vector_type(16)));
typedef short s16x4 __attribute__((ext_vector_type(4)));
typedef short v4i16_t __attribute__((ext_vector_type(4)));
__device__ __forceinline__ s16x4 vtr(const LAS unsigned char* p) { return __builtin_bit_cast(s16x4, __builtin_amdgcn_ds_read_tr16_b64_v4i16((LAS v4i16_t*)p)); }
__device__ __forceinline__ int crow(int r, int hi) { return (r & 3) + 8 * (r >> 2) + 4 * hi; }
__device__ __forceinline__ float max3f(float a, float b, float c) { float r; asm("v_max3_f32 %0, %1, %2, %3" : "=v"(r) : "v"(a), "v"(b), "v"(c)); return r; }
__device__ __forceinline__ float max2f(float a, float b) { float r; asm("v_max_f32_e32 %0, %1, %2" : "=v"(r) : "v"(a), "v"(b)); return r; }
__device__ __forceinline__ float rowmax32(const f32x16& p0, const f32x16& p1) {
    float a = max3f(p0[0], p0[1], p1[0]), b = max3f(p0[2], p0[3], p1[1]); a = max3f(a, p1[2], p1[3]);
#pragma unroll
    for (int r = 4; r < 16; r += 4) { a = max3f(a, p0[r], p0[r + 1]); b = max3f(b, p0[r + 2], p0[r + 3]); a = max3f(a, p1[r], p1[r + 1]); b = max3f(b, p1[r + 2], p1[r + 3]); }
    const float m = max2f(a, b);
    auto rr = __builtin_amdgcn_permlane32_swap(__float_as_uint(m), __float_as_uint(m), false, false);
    return max2f(__uint_as_float(rr[0]), __uint_as_float(rr[1]));
}
#define ATT_WAIT_BAR() asm volatile("s_waitcnt vmcnt(0) lgkmcnt(0)\n\ts_barrier" ::: "memory")
#define GLDS16(src, dst) __builtin_amdgcn_global_load_lds((const unsigned*)(src), (LAS unsigned*)(dst), 16, 0, 0)
__device__ __forceinline__ void glds16_asm(const void* gsrc, LAS unsigned char* dst) { unsigned keep; const unsigned d = (unsigned)__builtin_amdgcn_readfirstlane((int)(unsigned)(size_t)dst);
    asm volatile("s_mov_b32 %0, m0\n\ts_mov_b32 m0, %2\n\ts_nop 0\n\tglobal_load_lds_dwordx4 %1, off\n\ts_mov_b32 m0, %0" : "=&s"(keep) : "v"(gsrc), "s"(d) : "memory"); }

template <int NS>
__device__ __forceinline__ void sm_update(f32x16 (&p)[NS], float& m, float& l, f32x16& o0, f32x16& o1, bf16x8 (&pf)[2 * NS]) {
    float mx = p[0][0];
#pragma unroll
    for (int s = 0; s < NS; ++s)
#pragma unroll
        for (int r = 0; r < 16; ++r) mx = fmaxf(mx, p[s][r]);
    { auto rr = __builtin_amdgcn_permlane32_swap(__float_as_uint(mx), __float_as_uint(mx), false, false); mx = fmaxf(__uint_as_float(rr[0]), __uint_as_float(rr[1])); }
    const float mn = fmaxf(m, mx); const float al = __builtin_amdgcn_exp2f(m - mn); m = mn;
    float sum = 0.f;
#pragma unroll
    for (int s = 0; s < NS; ++s)
#pragma unroll
        for (int r = 0; r < 16; ++r) { p[s][r] = __builtin_amdgcn_exp2f(p[s][r] - mn); sum += p[s][r]; }
    l = l * al + sum;
#pragma unroll
    for (int r = 0; r < 16; ++r) { o0[r] *= al; o1[r] *= al; }
#pragma unroll
    for (int s = 0; s < NS; ++s)
#pragma unroll
        for (int k = 0; k < 2; ++k) { u32x4 w; w.x = cvtpk(p[s][8 * k + 0], p[s][8 * k + 1]); w.y = cvtpk(p[s][8 * k + 2], p[s][8 * k + 3]); w.z = cvtpk(p[s][8 * k + 4], p[s][8 * k + 5]); w.w = cvtpk(p[s][8 * k + 6], p[s][8 * k + 7]);
            pf[2 * s + k] = __builtin_bit_cast(bf16x8, w); }
}
__device__ __forceinline__ void pv_step(f32x16& o0, f32x16& o1, const LAS unsigned char* vp, int dstride, bf16x8 pfk) {
    const s16x4 a0 = vtr(vp), a1 = vtr(vp + 512), b0 = vtr(vp + dstride), b1 = vtr(vp + dstride + 512);
    const bf16x8 v0 = (bf16x8){a0[0], a0[1], a0[2], a0[3], a1[0], a1[1], a1[2], a1[3]};
    const bf16x8 v1 = (bf16x8){b0[0], b0[1], b0[2], b0[3], b1[0], b1[1], b1[2], b1[3]};
    o0 = __builtin_amdgcn_mfma_f32_32x32x16_bf16(v0, pfk, o0, 0, 0, 0);
    o1 = __builtin_amdgcn_mfma_f32_32x32x16_bf16(v1, pfk, o1, 0, 0, 0);
}
__device__ __forceinline__ void store_o(bf16* orow, const f32x16& o0, const f32x16& o1, float il, int hi) {
#pragma unroll
    for (int g = 0; g < 4; ++g) {
        u32x2 w0, w1; w0.x = cvtpk(o0[4 * g] * il, o0[4 * g + 1] * il); w0.y = cvtpk(o0[4 * g + 2] * il, o0[4 * g + 3] * il);
        w1.x = cvtpk(o1[4 * g] * il, o1[4 * g + 1] * il); w1.y = cvtpk(o1[4 * g + 2] * il, o1[4 * g + 3] * il);
        *(u32x2*)(orow + 8 * g + 4 * hi) = w0; *(u32x2*)(orow + 32 + 8 * g + 4 * hi) = w1; }
}


template <class RowPtr>
__device__ __forceinline__ void store_o_staged(LAS unsigned char* stg, const f32x16& o0, const f32x16& o1, float il, int lane, const RowPtr& rowptr) {
    const int r32 = lane & 31, hi = lane >> 5;
#pragma unroll
    for (int d0 = 0; d0 < 2; ++d0) {
        const f32x16& o = d0 ? o1 : o0;
#pragma unroll
        for (int g = 0; g < 4; ++g) { u32x2 w; w.x = cvtpk(o[4 * g] * il, o[4 * g + 1] * il); w.y = cvtpk(o[4 * g + 2] * il, o[4 * g + 3] * il);
            *(LAS u32x2*)(stg + r32 * 64 + ((g ^ ((r32 >> 1) & 3)) * 16) + hi * 8) = w; }
        LDS_WAIT();
#pragma unroll
        for (int j = 0; j < 2; ++j) { const int row = 16 * j + (lane >> 2), c = lane & 3;
            const u32x4 v = *(const LAS u32x4*)(stg + row * 64 + ((c ^ ((row >> 1) & 3)) * 16));
            *(u32x4*)(rowptr(row) + d0 * 32 + c * 8) = v; }
        LDS_WAIT();
    }
}

constexpr int B_KBUF = 12288, B_VBUF = 8192, B_VOFF = 3 * B_KBUF;
constexpr float B_THR = 40.f;
#define SBAR() __builtin_amdgcn_sched_barrier(0)
template <int ABL>
__device__ __forceinline__ void attnB_unit(const Frame& F, int b, int head, int qb) {
    unsigned char* ws = F.ws; LAS unsigned char* lds = F.lds;
    const int lane = F.lane, wave = F.wave, r32 = lane & 31, hi = lane >> 5;
    const bf16* QB = (const bf16*)(ws + WS_QB); const bf16* KB = (const bf16*)(ws + WS_KB); const bf16* VB = (const bf16*)(ws + WS_VB); const bf16* KR = (const bf16*)(ws + WS_KR);
    const size_t t0 = (size_t)b * SEQ;
    const size_t tq = t0 + qb * 256 + wave * 32 + r32;
    const int kr8 = 8 * wave + (lane >> 3), kr16 = 16 * (wave & 3) + (lane >> 2);
    const bf16* ksrc = KB + (t0 + kr8) * 512 + head * 64 + (((lane & 7) ^ ((kr8 >> 1) & 7)) * 8);
    const bf16* rsrc = KR + (t0 + kr16) * 32 + (((lane & 3) ^ ((kr16 >> 2) & 3)) * 8);
    const bf16* vsrc = VB + (t0 + kr8) * 512 + head * 64 + (((lane & 7) ^ (((kr8 >> 1) & 1) << 2)) * 8);
#define B_ISSUE_K(kt, boff) do { if (ABL & 2) break; glds16_asm(ksrc + (size_t)(kt) * 64 * 512, lds + (boff) + wave * 1024); \
        glds16_asm(rsrc + (size_t)(kt) * 64 * 32, lds + (boff) + 8192 + (wave & 3) * 1024); } while (0)
#define B_ISSUE_V(kt, boff) do { if (!(ABL & 2)) glds16_asm(vsrc + (size_t)(kt) * 64 * 512, lds + B_VOFF + (boff) + wave * 1024); } while (0)
    B_ISSUE_K(0, 0); B_ISSUE_V(0, 0); B_ISSUE_K(1, B_KBUF); B_ISSUE_V(1, B_VBUF); B_ISSUE_K(2, 2 * B_KBUF);
    bf16x8 qf[6];
#pragma unroll
    for (int ks = 0; ks < 6; ++ks) qf[ks] = *(const bf16x8*)(QB + tq * 768 + head * 96 + ks * 16 + hi * 8);
    float mref; f32x16 o0, o1, o2, negm;
#pragma unroll
    for (int r = 0; r < 16; ++r) { o0[r] = 0.f; o1[r] = 0.f; o2[r] = 0.f; }
    const bf16x8 onesf = (bf16x8){(short)0x3F80, (short)0x3F80, (short)0x3F80, (short)0x3F80, (short)0x3F80, (short)0x3F80, (short)0x3F80, (short)0x3F80};
    int kad[6];
#pragma unroll
    for (int ks = 0; ks < 4; ++ks) kad[ks] = r32 * 128 + (((2 * ks + hi) ^ ((r32 >> 1) & 7)) * 16);
#pragma unroll
    for (int j = 0; j < 2; ++j) kad[4 + j] = 8192 + r32 * 64 + (((2 * j + hi) ^ ((r32 >> 2) & 3)) * 16);
    const int vq = (lane & 15) >> 2;
    const int vbo0 = (4 * hi + vq) * 128 + (((((lane >> 4) & 1) * 2 + ((lane & 3) >> 1)) ^ (((vq >> 1) & 1) << 2)) * 16) + (lane & 1) * 8;
    constexpr int NT = SEQ / 64;
    f32x16 pA0, pA1, pB0, pB1;
    ATT_WAIT_BAR();
    {
        const LAS unsigned char* kb = lds;
#pragma unroll
        for (int r = 0; r < 16; ++r) { pA0[r] = 0.f; pA1[r] = 0.f; }
#pragma unroll
        for (int ks = 0; ks < 6; ++ks) {
            const bf16x8 k0 = *(const LAS bf16x8*)(kb + kad[ks]), k1 = *(const LAS bf16x8*)(kb + kad[ks] + (ks < 4 ? 4096 : 2048));
            pA0 = __builtin_amdgcn_mfma_f32_32x32x16_bf16(k0, qf[ks], pA0, 0, 0, 0);
            pA1 = __builtin_amdgcn_mfma_f32_32x32x16_bf16(k1, qf[ks], pA1, 0, 0, 0);
        }
        asm volatile("s_nop 15" : "+v"(pA0), "+v"(pA1));
        const float mx = rowmax32(pA0, pA1);
        mref = mx;
#pragma unroll
        for (int r = 0; r < 16; ++r) { negm[r] = -mref; pA0[r] = __builtin_amdgcn_exp2f(pA0[r] - mref); pA1[r] = __builtin_amdgcn_exp2f(pA1[r] - mref); }
    }
    ATT_WAIT_BAR();
    bool resc = false; float fres = 1.f;
#define B_PIN(x) asm volatile("" : "+v"(x))
#define B_GAPA(MF, A0, A1, A2, WI, WA, WB, WC, WD, KRD) do { MF; pw_[WI] = cvtpk(WA, WB); pw_[WI + 1] = cvtpk(WC, WD); B_PIN(pw_[WI]); B_PIN(pw_[WI + 1]); KRD; SBAR(); } while (0)
#define B_GAPA0(MF, A0, A1, A2) do { MF; SBAR(); } while (0)
#define B_KRD(i_) kf_[i_] = *(const LAS bf16x8*)(kb_ + kad[(i_) >> 1] + (((i_) & 1) ? (((i_) >> 1) < 4 ? 4096 : 2048) : 0))
#define B_EX4(X, B) do { X[B] = __builtin_amdgcn_exp2f(X[B]); X[B + 1] = __builtin_amdgcn_exp2f(X[B + 1]); X[B + 2] = __builtin_amdgcn_exp2f(X[B + 2]); X[B + 3] = __builtin_amdgcn_exp2f(X[B + 3]); B_PIN(X); } while (0)
#define B_EX4C(X, B) do { if (!(ABL & 1)) B_EX4(X, B); } while (0)
#define B_MFQ(D, A, Bq, C) D = (ABL & 8) ? (C) : __builtin_amdgcn_mfma_f32_32x32x16_bf16(A, Bq, C, 0, 0, 0)
#define B_MFQ0(D, A, Bq, C) do { if (ABL & 8) D = (C); else asm volatile("v_mfma_f32_32x32x16_bf16 %0, %1, %2, %3" : "=&v"(D) : "v"(A), "v"(Bq), "v"(C)); } while (0)
#define B_MFP(D, A, Bq) do { if (!(ABL & 16)) D = __builtin_amdgcn_mfma_f32_32x32x16_bf16(A, Bq, D, 0, 0, 0); else { asm volatile("" :: "v"(A), "v"(Bq)); } } while (0)
#define B_STEP(PA0, PA1, PB0, PB1, t, HASN) do { \
      \
    const int krd_ = (i3 == 2 ? 0 : i3 + 1) * B_KBUF, kwr_ = i3 * B_KBUF, vrd_ = i3 * B_VBUF, vwr_ = (i3 == 0 ? 2 : i3 - 1) * B_VBUF; \
    if ((t) + 3 < NT) B_ISSUE_K((t) + 3, kwr_); \
    if ((t) + 2 < NT) B_ISSUE_V((t) + 2, vwr_); \
    unsigned pw_[16]; \
    if (HASN) { \
        const LAS unsigned char* kb_ = lds + krd_; bf16x8 kf_[12]; \
        B_KRD(0); B_KRD(1); B_KRD(2); B_KRD(3); \
        SBAR(); \
        B_GAPA(B_MFQ0(PB0, kf_[0], qf[0], negm), PA0[0], PA0[1], PA0[2],    0, PA0[0], PA0[1], PA0[2], PA0[3],     B_KRD(4)); \
        B_GAPA(B_MFQ0(PB1, kf_[1], qf[0], negm), PA0[3], PA0[4], PA0[5],    2, PA0[4], PA0[5], PA0[6], PA0[7],     B_KRD(5)); \
        B_GAPA(B_MFQ(PB0, kf_[2], qf[1], PB0),  PA0[6], PA0[7], PA0[8],    4, PA0[8], PA0[9], PA0[10], PA0[11],   B_KRD(6)); \
        B_GAPA(B_MFQ(PB1, kf_[3], qf[1], PB1),  PA0[9], PA0[10], PA0[11],  6, PA0[12], PA0[13], PA0[14], PA0[15], B_KRD(7)); \
        B_GAPA(B_MFQ(PB0, kf_[4], qf[2], PB0),  PA0[12], PA0[13], PA0[14], 8, PA1[0], PA1[1], PA1[2], PA1[3],     B_KRD(8)); \
        B_GAPA(B_MFQ(PB1, kf_[5], qf[2], PB1),  PA0[15], PA1[0], PA1[1],   10, PA1[4], PA1[5], PA1[6], PA1[7],    B_KRD(9)); \
        B_GAPA(B_MFQ(PB0, kf_[6], qf[3], PB0),  PA1[2], PA1[3], PA1[4],    12, PA1[8], PA1[9], PA1[10], PA1[11],  B_KRD(10)); \
        B_GAPA(B_MFQ(PB1, kf_[7], qf[3], PB1),  PA1[5], PA1[6], PA1[7],    14, PA1[12], PA1[13], PA1[14], PA1[15], B_KRD(11)); \
        B_GAPA0(B_MFQ(PB0, kf_[8], qf[4], PB0),  PA1[8], PA1[9], PA1[10]); \
        B_GAPA0(B_MFQ(PB1, kf_[9], qf[4], PB1),  PA1[11], PA1[12], PA1[13]); \
        B_GAPA0(B_MFQ(PB0, kf_[10], qf[5], PB0), PA1[14], PA1[15], 0.f); \
        B_MFQ(PB1, kf_[11], qf[5], PB1); SBAR(); \
    } else { \
        _Pragma("unroll") for (int i_ = 0; i_ < 8; ++i_) { pw_[i_] = cvtpk(PA0[2 * i_], PA0[2 * i_ + 1]); pw_[8 + i_] = cvtpk(PA1[2 * i_], PA1[2 * i_ + 1]); } \
    } \
    resc = false; \
    if (HASN) { \
        asm volatile("s_nop 15" : "+v"(PB0), "+v"(PB1)); \
        const float mx_ = rowmax32(PB0, PB1); \
        if (__builtin_expect(__any(mx_ > B_THR), 0)) { const float dl_ = fmaxf(mx_, 0.f); mref += dl_; \
            _Pragma("unroll") for (int r = 0; r < 16; ++r) { PB0[r] -= dl_; PB1[r] -= dl_; negm[r] = -mref; } \
            fres = __builtin_amdgcn_exp2f(-dl_); resc = true; } \
    } \
    SBAR(); \
    { const LAS unsigned char* vb_ = lds + B_VOFF + vrd_ + vbo0; const LAS unsigned char* vc_ = lds + B_VOFF + vrd_ + (vbo0 ^ 64); \
      const bf16x8 pf0_ = __builtin_bit_cast(bf16x8, ((u32x4){pw_[0], pw_[1], pw_[2], pw_[3]})), pf1_ = __builtin_bit_cast(bf16x8, ((u32x4){pw_[4], pw_[5], pw_[6], pw_[7]})), pf2_ = __builtin_bit_cast(bf16x8, ((u32x4){pw_[8], pw_[9], pw_[10], pw_[11]})), pf3_ = __builtin_bit_cast(bf16x8, ((u32x4){pw_[12], pw_[13], pw_[14], pw_[15]})); \
      s16x4 a0_ = vtr(vb_), a1_ = vtr(vb_ + 1024), b0_ = vtr(vc_), b1_ = vtr(vc_ + 1024), c0_, c1_, d0_, d1_; \
        \
      c0_ = vtr(vb_ + 2048); c1_ = vtr(vb_ + 2048 + 1024); d0_ = vtr(vc_ + 2048); d1_ = vtr(vc_ + 2048 + 1024); \
      B_MFP(o0, ((bf16x8){a0_[0], a0_[1], a0_[2], a0_[3], a1_[0], a1_[1], a1_[2], a1_[3]}), pf0_); if (HASN) B_EX4C(PB0, 0); SBAR(); \
      B_MFP(o1, ((bf16x8){b0_[0], b0_[1], b0_[2], b0_[3], b1_[0], b1_[1], b1_[2], b1_[3]}), pf0_); if (HASN) B_EX4C(PB0, 4); SBAR(); \
      B_MFP(o2, onesf, pf0_); SBAR(); \
        \
      a0_ = vtr(vb_ + 4096); a1_ = vtr(vb_ + 4096 + 1024); b0_ = vtr(vc_ + 4096); b1_ = vtr(vc_ + 4096 + 1024); \
      B_MFP(o0, ((bf16x8){c0_[0], c0_[1], c0_[2], c0_[3], c1_[0], c1_[1], c1_[2], c1_[3]}), pf1_); if (HASN) B_EX4C(PB0, 8); SBAR(); \
      B_MFP(o1, ((bf16x8){d0_[0], d0_[1], d0_[2], d0_[3], d1_[0], d1_[1], d1_[2], d1_[3]}), pf1_); if (HASN) B_EX4C(PB0, 12); SBAR(); \
      B_MFP(o2, onesf, pf1_); SBAR(); \
        \
      c0_ = vtr(vb_ + 6144); c1_ = vtr(vb_ + 6144 + 1024); d0_ = vtr(vc_ + 6144); d1_ = vtr(vc_ + 6144 + 1024); \
      B_MFP(o0, ((bf16x8){a0_[0], a0_[1], a0_[2], a0_[3], a1_[0], a1_[1], a1_[2], a1_[3]}), pf2_); if (HASN) B_EX4C(PB1, 0); SBAR(); \
      B_MFP(o1, ((bf16x8){b0_[0], b0_[1], b0_[2], b0_[3], b1_[0], b1_[1], b1_[2], b1_[3]}), pf2_); if (HASN) B_EX4C(PB1, 4); SBAR(); \
      B_MFP(o2, onesf, pf2_); SBAR(); \
        \
      B_MFP(o0, ((bf16x8){c0_[0], c0_[1], c0_[2], c0_[3], c1_[0], c1_[1], c1_[2], c1_[3]}), pf3_); if (HASN) B_EX4C(PB1, 8); SBAR(); \
      B_MFP(o1, ((bf16x8){d0_[0], d0_[1], d0_[2], d0_[3], d1_[0], d1_[1], d1_[2], d1_[3]}), pf3_); if (HASN) B_EX4C(PB1, 12); SBAR(); \
      B_MFP(o2, onesf, pf3_); SBAR(); \
    } \
    if (resc) { o2[0] *= fres; _Pragma("unroll") for (int r = 0; r < 16; ++r) { o0[r] *= fres; o1[r] *= fres; } } \
    i3 = (i3 == 2) ? 0 : i3 + 1; \
    } while (0)
#define B_WAIT3() do { if (ABL & 4) asm volatile("s_waitcnt vmcnt(3) lgkmcnt(0)" ::: "memory"); else asm volatile("s_waitcnt vmcnt(3) lgkmcnt(0)\n\ts_barrier" ::: "memory"); } while (0)
#define B_WAIT1() asm volatile("s_waitcnt vmcnt(1) lgkmcnt(0)\n\ts_barrier" ::: "memory")
    int i3 = 0;
    if (wave >= 4) __builtin_amdgcn_s_setprio(1);
    for (int t = 0; t + 4 < NT; t += 2) {
        B_STEP(pA0, pA1, pB0, pB1, t, true);     B_WAIT3();
        B_STEP(pB0, pB1, pA0, pA1, t + 1, true); B_WAIT3();
    }
    B_STEP(pA0, pA1, pB0, pB1, NT - 4, true);  B_WAIT3();
    B_STEP(pB0, pB1, pA0, pA1, NT - 3, true);  B_WAIT1();
    B_STEP(pA0, pA1, pB0, pB1, NT - 2, true);  ATT_WAIT_BAR();
    B_STEP(pB0, pB1, pA0, pA1, NT - 1, false);
#undef B_WAIT3
#undef B_WAIT1
#undef B_STEP
#undef B_MFQ
#undef B_MFQ0
#undef B_MFP
#undef B_EX4C
#undef B_GAPA
#undef B_GAPA0
#undef B_KRD
#undef B_PIN
#undef B_EX4
#undef B_ISSUE_K
#undef B_ISSUE_V
    __builtin_amdgcn_s_setprio(0);
    const float l = o2[0];
    { bf16* obase = (bf16*)(ws + WS_OB) + (t0 + qb * 256 + wave * 32) * 512 + head * 64;
      store_o_staged(lds + B_VOFF + 3 * B_VBUF + wave * 2048, o0, o1, 1.f / l, lane, [=](int row) { return obase + (size_t)row * 512; }); }
    ATT_WAIT_BAR();
}
__device__ __forceinline__ void p_attnB(const Frame& F, bool abl) {
    if (F.G == 256) {
        const int x = F.vcu >> 5, j = F.vcu & 31;
        for (int r = 0; r < 4; ++r) { const int bh = 16 * x + 4 * r + (j >> 3); { if (PROBE_ABL != 0 && abl) attnB_unit<PROBE_ABL>(F, bh >> 3, bh & 7, j & 7); else attnB_unit<0>(F, bh >> 3, bh & 7, j & 7); } }
    } else {
        for (int u = F.vcu; u < BATCH * 8 * 8; u += F.G) { const int bh = u >> 3; attnB_unit<0>(F, bh >> 3, bh & 7, u & 7); }
    }
}

constexpr int A_NSL = 384, A_KOFF = 0, A_VOFF = A_NSL * 128, A_TAB = 2 * A_NSL * 128, A_TABB = 4096, A_OST = A_TAB + 2 * A_TABB;
constexpr float A_NEG = -30000.f;
struct AGeo { int b, head, pat, g, dil, L, nslots; };
__device__ __forceinline__ AGeo a_geo(int vcu, int k) { AGeo q;
    const int x = vcu >> 5, j = vcu & 31, bh = 16 * x + 4 * (k / 3) + (j >> 3); q.b = bh >> 3; q.head = bh & 7; q.pat = k % 3; q.g = j & 7;
    q.dil = (q.pat == 0) ? 1 : (q.pat == 1) ? 4 : 16; q.L = SEQ / q.dil; q.nslots = (q.pat == 2) ? 256 : 384; return q; }
__device__ __forceinline__ int a_pos(const AGeo& q, int s) {
    if (q.pat == 2) return 2 * q.g + (s >> 7) + 16 * (s & 127);
    if (q.pat == 1) { int kn = 256 * (q.g & 1) - 64 + s; kn = kn < 0 ? 0 : (kn > 511 ? 511 : kn); return (q.g >> 1) + 4 * kn; }
    int kn = 256 * q.g - 64 + s; return kn < 0 ? 0 : (kn > 2047 ? 2047 : kn); }
__device__ __forceinline__ void glds16_s(const void* sbase, unsigned voff, LAS unsigned char* dst) { unsigned keep; const unsigned d = (unsigned)__builtin_amdgcn_readfirstlane((int)(unsigned)(size_t)dst);
    asm volatile("s_mov_b32 %0, m0\n\ts_mov_b32 m0, %3\n\ts_nop 0\n\tglobal_load_lds_dwordx4 %1, %2\n\ts_mov_b32 m0, %0" : "=&s"(keep) : "v"(voff), "s"(sbase), "s"(d) : "memory"); }
__device__ __forceinline__ void a_issue(const Frame& F, const AGeo& q, bool isv) {
    const unsigned char* src = F.ws + (isv ? WS_VA : WS_KA) + ((size_t)q.b * SEQ * 512 + q.head * 64) * 2;
    const int s0 = 8 * F.wave + (F.lane >> 3);
    const unsigned coff = (unsigned)((F.lane & 7) ^ (isv ? (((s0 >> 1) & 1) << 2) : ((s0 >> 1) & 7))) * 16u;
    LAS unsigned char* dst = F.lds + (isv ? A_VOFF : A_KOFF) + F.wave * 1024;
    if (q.pat == 2) {
        const unsigned o0 = (unsigned)(2 * q.g + 16 * s0) * 1024u + coff;
        glds16_s(src, o0, dst); glds16_s(src, o0 + 1024u * 1024u, dst + 8192); glds16_s(src, o0 + 1024u, dst + 16384); glds16_s(src, o0 + 1025u * 1024u, dst + 24576);
    } else {
        const int hi = q.pat == 1 ? 511 : 2047, sh = q.pat == 1 ? 12 : 10;
        const unsigned cb = (q.pat == 1 ? (unsigned)(q.g >> 1) * 1024u : 0u) + coff;
        const int w0 = (q.pat == 1 ? 256 * (q.g & 1) : 256 * q.g) - 64 + s0;
#pragma unroll
        for (int i = 0; i < 6; ++i) { int kn = w0 + 64 * i; kn = kn < 0 ? 0 : (kn > hi ? hi : kn); glds16_s(src, cb + ((unsigned)kn << sh), dst + i * 8192); }
    }
}
__device__ __forceinline__ void a_wave_geo(const AGeo& q, int wave, int& c, int& n0, int& hb, int& wstart) {
    if (q.pat == 2) { c = 2 * q.g + (wave >> 2); n0 = 32 * (wave & 3); hb = 128 * (wave >> 2); wstart = 0; }
    else if (q.pat == 1) { c = q.g >> 1; n0 = 256 * (q.g & 1) + 32 * wave; hb = 0; wstart = 256 * (q.g & 1) - 64; }
    else { c = 0; n0 = 256 * q.g + 32 * wave; hb = 0; wstart = 256 * q.g - 64; } }
__device__ __forceinline__ void a_load_q(const Frame& F, const AGeo& q, bf16x8 (&qf)[4]) {
    int c, n0, hb, wstart; a_wave_geo(q, F.wave, c, n0, hb, wstart);
    const size_t tq = (size_t)q.b * SEQ + c + q.dil * (n0 + (F.lane & 31));
    const bf16* QA = (const bf16*)(F.ws + WS_QA);
#pragma unroll
    for (int ks = 0; ks < 4; ++ks) qf[ks] = *(const bf16x8*)(QA + tq * 512 + q.head * 64 + ks * 16 + (F.lane >> 5) * 8);
}
__device__ __forceinline__ void a_write_tab(const Frame& F, const AGeo& q, int tsel) {
    if (F.wave < 4) glds16_asm((const bf16*)(F.ws + WS_BIMG) + (size_t)(q.pat * 8 + q.head) * 2048 + F.wave * 512 + F.lane * 8, F.lds + A_TAB + tsel * A_TABB + F.wave * 1024);
}
__device__ __forceinline__ f32x16 mfma_dc(bf16x8 a, bf16x8 b, const f32x16& c) { f32x16 d; asm volatile("v_mfma_f32_32x32x16_bf16 %0, %1, %2, %3" : "=&v"(d) : "v"(a), "v"(b), "v"(c)); return d; }
template <int ABL>
__device__ __forceinline__ void p_attnA(const Frame& F, bf16* OA, float* LSE) {
    if (F.vcu >= 256) return;
    LAS unsigned char* lds = F.lds;
    const int lane = F.lane, wave = F.wave, r32 = lane & 31, hi = lane >> 5;
    int kad[4];
#pragma unroll
    for (int ks = 0; ks < 4; ++ks) kad[ks] = r32 * 128 + (((2 * ks + hi) ^ ((r32 >> 1) & 7)) * 16);
    const int vq = (lane & 15) >> 2;
    const int vbo0 = (4 * hi + vq) * 128 + (((((lane >> 4) & 1) * 2 + ((lane & 3) >> 1)) ^ (((vq >> 1) & 1) << 2)) * 16) + (lane & 1) * 8;
    const int bm = (7 - r32) & 7;
    const int bbo = bm * 400 + (159 - 128 - r32 + 8 * hi - bm) * 2;
    bf16x8 idn[2];
#pragma unroll
    for (int s2 = 0; s2 < 2; ++s2)
#pragma unroll
        for (int j = 0; j < 8; ++j) idn[s2][j] = (16 * s2 + 8 * hi + j == r32) ? (short)0x3F80 : (short)0;
    constexpr int NU = 12;
    AGeo q = a_geo(F.vcu, 0);
    if (!(ABL & 2)) { a_issue(F, q, false); a_issue(F, q, true); } a_write_tab(F, q, 0);
    bf16x8 qf[4]; a_load_q(F, q, qf);
    ATT_WAIT_BAR();
#pragma unroll 1
    for (int k = 0; k < NU; ++k) {
        int c, n0, hb, wstart; a_wave_geo(q, wave, c, n0, hb, wstart);
        const LAS unsigned char* tbb = lds + A_TAB + (k & 1) * A_TABB + bbo;
        f32x16 p[5]; bool val[5]; float mref; f32x16 negm;
        {   const LAS unsigned char* kb = lds + A_KOFF + (hb + n0 - wstart) * 128;
#pragma unroll
            for (int r = 0; r < 16; ++r) p[2][r] = 0.f;
#pragma unroll
            for (int ks = 0; ks < 4; ++ks) { const bf16x8 kf = *(const LAS bf16x8*)(kb + kad[ks]); if (!(ABL & 8)) p[2] = __builtin_amdgcn_mfma_f32_32x32x16_bf16(kf, qf[ks], p[2], 0, 0, 0); else asm volatile("" :: "v"(kf)); }
#pragma unroll
            for (int s2 = 0; s2 < 2; ++s2) { const bf16x8 bfr = *(const LAS bf16x8*)(tbb + (16 * s2 + 32 * 2) * 2); if (!(ABL & 8)) p[2] = __builtin_amdgcn_mfma_f32_32x32x16_bf16(bfr, idn[s2], p[2], 0, 0, 0); else asm volatile("" :: "v"(bfr)); }
            asm volatile("s_nop 15" : "+v"(p[2]));
            float a = max3f(p[2][0], p[2][1], p[2][2]), b2 = max3f(p[2][3], p[2][4], p[2][5]);
            a = max3f(a, p[2][6], p[2][7]); b2 = max3f(b2, p[2][8], p[2][9]); a = max3f(a, p[2][10], p[2][11]); b2 = max3f(b2, p[2][12], p[2][13]); a = max3f(a, p[2][14], p[2][15]);
            float mx = max2f(a, b2);
            { auto rr = __builtin_amdgcn_permlane32_swap(__float_as_uint(mx), __float_as_uint(mx), false, false); mx = max2f(__uint_as_float(rr[0]), __uint_as_float(rr[1])); }
            mref = mx;
#pragma unroll
            for (int r = 0; r < 16; ++r) { negm[r] = -mref; p[2][r] -= mref; }
            val[2] = true;
        }
#pragma unroll
        for (int i = 0; i < 5; ++i) {
            if (i == 2) continue;
            const int kt0 = n0 - 64 + 32 * i; val[i] = (kt0 >= 0 && kt0 < q.L);
            if (val[i]) {
                const LAS unsigned char* kb = lds + A_KOFF + (hb + kt0 - wstart) * 128;
                { const bf16x8 kf = *(const LAS bf16x8*)(kb + kad[0]); if (!(ABL & 8)) p[i] = mfma_dc(kf, qf[0], negm); else { p[i] = negm; asm volatile("" :: "v"(kf)); } }
#pragma unroll
                for (int ks = 1; ks < 4; ++ks) { const bf16x8 kf = *(const LAS bf16x8*)(kb + kad[ks]); if (!(ABL & 8)) p[i] = __builtin_amdgcn_mfma_f32_32x32x16_bf16(kf, qf[ks], p[i], 0, 0, 0); else asm volatile("" :: "v"(kf)); }
#pragma unroll
                for (int s2 = 0; s2 < 2; ++s2) { const bf16x8 bfr = *(const LAS bf16x8*)(tbb + (16 * s2 + 32 * (4 - i)) * 2); if (!(ABL & 8)) p[i] = __builtin_amdgcn_mfma_f32_32x32x16_bf16(bfr, idn[s2], p[i], 0, 0, 0); else asm volatile("" :: "v"(bfr)); }
            }
        }
        if (ABL & 4) asm volatile("s_waitcnt vmcnt(0) lgkmcnt(0)" ::: "memory"); else ATT_WAIT_BAR();
        AGeo qn = q; bf16x8 qfn[4];
        if (k + 1 < NU) { qn = a_geo(F.vcu, k + 1); if (!(ABL & 64)) a_write_tab(F, qn, (k + 1) & 1); a_load_q(F, qn, qfn); if (!(ABL & 2)) a_issue(F, qn, false); }
        float l = 0.f; f32x16 o0, o1;
#pragma unroll
        for (int r = 0; r < 16; ++r) { o0[r] = 0.f; o1[r] = 0.f; }
#pragma unroll
        for (int i = 0; i < 5; ++i) {
            if (val[i]) {
#pragma unroll
                for (int r = 0; r < 16; ++r) { if (!(ABL & 1)) p[i][r] = __builtin_amdgcn_exp2f(p[i][r]); l += p[i][r]; }
                const int kt0 = n0 - 64 + 32 * i;
                const LAS unsigned char* vb = lds + A_VOFF + (hb + kt0 - wstart) * 128;
#pragma unroll
                for (int s2 = 0; s2 < 2; ++s2) {
                    u32x4 w; w.x = cvtpk(p[i][8 * s2 + 0], p[i][8 * s2 + 1]); w.y = cvtpk(p[i][8 * s2 + 2], p[i][8 * s2 + 3]); w.z = cvtpk(p[i][8 * s2 + 4], p[i][8 * s2 + 5]); w.w = cvtpk(p[i][8 * s2 + 6], p[i][8 * s2 + 7]);
                    const bf16x8 pf = __builtin_bit_cast(bf16x8, w);
                    const LAS unsigned char* v0p = vb + s2 * 2048 + vbo0; const LAS unsigned char* v1p = vb + s2 * 2048 + (vbo0 ^ 64);
                    if (!(ABL & 16)) {
                    const s16x4 a0 = vtr(v0p), a1 = vtr(v0p + 1024), b0 = vtr(v1p), b1 = vtr(v1p + 1024);
                    o0 = __builtin_amdgcn_mfma_f32_32x32x16_bf16(((bf16x8){a0[0], a0[1], a0[2], a0[3], a1[0], a1[1], a1[2], a1[3]}), pf, o0, 0, 0, 0);
                    o1 = __builtin_amdgcn_mfma_f32_32x32x16_bf16(((bf16x8){b0[0], b0[1], b0[2], b0[3], b1[0], b1[1], b1[2], b1[3]}), pf, o1, 0, 0, 0);
                    } else asm volatile("" :: "v"(pf));
                }
            }
        }
        { auto rr = __builtin_amdgcn_permlane32_swap(__float_as_uint(l), __float_as_uint(l), false, false); l = __uint_as_float(rr[0]) + __uint_as_float(rr[1]); }
        const size_t tq0 = (size_t)q.pat * T + (size_t)q.b * SEQ + c + q.dil * n0;
        if (!(ABL & 32)) { bf16* obase = OA + tq0 * 512 + q.head * 64; const int rstride = q.dil * 512;
          store_o_staged(lds + A_OST + wave * 2048, o0, o1, 1.f / l, lane, [=](int row) { return obase + (size_t)row * rstride; }); }
        if (!(ABL & 32)) { if (hi == 0) LSE[(tq0 + q.dil * r32) * 8 + q.head] = mref + __builtin_amdgcn_logf(l); } else asm volatile("" :: "v"(l), "v"(o0), "v"(o1));
        if (ABL & 4) asm volatile("s_waitcnt vmcnt(5) lgkmcnt(0)" ::: "memory"); else asm volatile("s_waitcnt vmcnt(5) lgkmcnt(0)\n\ts_barrier" ::: "memory");
        if (k + 1 < NU) { if (!(ABL & 2)) a_issue(F, qn, true);
#pragma unroll
            for (int ks = 0; ks < 4; ++ks) qf[ks] = qfn[ks];
            q = qn; }
    }
}
constexpr int MQ = 4;
template <int NP>
__device__ __forceinline__ void p_mixnorm(const Frame& F, const bf16* __restrict__ OA, const float* __restrict__ LSE, int row0, int nrows, int wid, int nw) {
    unsigned char* ws = F.ws; const int lane = F.lane;
    const bf16* __restrict__ OBp = (const bf16*)(ws + WS_OB); bf16* __restrict__ MIX = (bf16*)(ws + WS_MIX);
    float ga[8], gb[8];
#pragma unroll
    for (int i = 0; i < 8; ++i) { ga[i] = F.in[8][lane * 8 + i]; gb[i] = F.in[9][lane * 8 + i]; }
    const int head = lane >> 3;
    for (int m0 = row0 + wid * MQ; m0 < row0 + nrows; m0 += nw * MQ) {
        u32x4 pa[MQ][NP], pb[MQ]; float w[MQ][NP];
#pragma unroll
        for (int q = 0; q < MQ; ++q) { const int m = m0 + q;
#pragma unroll
            for (int p = 0; p < NP; ++p) { pa[q][p] = *(const u32x4*)(OA + ((size_t)p * T + m) * 512 + lane * 8); w[q][p] = LSE[((size_t)p * T + m) * 8 + head]; }
            pb[q] = *(const u32x4*)(OBp + (size_t)m * 512 + lane * 8); }
#pragma unroll
        for (int q = 0; q < MQ; ++q) { const int m = m0 + q; float a[8], mx = -1e30f;
#pragma unroll
            for (int p = 0; p < NP; ++p) mx = fmaxf(mx, w[q][p]);
            float wsum = 0.f;
#pragma unroll
            for (int p = 0; p < NP; ++p) { w[q][p] = exp2f(w[q][p] - mx); wsum += w[q][p]; }
            const float iw = 1.f / wsum;
#pragma unroll
            for (int i = 0; i < 8; ++i) a[i] = 0.f;
#pragma unroll
            for (int p = 0; p < NP; ++p) { float t8[8]; unpack8(pa[q][p], t8); const float ww = w[q][p] * iw;
#pragma unroll
                for (int i = 0; i < 8; ++i) a[i] += ww * t8[i]; }
            float bv[8]; unpack8(pb[q], bv);
            float sa = 0.f, sb = 0.f;
#pragma unroll
            for (int i = 0; i < 8; ++i) { sa += a[i] * a[i]; sb += bv[i] * bv[i]; }
            sa = wave_sum(sa); sb = wave_sum(sb);
            const float ra = rsqrtf(sa * (1.f / 512.f) + EPS), rb = rsqrtf(sb * (1.f / 512.f) + EPS);
            u32x4 oa, ob;
            oa.x = pk2(a[0] * ra * ga[0], a[1] * ra * ga[1]); oa.y = pk2(a[2] * ra * ga[2], a[3] * ra * ga[3]); oa.z = pk2(a[4] * ra * ga[4], a[5] * ra * ga[5]); oa.w = pk2(a[6] * ra * ga[6], a[7] * ra * ga[7]);
            ob.x = pk2(bv[0] * rb * gb[0], bv[1] * rb * gb[1]); ob.y = pk2(bv[2] * rb * gb[2], bv[3] * rb * gb[3]); ob.z = pk2(bv[4] * rb * gb[4], bv[5] * rb * gb[5]); ob.w = pk2(bv[6] * rb * gb[6], bv[7] * rb * gb[7]);
            bf16* mix = MIX + (size_t)m * 1024;
            *(u32x4*)(mix + lane * 8) = oa; *(u32x4*)(mix + 512 + lane * 8) = ob; }
    }
}
constexpr int R_BUF = 96 * 512, R_LG = 2 * R_BUF, R_CNT = R_LG + 8 * 16 * 52 * 4;
__device__ __forceinline__ void p_router(const Frame& F) {
    unsigned char* ws = F.ws; const int lane = F.lane, wave = F.wave; LAS unsigned char* lds = F.lds;
    LAS float* lg = (LAS float*)(lds + R_LG + wave * (16 * 52 * 4));
    LAS int* cnt_l = (LAS int*)(lds + R_CNT); LAS int* base_l = cnt_l + 32;
    const bf16* X1 = (const bf16*)(ws + WS_X1); const bf16* WR = (const bf16*)(ws + WS_WR);
    const float* brg = F.in[13]; const float* bre = F.in[15];
    int* counts = (int*)(ws + WS_CTL) + CW_COUNTS; const float* ssq1 = (const float*)(ws + CTL_SSQ1);
    if (F.tid < 32) cnt_l[F.tid] = 0;
#define R_ISSUE(kc, buf) do { _Pragma("unroll") for (int i_ = 0; i_ < 6; ++i_) { const int p_ = wave + 8 * i_, row_ = 2 * p_ + (lane >> 5); \
        glds16_asm(WR + (size_t)row_ * 1024 + (kc) * 256 + (((lane & 31) ^ (row_ & 15)) * 8), lds + (buf) * R_BUF + p_ * 1024); } } while (0)
    const int col = lane & 15, kq = lane >> 4;
    for (int unit = F.vcu; unit < T / 128; unit += F.G) {
        const int tok0 = unit * 128 + wave * 16;
        f32x4 acc[3];
#pragma unroll
        for (int ct = 0; ct < 3; ++ct) acc[ct] = (f32x4){0.f, 0.f, 0.f, 0.f};
        const bf16* arow = X1 + (size_t)(tok0 + col) * 1024 + kq * 8;
        ATT_WAIT_BAR();
        R_ISSUE(0, 0);
#pragma unroll 1
        for (int kc = 0; kc < 4; ++kc) {
            bf16x8 af[8];
#pragma unroll
            for (int kk = 0; kk < 8; ++kk) af[kk] = *(const bf16x8*)(arow + kc * 256 + kk * 32);
            if (kc + 1 < 4) { R_ISSUE(kc + 1, (kc + 1) & 1); asm volatile("s_waitcnt vmcnt(6) lgkmcnt(0)\n\ts_barrier" ::: "memory"); }
            else ATT_WAIT_BAR();
            const LAS unsigned char* wb = lds + (kc & 1) * R_BUF;
#pragma unroll
            for (int kk = 0; kk < 8; ++kk) {
#pragma unroll
                for (int ct = 0; ct < 3; ++ct) {
                    const int rh = ct * 16 + col, rl = 48 + ct * 16 + col, c16 = kk * 4 + kq;
                    const bf16x8 bh = *(const LAS bf16x8*)(wb + rh * 512 + ((c16 ^ (rh & 15)) * 16)), bl = *(const LAS bf16x8*)(wb + rl * 512 + ((c16 ^ (rl & 15)) * 16));
                    acc[ct] = __builtin_amdgcn_mfma_f32_16x16x32_bf16(af[kk], bh, acc[ct], 0, 0, 0);
                    acc[ct] = __builtin_amdgcn_mfma_f32_16x16x32_bf16(af[kk], bl, acc[ct], 0, 0, 0);
                }
            }
            if (kc + 1 < 4) asm volatile("s_waitcnt lgkmcnt(0)\n\ts_barrier" ::: "memory");
            if (kc + 2 < 4) {   }
        }
#pragma unroll
        for (int ct = 0; ct < 3; ++ct)
#pragma unroll
            for (int j = 0; j < 4; ++j) lg[(4 * (lane >> 4) + j) * 52 + ct * 16 + (lane & 15)] = acc[ct][j];
        LDS_WAIT();
        int e1 = 0, e2 = 0, q1 = 0, q2 = 0; float g1 = 0.f, g2 = 0.f; const int m = tok0 + lane;
        if (lane < 16) {
            const float rs = rsqrtf(ssq1[m] * (1.f / D) + EPS);
            const LAS float* L = lg + lane * 52;
            int gi = 0; float gm = L[0] * rs + brg[0];
            float gl1 = L[1] * rs + brg[1], gl2 = L[2] * rs + brg[2], gl3 = L[3] * rs + brg[3]; const float gl0 = gm;
            if (gl1 > gm) { gm = gl1; gi = 1; } if (gl2 > gm) { gm = gl2; gi = 2; } if (gl3 > gm) { gm = gl3; gi = 3; }
            const float gs = __expf(gl0 - gm) + __expf(gl1 - gm) + __expf(gl2 - gm) + __expf(gl3 - gm);
            const float ggate = 1.f / gs;
            const LAS float* EL = L + 4 + gi * 8; const float* eb = bre + gi * 8;
            int i1 = 0; float m1 = EL[0] * rs + eb[0];
            for (int i = 1; i < 8; ++i) { const float v = EL[i] * rs + eb[i]; if (v > m1) { m1 = v; i1 = i; } }
            int i2 = -1; float m2 = -3.0e38f;
            for (int i = 0; i < 8; ++i) { const float v = EL[i] * rs + eb[i]; if (i != i1 && v > m2) { m2 = v; i2 = i; } }
            const float p2 = __expf(m2 - m1); g1 = ggate / (1.f + p2); g2 = ggate * p2 / (1.f + p2);
            e1 = gi * 8 + i1; e2 = gi * 8 + i2;
            q1 = __hip_atomic_fetch_add(cnt_l + e1, 1, __ATOMIC_RELAXED, __HIP_MEMORY_SCOPE_WORKGROUP);
            q2 = __hip_atomic_fetch_add(cnt_l + e2, 1, __ATOMIC_RELAXED, __HIP_MEMORY_SCOPE_WORKGROUP);
        }
        __syncthreads();
        if (F.tid < 32) { const int c = cnt_l[F.tid]; base_l[F.tid] = c ? atomicAdd(&counts[F.tid], c) : 0; }
        __syncthreads();
        if (lane < 16) {
            const int p1 = base_l[e1] + q1, pp2 = base_l[e2] + q2;
            ((int*)(ws + WS_TOK))[e1 * CAP + p1] = m; ((int*)(ws + WS_TOK))[e2 * CAP + pp2] = m;
            ((float*)(ws + WS_GATE))[e1 * CAP + p1] = g1; ((float*)(ws + WS_GATE))[e2 * CAP + pp2] = g2;
            ((int*)(ws + WS_AE))[m * 2] = e1; ((int*)(ws + WS_AE))[m * 2 + 1] = e2; ((int*)(ws + WS_APOS))[m * 2] = p1; ((int*)(ws + WS_APOS))[m * 2 + 1] = pp2;
        }
        __syncthreads();
        if (F.tid < 32) cnt_l[F.tid] = 0;
        __syncthreads();
    }
#undef R_ISSUE
}
__device__ __forceinline__ void moe_tables(const Frame& F) {
    LAS int* pst = (LAS int*)(F.lds + MOE_OFF); LAS int* cnt = pst + 40;
    const int* counts = (const int*)(F.ws + WS_CTL) + CW_COUNTS;
    __syncthreads();
    if (F.tid < NE) cnt[F.tid] = counts[F.tid];
    __syncthreads();
    if (F.tid == 0) { int acc = 0; for (int e = 0; e < NE; ++e) { pst[e] = acc; acc += (cnt[e] + 255) >> 8; } pst[NE] = acc; }
    __syncthreads();
}
constexpr int FQ = 2;
__device__ __forceinline__ void p_final(const Frame& F) {
    unsigned char* ws = F.ws; const int lane = F.lane; const float* __restrict__ gfin = F.in[19];
    const LAS int* pst = (const LAS int*)(F.lds + MOE_OFF);
    const int* __restrict__ AE = (const int*)(ws + WS_AE); const int* __restrict__ AP = (const int*)(ws + WS_APOS);
    const bf16* __restrict__ X1 = (const bf16*)(ws + WS_X1); const bf16* __restrict__ YB = (const bf16*)(ws + WS_YB);
    float* __restrict__ out = F.out;
    f32x4 g4[4];
#pragma unroll
    for (int j = 0; j < 2; ++j) { g4[2 * j] = *((const f32x4*)gfin + 2 * lane + 128 * j); g4[2 * j + 1] = *((const f32x4*)gfin + 2 * lane + 128 * j + 1); }
    const int step = F.G * NWAVES * FQ;
    int m0 = (F.vcu * NWAVES + F.wave) * FQ;
    if (m0 >= T) return;
    u32x2 ie[FQ], ip[FQ];
    u32x4 xa[FQ][2], ya[FQ][2], yb[FQ][2], xn[FQ][2], yan[FQ][2], ybn[FQ][2];
#define FIN_IDX(mm) do { _Pragma("unroll") for (int q = 0; q < FQ; ++q) { ie[q] = *(const u32x2*)(AE + ((mm) + q) * 2); ip[q] = *(const u32x2*)(AP + ((mm) + q) * 2); } } while (0)
#define FIN_ROWS(mm, XA, YA, YB_) do { _Pragma("unroll") for (int q = 0; q < FQ; ++q) { const int m = (mm) + q; \
        const int r1 = (int)ip[q].x + pst[ie[q].x] * 256, r2 = (int)ip[q].y + pst[ie[q].y] * 256; \
        _Pragma("unroll") for (int j = 0; j < 2; ++j) { XA[q][j] = *((const u32x4*)(X1 + (size_t)m * 1024) + lane + 64 * j); YA[q][j] = *((const u32x4*)(YB + (size_t)r1 * 1024) + lane + 64 * j); YB_[q][j] = *((const u32x4*)(YB + (size_t)r2 * 1024) + lane + 64 * j); } } } while (0)
    FIN_IDX(m0); FIN_ROWS(m0, xa, ya, yb);
    if (m0 + step < T) FIN_IDX(m0 + step);
    for (; m0 < T; m0 += step) {
        const bool more = (m0 + step < T);
        if (more) { FIN_ROWS(m0 + step, xn, yan, ybn); if (m0 + 2 * step < T) FIN_IDX(m0 + 2 * step); }
#pragma unroll
        for (int q = 0; q < FQ; ++q) { const int m = m0 + q; float v[2][8]; float s = 0.f;
#pragma unroll
            for (int j = 0; j < 2; ++j) { float a[8], b[8], c[8]; unpack8(xa[q][j], a); unpack8(ya[q][j], b); unpack8(yb[q][j], c);
#pragma unroll
                for (int i = 0; i < 8; ++i) { v[j][i] = a[i] + b[i] + c[i]; s += v[j][i] * v[j][i]; } }
            s = wave_sum(s); const float rs = rsqrtf(s * (1.f / D) + EPS);
#pragma unroll
            for (int j = 0; j < 2; ++j) { f32x4 o0, o1;
                o0.x = v[j][0] * rs * g4[2 * j].x; o0.y = v[j][1] * rs * g4[2 * j].y; o0.z = v[j][2] * rs * g4[2 * j].z; o0.w = v[j][3] * rs * g4[2 * j].w;
                o1.x = v[j][4] * rs * g4[2 * j + 1].x; o1.y = v[j][5] * rs * g4[2 * j + 1].y; o1.z = v[j][6] * rs * g4[2 * j + 1].z; o1.w = v[j][7] * rs * g4[2 * j + 1].w;
                f32x4* op = (f32x4*)(out + (size_t)m * D) + 2 * lane + 128 * j; op[0] = o0; op[1] = o1; } }
        if (more) {
#pragma unroll
            for (int q = 0; q < FQ; ++q)
#pragma unroll
                for (int j = 0; j < 2; ++j) { xa[q][j] = xn[q][j]; ya[q][j] = yan[q][j]; yb[q][j] = ybn[q][j]; } }
    }
#undef FIN_IDX
#undef FIN_ROWS
}

__global__ void __launch_bounds__(NWAVES * 64, 2) mk_fwd(Args args) {
    extern __shared__ __attribute__((aligned(16))) unsigned char lds_raw[];
    Frame F;
    F.lds = (LAS unsigned char*)lds_raw;
    F.tid = threadIdx.x; F.lane = F.tid & 63; F.wave = __builtin_amdgcn_readfirstlane(F.tid >> 6);
    F.G = gridDim.x; { const int bx = blockIdx.x; F.vcu = (F.G % 8 == 0) ? (bx % 8) * (F.G / 8) + bx / 8 : bx; }
    F.in = args.in; F.out = args.out; F.ws = args.ws; F.pflags = args.flags;
    unsigned char* ws = args.ws;
    for (int u = F.tid; u < (LDS_BYTES - LDSCTL_OFF) / 4; u += NWAVES * 64) ((LAS unsigned*)(F.lds + LDSCTL_OFF))[u] = 0u;
    __syncthreads();
#if MK_SPLIT
#define GRID_BAR() do { } while (0)
#else
    volatile LAS unsigned* MISC = (volatile LAS unsigned*)(F.lds + MISC_OFF);
    XcdBarrier bar = xcd_barrier_post((unsigned*)(ws + WS_CTL) + CW_BAR, MISC + 8);
#define GRID_BAR() xcd_barrier(bar)
#endif
#ifndef SLACK_PCT
#define SLACK_PCT 0
#endif
#define STAGGER_SLACK(n_units, t_unit_ticks, myid) do { const int nu_ = (n_units), rounds_ = (nu_ + F.G - 1) / F.G; const int mine_ = (nu_ - (myid) + F.G - 1) / F.G; \
        if (SLACK_PCT > 0 && mine_ < rounds_) { const unsigned long long t0_ = __builtin_amdgcn_s_memrealtime(); \
            const unsigned long long d_ = (unsigned long long)(t_unit_ticks) * SLACK_PCT / 100 * (unsigned)((F.vcu * 37) & 63) / 64; \
            while (__builtin_amdgcn_s_memrealtime() - t0_ < d_) __builtin_amdgcn_s_sleep(8); } } while (0)
    const int lo = args.ph_lo, hi = args.ph_hi;
#ifndef PH_MASK
#define PH_MASK 0x3ff
#endif
#define IN(k) (((PH_MASK >> (k)) & 1) && lo <= (k) && (k) < hi)
#define BOTH(k) (IN(k) && IN((k) + 1))
    bf16* OA = (bf16*)args.out; float* LSE = (float*)(ws + WS_LSE);
    const LAS int* pst = (const LAS int*)(F.lds + MOE_OFF); const LAS int* cnt = pst + 40;

#ifndef ATTN_A_NAIVE
#define ATTN_A_NAIVE 0
#endif
    static_assert(ATTN_A_NAIVE == 0, "the naive mixer-A body writes one partial; the fused merge expects three");
#ifndef ATTN_B_NAIVE
#define ATTN_B_NAIVE 0
#endif
    if (IN(0)) { p_prologue(F); if (BOTH(0)) GRID_BAR(); }
    if (IN(1)) {
        PlainSched S; S.so.init(T, NINP, F.G, (int)blockIdx.x); S.A = (const bf16*)(ws + WS_XB); S.Bt = (const bf16*)(ws + WS_WI); S.lda = 1024; S.ldb = 1024; S.acol_pn = 1 << 30; S.acol_off = 0;
        EpiInProj E{ws};
        pg8::gemm_phase<EpiInProj, PlainSched, true>(F.lds, 1024, 1024, S, E);
        if (BOTH(1)) GRID_BAR();
    }
    if (IN(2)) {
        PlainSched S; S.so.init(T, 768 + 1024, F.G, (int)blockIdx.x); S.A = (const bf16*)(ws + WS_LAT); S.Bt = (const bf16*)(ws + WS_WQKV); S.lda = 512; S.ldb = 256; S.acol_pn = 3; S.acol_off = 256;
        EpiUps E{ws};
        STAGGER_SLACK(896, 1500, (int)blockIdx.x);
        pg8::gemm_phase<EpiUps, PlainSched, true>(F.lds, 256, 256, S, E);
        if (!(args.flags & 2)) { if (ATTN_A_NAIVE) p_attnA_naive(F, OA, LSE); else if (PROBE_ABL != 0 && (args.flags & 8)) p_attnA<PROBE_ABL>(F, OA, LSE); else p_attnA<0>(F, OA, LSE); }
        { const int r_ = S.so.nwg % F.G, c_ = (int)blockIdx.x;
          if (r_ == 0) p_convert_experts(F, 0, c_ * NWAVES + F.wave, F.G * NWAVES); else if (c_ >= r_) p_convert_experts(F, 0, (c_ - r_) * NWAVES + F.wave, (F.G - r_) * NWAVES); }
        if (BOTH(2)) GRID_BAR();
    }
    if (IN(3)) {
        if (!(args.flags & 1)) { if (ATTN_B_NAIVE) p_attnB_naive(F); else p_attnB(F, (args.flags & 4) != 0); }
        if (BOTH(3)) GRID_BAR(); }
    if (IN(4)) { p_mixnorm<3>(F, OA, LSE, 0, T, F.vcu * NWAVES + F.wave, F.G * NWAVES); if (BOTH(4)) GRID_BAR(); }
    if (IN(5)) {
        EpiOut E{ws, (args.flags >> 9) & 7};
        PlainSched S; S.so.init(T, 1024, F.G, (int)blockIdx.x); S.A = (const bf16*)(ws + WS_MIX); S.Bt = (const bf16*)(ws + WS_WO); S.lda = 1024; S.ldb = 1024; S.acol_pn = 1 << 30; S.acol_off = 0;
        pg8::gemm_phase<EpiOut, PlainSched, true>(F.lds, 1024, 1024, S, E, (args.flags & 4096) != 0, (args.flags & 8192) != 0);
        if (BOTH(5)) GRID_BAR();
    }
    if (IN(6)) { p_router(F); if (BOTH(6)) GRID_BAR(); }
    if (IN(7)) {
        moe_tables(F);
        MoeSched S; S.G = F.G; S.c = F.vcu;      S.NT = 2; S.npanels = pst[NE]; S.pst = pst; S.cnt = cnt; S.toks = (const int*)(ws + WS_TOK);
        S.A = (const bf16*)(ws + WS_X1); S.Bt = (const bf16*)(ws + WS_WGU); S.lda = 1024; S.ldb = 1024; S.bstride = (size_t)512 * 1024; S.gather = true; S.mode = 0;
        EpiGateUp E{ws, cnt};
        STAGGER_SLACK(pst[NE] * 2, 2700, F.vcu);
        pg8::gemm_phase<EpiGateUp, MoeSched, true>(F.lds, 1024, 1024, S, E);
        S.mode = 1; pg8::gemm_phase<EpiGateUp, MoeSched, true, true>(F.lds, 1024, 1024, S, E);
        { const int r_ = S.tail_wgs(), c_ = F.vcu;
          if (r_ == 0) p_convert_experts(F, 1, c_ * NWAVES + F.wave, F.G * NWAVES); else if (c_ >= r_) p_convert_experts(F, 1, (c_ - r_) * NWAVES + F.wave, (F.G - r_) * NWAVES); }
        if (BOTH(7)) GRID_BAR();
    }
    if (IN(8)) {
        moe_tables(F);
        MoeSched S; S.G = F.G; S.c = F.vcu;      S.NT = 4; S.npanels = pst[NE]; S.pst = pst; S.cnt = cnt; S.toks = (const int*)(ws + WS_TOK);
        S.A = (const bf16*)(ws + WS_HB); S.Bt = (const bf16*)(ws + WS_WD); S.lda = 256; S.ldb = 256; S.bstride = (size_t)1024 * 256; S.gather = false; S.mode = 0;
        EpiDown E{ws, cnt, (args.flags >> 4) & 3};
        STAGGER_SLACK(pst[NE] * 4, 1400, F.vcu);
        pg8::gemm_phase<EpiDown, MoeSched, true>(F.lds, 256, 256, S, E, (args.flags & 32) != 0, (args.flags & 64) != 0);
        S.mode = 1; pg8::gemm_phase<EpiDown, MoeSched, true, true>(F.lds, 256, 256, S, E);
        if (BOTH(8)) GRID_BAR();
    }
    if (IN(9)) { moe_tables(F); p_final(F); }
#undef IN
#undef BOTH
}
}

extern "C" void kernel_launch(void* const* d_in, const int* in_sizes, int n_in, void* d_out, int out_size, void* d_ws, size_t ws_size, hipStream_t stream) {
    static int grid = 0;
    if (grid == 0) {
        if (n_in != 20 || ws_size < WS_END || out_size != T * D) { fprintf(stderr, "kernel_launch: unexpected shapes (n_in %d, ws %zu, out %d)\n", n_in, ws_size, out_size); grid = -1; return; }
        int dev = 0, cus = 0, per_cu = 0;
        if (hipGetDevice(&dev) != hipSuccess || hipDeviceGetAttribute(&cus, hipDeviceAttributeMultiprocessorCount, dev) != hipSuccess) { grid = -1; return; }
        if (hipFuncSetAttribute((const void*)mk_fwd, hipFuncAttributeMaxDynamicSharedMemorySize, LDS_BYTES) != hipSuccess) { fprintf(stderr, "kernel_launch: hipFuncSetAttribute failed\n"); grid = -1; return; }
        if (hipOccupancyMaxActiveBlocksPerMultiprocessor(&per_cu, (const void*)mk_fwd, NWAVES * 64, LDS_BYTES) != hipSuccess || per_cu < 1) { fprintf(stderr, "kernel_launch: occupancy query says %d\n", per_cu); }
        (void)hipGetLastError();
        if (cus < 256) { fprintf(stderr, "kernel_launch: this kernel's unit maps are written for a 256-workgroup grid, one workgroup per CU; the device has %d CUs; nothing launched\n", cus); grid = -1; return; }
        grid = 256;
    }
    if (grid < 0) return;
    (void)hipMemsetAsync((char*)d_ws + WS_CTL, 0, CTL_BYTES, stream);
    Args a{};
    for (int i = 0; i < 20; ++i) a.in[i] = (const float*)d_in[i];
    a.out = (float*)d_out; a.ws = (unsigned char*)d_ws;
#if MK_SPLIT
    for (int p = 0; p < NPHASE; ++p) { a.ph_lo = p; a.ph_hi = p + 1; hipLaunchKernelGGL(mk_fwd, dim3(grid), dim3(NWAVES * 64), LDS_BYTES, stream, a); }
#else
#ifndef PROBE_PREFIX
#define PROBE_PREFIX -1
#endif
#ifndef PROBE_FLAGS
#define PROBE_FLAGS 0
#endif
    if (PROBE_PREFIX >= 0) {
        a.ph_lo = 0; a.ph_hi = PROBE_PREFIX + 1; a.flags = PROBE_FLAGS;
        hipLaunchKernelGGL(mk_fwd, dim3(grid), dim3(NWAVES * 64), LDS_BYTES, stream, a);
        (void)hipMemsetAsync((char*)d_ws + WS_CTL, 0, CTL_BYTES, stream);
    }
    a.ph_lo = 0; a.ph_hi = NPHASE; a.flags = 0;
    hipLaunchKernelGGL(mk_fwd, dim3(grid), dim3(NWAVES * 64), LDS_BYTES, stream, a);
#endif
}
```

```cpp
#include <hip/hip_runtime.h>
#include <stdint.h>
#include <stdio.h>

#ifndef PROBE_ABL
#define PROBE_ABL 0
#endif
#ifndef MK_SPLIT
#define MK_SPLIT 0
#endif

#define LAS __attribute__((address_space(3)))
#define GAS __attribute__((address_space(1)))

namespace {
typedef unsigned short bf16;
typedef short bf16x8 __attribute__((ext_vector_type(8)));
typedef float f32x4 __attribute__((ext_vector_type(4)));
typedef unsigned u32x4 __attribute__((ext_vector_type(4)));
typedef unsigned u32x2 __attribute__((ext_vector_type(2)));

constexpr int D = 1024, BATCH = 16, SEQ = 2048, T = BATCH * SEQ;
constexpr int NIN = 1952, NINP = 2048;
constexpr int NE = 32, CAP = 32768;
constexpr float EPS = 1e-6f;
constexpr float LOG2E = 1.4426950408889634f;
constexpr float QS_A = 0.125f * LOG2E;
constexpr float QS_B = 0.10206207261596577f * LOG2E;
constexpr int NWAVES = 8;
constexpr int NPHASE = 10;

constexpr size_t MiB = 1u << 20;
constexpr size_t WS_CTL = 0;
constexpr size_t CTL_BYTES = 1 * MiB;
constexpr int CW_COUNTS = 64;
constexpr int CW_BAR = 4096;
constexpr size_t CTL_SSQQ = 128 * 1024, CTL_SSQKV = 256 * 1024, CTL_SSQ1 = 384 * 1024;
constexpr size_t WS_RS0 = 2 * MiB;
constexpr size_t WS_ROPE = WS_RS0 + 512 * 1024;
constexpr size_t WS_BT = WS_ROPE + 256 * 1024;
constexpr size_t WS_BIMG = WS_BT + 16 * 1024;
constexpr size_t WS_AE = 3 * MiB;
constexpr size_t WS_APOS = WS_AE + 256 * 1024;
constexpr size_t WS_LSE = 4 * MiB;
constexpr size_t WS_WR = 7 * MiB;
constexpr size_t WS_WI = 8 * MiB;
constexpr size_t WS_WQKV = 12 * MiB;
constexpr size_t WS_WO = 13 * MiB;
constexpr size_t WS_WGU = 16 * MiB;
constexpr size_t WS_WD = 48 * MiB;
constexpr size_t WS_XB = 64 * MiB;
constexpr size_t WS_QA = 128 * MiB, WS_KA = 160 * MiB, WS_VA = 192 * MiB;
constexpr size_t WS_LAT = 224 * MiB;
constexpr size_t WS_QB = 256 * MiB;
constexpr size_t WS_KB = 304 * MiB, WS_VB = 336 * MiB, WS_OB = 368 * MiB;
constexpr size_t WS_MIX = 400 * MiB;
constexpr size_t WS_KR = 464 * MiB;
constexpr size_t WS_TOK = 466 * MiB;
constexpr size_t WS_GATE = 470 * MiB;
constexpr size_t WS_END = 474 * MiB;
constexpr size_t WS_X1 = 128 * MiB;
constexpr size_t WS_HB = 192 * MiB;
constexpr size_t WS_YB = 256 * MiB;

constexpr int RING_BYTES = 131072;
constexpr int LDSCTL_OFF = RING_BYTES;
constexpr int MISC_OFF = LDSCTL_OFF + 320;
constexpr int MOE_OFF = LDSCTL_OFF + 1024;
constexpr int LDS_BYTES = 147456;

__device__ __forceinline__ float bf2f(bf16 b) { return __uint_as_float(((unsigned)b) << 16); }
__device__ __forceinline__ bf16 f2bf(float f) { unsigned u = __float_as_uint(f); u += 0x7fffu + ((u >> 16) & 1u); return (bf16)(u >> 16); }
typedef float f32x2_t __attribute__((ext_vector_type(2))); typedef __bf16 bf16x2_t __attribute__((ext_vector_type(2)));
__device__ __forceinline__ unsigned cvtpk(float lo, float hi) { f32x2_t v = {lo, hi}; bf16x2_t b = __builtin_convertvector(v, bf16x2_t); return __builtin_bit_cast(unsigned, b); }
__device__ __forceinline__ unsigned pk2(float lo, float hi) { return cvtpk(lo, hi); }
__device__ __forceinline__ float wave_sum(float v) {
#pragma unroll
    for (int o = 1; o < 64; o <<= 1) v += __shfl_xor(v, o);
    return v;
}
__device__ __forceinline__ void unpack8(u32x4 v, float (&a)[8]) {
    a[0] = __uint_as_float(v.x << 16); a[1] = __uint_as_float(v.x & 0xffff0000u); a[2] = __uint_as_float(v.y << 16); a[3] = __uint_as_float(v.y & 0xffff0000u);
    a[4] = __uint_as_float(v.z << 16); a[5] = __uint_as_float(v.z & 0xffff0000u); a[6] = __uint_as_float(v.w << 16); a[7] = __uint_as_float(v.w & 0xffff0000u); }
#define LDS_WAIT() asm volatile("s_waitcnt lgkmcnt(0)" ::: "memory")

#define XB_TMO      128
#define XB_XCNT(j)  (256  + 64 * (j))
#define XB_XSUB(j)  (1280 + 64 * (j))
#define XB_XGEN(j)  (2304 + 64 * (j))
#define XB_TOP      3328
#define XB_TOPGEN   3392
#define XCD_BAR_WORDS 3456
#define XB_SPIN_CAP (1u << 18)
__device__ __forceinline__ unsigned xb_ld(unsigned* p)              { return __hip_atomic_load(p, __ATOMIC_RELAXED, __HIP_MEMORY_SCOPE_AGENT); }
__device__ __forceinline__ unsigned xb_add(unsigned* p, unsigned v) { return __hip_atomic_fetch_add(p, v, __ATOMIC_RELAXED, __HIP_MEMORY_SCOPE_AGENT); }
__device__ __forceinline__ unsigned xb_xcc_id() { return (unsigned)__builtin_amdgcn_s_getreg((3 << 11) | 20) & 0xFu; }
#define XB_SPIN(cond, bar) do { unsigned _sp = 0; while (cond) { __builtin_amdgcn_s_sleep(1); \
    if ((++_sp & 255u) == 0u) { if (xb_ld(&(bar)[XB_TMO])) break; if (_sp > XB_SPIN_CAP) { atomicAdd(&(bar)[XB_TMO], 1u); break; } } } } while (0)
struct XcdBarrier { unsigned* bar; unsigned x; volatile LAS unsigned* st; };
__device__ __forceinline__ XcdBarrier xcd_barrier_post(unsigned* bar, volatile LAS unsigned* st) {
    XcdBarrier b; b.bar = bar; b.x = xb_xcc_id(); b.st = st;
    if (threadIdx.x == 0) (void)xb_add(&bar[XB_XCNT(b.x)], 1u);
    return b;
}
__device__ __forceinline__ void xcd_barrier_complete(unsigned* bar, unsigned x, unsigned& nloc, unsigned& nx) {
    const unsigned G = gridDim.x * gridDim.y * gridDim.z;
    unsigned sum, cnt, mine, sp = 0u;
    for (;;) {
        sum = 0u; cnt = 0u; mine = 0u;
#pragma unroll
        for (unsigned j = 0; j < 16; ++j) { const unsigned c = xb_ld(&bar[XB_XCNT(j)]); sum += c; cnt += (c > 0u) ? 1u : 0u; mine = (j == x) ? c : mine; }
        if (sum == G) break;
        __builtin_amdgcn_s_sleep(1);
        if ((++sp & 255u) == 0u) { if (xb_ld(&bar[XB_TMO])) break; if (sp > XB_SPIN_CAP) { atomicAdd(&bar[XB_TMO], 1u); break; } }
    }
    nloc = mine > 0u ? mine : 1u; nx = cnt > 0u ? cnt : 1u;
}
__device__ __forceinline__ void xcd_barrier(const XcdBarrier& b) {
    asm volatile("s_waitcnt vmcnt(0)" ::: "memory");
    __syncthreads();
    if (threadIdx.x == 0) {
        unsigned* bar = b.bar;
        __builtin_amdgcn_s_waitcnt(0);
        unsigned nloc = b.st[0], nx = b.st[1];
        if (nloc == 0u) { xcd_barrier_complete(bar, b.x, nloc, nx); b.st[0] = nloc; b.st[1] = nx; }
        const unsigned old = xb_add(&bar[XB_XSUB(b.x)], 1u);
        const unsigned gen = old / nloc;
        if (old + 1u == (gen + 1u) * nloc) {
            __builtin_amdgcn_fence(__ATOMIC_RELEASE, "agent");
            asm volatile("s_waitcnt vmcnt(0)" ::: "memory");
            const unsigned og = xb_add(&bar[XB_TOP], 1u);
            const unsigned tg = og / nx;
            if (og + 1u == (tg + 1u) * nx) xb_add(&bar[XB_TOPGEN], 1u);
            else XB_SPIN(xb_ld(&bar[XB_TOPGEN]) == tg, bar);
            __builtin_amdgcn_fence(__ATOMIC_ACQUIRE, "agent");
            xb_add(&bar[XB_XGEN(b.x)], 1u);
            asm volatile("s_waitcnt vmcnt(0)" ::: "memory");
        } else {
            XB_SPIN(xb_ld(&bar[XB_XGEN(b.x)]) == gen, bar);
            __builtin_amdgcn_fence(__ATOMIC_ACQUIRE, "agent");
            asm volatile("s_waitcnt vmcnt(0)" ::: "memory");
        }
    }
    __syncthreads();
}

namespace pg8 {
constexpr int BM = 256, BK = 64, HALF = 128, HTB = HALF * BK * 2, STAGE_BYTES = 8 * HTB, NXCD = 8, WGM = 8;
__device__ __forceinline__ int lds_byte(int r, int c) { const int st = (r >> 4) * 2 + (c >> 5), rr = r & 15, cc = c & 31, ob = rr * 64 + cc * 2; return st * 1024 + (ob ^ (((ob >> 9) & 1) << 5)); }
__device__ __forceinline__ void stage_rc(int b, int& R, int& C) { const int st = b / 1024, sb = b % 1024, swz = sb ^ (((sb >> 9) & 1) << 5); R = (st >> 1) * 16 + swz / 64; C = (st & 1) * 32 + (swz % 64) / 2; }
__device__ __forceinline__ int perm32(int rho) { const int n = rho >> 4, i = rho & 15; return 8 * (i >> 2) + 4 * n + (i & 3); }
struct Unit { int pm, pn, e, lr0, half; };
struct StaticOrder {
    int nM, nN, nwg, G, c;
    __device__ void init(int M, int N, int G_, int c_) { nM = M / BM; nN = N / BM; nwg = nM * nN; G = G_; c = c_; }
    __device__ bool next(int i, Unit& u) const {
        const long L = (long)i * G + c; if (L >= nwg) return false;
        int wgid = (int)L; { const int q = nwg / NXCD, r = nwg % NXCD, xcd = wgid % NXCD, off = wgid / NXCD; wgid = (xcd < r ? xcd * (q + 1) : r * (q + 1) + (xcd - r) * q) + off; }
        const int nig = WGM * nN, gid = wgid / nig, fm = gid * WGM, gsz = (nM - fm) < WGM ? (nM - fm) : WGM;
        u.pm = fm + ((wgid % nig) % gsz); u.pn = (wgid % nig) / gsz; u.e = 0; u.lr0 = 0; u.half = 0; return true;
    }
};

template <class Epi, class Sched, bool ALIGN_EPI, bool HALFM = false>
__device__ __forceinline__ void gemm_phase(LAS unsigned char* lds, const int K, const int ldb, const Sched& S, const Epi& E, const bool nomma = false, const bool nostage = false) {
    const int tid = threadIdx.x, wid = __builtin_amdgcn_readfirstlane(tid >> 6), lane = tid & 63, wr = wid >> 2, wc = wid & 3, fr = lane & 15, fq = lane >> 4;
    const int nt = K / BK;
    int Rr[2], Cc[2]; unsigned voffB[2];
#pragma unroll
    for (int i = 0; i < 2; ++i) { stage_rc(tid * 16 + i * 8192, Rr[i], Cc[i]); const int Rb = (Rr[i] & ~31) + perm32(Rr[i] & 31); voffB[i] = (unsigned)(Rb * ldb + Cc[i]) * 2u; }
    const size_t kstep = (size_t)(BK * 2);
    const size_t hstepB = (size_t)HALF * ldb * 2;
    const unsigned ldsw = (unsigned)wid * 1024u;
    const int aoff = lds_byte(wr * 64 + fr, fq * 8), boff = lds_byte(wc * 32 + fr, fq * 8);
#define PG8_SA(b, h) (((b) * 2 + (h)) * HTB)
#define PG8_SB(b, h) ((4 + (b) * 2 + (h)) * HTB)
#define PG8_STAGE(bufoff, gbase, voff) do { if (nostage) break; _Pragma("unroll") for (int _i = 0; _i < 2; ++_i) \
        __builtin_amdgcn_global_load_lds((const unsigned*)((const char*)(gbase) + (voff)[_i]), (LAS unsigned*)(lds + (bufoff) + ldsw + _i * 8192), 16, 0, 0); } while (0)
#define PG8_LDA(dst, b, h) do { _Pragma("unroll") for (int m = 0; m < 4; ++m) _Pragma("unroll") for (int k = 0; k < 2; ++k) dst[m][k] = *(const LAS bf16x8*)(lds + PG8_SA(b, h) + aoff + m * 2048 + k * 1024); } while (0)
#define PG8_LDB(dst, b, h) do { _Pragma("unroll") for (int n = 0; n < 2; ++n) _Pragma("unroll") for (int k = 0; k < 2; ++k) dst[n][k] = *(const LAS bf16x8*)(lds + PG8_SB(b, h) + boff + n * 2048 + k * 1024); } while (0)
#define PG8_MMA(ai, bj, At, Bt) do { if (nomma) { asm volatile("" :: "v"(At[0][0]), "v"(At[3][1]), "v"(Bt[0][0]), "v"(Bt[1][1])); break; } __builtin_amdgcn_s_setprio(1); _Pragma("unroll") for (int m = 0; m < 4; ++m) _Pragma("unroll") for (int n = 0; n < 2; ++n) _Pragma("unroll") for (int k = 0; k < 2; ++k) \
        acc[ai][bj][m][n] = __builtin_amdgcn_mfma_f32_16x16x32_bf16(Bt[n][k], At[m][k], acc[ai][bj][m][n], 0, 0, 0); __builtin_amdgcn_s_setprio(0); } while (0)
#define PG8_WAIT_V(n) asm volatile("s_waitcnt vmcnt(" #n ")" ::: "memory")
#define PG8_WAIT_L(n) asm volatile("s_waitcnt lgkmcnt(" #n ")" ::: "memory")
#define PG8_BAR __builtin_amdgcn_s_barrier()
#define PG8_SCHED __builtin_amdgcn_sched_barrier(0)
    Unit cur, nxt; int ui = 0;
    if (!S.next(0, cur)) return;
    f32x4 acc[2][2][4][2];
#pragma unroll
    for (int a = 0; a < 2; ++a)
#pragma unroll
        for (int b = 0; b < 2; ++b)
#pragma unroll
            for (int m = 0; m < 4; ++m)
#pragma unroll
                for (int n = 0; n < 2; ++n) acc[a][b][m][n] = (f32x4){0.f, 0.f, 0.f, 0.f};
    bf16x8 At[4][2], B0[2][2], B1[2][2];
    const char* cA = S.a_base(cur); const char* cB = S.b_base(cur);
    unsigned vAc[2][2], vAn[2][2], v2[2][2];
    S.a_offs(cur, Rr, Cc, vAc);
    PG8_STAGE(PG8_SB(0, 0), cB, voffB); PG8_STAGE(PG8_SB(0, 1), cB + hstepB, voffB); PG8_STAGE(PG8_SA(0, 0), cA, vAc[0]); PG8_STAGE(PG8_SA(0, 1), cA, vAc[1]);
    if (wr == 1) PG8_BAR;
    PG8_WAIT_V(2); PG8_BAR;
    PG8_STAGE(PG8_SB(1, 0), cB + kstep, voffB); PG8_STAGE(PG8_SA(1, 0), cA + kstep, vAc[0]); PG8_STAGE(PG8_SB(1, 1), cB + hstepB + kstep, voffB);
    PG8_WAIT_V(6); PG8_BAR;
    for (;;) {
        const bool has_next = S.next(ui + 1, nxt);
        const char* nA = has_next ? S.a_base(nxt) : cA; const char* nB = has_next ? S.b_base(nxt) : cB;
        if (has_next) S.a_offs(nxt, Rr, Cc, vAn);
        else {
#pragma unroll
            for (int h = 0; h < 2; ++h)
#pragma unroll
                for (int i = 0; i < 2; ++i) vAn[h][i] = vAc[h][i]; }
#pragma unroll 1
        for (int t = 0; t < nt; t += 2) {
            const bool last = (t == nt - 2);
            const char* a1 = cA + (size_t)(t + 1) * kstep;
            const char* a2 = last ? nA : cA + (size_t)(t + 2) * kstep; const char* b2 = last ? nB : cB + (size_t)(t + 2) * kstep;
            const char* a3 = a2 + kstep; const char* b3 = b2 + kstep;
#pragma unroll
            for (int h = 0; h < 2; ++h)
#pragma unroll
                for (int i = 0; i < 2; ++i) v2[h][i] = last ? vAn[h][i] : vAc[h][i];
            PG8_LDB(B0, 0, 0); PG8_LDB(B1, 0, 1); PG8_SCHED; PG8_LDA(At, 0, 0); PG8_STAGE(PG8_SA(1, 1), a1, vAc[1]);
            PG8_WAIT_V(8); PG8_WAIT_L(0); PG8_BAR; PG8_MMA(0, 0, At, B0); PG8_MMA(0, 1, At, B1); PG8_BAR; PG8_SCHED;
            if constexpr (!HALFM) { PG8_LDA(At, 0, 1); } PG8_STAGE(PG8_SB(0, 0), b2, voffB); PG8_STAGE(PG8_SB(0, 1), b2 + hstepB, voffB); PG8_STAGE(PG8_SA(0, 0), a2, v2[0]);
            PG8_WAIT_V(8); PG8_WAIT_L(0); PG8_BAR; if constexpr (!HALFM) { PG8_MMA(1, 0, At, B0); PG8_MMA(1, 1, At, B1); } PG8_BAR; PG8_SCHED;
            PG8_LDB(B0, 1, 0); PG8_LDB(B1, 1, 1); PG8_SCHED; PG8_LDA(At, 1, 0); PG8_STAGE(PG8_SA(0, 1), a2, v2[1]);
            PG8_WAIT_V(8); PG8_WAIT_L(0); PG8_BAR; PG8_MMA(0, 0, At, B0); PG8_MMA(0, 1, At, B1); PG8_BAR; PG8_SCHED;
            if constexpr (!HALFM) { PG8_LDA(At, 1, 1); } PG8_STAGE(PG8_SB(1, 0), b3, voffB); PG8_STAGE(PG8_SB(1, 1), b3 + hstepB, voffB); PG8_STAGE(PG8_SA(1, 0), a3, v2[0]);
            PG8_WAIT_V(8); PG8_WAIT_L(0); PG8_BAR; if constexpr (!HALFM) { PG8_MMA(1, 0, At, B0); PG8_MMA(1, 1, At, B1); } PG8_BAR; PG8_SCHED;
        }
        if constexpr (ALIGN_EPI) { if (wr == 0) PG8_BAR; }
        if constexpr (!HALFM) cur.half = 0; else cur.half = (cur.half == 2) ? 2 : 1;
        E(acc, cur, wr, wc, fr, fq);
        if (!has_next) break;
#pragma unroll
        for (int a = 0; a < 2; ++a)
#pragma unroll
            for (int b = 0; b < 2; ++b)
#pragma unroll
                for (int m = 0; m < 4; ++m)
#pragma unroll
                    for (int n = 0; n < 2; ++n) acc[a][b][m][n] = (f32x4){0.f, 0.f, 0.f, 0.f};
        cur = nxt; cA = nA; cB = nB; ++ui;
#pragma unroll
        for (int h = 0; h < 2; ++h)
#pragma unroll
            for (int i = 0; i < 2; ++i) vAc[h][i] = vAn[h][i];
        if constexpr (ALIGN_EPI) { if (wr == 1) PG8_BAR; }
    }
    PG8_WAIT_V(0);
    if constexpr (!ALIGN_EPI) { if (wr == 0) PG8_BAR; }
    PG8_BAR;
#undef PG8_SA
#undef PG8_SB
#undef PG8_STAGE
#undef PG8_LDA
#undef PG8_LDB
#undef PG8_MMA
#undef PG8_WAIT_V
#undef PG8_WAIT_L
#undef PG8_BAR
#undef PG8_SCHED
}
}
using pg8::Unit;

struct PlainSched {
    pg8::StaticOrder so; const bf16* A; const bf16* Bt; int lda, ldb; int acol_pn, acol_off;
    __device__ __forceinline__ bool next(int i, Unit& u) const { return so.next(i, u); }
    __device__ __forceinline__ const char* a_base(const Unit& u) const { return (const char*)(A + (size_t)u.pm * 256 * lda + (u.pn >= acol_pn ? acol_off : 0)); }
    __device__ __forceinline__ const char* b_base(const Unit& u) const { return (const char*)(Bt + (size_t)u.pn * 256 * ldb); }
    __device__ __forceinline__ void a_offs(const Unit&, const int (&R)[2], const int (&C)[2], unsigned (&v)[2][2]) const {
#pragma unroll
        for (int h = 0; h < 2; ++h)
#pragma unroll
            for (int i = 0; i < 2; ++i) v[h][i] = (unsigned)((h * 128 + R[i]) * lda + C[i]) * 2u; }
};
struct PairSched {
    int pm, pn0; const bf16* A; const bf16* Bt; int lda, ldb;
    __device__ __forceinline__ bool next(int i, Unit& u) const { if (i >= 2) return false; u.pm = pm; u.pn = pn0 + i; u.e = 0; u.lr0 = 0; u.half = 0; return true; }
    __device__ __forceinline__ const char* a_base(const Unit& u) const { return (const char*)(A + (size_t)u.pm * 256 * lda); }
    __device__ __forceinline__ const char* b_base(const Unit& u) const { return (const char*)(Bt + (size_t)u.pn * 256 * ldb); }
    __device__ __forceinline__ void a_offs(const Unit&, const int (&R)[2], const int (&C)[2], unsigned (&v)[2][2]) const {
#pragma unroll
        for (int h = 0; h < 2; ++h)
#pragma unroll
            for (int i = 0; i < 2; ++i) v[h][i] = (unsigned)((h * 128 + R[i]) * lda + C[i]) * 2u; }
};
struct MoeSched {
    int G, c, NT, npanels; const LAS int* pst; const LAS int* cnt; const int* toks; const bf16* A; const bf16* Bt; int lda, ldb; size_t bstride; bool gather; int mode;
    __device__ __forceinline__ int rem() const { return (npanels * NT) % G; }
    __device__ __forceinline__ bool split() const { const int r = rem(); return r > 0 && 2 * r <= G; }
    __device__ __forceinline__ int tail_wgs() const { return split() ? 2 * rem() : rem(); }
    __device__ __forceinline__ bool next(int i, Unit& u) const {
        const int nu = npanels * NT, full = nu - rem(); int L;
        if (mode == 0) { L = i * G + c; if (L >= (split() ? full : nu)) return false; u.half = 0; }
        else { if (i > 0 || !split() || c >= 2 * rem()) return false; L = full + (c >> 1); u.half = 1 + (c & 1); }
        u.pm = L / NT; u.pn = L % NT; int e = 0;
#pragma unroll 1
        for (int q = 1; q < NE; ++q) e = (pst[q] <= u.pm) ? q : e;
        u.e = e; u.lr0 = (u.pm - pst[e]) * 256; return true; }
    __device__ __forceinline__ const char* a_base(const Unit& u) const { return gather ? (const char*)A : (const char*)(A + (size_t)u.pm * 256 * lda); }
    __device__ __forceinline__ const char* b_base(const Unit& u) const { return (const char*)(Bt + (size_t)u.e * bstride + (size_t)u.pn * 256 * ldb); }
    __device__ __forceinline__ void a_offs(const Unit& u, const int (&R)[2], const int (&C)[2], unsigned (&v)[2][2]) const {
        const int ce = cnt[u.e];
#pragma unroll
        for (int h = 0; h < 2; ++h)
#pragma unroll
            for (int i = 0; i < 2; ++i) {
                const int hh = (u.half == 2) ? 1 : h;
                if (gather) { const int lrow = u.lr0 + hh * 128 + R[i]; const int tok = toks[u.e * CAP + (lrow < ce ? lrow : 0)]; v[h][i] = (unsigned)(tok * lda + C[i]) * 2u; }
                else v[h][i] = (unsigned)((hh * 128 + R[i]) * lda + C[i]) * 2u; } }
};

#ifndef ST8_SC1
#define ST8_SC1 0
#endif
__device__ __forceinline__ void st8(bf16* p, f32x4 a, f32x4 b) { u32x4 o; o.x = pk2(a.x, a.y); o.y = pk2(a.z, a.w); o.z = pk2(b.x, b.y); o.w = pk2(b.z, b.w);
    if (ST8_SC1) asm volatile("global_store_dwordx4 %0, %1, off sc1\n\ts_nop 1" :: "v"(p), "v"(o) : "memory"); else *(u32x4*)p = o; }
__device__ __forceinline__ void st4(bf16* p, f32x4 v) { u32x2 o; o.x = pk2(v.x, v.y); o.y = pk2(v.z, v.w); *(u32x2*)p = o; }
__device__ __forceinline__ float sq4(f32x4 v) { return (v.x * v.x + v.y * v.y) + (v.z * v.z + v.w * v.w); }

struct EpiInProj {
    unsigned char* ws;
    __device__ __forceinline__ void operator()(const f32x4 (&acc)[2][2][4][2], const Unit& u, int wr, int wc, int fr, int fq) const {
        const float* __restrict__ rs0 = (const float*)(ws + WS_RS0);
        const int reg = u.pn >> 1;
        bf16* __restrict__ dst = (bf16*)(ws + (reg == 0 ? WS_QA : reg == 1 ? WS_KA : reg == 2 ? WS_VA : WS_LAT));
        const float qs = (reg == 0) ? QS_A : 1.f;
        const int row0 = u.pm * 256 + wr * 64 + fr;
        float rsv[2][4];
#pragma unroll
        for (int ai = 0; ai < 2; ++ai)
#pragma unroll
            for (int m = 0; m < 4; ++m) rsv[ai][m] = rs0[row0 + ai * 128 + m * 16];
        const bool isrope = (u.pn == 7 && wc == 0);
        float2 csv[2][4][4];
        if (isrope) {
#pragma unroll
            for (int ai = 0; ai < 2; ++ai)
#pragma unroll
                for (int m = 0; m < 4; ++m) { const float2* cs = (const float2*)(ws + WS_ROPE) + ((row0 + ai * 128 + m * 16) & (SEQ - 1)) * 16 + fq * 4;
#pragma unroll
                    for (int j = 0; j < 4; ++j) csv[ai][m][j] = cs[j]; }
        }
#pragma unroll
        for (int ai = 0; ai < 2; ++ai)
#pragma unroll
            for (int m = 0; m < 4; ++m) {
                const int row = row0 + ai * 128 + m * 16;
                const float rs = rsv[ai][m]; const float sc = rs * qs;
                float ssq = 0.f;
#pragma unroll
                for (int bj = 0; bj < 2; ++bj) {
                    const int lc = (u.pn & 1) * 256 + bj * 128 + wc * 32 + fq * 8;
                    const f32x4 v0 = acc[ai][bj][m][0] * sc, v1 = acc[ai][bj][m][1] * sc;
                    st8(dst + (size_t)row * 512 + lc, v0, v1);
                    if (u.pn == 6 || (u.pn == 7 && bj == 0)) ssq += sq4(v0) + sq4(v1);
                }
                if (u.pn >= 6) {
                    ssq += __shfl_xor(ssq, 16); ssq += __shfl_xor(ssq, 32);
                    if (fq == 0) atomicAdd((float*)(ws + (u.pn == 6 ? CTL_SSQQ : CTL_SSQKV)) + row, ssq);
                    if (isrope) {
                        const f32x4 x1 = acc[ai][1][m][0] * rs, x2 = acc[ai][1][m][1] * rs;
                        f32x4 y1, y2;
#pragma unroll
                        for (int j = 0; j < 4; ++j) { const float2 c = csv[ai][m][j]; y1[j] = x1[j] * c.x - x2[j] * c.y; y2[j] = x1[j] * c.y + x2[j] * c.x; }
                        bf16* kr = (bf16*)(ws + WS_KR) + (size_t)row * 32 + fq * 4;
                        st4(kr, y1); st4(kr + 16, y2);
                    }
                }
            }
    }
};
struct EpiUps {
    unsigned char* ws;
    __device__ __forceinline__ void operator()(const f32x4 (&acc)[2][2][4][2], const Unit& u, int wr, int wc, int fr, int fq) const {
        const bool isq = u.pn < 3;
        const float* __restrict__ ssq = (const float*)(ws + (isq ? CTL_SSQQ : CTL_SSQKV));
        const int row0 = u.pm * 256 + wr * 64 + fr;
        float sv[2][4];
#pragma unroll
        for (int ai = 0; ai < 2; ++ai)
#pragma unroll
            for (int m = 0; m < 4; ++m) sv[ai][m] = ssq[row0 + ai * 128 + m * 16];
        const bool rope0 = isq && ((u.pn * 8 + wc) % 3 == 2), rope1 = isq && ((u.pn * 8 + 4 + wc) % 3 == 2);
        float2 csv[2][4][4];
        if (rope0 || rope1) {
#pragma unroll
            for (int ai = 0; ai < 2; ++ai)
#pragma unroll
                for (int m = 0; m < 4; ++m) { const float2* cs = (const float2*)(ws + WS_ROPE) + ((row0 + ai * 128 + m * 16) & (SEQ - 1)) * 16 + fq * 4;
#pragma unroll
                    for (int j = 0; j < 4; ++j) csv[ai][m][j] = cs[j]; }
        }
#pragma unroll
        for (int ai = 0; ai < 2; ++ai)
#pragma unroll
            for (int m = 0; m < 4; ++m) {
                const int row = row0 + ai * 128 + m * 16;
                const float rs = rsqrtf(sv[ai][m] * (isq ? (1.f / 256.f) : (1.f / 128.f)) + EPS) * (isq ? QS_B : 1.f);
#pragma unroll
                for (int bj = 0; bj < 2; ++bj) {
                    if (isq) {
                        const int cg = u.pn * 8 + bj * 4 + wc;
                        bf16* q = (bf16*)(ws + WS_QB) + (size_t)row * 768 + cg * 32;
                        f32x4 a = acc[ai][bj][m][0] * rs, b = acc[ai][bj][m][1] * rs;
                        if (bj ? rope1 : rope0) {
                            f32x4 y1, y2;
#pragma unroll
                            for (int j = 0; j < 4; ++j) { const float2 c = csv[ai][m][j]; y1[j] = a[j] * c.x - b[j] * c.y; y2[j] = a[j] * c.y + b[j] * c.x; }
                            st4(q + fq * 4, y1); st4(q + 16 + fq * 4, y2);
                        } else st8(q + fq * 8, a, b);
                    } else {
                        const int head = (u.pn - 3) * 2 + bj;
                        bf16* dst = (bf16*)(ws + (wc < 2 ? WS_KB : WS_VB)) + (size_t)row * 512 + head * 64 + (wc & 1) * 32 + fq * 8;
                        st8(dst, acc[ai][bj][m][0] * rs, acc[ai][bj][m][1] * rs);
                    }
                }
            }
    }
};
struct EpiOut {
    unsigned char* ws; int gabl;
    __device__ __forceinline__ void operator()(const f32x4 (&acc)[2][2][4][2], const Unit& u, int wr, int wc, int fr, int fq) const {
        const bf16* __restrict__ xb = (const bf16*)(ws + WS_XB); bf16* __restrict__ x1 = (bf16*)(ws + WS_X1);
        int pm_ = u.pm; asm volatile("" : "+s"(pm_));
        const int row0 = pm_ * 256 + wr * 64 + fr; const int col0 = u.pn * 256 + wc * 32 + fq * 8;
        u32x4 xv[4][2], pk[4][2]; float sq[4];
#define EO_LOAD(ai) _Pragma("unroll") for (int m = 0; m < 4; ++m) _Pragma("unroll") for (int bj = 0; bj < 2; ++bj) \
            xv[m][bj] = (gabl & 1) ? (u32x4){0u, 0u, 0u, 0u} : *(const u32x4*)(xb + (size_t)(row0 + (ai) * 128 + m * 16) * 1024 + col0 + bj * 128)
#define EO_PACK(ai) _Pragma("unroll") for (int m = 0; m < 4; ++m) { float ssq = 0.f; _Pragma("unroll") for (int bj = 0; bj < 2; ++bj) { float t8[8]; unpack8(xv[m][bj], t8); \
                f32x4 v0 = acc[ai][bj][m][0], v1 = acc[ai][bj][m][1]; \
                v0.x += t8[0]; v0.y += t8[1]; v0.z += t8[2]; v0.w += t8[3]; v1.x += t8[4]; v1.y += t8[5]; v1.z += t8[6]; v1.w += t8[7]; \
                pk[m][bj].x = pk2(v0.x, v0.y); pk[m][bj].y = pk2(v0.z, v0.w); pk[m][bj].z = pk2(v1.x, v1.y); pk[m][bj].w = pk2(v1.z, v1.w); ssq += sq4(v0) + sq4(v1); } \
            ssq += __shfl_xor(ssq, 16); ssq += __shfl_xor(ssq, 32); sq[m] = ssq; }
#define EO_STORE(ai) _Pragma("unroll") for (int m = 0; m < 4; ++m) { const int row = row0 + (ai) * 128 + m * 16; \
            _Pragma("unroll") for (int bj = 0; bj < 2; ++bj) { if (!(gabl & 2)) *(u32x4*)(x1 + (size_t)row * 1024 + col0 + bj * 128) = pk[m][bj]; else asm volatile("" :: "v"(pk[m][bj])); } \
            if (fq == 0 && !(gabl & 4)) atomicAdd((float*)(ws + CTL_SSQ1) + row, sq[m]); else asm volatile("" :: "v"(sq[m])); }
        EO_LOAD(0); EO_PACK(0); EO_LOAD(1); EO_STORE(0); EO_PACK(1); EO_STORE(1);
#undef EO_LOAD
#undef EO_PACK
#undef EO_STORE
    }
};
struct EpiGateUp {
    unsigned char* ws; const LAS int* cnt;
    __device__ __forceinline__ void operator()(const f32x4 (&acc)[2][2][4][2], const Unit& u, int wr, int wc, int fr, int fq) const {
        const int ce = cnt[u.e]; const int* __restrict__ toks = (const int*)(ws + WS_TOK) + u.e * CAP; const float* __restrict__ ssq1 = (const float*)(ws + CTL_SSQ1);
        const int lr0 = wr * 64 + fr + (u.half == 2 ? 128 : 0);
        int tk[2][4]; float sv[2][4];
#pragma unroll
        for (int ai = 0; ai < 2; ++ai)
#pragma unroll
            for (int m = 0; m < 4; ++m) { const int lrow = u.lr0 + lr0 + ai * 128 + m * 16; tk[ai][m] = toks[lrow < ce ? lrow : 0]; }
#pragma unroll
        for (int ai = 0; ai < 2; ++ai)
#pragma unroll
            for (int m = 0; m < 4; ++m) sv[ai][m] = ssq1[tk[ai][m]];
#pragma unroll
        for (int ai = 0; ai < 2; ++ai)
#pragma unroll
            for (int m = 0; m < 4; ++m) {
                if (ai == 1 && u.half) continue;
                const int lr = lr0 + ai * 128 + m * 16;
                const float rs = rsqrtf(sv[ai][m] * (1.f / D) + EPS);
                bf16* dst = (bf16*)(ws + WS_HB) + (size_t)(u.pm * 256 + lr) * 256 + u.pn * 128 + wc * 32 + fq * 8;
                f32x4 h[2];
#pragma unroll
                for (int n = 0; n < 2; ++n) { const f32x4 g = acc[ai][0][m][n] * rs, up = acc[ai][1][m][n] * rs;
#pragma unroll
                    for (int j = 0; j < 4; ++j) h[n][j] = g[j] / (1.f + __expf(-g[j])) * up[j]; }
                st8(dst, h[0], h[1]);
            }
    }
};
struct EpiDown {
    unsigned char* ws; const LAS int* cnt; int gabl;
    __device__ __forceinline__ void operator()(const f32x4 (&acc)[2][2][4][2], const Unit& u, int wr, int wc, int fr, int fq) const {
        const int ce = cnt[u.e]; const float* __restrict__ gates = (const float*)(ws + WS_GATE) + u.e * CAP;
        const int lr0 = wr * 64 + fr + (u.half == 2 ? 128 : 0);
        float gv[2][4];
#pragma unroll
        for (int ai = 0; ai < 2; ++ai)
#pragma unroll
            for (int m = 0; m < 4; ++m) { const int lrow = u.lr0 + lr0 + ai * 128 + m * 16; const float g = gates[lrow < ce ? lrow : 0]; gv[ai][m] = lrow < ce ? g : 0.f; }
#pragma unroll
        for (int ai = 0; ai < 2; ++ai)
#pragma unroll
            for (int m = 0; m < 4; ++m) {
                if (ai == 1 && u.half) continue;
                const int lr = lr0 + ai * 128 + m * 16;
                const float gt = gv[ai][m];
                bf16* dst = (bf16*)(ws + WS_YB) + (size_t)(u.pm * 256 + lr) * 1024 + u.pn * 256 + wc * 32 + fq * 8;
#pragma unroll
                for (int bj = 0; bj < 2; ++bj) { if (!(gabl & 1)) st8(dst + bj * 128, acc[ai][bj][m][0] * gt, acc[ai][bj][m][1] * gt); else asm volatile("" :: "v"(acc[ai][bj][m][0] * gt), "v"(acc[ai][bj][m][1] * gt)); }
            }
    }
};

struct Args { const float* in[20]; float* out; unsigned char* ws; int ph_lo, ph_hi, flags, pad; };
struct Frame { LAS unsigned char* lds; int tid, lane, wave, vcu, G; const float* const* in; float* out; unsigned char* ws; int pflags; };

__device__ __forceinline__ void transpose_item(const float* W, int ldw, const float* gain, bf16* WT, int ldwt, int k0, int n0, int dstrow0, LAS float* scr, int lane, bool ropeperm = false) {
    f32x4 v[8];
#pragma unroll
    for (int i = 0; i < 8; ++i) v[i] = *(const f32x4*)(W + (size_t)(k0 + 8 * i + (lane >> 3)) * ldw + n0 + 4 * (lane & 7));
#pragma unroll
    for (int i = 0; i < 8; ++i) { const int kk = 8 * i + (lane >> 3); const float g = gain ? gain[k0 + kk] : 1.f; LAS float* d = scr + kk * 33 + 4 * (lane & 7);
        d[0] = v[i].x * g; d[1] = v[i].y * g; d[2] = v[i].z * g; d[3] = v[i].w * g; }
    LDS_WAIT();
    const int c = lane & 7;
#pragma unroll
    for (int j = 0; j < 4; ++j) { const int n = (lane >> 3) + 8 * j; const LAS float* s = scr + (8 * c) * 33 + n;
        u32x4 o; o.x = pk2(s[0 * 33], s[1 * 33]); o.y = pk2(s[2 * 33], s[3 * 33]); o.z = pk2(s[4 * 33], s[5 * 33]); o.w = pk2(s[6 * 33], s[7 * 33]);
        const int dn = ropeperm ? (8 * ((n & 15) >> 2) + 4 * (n >> 4) + (n & 3)) : n;
        *(u32x4*)(WT + (size_t)(dstrow0 + dn) * ldwt + k0 + 8 * c) = o; }
    LDS_WAIT();
}

struct XItem { const float* W; const float* gain; bf16* WT; int ldw, ldwt, k0, n0, dstrow0; };
__device__ __forceinline__ XItem xitem_decode(const Frame& F, int kind, int r) {
    unsigned char* ws = F.ws; XItem t; constexpr int I_G = 16 * 8, I_D = 4 * 32;
    if (kind == 0) { const int mtx = r / I_G, q = r % I_G, e = mtx >> 1, gu = mtx & 1, kb = q / 8, nb = q % 8; const int n0 = nb * 32;
        t.W = (gu ? F.in[17] : F.in[16]) + (size_t)e * 1024 * 256; t.ldw = 256; t.gain = F.in[11]; t.WT = (bf16*)(ws + WS_WGU) + (size_t)e * 512 * 1024; t.ldwt = 1024; t.k0 = kb * 64; t.n0 = n0;
        t.dstrow0 = 256 * (n0 >> 7) + gu * 128 + (n0 & 127); }
    else { const int e = r / I_D, q = r % I_D, kb = q / 32, nb = q % 32;
        t.W = F.in[18] + (size_t)e * 256 * 1024; t.ldw = 1024; t.gain = nullptr; t.WT = (bf16*)(ws + WS_WD) + (size_t)e * 1024 * 256; t.ldwt = 256; t.k0 = kb * 64; t.n0 = nb * 32; t.dstrow0 = nb * 32; }
    return t;
}
__device__ __forceinline__ void xitem_load(const XItem& t, f32x4 (&v)[8], int lane) {
#pragma unroll
    for (int i = 0; i < 8; ++i) v[i] = *(const f32x4*)(t.W + (size_t)(t.k0 + 8 * i + (lane >> 3)) * t.ldw + t.n0 + 4 * (lane & 7));
}
__device__ __forceinline__ void xitem_store(const XItem& t, const f32x4 (&v)[8], LAS float* scr, int lane) {
#pragma unroll
    for (int i = 0; i < 8; ++i) { const int kk = 8 * i + (lane >> 3); const float g = t.gain ? t.gain[t.k0 + kk] : 1.f; LAS float* d = scr + kk * 33 + 4 * (lane & 7);
        d[0] = v[i].x * g; d[1] = v[i].y * g; d[2] = v[i].z * g; d[3] = v[i].w * g; }
    LDS_WAIT();
    const int c = lane & 7;
#pragma unroll
    for (int j = 0; j < 4; ++j) { const int n = (lane >> 3) + 8 * j; const LAS float* s = scr + (8 * c) * 33 + n;
        u32x4 o; o.x = pk2(s[0 * 33], s[1 * 33]); o.y = pk2(s[2 * 33], s[3 * 33]); o.z = pk2(s[4 * 33], s[5 * 33]); o.w = pk2(s[6 * 33], s[7 * 33]);
        *(u32x4*)(t.WT + (size_t)(t.dstrow0 + n) * t.ldwt + t.k0 + 8 * c) = o; }
    LDS_WAIT();
}
__device__ __forceinline__ void p_convert_experts(const Frame& F, int kind, int wid, int nw) {
    const int lane = F.lane; LAS float* scr = (LAS float*)(F.lds + F.wave * 16384);
    const int nitems = kind == 0 ? 64 * 16 * 8 : 32 * 4 * 32;
    if (wid >= nitems) return;
    XItem cur = xitem_decode(F, kind, wid); f32x4 v[8], vn[8]; xitem_load(cur, v, lane);
    for (int r = wid; r < nitems; r += nw) {
        const bool more = (r + nw < nitems); XItem nxt = cur;
        if (more) { nxt = xitem_decode(F, kind, r + nw); xitem_load(nxt, vn, lane); }
        xitem_store(cur, v, scr, lane);
        if (more) { cur = nxt;
#pragma unroll
            for (int i = 0; i < 8; ++i) v[i] = vn[i]; }
    }
}
__device__ __forceinline__ void p_prologue(const Frame& F) {
    unsigned char* ws = F.ws; const int lane = F.lane;
    LAS float* scr = (LAS float*)(F.lds + F.wave * 16384);
    const int gw = F.vcu * NWAVES + F.wave, NGW = F.G * NWAVES;
    constexpr int I_IN = 16 * 61, I_Q = 4 * 24, I_KV = 2 * 32, I_O = 16 * 32;
    constexpr int NITEMS = I_IN + I_Q + I_KV + I_O;
    for (int it = gw; it < NITEMS; it += NGW) {
        if (F.pflags & 128) break;
        int r = it;
        if (r < I_IN) { const int kb = r / 61, nb = r % 61; transpose_item(F.in[2], NIN, F.in[1], (bf16*)(ws + WS_WI), 1024, kb * 64, nb * 32, nb * 32, scr, lane, nb == 60); continue; } r -= I_IN;
        if (r < I_Q) { const int kb = r / 24, nb = r % 24; transpose_item(F.in[5], 768, F.in[4], (bf16*)(ws + WS_WQKV), 256, kb * 64, nb * 32, nb * 32, scr, lane, nb % 3 == 2); continue; } r -= I_Q;
        if (r < I_KV) { const int kb = r / 32, nb = r % 32; transpose_item(F.in[7], 1024, F.in[6], (bf16*)(ws + WS_WQKV), 256, kb * 64, nb * 32, 768 + nb * 32, scr, lane); continue; } r -= I_KV;
        { const int kb = r / 32, nb = r % 32; transpose_item(F.in[10], 1024, nullptr, (bf16*)(ws + WS_WO), 1024, kb * 64, nb * 32, nb * 32, scr, lane); }
    }
    const size_t gt = (size_t)F.vcu * 512 + F.tid, NGT = (size_t)F.G * 512;
    for (size_t i = gt; i < (size_t)96 * 1024 / 8; i += NGT) ((u32x4*)((bf16*)(ws + WS_WI) + (size_t)1952 * 1024))[i] = (u32x4){0, 0, 0, 0};
    for (size_t i = gt; i < (size_t)1024 * 16; i += NGT) { const size_t row = i >> 4, c = i & 15; *(u32x4*)((bf16*)(ws + WS_WQKV) + (768 + row) * 256 + 128 + c * 8) = (u32x4){0, 0, 0, 0}; }
    { const float* __restrict__ xin = F.in[0]; bf16* __restrict__ XBp = (bf16*)(ws + WS_XB); float* __restrict__ rs0 = (float*)(ws + WS_RS0);
    for (int m0 = gw * 4; m0 < T; m0 += NGW * 4) {
        if (F.pflags & 256) break;
        f32x4 v[4][4];
#pragma unroll
        for (int q = 0; q < 4; ++q)
#pragma unroll
            for (int j = 0; j < 4; ++j) v[q][j] = *((const f32x4*)(xin + (size_t)(m0 + q) * D) + lane + 64 * j);
#pragma unroll
        for (int q = 0; q < 4; ++q) { float s = 0.f;
#pragma unroll
            for (int j = 0; j < 4; ++j) s += sq4(v[q][j]);
            s = wave_sum(s);
            u32x2* o8 = (u32x2*)(XBp + (size_t)(m0 + q) * D) + lane;
#pragma unroll
            for (int j = 0; j < 4; ++j) { u32x2 o; o.x = pk2(v[q][j].x, v[q][j].y); o.y = pk2(v[q][j].z, v[q][j].w); o8[64 * j] = o; }
            if (lane == 0) rs0[m0 + q] = rsqrtf(s * (1.f / D) + EPS); }
    } }
    for (size_t i = gt; i < (size_t)48 * 1024; i += NGT) { const int c = (int)(i >> 10), k = (int)(i & 1023);
        float w = 0.f; if (c < 4) w = F.in[12][k * 4 + c] * F.in[11][k]; else if (c < 36) w = F.in[14][k * 32 + c - 4] * F.in[11][k];
        const bf16 hi = f2bf(w); const bf16 lo = f2bf(w - bf2f(hi));
        ((bf16*)(ws + WS_WR))[i] = hi; ((bf16*)(ws + WS_WR))[(size_t)48 * 1024 + i] = lo; }
    for (size_t i = gt; i < (size_t)SEQ * 16; i += NGT) { const int s = (int)(i >> 4), f = (int)(i & 15);
        const float inv = (float)pow(10000.0, -(double)f / 16.0); const float ang = (float)s * inv;
        float2 cs; cs.x = (float)cos((double)ang); cs.y = (float)sin((double)ang); ((float2*)(ws + WS_ROPE))[i] = cs; }
    for (size_t i = gt; i < (size_t)24 * 2048; i += NGT) { const int ph = (int)(i >> 11), e = (int)(i & 2047), p = ph >> 3, h = ph & 7;
        float val = 0.f;
        if (e < 1600) { const int m = e / 200, x = e - m * 200, y = x + m, t = 191 - y;
            val = -30000.f;
            if (y <= 191 && t >= 32 && t <= 160) { const int dil = (p == 0) ? 1 : (p == 1) ? 4 : 16; const int rel = (t - 96) * dil; const int n = rel < 0 ? -rel : rel;
                int large = 8 + (int)(log((double)(n > 1 ? n : 1) / 8.0) / log(128.0) * 8.0); if (large > 15) large = 15;
                const int bucket = (rel > 0 ? 16 : 0) + (n < 8 ? n : large);
                val = F.in[3][bucket * 8 + h] * LOG2E; } }
        ((bf16*)(ws + WS_BIMG))[i] = f2bf(val); }
    for (size_t i = gt; i < (size_t)3 * 8 * 132; i += NGT) { const int p = (int)(i / (8 * 132)), h = (int)((i / 132) % 8), jj = (int)(i % 132);
        float val = 0.f;
        if (jj <= 128) { const int dil = (p == 0) ? 1 : (p == 1) ? 4 : 16; const int rel = (jj - 64) * dil; const int n = rel < 0 ? -rel : rel;
            int large = 8 + (int)(log((double)(n > 1 ? n : 1) / 8.0) / log(128.0) * 8.0); if (large > 15) large = 15;
            const int bucket = (rel > 0 ? 16 : 0) + (n < 8 ? n : large);
            val = F.in[3][bucket * 8 + h] * LOG2E; }
        ((float*)(ws + WS_BT))[i] = val; }
}

__device__ __forceinline__ void p_attnA_naive(const Frame& F, bf16* OA, float* LSE) {
    unsigned char* ws = F.ws;
    const bf16* QA = (const bf16*)(ws + WS_QA); const bf16* KA = (const bf16*)(ws + WS_KA); const bf16* VA = (const bf16*)(ws + WS_VA);
    const float* BT = (const float*)(ws + WS_BT);
    for (int idx = F.vcu * 512 + F.tid; idx < T * 8; idx += F.G * 512) {
        const int s = idx & (SEQ - 1), h = (idx >> 11) & 7, b = idx >> 14;
        float q[64], o[64];
        const size_t t = (size_t)b * SEQ + s;
#pragma unroll
        for (int i = 0; i < 64; ++i) { q[i] = bf2f(QA[t * 512 + h * 64 + i]); o[i] = 0.f; }
        float m = -1e30f, l = 0.f;
        for (int p = 0; p < 3; ++p) { const int dil = (p == 0) ? 1 : (p == 1) ? 4 : 16;
            for (int j = -64; j <= 64; ++j) { const int pos = s + j * dil; if (pos < 0 || pos >= SEQ) continue;
                const bf16* kp = KA + ((size_t)b * SEQ + pos) * 512 + h * 64; const bf16* vp = VA + ((size_t)b * SEQ + pos) * 512 + h * 64;
                float sc = BT[(p * 8 + h) * 132 + j + 64];
#pragma unroll
                for (int i = 0; i < 64; ++i) sc += q[i] * bf2f(kp[i]);
                const float mn = fmaxf(m, sc), al = exp2f(m - mn), pe = exp2f(sc - mn);
                l = l * al + pe; m = mn;
#pragma unroll
                for (int i = 0; i < 64; ++i) o[i] = o[i] * al + pe * bf2f(vp[i]);
            } }
        const float il = 1.f / l;
#pragma unroll
        for (int i = 0; i < 64; ++i) OA[t * 512 + h * 64 + i] = f2bf(o[i] * il);
        LSE[t * 8 + h] = m + log2f(l);
    }
}
__device__ __forceinline__ void p_attnB_naive(const Frame& F) {
    unsigned char* ws = F.ws;
    const bf16* QB = (const bf16*)(ws + WS_QB); const bf16* KB = (const bf16*)(ws + WS_KB); const bf16* VB = (const bf16*)(ws + WS_VB); const bf16* KR = (const bf16*)(ws + WS_KR);
    for (int idx = F.vcu * 512 + F.tid; idx < T * 8; idx += F.G * 512) {
        const int s = idx & (SEQ - 1), h = (idx >> 11) & 7, b = idx >> 14;
        float q[96], o[64];
        const size_t t = (size_t)b * SEQ + s;
#pragma unroll
        for (int i = 0; i < 96; ++i) q[i] = bf2f(QB[t * 768 + h * 96 + i]);
#pragma unroll
        for (int i = 0; i < 64; ++i) o[i] = 0.f;
        float m = -1e30f, l = 0.f;
        for (int key = 0; key < SEQ; ++key) { const size_t tk = (size_t)b * SEQ + key;
            const bf16* kp = KB + tk * 512 + h * 64; const bf16* rp = KR + tk * 32; const bf16* vp = VB + tk * 512 + h * 64;
            float sc = 0.f;
#pragma unroll
            for (int i = 0; i < 64; ++i) sc += q[i] * bf2f(kp[i]);
#pragma unroll
            for (int i = 0; i < 32; ++i) sc += q[64 + i] * bf2f(rp[i]);
            const float mn = fmaxf(m, sc), al = exp2f(m - mn), pe = exp2f(sc - mn);
            l = l * al + pe; m = mn;
#pragma unroll
            for (int i = 0; i < 64; ++i) o[i] = o[i] * al + pe * bf2f(vp[i]);
        }
        const float il = 1.f / l;
#pragma unroll
        for (int i = 0; i < 64; ++i) ((bf16*)(ws + WS_OB))[t * 512 + h * 64 + i] = f2bf(o[i] * il);
    }
}

typedef float f32x16 __attribute__((ext_vector_type(16)));
typedef short s16x4 __attribute__((ext_vector_type(4)));
typedef short v4i16_t __attribute__((ext_vector_type(4)));
__device__ __forceinline__ s16x4 vtr(const LAS unsigned char* p) { return __builtin_bit_cast(s16x4, __builtin_amdgcn_ds_read_tr16_b64_v4i16((LAS v4i16_t*)p)); }
__device__ __forceinline__ int crow(int r, int hi) { return (r & 3) + 8 * (r >> 2) + 4 * hi; }
__device__ __forceinline__ float max3f(float a, float b, float c) { float r; asm("v_max3_f32 %0, %1, %2, %3" : "=v"(r) : "v"(a), "v"(b), "v"(c)); return r; }
__device__ __forceinline__ float max2f(float a, float b) { float r; asm("v_max_f32_e32 %0, %1, %2" : "=v"(r) : "v"(a), "v"(b)); return r; }
__device__ __forceinline__ float rowmax32(const f32x16& p0, const f32x16& p1) {
    float a = max3f(p0[0], p0[1], p1[0]), b = max3f(p0[2], p0[3], p1[1]); a = max3f(a, p1[2], p1[3]);
#pragma unroll
    for (int r = 4; r < 16; r += 4) { a = max3f(a, p0[r], p0[r + 1]); b = max3f(b, p0[r + 2], p0[r + 3]); a = max3f(a, p1[r], p1[r + 1]); b = max3f(b, p1[r + 2], p1[r + 3]); }
    const float m = max2f(a, b);
    auto rr = __builtin_amdgcn_permlane32_swap(__float_as_uint(m), __float_as_uint(m), false, false);
    return max2f(__uint_as_float(rr[0]), __uint_as_float(rr[1]));
}
#define ATT_WAIT_BAR() asm volatile("s_waitcnt vmcnt(0) lgkmcnt(0)\n\ts_barrier" ::: "memory")
#define GLDS16(src, dst) __builtin_amdgcn_global_load_lds((const unsigned*)(src), (LAS unsigned*)(dst), 16, 0, 0)
__device__ __forceinline__ void glds16_asm(const void* gsrc, LAS unsigned char* dst) { unsigned keep; const unsigned d = (unsigned)__builtin_amdgcn_readfirstlane((int)(unsigned)(size_t)dst);
    asm volatile("s_mov_b32 %0, m0\n\ts_mov_b32 m0, %2\n\ts_nop 0\n\tglobal_load_lds_dwordx4 %1, off\n\ts_mov_b32 m0, %0" : "=&s"(keep) : "v"(gsrc), "s"(d) : "memory"); }

template <int NS>
__device__ __forceinline__ void sm_update(f32x16 (&p)[NS], float& m, float& l, f32x16& o0, f32x16& o1, bf16x8 (&pf)[2 * NS]) {
    float mx = p[0][0];
#pragma unroll
    for (int s = 0; s < NS; ++s)
#pragma unroll
        for (int r = 0; r < 16; ++r) mx = fmaxf(mx, p[s][r]);
    { auto rr = __builtin_amdgcn_permlane32_swap(__float_as_uint(mx), __float_as_uint(mx), false, false); mx = fmaxf(__uint_as_float(rr[0]), __uint_as_float(rr[1])); }
    const float mn = fmaxf(m, mx); const float al = __builtin_amdgcn_exp2f(m - mn); m = mn;
    float sum = 0.f;
#pragma unroll
    for (int s = 0; s < NS; ++s)
#pragma unroll
        for (int r = 0; r < 16; ++r) { p[s][r] = __builtin_amdgcn_exp2f(p[s][r] - mn); sum += p[s][r]; }
    l = l * al + sum;
#pragma unroll
    for (int r = 0; r < 16; ++r) { o0[r] *= al; o1[r] *= al; }
#pragma unroll
    for (int s = 0; s < NS; ++s)
#pragma unroll
        for (int k = 0; k < 2; ++k) { u32x4 w; w.x = cvtpk(p[s][8 * k + 0], p[s][8 * k + 1]); w.y = cvtpk(p[s][8 * k + 2], p[s][8 * k + 3]); w.z = cvtpk(p[s][8 * k + 4], p[s][8 * k + 5]); w.w = cvtpk(p[s][8 * k + 6], p[s][8 * k + 7]);
            pf[2 * s + k] = __builtin_bit_cast(bf16x8, w); }
}
__device__ __forceinline__ void pv_step(f32x16& o0, f32x16& o1, const LAS unsigned char* vp, int dstride, bf16x8 pfk) {
    const s16x4 a0 = vtr(vp), a1 = vtr(vp + 512), b0 = vtr(vp + dstride), b1 = vtr(vp + dstride + 512);
    const bf16x8 v0 = (bf16x8){a0[0], a0[1], a0[2], a0[3], a1[0], a1[1], a1[2], a1[3]};
    const bf16x8 v1 = (bf16x8){b0[0], b0[1], b0[2], b0[3], b1[0], b1[1], b1[2], b1[3]};
    o0 = __builtin_amdgcn_mfma_f32_32x32x16_bf16(v0, pfk, o0, 0, 0, 0);
    o1 = __builtin_amdgcn_mfma_f32_32x32x16_bf16(v1, pfk, o1, 0, 0, 0);
}
__device__ __forceinline__ void store_o(bf16* orow, const f32x16& o0, const f32x16& o1, float il, int hi) {
#pragma unroll
    for (int g = 0; g < 4; ++g) {
        u32x2 w0, w1; w0.x = cvtpk(o0[4 * g] * il, o0[4 * g + 1] * il); w0.y = cvtpk(o0[4 * g + 2] * il, o0[4 * g + 3] * il);
        w1.x = cvtpk(o1[4 * g] * il, o1[4 * g + 1] * il); w1.y = cvtpk(o1[4 * g + 2] * il, o1[4 * g + 3] * il);
        *(u32x2*)(orow + 8 * g + 4 * hi) = w0; *(u32x2*)(orow + 32 + 8 * g + 4 * hi) = w1; }
}


template <class RowPtr>
__device__ __forceinline__ void store_o_staged(LAS unsigned char* stg, const f32x16& o0, const f32x16& o1, float il, int lane, const RowPtr& rowptr) {
    const int r32 = lane & 31, hi = lane >> 5;
#pragma unroll
    for (int d0 = 0; d0 < 2; ++d0) {
        const f32x16& o = d0 ? o1 : o0;
#pragma unroll
        for (int g = 0; g < 4; ++g) { u32x2 w; w.x = cvtpk(o[4 * g] * il, o[4 * g + 1] * il); w.y = cvtpk(o[4 * g + 2] * il, o[4 * g + 3] * il);
            *(LAS u32x2*)(stg + r32 * 64 + ((g ^ ((r32 >> 1) & 3)) * 16) + hi * 8) = w; }
        LDS_WAIT();
#pragma unroll
        for (int j = 0; j < 2; ++j) { const int row = 16 * j + (lane >> 2), c = lane & 3;
            const u32x4 v = *(const LAS u32x4*)(stg + row * 64 + ((c ^ ((row >> 1) & 3)) * 16));
            *(u32x4*)(rowptr(row) + d0 * 32 + c * 8) = v; }
        LDS_WAIT();
    }
}

constexpr int B_KBUF = 12288, B_VBUF = 8192, B_VOFF = 3 * B_KBUF;
constexpr float B_THR = 40.f;
#define SBAR() __builtin_amdgcn_sched_barrier(0)
template <int ABL>
__device__ __forceinline__ void attnB_unit(const Frame& F, int b, int head, int qb) {
    unsigned char* ws = F.ws; LAS unsigned char* lds = F.lds;
    const int lane = F.lane, wave = F.wave, r32 = lane & 31, hi = lane >> 5;
    const bf16* QB = (const bf16*)(ws + WS_QB); const bf16* KB = (const bf16*)(ws + WS_KB); const bf16* VB = (const bf16*)(ws + WS_VB); const bf16* KR = (const bf16*)(ws + WS_KR);
    const size_t t0 = (size_t)b * SEQ;
    const size_t tq = t0 + qb * 256 + wave * 32 + r32;
    const int kr8 = 8 * wave + (lane >> 3), kr16 = 16 * (wave & 3) + (lane >> 2);
    const bf16* ksrc = KB + (t0 + kr8) * 512 + head * 64 + (((lane & 7) ^ ((kr8 >> 1) & 7)) * 8);
    const bf16* rsrc = KR + (t0 + kr16) * 32 + (((lane & 3) ^ ((kr16 >> 2) & 3)) * 8);
    const bf16* vsrc = VB + (t0 + kr8) * 512 + head * 64 + (((lane & 7) ^ (((kr8 >> 1) & 1) << 2)) * 8);
#define B_ISSUE_K(kt, boff) do { if (ABL & 2) break; glds16_asm(ksrc + (size_t)(kt) * 64 * 512, lds + (boff) + wave * 1024); \
        glds16_asm(rsrc + (size_t)(kt) * 64 * 32, lds + (boff) + 8192 + (wave & 3) * 1024); } while (0)
#define B_ISSUE_V(kt, boff) do { if (!(ABL & 2)) glds16_asm(vsrc + (size_t)(kt) * 64 * 512, lds + B_VOFF + (boff) + wave * 1024); } while (0)
    B_ISSUE_K(0, 0); B_ISSUE_V(0, 0); B_ISSUE_K(1, B_KBUF); B_ISSUE_V(1, B_VBUF); B_ISSUE_K(2, 2 * B_KBUF);
    bf16x8 qf[6];
#pragma unroll
    for (int ks = 0; ks < 6; ++ks) qf[ks] = *(const bf16x8*)(QB + tq * 768 + head * 96 + ks * 16 + hi * 8);
    float mref; f32x16 o0, o1, o2, negm;
#pragma unroll
    for (int r = 0; r < 16; ++r) { o0[r] = 0.f; o1[r] = 0.f; o2[r] = 0.f; }
    const bf16x8 onesf = (bf16x8){(short)0x3F80, (short)0x3F80, (short)0x3F80, (short)0x3F80, (short)0x3F80, (short)0x3F80, (short)0x3F80, (short)0x3F80};
    int kad[6];
#pragma unroll
    for (int ks = 0; ks < 4; ++ks) kad[ks] = r32 * 128 + (((2 * ks + hi) ^ ((r32 >> 1) & 7)) * 16);
#pragma unroll
    for (int j = 0; j < 2; ++j) kad[4 + j] = 8192 + r32 * 64 + (((2 * j + hi) ^ ((r32 >> 2) & 3)) * 16);
    const int vq = (lane & 15) >> 2;
    const int vbo0 = (4 * hi + vq) * 128 + (((((lane >> 4) & 1) * 2 + ((lane & 3) >> 1)) ^ (((vq >> 1) & 1) << 2)) * 16) + (lane & 1) * 8;
    constexpr int NT = SEQ / 64;
    f32x16 pA0, pA1, pB0, pB1;
    ATT_WAIT_BAR();
    {
        const LAS unsigned char* kb = lds;
#pragma unroll
        for (int r = 0; r < 16; ++r) { pA0[r] = 0.f; pA1[r] = 0.f; }
#pragma unroll
        for (int ks = 0; ks < 6; ++ks) {
            const bf16x8 k0 = *(const LAS bf16x8*)(kb + kad[ks]), k1 = *(const LAS bf16x8*)(kb + kad[ks] + (ks < 4 ? 4096 : 2048));
            pA0 = __builtin_amdgcn_mfma_f32_32x32x16_bf16(k0, qf[ks], pA0, 0, 0, 0);
            pA1 = __builtin_amdgcn_mfma_f32_32x32x16_bf16(k1, qf[ks], pA1, 0, 0, 0);
        }
        asm volatile("s_nop 15" : "+v"(pA0), "+v"(pA1));
        const float mx = rowmax32(pA0, pA1);
        mref = mx;
#pragma unroll
        for (int r = 0; r < 16; ++r) { negm[r] = -mref; pA0[r] = __builtin_amdgcn_exp2f(pA0[r] - mref); pA1[r] = __builtin_amdgcn_exp2f(pA1[r] - mref); }
    }
    ATT_WAIT_BAR();
    bool resc = false; float fres = 1.f;
#define B_PIN(x) asm volatile("" : "+v"(x))
#define B_GAPA(MF, A0, A1, A2, WI, WA, WB, WC, WD, KRD) do { MF; pw_[WI] = cvtpk(WA, WB); pw_[WI + 1] = cvtpk(WC, WD); B_PIN(pw_[WI]); B_PIN(pw_[WI + 1]); KRD; SBAR(); } while (0)
#define B_GAPA0(MF, A0, A1, A2) do { MF; SBAR(); } while (0)
#define B_KRD(i_) kf_[i_] = *(const LAS bf16x8*)(kb_ + kad[(i_) >> 1] + (((i_) & 1) ? (((i_) >> 1) < 4 ? 4096 : 2048) : 0))
#define B_EX4(X, B) do { X[B] = __builtin_amdgcn_exp2f(X[B]); X[B + 1] = __builtin_amdgcn_exp2f(X[B + 1]); X[B + 2] = __builtin_amdgcn_exp2f(X[B + 2]); X[B + 3] = __builtin_amdgcn_exp2f(X[B + 3]); B_PIN(X); } while (0)
#define B_EX4C(X, B) do { if (!(ABL & 1)) B_EX4(X, B); } while (0)
#define B_EXV(P0, P1, v) do { if ((v) < 16) P0[(v) & 15] = __builtin_amdgcn_exp2f(P0[(v) & 15]); else if ((v) < 32) P1[(v) & 15] = __builtin_amdgcn_exp2f(P1[(v) & 15]); } while (0)
#define B_EX3C(P0, P1, v) do { if (!(ABL & 1)) { B_EXV(P0, P1, v); B_EXV(P0, P1, (v) + 1); B_EXV(P0, P1, (v) + 2); B_PIN(P0); B_PIN(P1); } } while (0)
#define B_MFQ(D, A, Bq, C) D = (ABL & 8) ? (C) : __builtin_amdgcn_mfma_f32_32x32x16_bf16(A, Bq, C, 0, 0, 0)
#define B_MFQ0(D, A, Bq, C) do { if (ABL & 8) D = (C); else asm volatile("v_mfma_f32_32x32x16_bf16 %0, %1, %2, %3" : "=&v"(D) : "v"(A), "v"(Bq), "v"(C)); } while (0)
#define B_MFP(D, A, Bq) do { if (!(ABL & 16)) D = __builtin_amdgcn_mfma_f32_32x32x16_bf16(A, Bq, D, 0, 0, 0); else { asm volatile("" :: "v"(A), "v"(Bq)); } } while (0)
#define B_STEP(PA0, PA1, PB0, PB1, t, HASN) do { \
      \
    const int krd_ = (i3 == 2 ? 0 : i3 + 1) * B_KBUF, kwr_ = i3 * B_KBUF, vrd_ = i3 * B_VBUF, vwr_ = (i3 == 0 ? 2 : i3 - 1) * B_VBUF; \
    if ((t) + 3 < NT) B_ISSUE_K((t) + 3, kwr_); \
    if ((t) + 2 < NT) B_ISSUE_V((t) + 2, vwr_); \
    unsigned pw_[16]; \
    if (HASN) { \
        const LAS unsigned char* kb_ = lds + krd_; bf16x8 kf_[12]; \
        B_KRD(0); B_KRD(1); B_KRD(2); B_KRD(3); \
        SBAR(); \
        B_GAPA(B_MFQ0(PB0, kf_[0], qf[0], negm), PA0[0], PA0[1], PA0[2],    0, PA0[0], PA0[1], PA0[2], PA0[3],     B_KRD(4)); \
        B_GAPA(B_MFQ0(PB1, kf_[1], qf[0], negm), PA0[3], PA0[4], PA0[5],    2, PA0[4], PA0[5], PA0[6], PA0[7],     B_KRD(5)); \
        B_GAPA(B_MFQ(PB0, kf_[2], qf[1], PB0),  PA0[6], PA0[7], PA0[8],    4, PA0[8], PA0[9], PA0[10], PA0[11],   B_KRD(6)); \
        B_GAPA(B_MFQ(PB1, kf_[3], qf[1], PB1),  PA0[9], PA0[10], PA0[11],  6, PA0[12], PA0[13], PA0[14], PA0[15], B_KRD(7)); \
        B_GAPA(B_MFQ(PB0, kf_[4], qf[2], PB0),  PA0[12], PA0[13], PA0[14], 8, PA1[0], PA1[1], PA1[2], PA1[3],     B_KRD(8)); \
        B_GAPA(B_MFQ(PB1, kf_[5], qf[2], PB1),  PA0[15], PA1[0], PA1[1],   10, PA1[4], PA1[5], PA1[6], PA1[7],    B_KRD(9)); \
        B_GAPA(B_MFQ(PB0, kf_[6], qf[3], PB0),  PA1[2], PA1[3], PA1[4],    12, PA1[8], PA1[9], PA1[10], PA1[11],  B_KRD(10)); \
        B_GAPA(B_MFQ(PB1, kf_[7], qf[3], PB1),  PA1[5], PA1[6], PA1[7],    14, PA1[12], PA1[13], PA1[14], PA1[15], B_KRD(11)); \
        B_GAPA0(B_MFQ(PB0, kf_[8], qf[4], PB0),  PA1[8], PA1[9], PA1[10]); \
        B_GAPA0(B_MFQ(PB1, kf_[9], qf[4], PB1),  PA1[11], PA1[12], PA1[13]); \
        B_GAPA0(B_MFQ(PB0, kf_[10], qf[5], PB0), PA1[14], PA1[15], 0.f); \
        B_MFQ(PB1, kf_[11], qf[5], PB1); SBAR(); \
    } else { \
        _Pragma("unroll") for (int i_ = 0; i_ < 8; ++i_) { pw_[i_] = cvtpk(PA0[2 * i_], PA0[2 * i_ + 1]); pw_[8 + i_] = cvtpk(PA1[2 * i_], PA1[2 * i_ + 1]); } \
    } \
    resc = false; \
    if (HASN) { \
        asm volatile("s_nop 15" : "+v"(PB0), "+v"(PB1)); \
        const float mx_ = rowmax32(PB0, PB1); \
        if (__builtin_expect(__any(mx_ > B_THR), 0)) { const float dl_ = fmaxf(mx_, 0.f); mref += dl_; \
            _Pragma("unroll") for (int r = 0; r < 16; ++r) { PB0[r] -= dl_; PB1[r] -= dl_; negm[r] = -mref; } \
            fres = __builtin_amdgcn_exp2f(-dl_); resc = true; } \
    } \
    SBAR(); \
    { const LAS unsigned char* vb_ = lds + B_VOFF + vrd_ + vbo0; const LAS unsigned char* vc_ = lds + B_VOFF + vrd_ + (vbo0 ^ 64); \
      const bf16x8 pf0_ = __builtin_bit_cast(bf16x8, ((u32x4){pw_[0], pw_[1], pw_[2], pw_[3]})), pf1_ = __builtin_bit_cast(bf16x8, ((u32x4){pw_[4], pw_[5], pw_[6], pw_[7]})), pf2_ = __builtin_bit_cast(bf16x8, ((u32x4){pw_[8], pw_[9], pw_[10], pw_[11]})), pf3_ = __builtin_bit_cast(bf16x8, ((u32x4){pw_[12], pw_[13], pw_[14], pw_[15]})); \
      s16x4 a0_ = vtr(vb_), a1_ = vtr(vb_ + 1024), b0_ = vtr(vc_), b1_ = vtr(vc_ + 1024), c0_, c1_, d0_, d1_; \
        \
      c0_ = vtr(vb_ + 2048); c1_ = vtr(vb_ + 2048 + 1024); d0_ = vtr(vc_ + 2048); d1_ = vtr(vc_ + 2048 + 1024); \
      B_MFP(o0, ((bf16x8){a0_[0], a0_[1], a0_[2], a0_[3], a1_[0], a1_[1], a1_[2], a1_[3]}), pf0_); if (HASN) B_EX3C(PB0, PB1, 0); SBAR(); \
      B_MFP(o1, ((bf16x8){b0_[0], b0_[1], b0_[2], b0_[3], b1_[0], b1_[1], b1_[2], b1_[3]}), pf0_); if (HASN) B_EX3C(PB0, PB1, 3); SBAR(); \
      B_MFP(o2, onesf, pf0_); if (HASN) B_EX3C(PB0, PB1, 6); SBAR(); \
        \
      a0_ = vtr(vb_ + 4096); a1_ = vtr(vb_ + 4096 + 1024); b0_ = vtr(vc_ + 4096); b1_ = vtr(vc_ + 4096 + 1024); \
      B_MFP(o0, ((bf16x8){c0_[0], c0_[1], c0_[2], c0_[3], c1_[0], c1_[1], c1_[2], c1_[3]}), pf1_); if (HASN) B_EX3C(PB0, PB1, 9); SBAR(); \
      B_MFP(o1, ((bf16x8){d0_[0], d0_[1], d0_[2], d0_[3], d1_[0], d1_[1], d1_[2], d1_[3]}), pf1_); if (HASN) B_EX3C(PB0, PB1, 12); SBAR(); \
      B_MFP(o2, onesf, pf1_); if (HASN) B_EX3C(PB0, PB1, 15); SBAR(); \
        \
      c0_ = vtr(vb_ + 6144); c1_ = vtr(vb_ + 6144 + 1024); d0_ = vtr(vc_ + 6144); d1_ = vtr(vc_ + 6144 + 1024); \
      B_MFP(o0, ((bf16x8){a0_[0], a0_[1], a0_[2], a0_[3], a1_[0], a1_[1], a1_[2], a1_[3]}), pf2_); if (HASN) B_EX3C(PB0, PB1, 18); SBAR(); \
      B_MFP(o1, ((bf16x8){b0_[0], b0_[1], b0_[2], b0_[3], b1_[0], b1_[1], b1_[2], b1_[3]}), pf2_); if (HASN) B_EX3C(PB0, PB1, 21); SBAR(); \
      B_MFP(o2, onesf, pf2_); if (HASN) B_EX3C(PB0, PB1, 24); SBAR(); \
        \
      B_MFP(o0, ((bf16x8){c0_[0], c0_[1], c0_[2], c0_[3], c1_[0], c1_[1], c1_[2], c1_[3]}), pf3_); if (HASN) B_EX3C(PB0, PB1, 27); SBAR(); \
      B_MFP(o1, ((bf16x8){d0_[0], d0_[1], d0_[2], d0_[3], d1_[0], d1_[1], d1_[2], d1_[3]}), pf3_); if (HASN) B_EX3C(PB0, PB1, 30); SBAR(); \
      B_MFP(o2, onesf, pf3_); SBAR(); \
    } \
    if (resc) { o2[0] *= fres; _Pragma("unroll") for (int r = 0; r < 16; ++r) { o0[r] *= fres; o1[r] *= fres; } } \
    i3 = (i3 == 2) ? 0 : i3 + 1; \
    } while (0)
#define B_WAIT3() do { if (ABL & 4) asm volatile("s_waitcnt vmcnt(3) lgkmcnt(0)" ::: "memory"); else asm volatile("s_waitcnt vmcnt(3) lgkmcnt(0)\n\ts_barrier" ::: "memory"); } while (0)
#define B_WAIT1() asm volatile("s_waitcnt vmcnt(1) lgkmcnt(0)\n\ts_barrier" ::: "memory")
    int i3 = 0;
    for (int t = 0; t + 4 < NT; t += 2) {
        B_STEP(pA0, pA1, pB0, pB1, t, true);     B_WAIT3();
        B_STEP(pB0, pB1, pA0, pA1, t + 1, true); B_WAIT3();
    }
    B_STEP(pA0, pA1, pB0, pB1, NT - 4, true);  B_WAIT3();
    B_STEP(pB0, pB1, pA0, pA1, NT - 3, true);  B_WAIT1();
    B_STEP(pA0, pA1, pB0, pB1, NT - 2, true);  ATT_WAIT_BAR();
    B_STEP(pB0, pB1, pA0, pA1, NT - 1, false);
#undef B_WAIT3
#undef B_WAIT1
#undef B_STEP
#undef B_MFQ
#undef B_MFQ0
#undef B_MFP
#undef B_EX4C
#undef B_EX3C
#undef B_EXV
#undef B_GAPA
#undef B_GAPA0
#undef B_KRD
#undef B_PIN
#undef B_EX4
#undef B_ISSUE_K
#undef B_ISSUE_V
    const float l = o2[0];
    { bf16* obase = (bf16*)(ws + WS_OB) + (t0 + qb * 256 + wave * 32) * 512 + head * 64;
      store_o_staged(lds + B_VOFF + 3 * B_VBUF + wave * 2048, o0, o1, 1.f / l, lane, [=](int row) { return obase + (size_t)row * 512; }); }
    ATT_WAIT_BAR();
}
__device__ __forceinline__ void p_attnB(const Frame& F, bool abl) {
    if (F.G == 256) {
        const int x = F.vcu >> 5, j = F.vcu & 31;
        for (int r = 0; r < 4; ++r) { const int bh = 16 * x + 4 * r + (j >> 3); { if (PROBE_ABL != 0 && abl) attnB_unit<PROBE_ABL>(F, bh >> 3, bh & 7, j & 7); else attnB_unit<0>(F, bh >> 3, bh & 7, j & 7); } }
    } else {
        for (int u = F.vcu; u < BATCH * 8 * 8; u += F.G) { const int bh = u >> 3; attnB_unit<0>(F, bh >> 3, bh & 7, u & 7); }
    }
}

constexpr int A_NSL = 384, A_KOFF = 0, A_VOFF = A_NSL * 128, A_TAB = 2 * A_NSL * 128, A_TABB = 4096, A_OST = A_TAB + 2 * A_TABB;
constexpr float A_NEG = -30000.f;
struct AGeo { int b, head, pat, g, dil, L, nslots; };
__device__ __forceinline__ AGeo a_geo(int vcu, int k) { AGeo q;
    const int x = vcu >> 5, j = vcu & 31, bh = 16 * x + 4 * (k / 3) + (j >> 3); q.b = bh >> 3; q.head = bh & 7; q.pat = k % 3; q.g = j & 7;
    q.dil = (q.pat == 0) ? 1 : (q.pat == 1) ? 4 : 16; q.L = SEQ / q.dil; q.nslots = (q.pat == 2) ? 256 : 384; return q; }
__device__ __forceinline__ int a_pos(const AGeo& q, int s) {
    if (q.pat == 2) return 2 * q.g + (s >> 7) + 16 * (s & 127);
    if (q.pat == 1) { int kn = 256 * (q.g & 1) - 64 + s; kn = kn < 0 ? 0 : (kn > 511 ? 511 : kn); return (q.g >> 1) + 4 * kn; }
    int kn = 256 * q.g - 64 + s; return kn < 0 ? 0 : (kn > 2047 ? 2047 : kn); }
__device__ __forceinline__ void glds16_s(const void* sbase, unsigned voff, LAS unsigned char* dst) { unsigned keep; const unsigned d = (unsigned)__builtin_amdgcn_readfirstlane((int)(unsigned)(size_t)dst);
    asm volatile("s_mov_b32 %0, m0\n\ts_mov_b32 m0, %3\n\ts_nop 0\n\tglobal_load_lds_dwordx4 %1, %2\n\ts_mov_b32 m0, %0" : "=&s"(keep) : "v"(voff), "s"(sbase), "s"(d) : "memory"); }
__device__ __forceinline__ void a_issue(const Frame& F, const AGeo& q, bool isv) {
    const unsigned char* src = F.ws + (isv ? WS_VA : WS_KA) + ((size_t)q.b * SEQ * 512 + q.head * 64) * 2;
    const int s0 = 8 * F.wave + (F.lane >> 3);
    const unsigned coff = (unsigned)((F.lane & 7) ^ (isv ? (((s0 >> 1) & 1) << 2) : ((s0 >> 1) & 7))) * 16u;
    LAS unsigned char* dst = F.lds + (isv ? A_VOFF : A_KOFF) + F.wave * 1024;
    if (q.pat == 2) {
        const unsigned o0 = (unsigned)(2 * q.g + 16 * s0) * 1024u + coff;
        glds16_s(src, o0, dst); glds16_s(src, o0 + 1024u * 1024u, dst + 8192); glds16_s(src, o0 + 1024u, dst + 16384); glds16_s(src, o0 + 1025u * 1024u, dst + 24576);
    } else {
        const int hi = q.pat == 1 ? 511 : 2047, sh = q.pat == 1 ? 12 : 10;
        const unsigned cb = (q.pat == 1 ? (unsigned)(q.g >> 1) * 1024u : 0u) + coff;
        const int w0 = (q.pat == 1 ? 256 * (q.g & 1) : 256 * q.g) - 64 + s0;
#pragma unroll
        for (int i = 0; i < 6; ++i) { int kn = w0 + 64 * i; kn = kn < 0 ? 0 : (kn > hi ? hi : kn); glds16_s(src, cb + ((unsigned)kn << sh), dst + i * 8192); }
    }
}
__device__ __forceinline__ void a_wave_geo(const AGeo& q, int wave, int& c, int& n0, int& hb, int& wstart) {
    if (q.pat == 2) { c = 2 * q.g + (wave >> 2); n0 = 32 * (wave & 3); hb = 128 * (wave >> 2); wstart = 0; }
    else if (q.pat == 1) { c = q.g >> 1; n0 = 256 * (q.g & 1) + 32 * wave; hb = 0; wstart = 256 * (q.g & 1) - 64; }
    else { c = 0; n0 = 256 * q.g + 32 * wave; hb = 0; wstart = 256 * q.g - 64; } }
__device__ __forceinline__ void a_load_q(const Frame& F, const AGeo& q, bf16x8 (&qf)[4]) {
    int c, n0, hb, wstart; a_wave_geo(q, F.wave, c, n0, hb, wstart);
    const size_t tq = (size_t)q.b * SEQ + c + q.dil * (n0 + (F.lane & 31));
    const bf16* QA = (const bf16*)(F.ws + WS_QA);
#pragma unroll
    for (int ks = 0; ks < 4; ++ks) qf[ks] = *(const bf16x8*)(QA + tq * 512 + q.head * 64 + ks * 16 + (F.lane >> 5) * 8);
}
__device__ __forceinline__ void a_write_tab(const Frame& F, const AGeo& q, int tsel) {
    if (F.wave < 4) glds16_asm((const bf16*)(F.ws + WS_BIMG) + (size_t)(q.pat * 8 + q.head) * 2048 + F.wave * 512 + F.lane * 8, F.lds + A_TAB + tsel * A_TABB + F.wave * 1024);
}
__device__ __forceinline__ f32x16 mfma_dc(bf16x8 a, bf16x8 b, const f32x16& c) { f32x16 d; asm volatile("v_mfma_f32_32x32x16_bf16 %0, %1, %2, %3" : "=&v"(d) : "v"(a), "v"(b), "v"(c)); return d; }
template <int ABL>
__device__ __forceinline__ void p_attnA(const Frame& F, bf16* OA, float* LSE) {
    if (F.vcu >= 256) return;
    LAS unsigned char* lds = F.lds;
    const int lane = F.lane, wave = F.wave, r32 = lane & 31, hi = lane >> 5;
    int kad[4];
#pragma unroll
    for (int ks = 0; ks < 4; ++ks) kad[ks] = r32 * 128 + (((2 * ks + hi) ^ ((r32 >> 1) & 7)) * 16);
    const int vq = (lane & 15) >> 2;
    const int vbo0 = (4 * hi + vq) * 128 + (((((lane >> 4) & 1) * 2 + ((lane & 3) >> 1)) ^ (((vq >> 1) & 1) << 2)) * 16) + (lane & 1) * 8;
    const int bm = (7 - r32) & 7;
    const int bbo = bm * 400 + (159 - 128 - r32 + 8 * hi - bm) * 2;
    bf16x8 idn[2];
#pragma unroll
    for (int s2 = 0; s2 < 2; ++s2)
#pragma unroll
        for (int j = 0; j < 8; ++j) idn[s2][j] = (16 * s2 + 8 * hi + j == r32) ? (short)0x3F80 : (short)0;
    constexpr int NU = 12;
    AGeo q = a_geo(F.vcu, 0);
    if (!(ABL & 2)) { a_issue(F, q, false); a_issue(F, q, true); } a_write_tab(F, q, 0);
    bf16x8 qf[4]; a_load_q(F, q, qf);
    ATT_WAIT_BAR();
#pragma unroll 1
    for (int k = 0; k < NU; ++k) {
        int c, n0, hb, wstart; a_wave_geo(q, wave, c, n0, hb, wstart);
        const LAS unsigned char* tbb = lds + A_TAB + (k & 1) * A_TABB + bbo;
        f32x16 p[5]; bool val[5]; float mref; f32x16 negm;
        {   const LAS unsigned char* kb = lds + A_KOFF + (hb + n0 - wstart) * 128;
#pragma unroll
            for (int r = 0; r < 16; ++r) p[2][r] = 0.f;
#pragma unroll
            for (int ks = 0; ks < 4; ++ks) { const bf16x8 kf = *(const LAS bf16x8*)(kb + kad[ks]); if (!(ABL & 8)) p[2] = __builtin_amdgcn_mfma_f32_32x32x16_bf16(kf, qf[ks], p[2], 0, 0, 0); else asm volatile("" :: "v"(kf)); }
#pragma unroll
            for (int s2 = 0; s2 < 2; ++s2) { const bf16x8 bfr = *(const LAS bf16x8*)(tbb + (16 * s2 + 32 * 2) * 2); if (!(ABL & 8)) p[2] = __builtin_amdgcn_mfma_f32_32x32x16_bf16(bfr, idn[s2], p[2], 0, 0, 0); else asm volatile("" :: "v"(bfr)); }
            asm volatile("s_nop 15" : "+v"(p[2]));
            float a = max3f(p[2][0], p[2][1], p[2][2]), b2 = max3f(p[2][3], p[2][4], p[2][5]);
            a = max3f(a, p[2][6], p[2][7]); b2 = max3f(b2, p[2][8], p[2][9]); a = max3f(a, p[2][10], p[2][11]); b2 = max3f(b2, p[2][12], p[2][13]); a = max3f(a, p[2][14], p[2][15]);
            float mx = max2f(a, b2);
            { auto rr = __builtin_amdgcn_permlane32_swap(__float_as_uint(mx), __float_as_uint(mx), false, false); mx = max2f(__uint_as_float(rr[0]), __uint_as_float(rr[1])); }
            mref = mx;
#pragma unroll
            for (int r = 0; r < 16; ++r) { negm[r] = -mref; p[2][r] -= mref; }
            val[2] = true;
        }
#pragma unroll
        for (int i = 0; i < 5; ++i) {
            if (i == 2) continue;
            const int kt0 = n0 - 64 + 32 * i; val[i] = (kt0 >= 0 && kt0 < q.L);
            if (val[i]) {
                const LAS unsigned char* kb = lds + A_KOFF + (hb + kt0 - wstart) * 128;
                { const bf16x8 kf = *(const LAS bf16x8*)(kb + kad[0]); if (!(ABL & 8)) p[i] = mfma_dc(kf, qf[0], negm); else { p[i] = negm; asm volatile("" :: "v"(kf)); } }
#pragma unroll
                for (int ks = 1; ks < 4; ++ks) { const bf16x8 kf = *(const LAS bf16x8*)(kb + kad[ks]); if (!(ABL & 8)) p[i] = __builtin_amdgcn_mfma_f32_32x32x16_bf16(kf, qf[ks], p[i], 0, 0, 0); else asm volatile("" :: "v"(kf)); }
#pragma unroll
                for (int s2 = 0; s2 < 2; ++s2) { const bf16x8 bfr = *(const LAS bf16x8*)(tbb + (16 * s2 + 32 * (4 - i)) * 2); if (!(ABL & 8)) p[i] = __builtin_amdgcn_mfma_f32_32x32x16_bf16(bfr, idn[s2], p[i], 0, 0, 0); else asm volatile("" :: "v"(bfr)); }
            }
        }
        if (ABL & 4) asm volatile("s_waitcnt vmcnt(0) lgkmcnt(0)" ::: "memory"); else ATT_WAIT_BAR();
        AGeo qn = q; bf16x8 qfn[4];
        if (k + 1 < NU) { qn = a_geo(F.vcu, k + 1); if (!(ABL & 64)) a_write_tab(F, qn, (k + 1) & 1); a_load_q(F, qn, qfn); if (!(ABL & 2)) a_issue(F, qn, false); }
        float l = 0.f; f32x16 o0, o1;
#pragma unroll
        for (int r = 0; r < 16; ++r) { o0[r] = 0.f; o1[r] = 0.f; }
#pragma unroll
        for (int i = 0; i < 5; ++i) {
            if (val[i]) {
#pragma unroll
                for (int r = 0; r < 16; ++r) { if (!(ABL & 1)) p[i][r] = __builtin_amdgcn_exp2f(p[i][r]); l += p[i][r]; }
                const int kt0 = n0 - 64 + 32 * i;
                const LAS unsigned char* vb = lds + A_VOFF + (hb + kt0 - wstart) * 128;
#pragma unroll
                for (int s2 = 0; s2 < 2; ++s2) {
                    u32x4 w; w.x = cvtpk(p[i][8 * s2 + 0], p[i][8 * s2 + 1]); w.y = cvtpk(p[i][8 * s2 + 2], p[i][8 * s2 + 3]); w.z = cvtpk(p[i][8 * s2 + 4], p[i][8 * s2 + 5]); w.w = cvtpk(p[i][8 * s2 + 6], p[i][8 * s2 + 7]);
                    const bf16x8 pf = __builtin_bit_cast(bf16x8, w);
                    const LAS unsigned char* v0p = vb + s2 * 2048 + vbo0; const LAS unsigned char* v1p = vb + s2 * 2048 + (vbo0 ^ 64);
                    if (!(ABL & 16)) {
                    const s16x4 a0 = vtr(v0p), a1 = vtr(v0p + 1024), b0 = vtr(v1p), b1 = vtr(v1p + 1024);
                    o0 = __builtin_amdgcn_mfma_f32_32x32x16_bf16(((bf16x8){a0[0], a0[1], a0[2], a0[3], a1[0], a1[1], a1[2], a1[3]}), pf, o0, 0, 0, 0);
                    o1 = __builtin_amdgcn_mfma_f32_32x32x16_bf16(((bf16x8){b0[0], b0[1], b0[2], b0[3], b1[0], b1[1], b1[2], b1[3]}), pf, o1, 0, 0, 0);
                    } else asm volatile("" :: "v"(pf));
                }
            }
        }
        { auto rr = __builtin_amdgcn_permlane32_swap(__float_as_uint(l), __float_as_uint(l), false, false); l = __uint_as_float(rr[0]) + __uint_as_float(rr[1]); }
        const size_t tq0 = (size_t)q.pat * T + (size_t)q.b * SEQ + c + q.dil * n0;
        if (!(ABL & 32)) { bf16* obase = OA + tq0 * 512 + q.head * 64; const int rstride = q.dil * 512;
          store_o_staged(lds + A_OST + wave * 2048, o0, o1, 1.f / l, lane, [=](int row) { return obase + (size_t)row * rstride; }); }
        if (!(ABL & 32)) { if (hi == 0) LSE[(tq0 + q.dil * r32) * 8 + q.head] = mref + __builtin_amdgcn_logf(l); } else asm volatile("" :: "v"(l), "v"(o0), "v"(o1));
        if (ABL & 4) asm volatile("s_waitcnt vmcnt(5) lgkmcnt(0)" ::: "memory"); else asm volatile("s_waitcnt vmcnt(5) lgkmcnt(0)\n\ts_barrier" ::: "memory");
        if (k + 1 < NU) { if (!(ABL & 2)) a_issue(F, qn, true);
#pragma unroll
            for (int ks = 0; ks < 4; ++ks) qf[ks] = qfn[ks];
            q = qn; }
    }
}
constexpr int MQ = 4;
template <int NP>
__device__ __forceinline__ void p_mixnorm(const Frame& F, const bf16* __restrict__ OA, const float* __restrict__ LSE, int row0, int nrows, int wid, int nw) {
    unsigned char* ws = F.ws; const int lane = F.lane;
    const bf16* __restrict__ OBp = (const bf16*)(ws + WS_OB); bf16* __restrict__ MIX = (bf16*)(ws + WS_MIX);
    float ga[8], gb[8];
#pragma unroll
    for (int i = 0; i < 8; ++i) { ga[i] = F.in[8][lane * 8 + i]; gb[i] = F.in[9][lane * 8 + i]; }
    const int head = lane >> 3;
    for (int m0 = row0 + wid * MQ; m0 < row0 + nrows; m0 += nw * MQ) {
        u32x4 pa[MQ][NP], pb[MQ]; float w[MQ][NP];
#pragma unroll
        for (int q = 0; q < MQ; ++q) { const int m = m0 + q;
#pragma unroll
            for (int p = 0; p < NP; ++p) { pa[q][p] = *(const u32x4*)(OA + ((size_t)p * T + m) * 512 + lane * 8); w[q][p] = LSE[((size_t)p * T + m) * 8 + head]; }
            pb[q] = *(const u32x4*)(OBp + (size_t)m * 512 + lane * 8); }
#pragma unroll
        for (int q = 0; q < MQ; ++q) { const int m = m0 + q; float a[8], mx = -1e30f;
#pragma unroll
            for (int p = 0; p < NP; ++p) mx = fmaxf(mx, w[q][p]);
            float wsum = 0.f;
#pragma unroll
            for (int p = 0; p < NP; ++p) { w[q][p] = exp2f(w[q][p] - mx); wsum += w[q][p]; }
            const float iw = 1.f / wsum;
#pragma unroll
            for (int i = 0; i < 8; ++i) a[i] = 0.f;
#pragma unroll
            for (int p = 0; p < NP; ++p) { float t8[8]; unpack8(pa[q][p], t8); const float ww = w[q][p] * iw;
#pragma unroll
                for (int i = 0; i < 8; ++i) a[i] += ww * t8[i]; }
            float bv[8]; unpack8(pb[q], bv);
            float sa = 0.f, sb = 0.f;
#pragma unroll
            for (int i = 0; i < 8; ++i) { sa += a[i] * a[i]; sb += bv[i] * bv[i]; }
            sa = wave_sum(sa); sb = wave_sum(sb);
            const float ra = rsqrtf(sa * (1.f / 512.f) + EPS), rb = rsqrtf(sb * (1.f / 512.f) + EPS);
            u32x4 oa, ob;
            oa.x = pk2(a[0] * ra * ga[0], a[1] * ra * ga[1]); oa.y = pk2(a[2] * ra * ga[2], a[3] * ra * ga[3]); oa.z = pk2(a[4] * ra * ga[4], a[5] * ra * ga[5]); oa.w = pk2(a[6] * ra * ga[6], a[7] * ra * ga[7]);
            ob.x = pk2(bv[0] * rb * gb[0], bv[1] * rb * gb[1]); ob.y = pk2(bv[2] * rb * gb[2], bv[3] * rb * gb[3]); ob.z = pk2(bv[4] * rb * gb[4], bv[5] * rb * gb[5]); ob.w = pk2(bv[6] * rb * gb[6], bv[7] * rb * gb[7]);
            bf16* mix = MIX + (size_t)m * 1024;
            *(u32x4*)(mix + lane * 8) = oa; *(u32x4*)(mix + 512 + lane * 8) = ob; }
    }
}
constexpr int R_BUF = 96 * 512, R_LG = 2 * R_BUF, R_CNT = R_LG + 8 * 16 * 52 * 4;
__device__ __forceinline__ void p_router(const Frame& F) {
    unsigned char* ws = F.ws; const int lane = F.lane, wave = F.wave; LAS unsigned char* lds = F.lds;
    LAS float* lg = (LAS float*)(lds + R_LG + wave * (16 * 52 * 4));
    LAS int* cnt_l = (LAS int*)(lds + R_CNT); LAS int* base_l = cnt_l + 32;
    const bf16* X1 = (const bf16*)(ws + WS_X1); const bf16* WR = (const bf16*)(ws + WS_WR);
    const float* brg = F.in[13]; const float* bre = F.in[15];
    int* counts = (int*)(ws + WS_CTL) + CW_COUNTS; const float* ssq1 = (const float*)(ws + CTL_SSQ1);
    if (F.tid < 32) cnt_l[F.tid] = 0;
#define R_ISSUE(kc, buf) do { _Pragma("unroll") for (int i_ = 0; i_ < 6; ++i_) { const int p_ = wave + 8 * i_, row_ = 2 * p_ + (lane >> 5); \
        glds16_asm(WR + (size_t)row_ * 1024 + (kc) * 256 + (((lane & 31) ^ (row_ & 15)) * 8), lds + (buf) * R_BUF + p_ * 1024); } } while (0)
    const int col = lane & 15, kq = lane >> 4;
    for (int unit = F.vcu; unit < T / 128; unit += F.G) {
        const int tok0 = unit * 128 + wave * 16;
        f32x4 acc[3];
#pragma unroll
        for (int ct = 0; ct < 3; ++ct) acc[ct] = (f32x4){0.f, 0.f, 0.f, 0.f};
        const bf16* arow = X1 + (size_t)(tok0 + col) * 1024 + kq * 8;
        ATT_WAIT_BAR();
        R_ISSUE(0, 0);
#pragma unroll 1
        for (int kc = 0; kc < 4; ++kc) {
            bf16x8 af[8];
#pragma unroll
            for (int kk = 0; kk < 8; ++kk) af[kk] = *(const bf16x8*)(arow + kc * 256 + kk * 32);
            if (kc + 1 < 4) { R_ISSUE(kc + 1, (kc + 1) & 1); asm volatile("s_waitcnt vmcnt(6) lgkmcnt(0)\n\ts_barrier" ::: "memory"); }
            else ATT_WAIT_BAR();
            const LAS unsigned char* wb = lds + (kc & 1) * R_BUF;
#pragma unroll
            for (int kk = 0; kk < 8; ++kk) {
#pragma unroll
                for (int ct = 0; ct < 3; ++ct) {
                    const int rh = ct * 16 + col, rl = 48 + ct * 16 + col, c16 = kk * 4 + kq;
                    const bf16x8 bh = *(const LAS bf16x8*)(wb + rh * 512 + ((c16 ^ (rh & 15)) * 16)), bl = *(const LAS bf16x8*)(wb + rl * 512 + ((c16 ^ (rl & 15)) * 16));
                    acc[ct] = __builtin_amdgcn_mfma_f32_16x16x32_bf16(af[kk], bh, acc[ct], 0, 0, 0);
                    acc[ct] = __builtin_amdgcn_mfma_f32_16x16x32_bf16(af[kk], bl, acc[ct], 0, 0, 0);
                }
            }
            if (kc + 1 < 4) asm volatile("s_waitcnt lgkmcnt(0)\n\ts_barrier" ::: "memory");
            if (kc + 2 < 4) {   }
        }
#pragma unroll
        for (int ct = 0; ct < 3; ++ct)
#pragma unroll
            for (int j = 0; j < 4; ++j) lg[(4 * (lane >> 4) + j) * 52 + ct * 16 + (lane & 15)] = acc[ct][j];
        LDS_WAIT();
        int e1 = 0, e2 = 0, q1 = 0, q2 = 0; float g1 = 0.f, g2 = 0.f; const int m = tok0 + lane;
        if (lane < 16) {
            const float rs = rsqrtf(ssq1[m] * (1.f / D) + EPS);
            const LAS float* L = lg + lane * 52;
            int gi = 0; float gm = L[0] * rs + brg[0];
            float gl1 = L[1] * rs + brg[1], gl2 = L[2] * rs + brg[2], gl3 = L[3] * rs + brg[3]; const float gl0 = gm;
            if (gl1 > gm) { gm = gl1; gi = 1; } if (gl2 > gm) { gm = gl2; gi = 2; } if (gl3 > gm) { gm = gl3; gi = 3; }
            const float gs = __expf(gl0 - gm) + __expf(gl1 - gm) + __expf(gl2 - gm) + __expf(gl3 - gm);
            const float ggate = 1.f / gs;
            const LAS float* EL = L + 4 + gi * 8; const float* eb = bre + gi * 8;
            int i1 = 0; float m1 = EL[0] * rs + eb[0];
            for (int i = 1; i < 8; ++i) { const float v = EL[i] * rs + eb[i]; if (v > m1) { m1 = v; i1 = i; } }
            int i2 = -1; float m2 = -3.0e38f;
            for (int i = 0; i < 8; ++i) { const float v = EL[i] * rs + eb[i]; if (i != i1 && v > m2) { m2 = v; i2 = i; } }
            const float p2 = __expf(m2 - m1); g1 = ggate / (1.f + p2); g2 = ggate * p2 / (1.f + p2);
            e1 = gi * 8 + i1; e2 = gi * 8 + i2;
            q1 = __hip_atomic_fetch_add(cnt_l + e1, 1, __ATOMIC_RELAXED, __HIP_MEMORY_SCOPE_WORKGROUP);
            q2 = __hip_atomic_fetch_add(cnt_l + e2, 1, __ATOMIC_RELAXED, __HIP_MEMORY_SCOPE_WORKGROUP);
        }
        __syncthreads();
        if (F.tid < 32) { const int c = cnt_l[F.tid]; base_l[F.tid] = c ? atomicAdd(&counts[F.tid], c) : 0; }
        __syncthreads();
        if (lane < 16) {
            const int p1 = base_l[e1] + q1, pp2 = base_l[e2] + q2;
            ((int*)(ws + WS_TOK))[e1 * CAP + p1] = m; ((int*)(ws + WS_TOK))[e2 * CAP + pp2] = m;
            ((float*)(ws + WS_GATE))[e1 * CAP + p1] = g1; ((float*)(ws + WS_GATE))[e2 * CAP + pp2] = g2;
            ((int*)(ws + WS_AE))[m * 2] = e1; ((int*)(ws + WS_AE))[m * 2 + 1] = e2; ((int*)(ws + WS_APOS))[m * 2] = p1; ((int*)(ws + WS_APOS))[m * 2 + 1] = pp2;
        }
        __syncthreads();
        if (F.tid < 32) cnt_l[F.tid] = 0;
        __syncthreads();
    }
#undef R_ISSUE
}
__device__ __forceinline__ void moe_tables(const Frame& F) {
    LAS int* pst = (LAS int*)(F.lds + MOE_OFF); LAS int* cnt = pst + 40;
    const int* counts = (const int*)(F.ws + WS_CTL) + CW_COUNTS;
    __syncthreads();
    if (F.tid < NE) cnt[F.tid] = counts[F.tid];
    __syncthreads();
    if (F.tid == 0) { int acc = 0; for (int e = 0; e < NE; ++e) { pst[e] = acc; acc += (cnt[e] + 255) >> 8; } pst[NE] = acc; }
    __syncthreads();
}
constexpr int FQ = 2;
__device__ __forceinline__ void p_final(const Frame& F) {
    unsigned char* ws = F.ws; const int lane = F.lane; const float* __restrict__ gfin = F.in[19];
    const LAS int* pst = (const LAS int*)(F.lds + MOE_OFF);
    const int* __restrict__ AE = (const int*)(ws + WS_AE); const int* __restrict__ AP = (const int*)(ws + WS_APOS);
    const bf16* __restrict__ X1 = (const bf16*)(ws + WS_X1); const bf16* __restrict__ YB = (const bf16*)(ws + WS_YB);
    float* __restrict__ out = F.out;
    f32x4 g4[4];
#pragma unroll
    for (int j = 0; j < 2; ++j) { g4[2 * j] = *((const f32x4*)gfin + 2 * lane + 128 * j); g4[2 * j + 1] = *((const f32x4*)gfin + 2 * lane + 128 * j + 1); }
    const int step = F.G * NWAVES * FQ;
    int m0 = (F.vcu * NWAVES + F.wave) * FQ;
    if (m0 >= T) return;
    u32x2 ie[FQ], ip[FQ];
    u32x4 xa[FQ][2], ya[FQ][2], yb[FQ][2], xn[FQ][2], yan[FQ][2], ybn[FQ][2];
#define FIN_IDX(mm) do { _Pragma("unroll") for (int q = 0; q < FQ; ++q) { ie[q] = *(const u32x2*)(AE + ((mm) + q) * 2); ip[q] = *(const u32x2*)(AP + ((mm) + q) * 2); } } while (0)
#define FIN_ROWS(mm, XA, YA, YB_) do { _Pragma("unroll") for (int q = 0; q < FQ; ++q) { const int m = (mm) + q; \
        const int r1 = (int)ip[q].x + pst[ie[q].x] * 256, r2 = (int)ip[q].y + pst[ie[q].y] * 256; \
        _Pragma("unroll") for (int j = 0; j < 2; ++j) { XA[q][j] = *((const u32x4*)(X1 + (size_t)m * 1024) + lane + 64 * j); YA[q][j] = *((const u32x4*)(YB + (size_t)r1 * 1024) + lane + 64 * j); YB_[q][j] = *((const u32x4*)(YB + (size_t)r2 * 1024) + lane + 64 * j); } } } while (0)
    FIN_IDX(m0); FIN_ROWS(m0, xa, ya, yb);
    if (m0 + step < T) FIN_IDX(m0 + step);
    for (; m0 < T; m0 += step) {
        const bool more = (m0 + step < T);
        if (more) { FIN_ROWS(m0 + step, xn, yan, ybn); if (m0 + 2 * step < T) FIN_IDX(m0 + 2 * step); }
#pragma unroll
        for (int q = 0; q < FQ; ++q) { const int m = m0 + q; float v[2][8]; float s = 0.f;
#pragma unroll
            for (int j = 0; j < 2; ++j) { float a[8], b[8], c[8]; unpack8(xa[q][j], a); unpack8(ya[q][j], b); unpack8(yb[q][j], c);
#pragma unroll
                for (int i = 0; i < 8; ++i) { v[j][i] = a[i] + b[i] + c[i]; s += v[j][i] * v[j][i]; } }
            s = wave_sum(s); const float rs = rsqrtf(s * (1.f / D) + EPS);
#pragma unroll
            for (int j = 0; j < 2; ++j) { f32x4 o0, o1;
                o0.x = v[j][0] * rs * g4[2 * j].x; o0.y = v[j][1] * rs * g4[2 * j].y; o0.z = v[j][2] * rs * g4[2 * j].z; o0.w = v[j][3] * rs * g4[2 * j].w;
                o1.x = v[j][4] * rs * g4[2 * j + 1].x; o1.y = v[j][5] * rs * g4[2 * j + 1].y; o1.z = v[j][6] * rs * g4[2 * j + 1].z; o1.w = v[j][7] * rs * g4[2 * j + 1].w;
                f32x4* op = (f32x4*)(out + (size_t)m * D) + 2 * lane + 128 * j; op[0] = o0; op[1] = o1; } }
        if (more) {
#pragma unroll
            for (int q = 0; q < FQ; ++q)
#pragma unroll
                for (int j = 0; j < 2; ++j) { xa[q][j] = xn[q][j]; ya[q][j] = yan[q][j]; yb[q][j] = ybn[q][j]; } }
    }
#undef FIN_IDX
#undef FIN_ROWS
}

__global__ void __launch_bounds__(NWAVES * 64, 2) mk_fwd(Args args) {
    extern __shared__ __attribute__((aligned(16))) unsigned char lds_raw[];
    Frame F;
    F.lds = (LAS unsigned char*)lds_raw;
    F.tid = threadIdx.x; F.lane = F.tid & 63; F.wave = __builtin_amdgcn_readfirstlane(F.tid >> 6);
    F.G = gridDim.x; { const int bx = blockIdx.x; F.vcu = (F.G % 8 == 0) ? (bx % 8) * (F.G / 8) + bx / 8 : bx; }
    F.in = args.in; F.out = args.out; F.ws = args.ws; F.pflags = args.flags;
    unsigned char* ws = args.ws;
    for (int u = F.tid; u < (LDS_BYTES - LDSCTL_OFF) / 4; u += NWAVES * 64) ((LAS unsigned*)(F.lds + LDSCTL_OFF))[u] = 0u;
    __syncthreads();
#if MK_SPLIT
#define GRID_BAR() do { } while (0)
#else
    volatile LAS unsigned* MISC = (volatile LAS unsigned*)(F.lds + MISC_OFF);
    XcdBarrier bar = xcd_barrier_post((unsigned*)(ws + WS_CTL) + CW_BAR, MISC + 8);
#define GRID_BAR() xcd_barrier(bar)
#endif
#ifndef SLACK_PCT
#define SLACK_PCT 0
#endif
#define STAGGER_SLACK(n_units, t_unit_ticks, myid) do { const int nu_ = (n_units), rounds_ = (nu_ + F.G - 1) / F.G; const int mine_ = (nu_ - (myid) + F.G - 1) / F.G; \
        if (SLACK_PCT > 0 && mine_ < rounds_) { const unsigned long long t0_ = __builtin_amdgcn_s_memrealtime(); \
            const unsigned long long d_ = (unsigned long long)(t_unit_ticks) * SLACK_PCT / 100 * (unsigned)((F.vcu * 37) & 63) / 64; \
            while (__builtin_amdgcn_s_memrealtime() - t0_ < d_) __builtin_amdgcn_s_sleep(8); } } while (0)
    const int lo = args.ph_lo, hi = args.ph_hi;
#ifndef PH_MASK
#define PH_MASK 0x3ff
#endif
#define IN(k) (((PH_MASK >> (k)) & 1) && lo <= (k) && (k) < hi)
#define BOTH(k) (IN(k) && IN((k) + 1))
    bf16* OA = (bf16*)args.out; float* LSE = (float*)(ws + WS_LSE);
    const LAS int* pst = (const LAS int*)(F.lds + MOE_OFF); const LAS int* cnt = pst + 40;

#ifndef ATTN_A_NAIVE
#define ATTN_A_NAIVE 0
#endif
    static_assert(ATTN_A_NAIVE == 0, "the naive mixer-A body writes one partial; the fused merge expects three");
#ifndef ATTN_B_NAIVE
#define ATTN_B_NAIVE 0
#endif
    if (IN(0)) { p_prologue(F); if (BOTH(0)) GRID_BAR(); }
    if (IN(1)) {
        PlainSched S; S.so.init(T, NINP, F.G, (int)blockIdx.x); S.A = (const bf16*)(ws + WS_XB); S.Bt = (const bf16*)(ws + WS_WI); S.lda = 1024; S.ldb = 1024; S.acol_pn = 1 << 30; S.acol_off = 0;
        EpiInProj E{ws};
        pg8::gemm_phase<EpiInProj, PlainSched, true>(F.lds, 1024, 1024, S, E);
        if (BOTH(1)) GRID_BAR();
    }
    if (IN(2)) {
        PlainSched S; S.so.init(T, 768 + 1024, F.G, (int)blockIdx.x); S.A = (const bf16*)(ws + WS_LAT); S.Bt = (const bf16*)(ws + WS_WQKV); S.lda = 512; S.ldb = 256; S.acol_pn = 3; S.acol_off = 256;
        EpiUps E{ws};
        STAGGER_SLACK(896, 1500, (int)blockIdx.x);
        pg8::gemm_phase<EpiUps, PlainSched, true>(F.lds, 256, 256, S, E);
        if (!(args.flags & 2)) { if (ATTN_A_NAIVE) p_attnA_naive(F, OA, LSE); else if (PROBE_ABL != 0 && (args.flags & 8)) p_attnA<PROBE_ABL>(F, OA, LSE); else p_attnA<0>(F, OA, LSE); }
        { const int r_ = S.so.nwg % F.G, c_ = (int)blockIdx.x;
          if (r_ == 0) p_convert_experts(F, 0, c_ * NWAVES + F.wave, F.G * NWAVES); else if (c_ >= r_) p_convert_experts(F, 0, (c_ - r_) * NWAVES + F.wave, (F.G - r_) * NWAVES); }
        if (BOTH(2)) GRID_BAR();
    }
    if (IN(3)) {
        if (!(args.flags & 1)) { if (ATTN_B_NAIVE) p_attnB_naive(F); else p_attnB(F, (args.flags & 4) != 0); }
        if (BOTH(3)) GRID_BAR(); }
    if (IN(4)) { p_mixnorm<3>(F, OA, LSE, 0, T, F.vcu * NWAVES + F.wave, F.G * NWAVES); if (BOTH(4)) GRID_BAR(); }
    if (IN(5)) {
        EpiOut E{ws, (args.flags >> 9) & 7};
        PlainSched S; S.so.init(T, 1024, F.G, (int)blockIdx.x); S.A = (const bf16*)(ws + WS_MIX); S.Bt = (const bf16*)(ws + WS_WO); S.lda = 1024; S.ldb = 1024; S.acol_pn = 1 << 30; S.acol_off = 0;
        pg8::gemm_phase<EpiOut, PlainSched, true>(F.lds, 1024, 1024, S, E, (args.flags & 4096) != 0, (args.flags & 8192) != 0);
        if (BOTH(5)) GRID_BAR();
    }
    if (IN(6)) { p_router(F); if (BOTH(6)) GRID_BAR(); }
    if (IN(7)) {
        moe_tables(F);
        MoeSched S; S.G = F.G; S.c = F.vcu;      S.NT = 2; S.npanels = pst[NE]; S.pst = pst; S.cnt = cnt; S.toks = (const int*)(ws + WS_TOK);
        S.A = (const bf16*)(ws + WS_X1); S.Bt = (const bf16*)(ws + WS_WGU); S.lda = 1024; S.ldb = 1024; S.bstride = (size_t)512 * 1024; S.gather = true; S.mode = 0;
        EpiGateUp E{ws, cnt};
        STAGGER_SLACK(pst[NE] * 2, 2700, F.vcu);
        pg8::gemm_phase<EpiGateUp, MoeSched, true>(F.lds, 1024, 1024, S, E);
        S.mode = 1; pg8::gemm_phase<EpiGateUp, MoeSched, true, true>(F.lds, 1024, 1024, S, E);
        { const int r_ = S.tail_wgs(), c_ = F.vcu;
          if (r_ == 0) p_convert_experts(F, 1, c_ * NWAVES + F.wave, F.G * NWAVES); else if (c_ >= r_) p_convert_experts(F, 1, (c_ - r_) * NWAVES + F.wave, (F.G - r_) * NWAVES); }
        if (BOTH(7)) GRID_BAR();
    }
    if (IN(8)) {
        moe_tables(F);
        MoeSched S; S.G = F.G; S.c = F.vcu;      S.NT = 4; S.npanels = pst[NE]; S.pst = pst; S.cnt = cnt; S.toks = (const int*)(ws + WS_TOK);
        S.A = (const bf16*)(ws + WS_HB); S.Bt = (const bf16*)(ws + WS_WD); S.lda = 256; S.ldb = 256; S.bstride = (size_t)1024 * 256; S.gather = false; S.mode = 0;
        EpiDown E{ws, cnt, (args.flags >> 4) & 3};
        STAGGER_SLACK(pst[NE] * 4, 1400, F.vcu);
        pg8::gemm_phase<EpiDown, MoeSched, true>(F.lds, 256, 256, S, E, (args.flags & 32) != 0, (args.flags & 64) != 0);
        S.mode = 1; pg8::gemm_phase<EpiDown, MoeSched, true, true>(F.lds, 256, 256, S, E);
        if (BOTH(8)) GRID_BAR();
    }
    if (IN(9)) { moe_tables(F); p_final(F); }
#undef IN
#undef BOTH
}
}

extern "C" void kernel_launch(void* const* d_in, const int* in_sizes, int n_in, void* d_out, int out_size, void* d_ws, size_t ws_size, hipStream_t stream) {
    static int grid = 0;
    if (grid == 0) {
        if (n_in != 20 || ws_size < WS_END || out_size != T * D) { fprintf(stderr, "kernel_launch: unexpected shapes (n_in %d, ws %zu, out %d)\n", n_in, ws_size, out_size); grid = -1; return; }
        int dev = 0, cus = 0, per_cu = 0;
        if (hipGetDevice(&dev) != hipSuccess || hipDeviceGetAttribute(&cus, hipDeviceAttributeMultiprocessorCount, dev) != hipSuccess) { grid = -1; return; }
        if (hipFuncSetAttribute((const void*)mk_fwd, hipFuncAttributeMaxDynamicSharedMemorySize, LDS_BYTES) != hipSuccess) { fprintf(stderr, "kernel_launch: hipFuncSetAttribute failed\n"); grid = -1; return; }
        if (hipOccupancyMaxActiveBlocksPerMultiprocessor(&per_cu, (const void*)mk_fwd, NWAVES * 64, LDS_BYTES) != hipSuccess || per_cu < 1) { fprintf(stderr, "kernel_launch: occupancy query says %d\n", per_cu); }
        (void)hipGetLastError();
        if (cus < 256) { fprintf(stderr, "kernel_launch: this kernel's unit maps are written for a 256-workgroup grid, one workgroup per CU; the device has %d CUs; nothing launched\n", cus); grid = -1; return; }
        grid = 256;
    }
    if (grid < 0) return;
    (void)hipMemsetAsync((char*)d_ws + WS_CTL, 0, CTL_BYTES, stream);
    Args a{};
    for (int i = 0; i < 20; ++i) a.in[i] = (const float*)d_in[i];
    a.out = (float*)d_out; a.ws = (unsigned char*)d_ws;
#if MK_SPLIT
    for (int p = 0; p < NPHASE; ++p) { a.ph_lo = p; a.ph_hi = p + 1; hipLaunchKernelGGL(mk_fwd, dim3(grid), dim3(NWAVES * 64), LDS_BYTES, stream, a); }
#else
#ifndef PROBE_PREFIX
#define PROBE_PREFIX -1
#endif
#ifndef PROBE_FLAGS
#define PROBE_FLAGS 0
#endif
    if (PROBE_PREFIX >= 0) {
        a.ph_lo = 0; a.ph_hi = PROBE_PREFIX + 1; a.flags = PROBE_FLAGS;
        hipLaunchKernelGGL(mk_fwd, dim3(grid), dim3(NWAVES * 64), LDS_BYTES, stream, a);
        (void)hipMemsetAsync((char*)d_ws + WS_CTL, 0, CTL_BYTES, stream);
    }
    a.ph_lo = 0; a.ph_hi = NPHASE; a.flags = 0;
    hipLaunchKernelGGL(mk_fwd, dim3(grid), dim3(NWAVES * 64), LDS_BYTES, stream, a);
#endif
}
```

```cpp
#include <hip/hip_runtime.h>
#include <stdint.h>
#include <stdio.h>

#ifndef PROBE_ABL
#define PROBE_ABL 0
#endif
#ifndef MK_SPLIT
#define MK_SPLIT 0
#endif

#define LAS __attribute__((address_space(3)))
#define GAS __attribute__((address_space(1)))

namespace {
typedef unsigned short bf16;
typedef short bf16x8 __attribute__((ext_vector_type(8)));
typedef float f32x4 __attribute__((ext_vector_type(4)));
typedef unsigned u32x4 __attribute__((ext_vector_type(4)));
typedef unsigned u32x2 __attribute__((ext_vector_type(2)));

constexpr int D = 1024, BATCH = 16, SEQ = 2048, T = BATCH * SEQ;
constexpr int NIN = 1952, NINP = 2048;
constexpr int NE = 32, CAP = 32768;
constexpr float EPS = 1e-6f;
constexpr float LOG2E = 1.4426950408889634f;
constexpr float QS_A = 0.125f * LOG2E;
constexpr float QS_B = 0.10206207261596577f * LOG2E;
constexpr int NWAVES = 8;
constexpr int NPHASE = 10;

constexpr size_t MiB = 1u << 20;
constexpr size_t WS_CTL = 0;
constexpr size_t CTL_BYTES = 1 * MiB;
constexpr int CW_COUNTS = 64;
constexpr int CW_BAR = 4096;
constexpr size_t CTL_SSQQ = 128 * 1024, CTL_SSQKV = 256 * 1024, CTL_SSQ1 = 384 * 1024;
constexpr size_t WS_RS0 = 2 * MiB;
constexpr size_t WS_ROPE = WS_RS0 + 512 * 1024;
constexpr size_t WS_BT = WS_ROPE + 256 * 1024;
constexpr size_t WS_BIMG = WS_BT + 16 * 1024;
constexpr size_t WS_AE = 3 * MiB;
constexpr size_t WS_APOS = WS_AE + 256 * 1024;
constexpr size_t WS_LSE = 4 * MiB;
constexpr size_t WS_WR = 7 * MiB;
constexpr size_t WS_WI = 8 * MiB;
constexpr size_t WS_WQKV = 12 * MiB;
constexpr size_t WS_WO = 13 * MiB;
constexpr size_t WS_WGU = 16 * MiB;
constexpr size_t WS_WD = 48 * MiB;
constexpr size_t WS_XB = 64 * MiB;
constexpr size_t WS_QA = 128 * MiB, WS_KA = 160 * MiB, WS_VA = 192 * MiB;
constexpr size_t WS_LAT = 224 * MiB;
constexpr size_t WS_QB = 256 * MiB;
constexpr size_t WS_KB = 304 * MiB, WS_VB = 336 * MiB, WS_OB = 368 * MiB;
constexpr size_t WS_MIX = 400 * MiB;
constexpr size_t WS_KR = 464 * MiB;
constexpr size_t WS_TOK = 466 * MiB;
constexpr size_t WS_GATE = 470 * MiB;
constexpr size_t WS_END = 474 * MiB;
constexpr size_t WS_X1 = 128 * MiB;
constexpr size_t WS_HB = 192 * MiB;
constexpr size_t WS_YB = 256 * MiB;

constexpr int RING_BYTES = 131072;
constexpr int LDSCTL_OFF = RING_BYTES;
constexpr int MISC_OFF = LDSCTL_OFF + 320;
constexpr int MOE_OFF = LDSCTL_OFF + 1024;
constexpr int LDS_BYTES = 147456;

__device__ __forceinline__ float bf2f(bf16 b) { return __uint_as_float(((unsigned)b) << 16); }
__device__ __forceinline__ bf16 f2bf(float f) { unsigned u = __float_as_uint(f); u += 0x7fffu + ((u >> 16) & 1u); return (bf16)(u >> 16); }
typedef float f32x2_t __attribute__((ext_vector_type(2))); typedef __bf16 bf16x2_t __attribute__((ext_vector_type(2)));
__device__ __forceinline__ unsigned cvtpk(float lo, float hi) { f32x2_t v = {lo, hi}; bf16x2_t b = __builtin_convertvector(v, bf16x2_t); return __builtin_bit_cast(unsigned, b); }
__device__ __forceinline__ unsigned pk2(float lo, float hi) { return cvtpk(lo, hi); }
__device__ __forceinline__ float wave_sum(float v) {
#pragma unroll
    for (int o = 1; o < 64; o <<= 1) v += __shfl_xor(v, o);
    return v;
}
__device__ __forceinline__ void unpack8(u32x4 v, float (&a)[8]) {
    a[0] = __uint_as_float(v.x << 16); a[1] = __uint_as_float(v.x & 0xffff0000u); a[2] = __uint_as_float(v.y << 16); a[3] = __uint_as_float(v.y & 0xffff0000u);
    a[4] = __uint_as_float(v.z << 16); a[5] = __uint_as_float(v.z & 0xffff0000u); a[6] = __uint_as_float(v.w << 16); a[7] = __uint_as_float(v.w & 0xffff0000u); }
#define LDS_WAIT() asm volatile("s_waitcnt lgkmcnt(0)" ::: "memory")

#define XB_TMO      128
#define XB_XCNT(j)  (256  + 64 * (j))
#define XB_XSUB(j)  (1280 + 64 * (j))
#define XB_XGEN(j)  (2304 + 64 * (j))
#define XB_TOP      3328
#define XB_TOPGEN   3392
#define XCD_BAR_WORDS 3456
#define XB_SPIN_CAP (1u << 18)
__device__ __forceinline__ unsigned xb_ld(unsigned* p)              { return __hip_atomic_load(p, __ATOMIC_RELAXED, __HIP_MEMORY_SCOPE_AGENT); }
__device__ __forceinline__ unsigned xb_add(unsigned* p, unsigned v) { return __hip_atomic_fetch_add(p, v, __ATOMIC_RELAXED, __HIP_MEMORY_SCOPE_AGENT); }
__device__ __forceinline__ unsigned xb_xcc_id() { return (unsigned)__builtin_amdgcn_s_getreg((3 << 11) | 20) & 0xFu; }
#define XB_SPIN(cond, bar) do { unsigned _sp = 0; while (cond) { __builtin_amdgcn_s_sleep(1); \
    if ((++_sp & 255u) == 0u) { if (xb_ld(&(bar)[XB_TMO])) break; if (_sp > XB_SPIN_CAP) { atomicAdd(&(bar)[XB_TMO], 1u); break; } } } } while (0)
struct XcdBarrier { unsigned* bar; unsigned x; volatile LAS unsigned* st; };
__device__ __forceinline__ XcdBarrier xcd_barrier_post(unsigned* bar, volatile LAS unsigned* st) {
    XcdBarrier b; b.bar = bar; b.x = xb_xcc_id(); b.st = st;
    if (threadIdx.x == 0) (void)xb_add(&bar[XB_XCNT(b.x)], 1u);
    return b;
}
__device__ __forceinline__ void xcd_barrier_complete(unsigned* bar, unsigned x, unsigned& nloc, unsigned& nx) {
    const unsigned G = gridDim.x * gridDim.y * gridDim.z;
    unsigned sum, cnt, mine, sp = 0u;
    for (;;) {
        sum = 0u; cnt = 0u; mine = 0u;
#pragma unroll
        for (unsigned j = 0; j < 16; ++j) { const unsigned c = xb_ld(&bar[XB_XCNT(j)]); sum += c; cnt += (c > 0u) ? 1u : 0u; mine = (j == x) ? c : mine; }
        if (sum == G) break;
        __builtin_amdgcn_s_sleep(1);
        if ((++sp & 255u) == 0u) { if (xb_ld(&bar[XB_TMO])) break; if (sp > XB_SPIN_CAP) { atomicAdd(&bar[XB_TMO], 1u); break; } }
    }
    nloc = mine > 0u ? mine : 1u; nx = cnt > 0u ? cnt : 1u;
}
__device__ __forceinline__ void xcd_barrier(const XcdBarrier& b) {
    asm volatile("s_waitcnt vmcnt(0)" ::: "memory");
    __syncthreads();
    if (threadIdx.x == 0) {
        unsigned* bar = b.bar;
        __builtin_amdgcn_s_waitcnt(0);
        unsigned nloc = b.st[0], nx = b.st[1];
        if (nloc == 0u) { xcd_barrier_complete(bar, b.x, nloc, nx); b.st[0] = nloc; b.st[1] = nx; }
        const unsigned old = xb_add(&bar[XB_XSUB(b.x)], 1u);
        const unsigned gen = old / nloc;
        if (old + 1u == (gen + 1u) * nloc) {
            __builtin_amdgcn_fence(__ATOMIC_RELEASE, "agent");
            asm volatile("s_waitcnt vmcnt(0)" ::: "memory");
            const unsigned og = xb_add(&bar[XB_TOP], 1u);
            const unsigned tg = og / nx;
            if (og + 1u == (tg + 1u) * nx) xb_add(&bar[XB_TOPGEN], 1u);
            else XB_SPIN(xb_ld(&bar[XB_TOPGEN]) == tg, bar);
            __builtin_amdgcn_fence(__ATOMIC_ACQUIRE, "agent");
            xb_add(&bar[XB_XGEN(b.x)], 1u);
            asm volatile("s_waitcnt vmcnt(0)" ::: "memory");
        } else {
            XB_SPIN(xb_ld(&bar[XB_XGEN(b.x)]) == gen, bar);
            __builtin_amdgcn_fence(__ATOMIC_ACQUIRE, "agent");
            asm volatile("s_waitcnt vmcnt(0)" ::: "memory");
        }
    }
    __syncthreads();
}

namespace pg8 {
constexpr int BM = 256, BK = 64, HALF = 128, HTB = HALF * BK * 2, STAGE_BYTES = 8 * HTB, NXCD = 8, WGM = 8;
__device__ __forceinline__ int lds_byte(int r, int c) { const int st = (r >> 4) * 2 + (c >> 5), rr = r & 15, cc = c & 31, ob = rr * 64 + cc * 2; return st * 1024 + (ob ^ (((ob >> 9) & 1) << 5)); }
__device__ __forceinline__ void stage_rc(int b, int& R, int& C) { const int st = b / 1024, sb = b % 1024, swz = sb ^ (((sb >> 9) & 1) << 5); R = (st >> 1) * 16 + swz / 64; C = (st & 1) * 32 + (swz % 64) / 2; }
__device__ __forceinline__ int perm32(int rho) { const int n = rho >> 4, i = rho & 15; return 8 * (i >> 2) + 4 * n + (i & 3); }
struct Unit { int pm, pn, e, lr0, half; };
struct StaticOrder {
    int nM, nN, nwg, G, c;
    __device__ void init(int M, int N, int G_, int c_) { nM = M / BM; nN = N / BM; nwg = nM * nN; G = G_; c = c_; }
    __device__ bool next(int i, Unit& u) const {
        const long L = (long)i * G + c; if (L >= nwg) return false;
        int wgid = (int)L; { const int q = nwg / NXCD, r = nwg % NXCD, xcd = wgid % NXCD, off = wgid / NXCD; wgid = (xcd < r ? xcd * (q + 1) : r * (q + 1) + (xcd - r) * q) + off; }
        const int nig = WGM * nN, gid = wgid / nig, fm = gid * WGM, gsz = (nM - fm) < WGM ? (nM - fm) : WGM;
        u.pm = fm + ((wgid % nig) % gsz); u.pn = (wgid % nig) / gsz; u.e = 0; u.lr0 = 0; u.half = 0; return true;
    }
};

template <class Epi, class Sched, bool ALIGN_EPI, bool HALFM = false>
__device__ __forceinline__ void gemm_phase(LAS unsigned char* lds, const int K, const int ldb, const Sched& S, const Epi& E, const bool nomma = false, const bool nostage = false) {
    const int tid = threadIdx.x, wid = __builtin_amdgcn_readfirstlane(tid >> 6), lane = tid & 63, wr = wid >> 2, wc = wid & 3, fr = lane & 15, fq = lane >> 4;
    const int nt = K / BK;
    int Rr[2], Cc[2]; unsigned voffB[2];
#pragma unroll
    for (int i = 0; i < 2; ++i) { stage_rc(tid * 16 + i * 8192, Rr[i], Cc[i]); const int Rb = (Rr[i] & ~31) + perm32(Rr[i] & 31); voffB[i] = (unsigned)(Rb * ldb + Cc[i]) * 2u; }
    const size_t kstep = (size_t)(BK * 2);
    const size_t hstepB = (size_t)HALF * ldb * 2;
    const unsigned ldsw = (unsigned)wid * 1024u;
    const int aoff = lds_byte(wr * 64 + fr, fq * 8), boff = lds_byte(wc * 32 + fr, fq * 8);
#define PG8_SA(b, h) (((b) * 2 + (h)) * HTB)
#define PG8_SB(b, h) ((4 + (b) * 2 + (h)) * HTB)
#define PG8_STAGE(bufoff, gbase, voff) do { if (nostage) break; _Pragma("unroll") for (int _i = 0; _i < 2; ++_i) \
        __builtin_amdgcn_global_load_lds((const unsigned*)((const char*)(gbase) + (voff)[_i]), (LAS unsigned*)(lds + (bufoff) + ldsw + _i * 8192), 16, 0, 0); } while (0)
#define PG8_LDA(dst, b, h) do { _Pragma("unroll") for (int m = 0; m < 4; ++m) _Pragma("unroll") for (int k = 0; k < 2; ++k) dst[m][k] = *(const LAS bf16x8*)(lds + PG8_SA(b, h) + aoff + m * 2048 + k * 1024); } while (0)
#define PG8_LDB(dst, b, h) do { _Pragma("unroll") for (int n = 0; n < 2; ++n) _Pragma("unroll") for (int k = 0; k < 2; ++k) dst[n][k] = *(const LAS bf16x8*)(lds + PG8_SB(b, h) + boff + n * 2048 + k * 1024); } while (0)
#define PG8_MMA(ai, bj, At, Bt) do { if (nomma) { asm volatile("" :: "v"(At[0][0]), "v"(At[3][1]), "v"(Bt[0][0]), "v"(Bt[1][1])); break; } __builtin_amdgcn_s_setprio(1); _Pragma("unroll") for (int m = 0; m < 4; ++m) _Pragma("unroll") for (int n = 0; n < 2; ++n) _Pragma("unroll") for (int k = 0; k < 2; ++k) \
        acc[ai][bj][m][n] = __builtin_amdgcn_mfma_f32_16x16x32_bf16(Bt[n][k], At[m][k], acc[ai][bj][m][n], 0, 0, 0); __builtin_amdgcn_s_setprio(0); } while (0)
#define PG8_WAIT_V(n) asm volatile("s_waitcnt vmcnt(" #n ")" ::: "memory")
#define PG8_WAIT_L(n) asm volatile("s_waitcnt lgkmcnt(" #n ")" ::: "memory")
#define PG8_BAR __builtin_amdgcn_s_barrier()
#define PG8_SCHED __builtin_amdgcn_sched_barrier(0)
    Unit cur, nxt; int ui = 0;
    if (!S.next(0, cur)) return;
    f32x4 acc[2][2][4][2];
#pragma unroll
    for (int a = 0; a < 2; ++a)
#pragma unroll
        for (int b = 0; b < 2; ++b)
#pragma unroll
            for (int m = 0; m < 4; ++m)
#pragma unroll
                for (int n = 0; n < 2; ++n) acc[a][b][m][n] = (f32x4){0.f, 0.f, 0.f, 0.f};
    bf16x8 At[4][2], B0[2][2], B1[2][2];
    const char* cA = S.a_base(cur); const char* cB = S.b_base(cur);
    unsigned vAc[2][2], vAn[2][2], v2[2][2];
    S.a_offs(cur, Rr, Cc, vAc);
    PG8_STAGE(PG8_SB(0, 0), cB, voffB); PG8_STAGE(PG8_SB(0, 1), cB + hstepB, voffB); PG8_STAGE(PG8_SA(0, 0), cA, vAc[0]); PG8_STAGE(PG8_SA(0, 1), cA, vAc[1]);
    if (wr == 1) PG8_BAR;
    PG8_WAIT_V(2); PG8_BAR;
    PG8_STAGE(PG8_SB(1, 0), cB + kstep, voffB); PG8_STAGE(PG8_SA(1, 0), cA + kstep, vAc[0]); PG8_STAGE(PG8_SB(1, 1), cB + hstepB + kstep, voffB);
    PG8_WAIT_V(6); PG8_BAR;
    for (;;) {
        const bool has_next = S.next(ui + 1, nxt);
        const char* nA = has_next ? S.a_base(nxt) : cA; const char* nB = has_next ? S.b_base(nxt) : cB;
        if (has_next) S.a_offs(nxt, Rr, Cc, vAn);
        else {
#pragma unroll
            for (int h = 0; h < 2; ++h)
#pragma unroll
                for (int i = 0; i < 2; ++i) vAn[h][i] = vAc[h][i]; }
#pragma unroll 1
        for (int t = 0; t < nt; t += 2) {
            const bool last = (t == nt - 2);
            const char* a1 = cA + (size_t)(t + 1) * kstep;
            const char* a2 = last ? nA : cA + (size_t)(t + 2) * kstep; const char* b2 = last ? nB : cB + (size_t)(t + 2) * kstep;
            const char* a3 = a2 + kstep; const char* b3 = b2 + kstep;
#pragma unroll
            for (int h = 0; h < 2; ++h)
#pragma unroll
                for (int i = 0; i < 2; ++i) v2[h][i] = last ? vAn[h][i] : vAc[h][i];
            PG8_LDB(B0, 0, 0); PG8_LDB(B1, 0, 1); PG8_SCHED; PG8_LDA(At, 0, 0); PG8_STAGE(PG8_SA(1, 1), a1, vAc[1]);
            PG8_WAIT_V(8); PG8_WAIT_L(0); PG8_BAR; PG8_MMA(0, 0, At, B0); PG8_MMA(0, 1, At, B1); PG8_BAR; PG8_SCHED;
            if constexpr (!HALFM) { PG8_LDA(At, 0, 1); } PG8_STAGE(PG8_SB(0, 0), b2, voffB); PG8_STAGE(PG8_SB(0, 1), b2 + hstepB, voffB); PG8_STAGE(PG8_SA(0, 0), a2, v2[0]);
            PG8_WAIT_V(8); PG8_WAIT_L(0); PG8_BAR; if constexpr (!HALFM) { PG8_MMA(1, 0, At, B0); PG8_MMA(1, 1, At, B1); } PG8_BAR; PG8_SCHED;
            PG8_LDB(B0, 1, 0); PG8_LDB(B1, 1, 1); PG8_SCHED; PG8_LDA(At, 1, 0); PG8_STAGE(PG8_SA(0, 1), a2, v2[1]);
            PG8_WAIT_V(8); PG8_WAIT_L(0); PG8_BAR; PG8_MMA(0, 0, At, B0); PG8_MMA(0, 1, At, B1); PG8_BAR; PG8_SCHED;
            if constexpr (!HALFM) { PG8_LDA(At, 1, 1); } PG8_STAGE(PG8_SB(1, 0), b3, voffB); PG8_STAGE(PG8_SB(1, 1), b3 + hstepB, voffB); PG8_STAGE(PG8_SA(1, 0), a3, v2[0]);
            PG8_WAIT_V(8); PG8_WAIT_L(0); PG8_BAR; if constexpr (!HALFM) { PG8_MMA(1, 0, At, B0); PG8_MMA(1, 1, At, B1); } PG8_BAR; PG8_SCHED;
        }
        if constexpr (ALIGN_EPI) { if (wr == 0) PG8_BAR; }
        if constexpr (!HALFM) cur.half = 0; else cur.half = (cur.half == 2) ? 2 : 1;
        E(acc, cur, wr, wc, fr, fq);
        if (!has_next) break;
#pragma unroll
        for (int a = 0; a < 2; ++a)
#pragma unroll
            for (int b = 0; b < 2; ++b)
#pragma unroll
                for (int m = 0; m < 4; ++m)
#pragma unroll
                    for (int n = 0; n < 2; ++n) acc[a][b][m][n] = (f32x4){0.f, 0.f, 0.f, 0.f};
        cur = nxt; cA = nA; cB = nB; ++ui;
#pragma unroll
        for (int h = 0; h < 2; ++h)
#pragma unroll
            for (int i = 0; i < 2; ++i) vAc[h][i] = vAn[h][i];
        if constexpr (ALIGN_EPI) { if (wr == 1) PG8_BAR; }
    }
    PG8_WAIT_V(0);
    if constexpr (!ALIGN_EPI) { if (wr == 0) PG8_BAR; }
    PG8_BAR;
#undef PG8_SA
#undef PG8_SB
#undef PG8_STAGE
#undef PG8_LDA
#undef PG8_LDB
#undef PG8_MMA
#undef PG8_WAIT_V
#undef PG8_WAIT_L
#undef PG8_BAR
#undef PG8_SCHED
}
}
using pg8::Unit;

struct PlainSched {
    pg8::StaticOrder so; const bf16* A; const bf16* Bt; int lda, ldb; int acol_pn, acol_off;
    __device__ __forceinline__ bool next(int i, Unit& u) const { return so.next(i, u); }
    __device__ __forceinline__ const char* a_base(const Unit& u) const { return (const char*)(A + (size_t)u.pm * 256 * lda + (u.pn >= acol_pn ? acol_off : 0)); }
    __device__ __forceinline__ const char* b_base(const Unit& u) const { return (const char*)(Bt + (size_t)u.pn * 256 * ldb); }
    __device__ __forceinline__ void a_offs(const Unit&, const int (&R)[2], const int (&C)[2], unsigned (&v)[2][2]) const {
#pragma unroll
        for (int h = 0; h < 2; ++h)
#pragma unroll
            for (int i = 0; i < 2; ++i) v[h][i] = (unsigned)((h * 128 + R[i]) * lda + C[i]) * 2u; }
};
struct PairSched {
    int pm, pn0; const bf16* A; const bf16* Bt; int lda, ldb;
    __device__ __forceinline__ bool next(int i, Unit& u) const { if (i >= 2) return false; u.pm = pm; u.pn = pn0 + i; u.e = 0; u.lr0 = 0; u.half = 0; return true; }
    __device__ __forceinline__ const char* a_base(const Unit& u) const { return (const char*)(A + (size_t)u.pm * 256 * lda); }
    __device__ __forceinline__ const char* b_base(const Unit& u) const { return (const char*)(Bt + (size_t)u.pn * 256 * ldb); }
    __device__ __forceinline__ void a_offs(const Unit&, const int (&R)[2], const int (&C)[2], unsigned (&v)[2][2]) const {
#pragma unroll
        for (int h = 0; h < 2; ++h)
#pragma unroll
            for (int i = 0; i < 2; ++i) v[h][i] = (unsigned)((h * 128 + R[i]) * lda + C[i]) * 2u; }
};
struct MoeSched {
    int G, c, NT, npanels; const LAS int* pst; const LAS int* cnt; const int* toks; const bf16* A; const bf16* Bt; int lda, ldb; size_t bstride; bool gather; int mode;
    __device__ __forceinline__ int rem() const { return (npanels * NT) % G; }
    __device__ __forceinline__ bool split() const { const int r = rem(); return r > 0 && 2 * r <= G; }
    __device__ __forceinline__ int tail_wgs() const { return split() ? 2 * rem() : rem(); }
    __device__ __forceinline__ bool next(int i, Unit& u) const {
        const int nu = npanels * NT, full = nu - rem(); int L;
        if (mode == 0) { L = i * G + c; if (L >= (split() ? full : nu)) return false; u.half = 0; }
        else { if (i > 0 || !split() || c >= 2 * rem()) return false; L = full + (c >> 1); u.half = 1 + (c & 1); }
        u.pm = L / NT; u.pn = L % NT; int e = 0;
#pragma unroll 1
        for (int q = 1; q < NE; ++q) e = (pst[q] <= u.pm) ? q : e;
        u.e = e; u.lr0 = (u.pm - pst[e]) * 256; return true; }
    __device__ __forceinline__ const char* a_base(const Unit& u) const { return gather ? (const char*)A : (const char*)(A + (size_t)u.pm * 256 * lda); }
    __device__ __forceinline__ const char* b_base(const Unit& u) const { return (const char*)(Bt + (size_t)u.e * bstride + (size_t)u.pn * 256 * ldb); }
    __device__ __forceinline__ void a_offs(const Unit& u, const int (&R)[2], const int (&C)[2], unsigned (&v)[2][2]) const {
        const int ce = cnt[u.e];
#pragma unroll
        for (int h = 0; h < 2; ++h)
#pragma unroll
            for (int i = 0; i < 2; ++i) {
                const int hh = (u.half == 2) ? 1 : h;
                if (gather) { const int lrow = u.lr0 + hh * 128 + R[i]; const int tok = toks[u.e * CAP + (lrow < ce ? lrow : 0)]; v[h][i] = (unsigned)(tok * lda + C[i]) * 2u; }
                else v[h][i] = (unsigned)((hh * 128 + R[i]) * lda + C[i]) * 2u; } }
};

#ifndef ST8_SC1
#define ST8_SC1 0
#endif
__device__ __forceinline__ void st8(bf16* p, f32x4 a, f32x4 b) { u32x4 o; o.x = pk2(a.x, a.y); o.y = pk2(a.z, a.w); o.z = pk2(b.x, b.y); o.w = pk2(b.z, b.w);
    if (ST8_SC1) asm volatile("global_store_dwordx4 %0, %1, off sc1\n\ts_nop 1" :: "v"(p), "v"(o) : "memory"); else *(u32x4*)p = o; }
__device__ __forceinline__ void st4(bf16* p, f32x4 v) { u32x2 o; o.x = pk2(v.x, v.y); o.y = pk2(v.z, v.w); *(u32x2*)p = o; }
__device__ __forceinline__ float sq4(f32x4 v) { return (v.x * v.x + v.y * v.y) + (v.z * v.z + v.w * v.w); }

struct EpiInProj {
    unsigned char* ws;
    __device__ __forceinline__ void operator()(const f32x4 (&acc)[2][2][4][2], const Unit& u, int wr, int wc, int fr, int fq) const {
        const float* __restrict__ rs0 = (const float*)(ws + WS_RS0);
        const int reg = u.pn >> 1;
        bf16* __restrict__ dst = (bf16*)(ws + (reg == 0 ? WS_QA : reg == 1 ? WS_KA : reg == 2 ? WS_VA : WS_LAT));
        const float qs = (reg == 0) ? QS_A : 1.f;
        const int row0 = u.pm * 256 + wr * 64 + fr;
        float rsv[2][4];
#pragma unroll
        for (int ai = 0; ai < 2; ++ai)
#pragma unroll
            for (int m = 0; m < 4; ++m) rsv[ai][m] = rs0[row0 + ai * 128 + m * 16];
        const bool isrope = (u.pn == 7 && wc == 0);
        float2 csv[2][4][4];
        if (isrope) {
#pragma unroll
            for (int ai = 0; ai < 2; ++ai)
#pragma unroll
                for (int m = 0; m < 4; ++m) { const float2* cs = (const float2*)(ws + WS_ROPE) + ((row0 + ai * 128 + m * 16) & (SEQ - 1)) * 16 + fq * 4;
#pragma unroll
                    for (int j = 0; j < 4; ++j) csv[ai][m][j] = cs[j]; }
        }
#pragma unroll
        for (int ai = 0; ai < 2; ++ai)
#pragma unroll
            for (int m = 0; m < 4; ++m) {
                const int row = row0 + ai * 128 + m * 16;
                const float rs = rsv[ai][m]; const float sc = rs * qs;
                float ssq = 0.f;
#pragma unroll
                for (int bj = 0; bj < 2; ++bj) {
                    const int lc = (u.pn & 1) * 256 + bj * 128 + wc * 32 + fq * 8;
                    const f32x4 v0 = acc[ai][bj][m][0] * sc, v1 = acc[ai][bj][m][1] * sc;
                    st8(dst + (size_t)row * 512 + lc, v0, v1);
                    if (u.pn == 6 || (u.pn == 7 && bj == 0)) ssq += sq4(v0) + sq4(v1);
                }
                if (u.pn >= 6) {
                    ssq += __shfl_xor(ssq, 16); ssq += __shfl_xor(ssq, 32);
                    if (fq == 0) atomicAdd((float*)(ws + (u.pn == 6 ? CTL_SSQQ : CTL_SSQKV)) + row, ssq);
                    if (isrope) {
                        const f32x4 x1 = acc[ai][1][m][0] * rs, x2 = acc[ai][1][m][1] * rs;
                        f32x4 y1, y2;
#pragma unroll
                        for (int j = 0; j < 4; ++j) { const float2 c = csv[ai][m][j]; y1[j] = x1[j] * c.x - x2[j] * c.y; y2[j] = x1[j] * c.y + x2[j] * c.x; }
                        bf16* kr = (bf16*)(ws + WS_KR) + (size_t)row * 32 + fq * 4;
                        st4(kr, y1); st4(kr + 16, y2);
                    }
                }
            }
    }
};
struct EpiUps {
    unsigned char* ws;
    __device__ __forceinline__ void operator()(const f32x4 (&acc)[2][2][4][2], const Unit& u, int wr, int wc, int fr, int fq) const {
        const bool isq = u.pn < 3;
        const float* __restrict__ ssq = (const float*)(ws + (isq ? CTL_SSQQ : CTL_SSQKV));
        const int row0 = u.pm * 256 + wr * 64 + fr;
        float sv[2][4];
#pragma unroll
        for (int ai = 0; ai < 2; ++ai)
#pragma unroll
            for (int m = 0; m < 4; ++m) sv[ai][m] = ssq[row0 + ai * 128 + m * 16];
        const bool rope0 = isq && ((u.pn * 8 + wc) % 3 == 2), rope1 = isq && ((u.pn * 8 + 4 + wc) % 3 == 2);
        float2 csv[2][4][4];
        if (rope0 || rope1) {
#pragma unroll
            for (int ai = 0; ai < 2; ++ai)
#pragma unroll
                for (int m = 0; m < 4; ++m) { const float2* cs = (const float2*)(ws + WS_ROPE) + ((row0 + ai * 128 + m * 16) & (SEQ - 1)) * 16 + fq * 4;
#pragma unroll
                    for (int j = 0; j < 4; ++j) csv[ai][m][j] = cs[j]; }
        }
#pragma unroll
        for (int ai = 0; ai < 2; ++ai)
#pragma unroll
            for (int m = 0; m < 4; ++m) {
                const int row = row0 + ai * 128 + m * 16;
                const float rs = rsqrtf(sv[ai][m] * (isq ? (1.f / 256.f) : (1.f / 128.f)) + EPS) * (isq ? QS_B : 1.f);
#pragma unroll
                for (int bj = 0; bj < 2; ++bj) {
                    if (isq) {
                        const int cg = u.pn * 8 + bj * 4 + wc;
                        bf16* q = (bf16*)(ws + WS_QB) + (size_t)row * 768 + cg * 32;
                        f32x4 a = acc[ai][bj][m][0] * rs, b = acc[ai][bj][m][1] * rs;
                        if (bj ? rope1 : rope0) {
                            f32x4 y1, y2;
#pragma unroll
                            for (int j = 0; j < 4; ++j) { const float2 c = csv[ai][m][j]; y1[j] = a[j] * c.x - b[j] * c.y; y2[j] = a[j] * c.y + b[j] * c.x; }
                            st4(q + fq * 4, y1); st4(q + 16 + fq * 4, y2);
                        } else st8(q + fq * 8, a, b);
                    } else {
                        const int head = (u.pn - 3) * 2 + bj;
                        bf16* dst = (bf16*)(ws + (wc < 2 ? WS_KB : WS_VB)) + (size_t)row * 512 + head * 64 + (wc & 1) * 32 + fq * 8;
                        st8(dst, acc[ai][bj][m][0] * rs, acc[ai][bj][m][1] * rs);
                    }
                }
            }
    }
};
struct EpiOut {
    unsigned char* ws; int gabl;
    __device__ __forceinline__ void operator()(const f32x4 (&acc)[2][2][4][2], const Unit& u, int wr, int wc, int fr, int fq) const {
        const bf16* __restrict__ xb = (const bf16*)(ws + WS_XB); bf16* __restrict__ x1 = (bf16*)(ws + WS_X1);
        int pm_ = u.pm; asm volatile("" : "+s"(pm_));
        const int row0 = pm_ * 256 + wr * 64 + fr; const int col0 = u.pn * 256 + wc * 32 + fq * 8;
        u32x4 xv[4][2], pk[4][2]; float sq[4];
#define EO_LOAD(ai) _Pragma("unroll") for (int m = 0; m < 4; ++m) _Pragma("unroll") for (int bj = 0; bj < 2; ++bj) \
            xv[m][bj] = (gabl & 1) ? (u32x4){0u, 0u, 0u, 0u} : *(const u32x4*)(xb + (size_t)(row0 + (ai) * 128 + m * 16) * 1024 + col0 + bj * 128)
#define EO_PACK(ai) _Pragma("unroll") for (int m = 0; m < 4; ++m) { float ssq = 0.f; _Pragma("unroll") for (int bj = 0; bj < 2; ++bj) { float t8[8]; unpack8(xv[m][bj], t8); \
                f32x4 v0 = acc[ai][bj][m][0], v1 = acc[ai][bj][m][1]; \
                v0.x += t8[0]; v0.y += t8[1]; v0.z += t8[2]; v0.w += t8[3]; v1.x += t8[4]; v1.y += t8[5]; v1.z += t8[6]; v1.w += t8[7]; \
                pk[m][bj].x = pk2(v0.x, v0.y); pk[m][bj].y = pk2(v0.z, v0.w); pk[m][bj].z = pk2(v1.x, v1.y); pk[m][bj].w = pk2(v1.z, v1.w); ssq += sq4(v0) + sq4(v1); } \
            ssq += __shfl_xor(ssq, 16); ssq += __shfl_xor(ssq, 32); sq[m] = ssq; }
#define EO_STORE(ai) _Pragma("unroll") for (int m = 0; m < 4; ++m) { const int row = row0 + (ai) * 128 + m * 16; \
            _Pragma("unroll") for (int bj = 0; bj < 2; ++bj) { if (!(gabl & 2)) *(u32x4*)(x1 + (size_t)row * 1024 + col0 + bj * 128) = pk[m][bj]; else asm volatile("" :: "v"(pk[m][bj])); } \
            if (fq == 0 && !(gabl & 4)) atomicAdd((float*)(ws + CTL_SSQ1) + row, sq[m]); else asm volatile("" :: "v"(sq[m])); }
        EO_LOAD(0); EO_PACK(0); EO_LOAD(1); EO_STORE(0); EO_PACK(1); EO_STORE(1);
#undef EO_LOAD
#undef EO_PACK
#undef EO_STORE
    }
};
struct EpiGateUp {
    unsigned char* ws; const LAS int* cnt;
    __device__ __forceinline__ void operator()(const f32x4 (&acc)[2][2][4][2], const Unit& u, int wr, int wc, int fr, int fq) const {
        const int ce = cnt[u.e]; const int* __restrict__ toks = (const int*)(ws + WS_TOK) + u.e * CAP; const float* __restrict__ ssq1 = (const float*)(ws + CTL_SSQ1);
        const int lr0 = wr * 64 + fr + (u.half == 2 ? 128 : 0);
        int tk[2][4]; float sv[2][4];
#pragma unroll
        for (int ai = 0; ai < 2; ++ai)
#pragma unroll
            for (int m = 0; m < 4; ++m) { const int lrow = u.lr0 + lr0 + ai * 128 + m * 16; tk[ai][m] = toks[lrow < ce ? lrow : 0]; }
#pragma unroll
        for (int ai = 0; ai < 2; ++ai)
#pragma unroll
            for (int m = 0; m < 4; ++m) sv[ai][m] = ssq1[tk[ai][m]];
#pragma unroll
        for (int ai = 0; ai < 2; ++ai)
#pragma unroll
            for (int m = 0; m < 4; ++m) {
                if (ai == 1 && u.half) continue;
                const int lr = lr0 + ai * 128 + m * 16;
                const float rs = rsqrtf(sv[ai][m] * (1.f / D) + EPS);
                bf16* dst = (bf16*)(ws + WS_HB) + (size_t)(u.pm * 256 + lr) * 256 + u.pn * 128 + wc * 32 + fq * 8;
                f32x4 h[2];
#pragma unroll
                for (int n = 0; n < 2; ++n) { const f32x4 g = acc[ai][0][m][n] * rs, up = acc[ai][1][m][n] * rs;
#pragma unroll
                    for (int j = 0; j < 4; ++j) h[n][j] = g[j] / (1.f + __expf(-g[j])) * up[j]; }
                st8(dst, h[0], h[1]);
            }
    }
};
struct EpiDown {
    unsigned char* ws; const LAS int* cnt; int gabl;
    __device__ __forceinline__ void operator()(const f32x4 (&acc)[2][2][4][2], const Unit& u, int wr, int wc, int fr, int fq) const {
        const int ce = cnt[u.e]; const float* __restrict__ gates = (const float*)(ws + WS_GATE) + u.e * CAP;
        const int lr0 = wr * 64 + fr + (u.half == 2 ? 128 : 0);
        float gv[2][4];
#pragma unroll
        for (int ai = 0; ai < 2; ++ai)
#pragma unroll
            for (int m = 0; m < 4; ++m) { const int lrow = u.lr0 + lr0 + ai * 128 + m * 16; const float g = gates[lrow < ce ? lrow : 0]; gv[ai][m] = lrow < ce ? g : 0.f; }
#pragma unroll
        for (int ai = 0; ai < 2; ++ai)
#pragma unroll
            for (int m = 0; m < 4; ++m) {
                if (ai == 1 && u.half) continue;
                const int lr = lr0 + ai * 128 + m * 16;
                const float gt = gv[ai][m];
                bf16* dst = (bf16*)(ws + WS_YB) + (size_t)(u.pm * 256 + lr) * 1024 + u.pn * 256 + wc * 32 + fq * 8;
#pragma unroll
                for (int bj = 0; bj < 2; ++bj) { if (!(gabl & 1)) st8(dst + bj * 128, acc[ai][bj][m][0] * gt, acc[ai][bj][m][1] * gt); else asm volatile("" :: "v"(acc[ai][bj][m][0] * gt), "v"(acc[ai][bj][m][1] * gt)); }
            }
    }
};

struct Args { const float* in[20]; float* out; unsigned char* ws; int ph_lo, ph_hi, flags, pad; };
struct Frame { LAS unsigned char* lds; int tid, lane, wave, vcu, G; const float* const* in; float* out; unsigned char* ws; int pflags; };

__device__ __forceinline__ void transpose_item(const float* W, int ldw, const float* gain, bf16* WT, int ldwt, int k0, int n0, int dstrow0, LAS float* scr, int lane, bool ropeperm = false) {
    f32x4 v[8];
#pragma unroll
    for (int i = 0; i < 8; ++i) v[i] = *(const f32x4*)(W + (size_t)(k0 + 8 * i + (lane >> 3)) * ldw + n0 + 4 * (lane & 7));
#pragma unroll
    for (int i = 0; i < 8; ++i) { const int kk = 8 * i + (lane >> 3); const float g = gain ? gain[k0 + kk] : 1.f; LAS float* d = scr + kk * 33 + 4 * (lane & 7);
        d[0] = v[i].x * g; d[1] = v[i].y * g; d[2] = v[i].z * g; d[3] = v[i].w * g; }
    LDS_WAIT();
    const int c = lane & 7;
#pragma unroll
    for (int j = 0; j < 4; ++j) { const int n = (lane >> 3) + 8 * j; const LAS float* s = scr + (8 * c) * 33 + n;
        u32x4 o; o.x = pk2(s[0 * 33], s[1 * 33]); o.y = pk2(s[2 * 33], s[3 * 33]); o.z = pk2(s[4 * 33], s[5 * 33]); o.w = pk2(s[6 * 33], s[7 * 33]);
        const int dn = ropeperm ? (8 * ((n & 15) >> 2) + 4 * (n >> 4) + (n & 3)) : n;
        *(u32x4*)(WT + (size_t)(dstrow0 + dn) * ldwt + k0 + 8 * c) = o; }
    LDS_WAIT();
}

struct XItem { const float* W; const float* gain; bf16* WT; int ldw, ldwt, k0, n0, dstrow0; };
__device__ __forceinline__ XItem xitem_decode(const Frame& F, int kind, int r) {
    unsigned char* ws = F.ws; XItem t; constexpr int I_G = 16 * 8, I_D = 4 * 32;
    if (kind == 0) { const int mtx = r / I_G, q = r % I_G, e = mtx >> 1, gu = mtx & 1, kb = q / 8, nb = q % 8; const int n0 = nb * 32;
        t.W = (gu ? F.in[17] : F.in[16]) + (size_t)e * 1024 * 256; t.ldw = 256; t.gain = F.in[11]; t.WT = (bf16*)(ws + WS_WGU) + (size_t)e * 512 * 1024; t.ldwt = 1024; t.k0 = kb * 64; t.n0 = n0;
        t.dstrow0 = 256 * (n0 >> 7) + gu * 128 + (n0 & 127); }
    else { const int e = r / I_D, q = r % I_D, kb = q / 32, nb = q % 32;
        t.W = F.in[18] + (size_t)e * 256 * 1024; t.ldw = 1024; t.gain = nullptr; t.WT = (bf16*)(ws + WS_WD) + (size_t)e * 1024 * 256; t.ldwt = 256; t.k0 = kb * 64; t.n0 = nb * 32; t.dstrow0 = nb * 32; }
    return t;
}
__device__ __forceinline__ void xitem_load(const XItem& t, f32x4 (&v)[8], int lane) {
#pragma unroll
    for (int i = 0; i < 8; ++i) v[i] = *(const f32x4*)(t.W + (size_t)(t.k0 + 8 * i + (lane >> 3)) * t.ldw + t.n0 + 4 * (lane & 7));
}
__device__ __forceinline__ void xitem_store(const XItem& t, const f32x4 (&v)[8], LAS float* scr, int lane) {
#pragma unroll
    for (int i = 0; i < 8; ++i) { const int kk = 8 * i + (lane >> 3); const float g = t.gain ? t.gain[t.k0 + kk] : 1.f; LAS float* d = scr + kk * 33 + 4 * (lane & 7);
        d[0] = v[i].x * g; d[1] = v[i].y * g; d[2] = v[i].z * g; d[3] = v[i].w * g; }
    LDS_WAIT();
    const int c = lane & 7;
#pragma unroll
    for (int j = 0; j < 4; ++j) { const int n = (lane >> 3) + 8 * j; const LAS float* s = scr + (8 * c) * 33 + n;
        u32x4 o; o.x = pk2(s[0 * 33], s[1 * 33]); o.y = pk2(s[2 * 33], s[3 * 33]); o.z = pk2(s[4 * 33], s[5 * 33]); o.w = pk2(s[6 * 33], s[7 * 33]);
        *(u32x4*)(t.WT + (size_t)(t.dstrow0 + n) * t.ldwt + t.k0 + 8 * c) = o; }
    LDS_WAIT();
}
__device__ __forceinline__ void p_convert_experts(const Frame& F, int kind, int wid, int nw) {
    const int lane = F.lane; LAS float* scr = (LAS float*)(F.lds + F.wave * 16384);
    const int nitems = kind == 0 ? 64 * 16 * 8 : 32 * 4 * 32;
    if (wid >= nitems) return;
    XItem cur = xitem_decode(F, kind, wid); f32x4 v[8], vn[8]; xitem_load(cur, v, lane);
    for (int r = wid; r < nitems; r += nw) {
        const bool more = (r + nw < nitems); XItem nxt = cur;
        if (more) { nxt = xitem_decode(F, kind, r + nw); xitem_load(nxt, vn, lane); }
        xitem_store(cur, v, scr, lane);
        if (more) { cur = nxt;
#pragma unroll
            for (int i = 0; i < 8; ++i) v[i] = vn[i]; }
    }
}
__device__ __forceinline__ void p_prologue(const Frame& F) {
    unsigned char* ws = F.ws; const int lane = F.lane;
    LAS float* scr = (LAS float*)(F.lds + F.wave * 16384);
    const int gw = F.vcu * NWAVES + F.wave, NGW = F.G * NWAVES;
    constexpr int I_IN = 16 * 61, I_Q = 4 * 24, I_KV = 2 * 32, I_O = 16 * 32;
    constexpr int NITEMS = I_IN + I_Q + I_KV + I_O;
    for (int it = gw; it < NITEMS; it += NGW) {
        if (F.pflags & 128) break;
        int r = it;
        if (r < I_IN) { const int kb = r / 61, nb = r % 61; transpose_item(F.in[2], NIN, F.in[1], (bf16*)(ws + WS_WI), 1024, kb * 64, nb * 32, nb * 32, scr, lane, nb == 60); continue; } r -= I_IN;
        if (r < I_Q) { const int kb = r / 24, nb = r % 24; transpose_item(F.in[5], 768, F.in[4], (bf16*)(ws + WS_WQKV), 256, kb * 64, nb * 32, nb * 32, scr, lane, nb % 3 == 2); continue; } r -= I_Q;
        if (r < I_KV) { const int kb = r / 32, nb = r % 32; transpose_item(F.in[7], 1024, F.in[6], (bf16*)(ws + WS_WQKV), 256, kb * 64, nb * 32, 768 + nb * 32, scr, lane); continue; } r -= I_KV;
        { const int kb = r / 32, nb = r % 32; transpose_item(F.in[10], 1024, nullptr, (bf16*)(ws + WS_WO), 1024, kb * 64, nb * 32, nb * 32, scr, lane); }
    }
    const size_t gt = (size_t)F.vcu * 512 + F.tid, NGT = (size_t)F.G * 512;
    for (size_t i = gt; i < (size_t)96 * 1024 / 8; i += NGT) ((u32x4*)((bf16*)(ws + WS_WI) + (size_t)1952 * 1024))[i] = (u32x4){0, 0, 0, 0};
    for (size_t i = gt; i < (size_t)1024 * 16; i += NGT) { const size_t row = i >> 4, c = i & 15; *(u32x4*)((bf16*)(ws + WS_WQKV) + (768 + row) * 256 + 128 + c * 8) = (u32x4){0, 0, 0, 0}; }
    { const float* __restrict__ xin = F.in[0]; bf16* __restrict__ XBp = (bf16*)(ws + WS_XB); float* __restrict__ rs0 = (float*)(ws + WS_RS0);
    for (int m0 = gw * 4; m0 < T; m0 += NGW * 4) {
        if (F.pflags & 256) break;
        f32x4 v[4][4];
#pragma unroll
        for (int q = 0; q < 4; ++q)
#pragma unroll
            for (int j = 0; j < 4; ++j) v[q][j] = *((const f32x4*)(xin + (size_t)(m0 + q) * D) + lane + 64 * j);
#pragma unroll
        for (int q = 0; q < 4; ++q) { float s = 0.f;
#pragma unroll
            for (int j = 0; j < 4; ++j) s += sq4(v[q][j]);
            s = wave_sum(s);
            u32x2* o8 = (u32x2*)(XBp + (size_t)(m0 + q) * D) + lane;
#pragma unroll
            for (int j = 0; j < 4; ++j) { u32x2 o; o.x = pk2(v[q][j].x, v[q][j].y); o.y = pk2(v[q][j].z, v[q][j].w); o8[64 * j] = o; }
            if (lane == 0) rs0[m0 + q] = rsqrtf(s * (1.f / D) + EPS); }
    } }
    for (size_t i = gt; i < (size_t)48 * 1024; i += NGT) { const int c = (int)(i >> 10), k = (int)(i & 1023);
        float w = 0.f; if (c < 4) w = F.in[12][k * 4 + c] * F.in[11][k]; else if (c < 36) w = F.in[14][k * 32 + c - 4] * F.in[11][k];
        const bf16 hi = f2bf(w); const bf16 lo = f2bf(w - bf2f(hi));
        ((bf16*)(ws + WS_WR))[i] = hi; ((bf16*)(ws + WS_WR))[(size_t)48 * 1024 + i] = lo; }
    for (size_t i = gt; i < (size_t)SEQ * 16; i += NGT) { const int s = (int)(i >> 4), f = (int)(i & 15);
        const float inv = (float)pow(10000.0, -(double)f / 16.0); const float ang = (float)s * inv;
        float2 cs; cs.x = (float)cos((double)ang); cs.y = (float)sin((double)ang); ((float2*)(ws + WS_ROPE))[i] = cs; }
    for (size_t i = gt; i < (size_t)24 * 2048; i += NGT) { const int ph = (int)(i >> 11), e = (int)(i & 2047), p = ph >> 3, h = ph & 7;
        float val = 0.f;
        if (e < 1600) { const int m = e / 200, x = e - m * 200, y = x + m, t = 191 - y;
            val = -30000.f;
            if (y <= 191 && t >= 32 && t <= 160) { const int dil = (p == 0) ? 1 : (p == 1) ? 4 : 16; const int rel = (t - 96) * dil; const int n = rel < 0 ? -rel : rel;
                int large = 8 + (int)(log((double)(n > 1 ? n : 1) / 8.0) / log(128.0) * 8.0); if (large > 15) large = 15;
                const int bucket = (rel > 0 ? 16 : 0) + (n < 8 ? n : large);
                val = F.in[3][bucket * 8 + h] * LOG2E; } }
        ((bf16*)(ws + WS_BIMG))[i] = f2bf(val); }
    for (size_t i = gt; i < (size_t)3 * 8 * 132; i += NGT) { const int p = (int)(i / (8 * 132)), h = (int)((i / 132) % 8), jj = (int)(i % 132);
        float val = 0.f;
        if (jj <= 128) { const int dil = (p == 0) ? 1 : (p == 1) ? 4 : 16; const int rel = (jj - 64) * dil; const int n = rel < 0 ? -rel : rel;
            int large = 8 + (int)(log((double)(n > 1 ? n : 1) / 8.0) / log(128.0) * 8.0); if (large > 15) large = 15;
            const int bucket = (rel > 0 ? 16 : 0) + (n < 8 ? n : large);
            val = F.in[3][bucket * 8 + h] * LOG2E; }
        ((float*)(ws + WS_BT))[i] = val; }
}

__device__ __forceinline__ void p_attnA_naive(const Frame& F, bf16* OA, float* LSE) {
    unsigned char* ws = F.ws;
    const bf16* QA = (const bf16*)(ws + WS_QA); const bf16* KA = (const bf16*)(ws + WS_KA); const bf16* VA = (const bf16*)(ws + WS_VA);
    const float* BT = (const float*)(ws + WS_BT);
    for (int idx = F.vcu * 512 + F.tid; idx < T * 8; idx += F.G * 512) {
        const int s = idx & (SEQ - 1), h = (idx >> 11) & 7, b = idx >> 14;
        float q[64], o[64];
        const size_t t = (size_t)b * SEQ + s;
#pragma unroll
        for (int i = 0; i < 64; ++i) { q[i] = bf2f(QA[t * 512 + h * 64 + i]); o[i] = 0.f; }
        float m = -1e30f, l = 0.f;
        for (int p = 0; p < 3; ++p) { const int dil = (p == 0) ? 1 : (p == 1) ? 4 : 16;
            for (int j = -64; j <= 64; ++j) { const int pos = s + j * dil; if (pos < 0 || pos >= SEQ) continue;
                const bf16* kp = KA + ((size_t)b * SEQ + pos) * 512 + h * 64; const bf16* vp = VA + ((size_t)b * SEQ + pos) * 512 + h * 64;
                float sc = BT[(p * 8 + h) * 132 + j + 64];
#pragma unroll
                for (int i = 0; i < 64; ++i) sc += q[i] * bf2f(kp[i]);
                const float mn = fmaxf(m, sc), al = exp2f(m - mn), pe = exp2f(sc - mn);
                l = l * al + pe; m = mn;
#pragma unroll
                for (int i = 0; i < 64; ++i) o[i] = o[i] * al + pe * bf2f(vp[i]);
            } }
        const float il = 1.f / l;
#pragma unroll
        for (int i = 0; i < 64; ++i) OA[t * 512 + h * 64 + i] = f2bf(o[i] * il);
        LSE[t * 8 + h] = m + log2f(l);
    }
}
__device__ __forceinline__ void p_attnB_naive(const Frame& F) {
    unsigned char* ws = F.ws;
    const bf16* QB = (const bf16*)(ws + WS_QB); const bf16* KB = (const bf16*)(ws + WS_KB); const bf16* VB = (const bf16*)(ws + WS_VB); const bf16* KR = (const bf16*)(ws + WS_KR);
    for (int idx = F.vcu * 512 + F.tid; idx < T * 8; idx += F.G * 512) {
        const int s = idx & (SEQ - 1), h = (idx >> 11) & 7, b = idx >> 14;
        float q[96], o[64];
        const size_t t = (size_t)b * SEQ + s;
#pragma unroll
        for (int i = 0; i < 96; ++i) q[i] = bf2f(QB[t * 768 + h * 96 + i]);
#pragma unroll
        for (int i = 0; i < 64; ++i) o[i] = 0.f;
        float m = -1e30f, l = 0.f;
        for (int key = 0; key < SEQ; ++key) { const size_t tk = (size_t)b * SEQ + key;
            const bf16* kp = KB + tk * 512 + h * 64; const bf16* rp = KR + tk * 32; const bf16* vp = VB + tk * 512 + h * 64;
            float sc = 0.f;
#pragma unroll
            for (int i = 0; i < 64; ++i) sc += q[i] * bf2f(kp[i]);
#pragma unroll
            for (int i = 0; i < 32; ++i) sc += q[64 + i] * bf2f(rp[i]);
            const float mn = fmaxf(m, sc), al = exp2f(m - mn), pe = exp2f(sc - mn);
            l = l * al + pe; m = mn;
#pragma unroll
            for (int i = 0; i < 64; ++i) o[i] = o[i] * al + pe * bf2f(vp[i]);
        }
        const float il = 1.f / l;
#pragma unroll
        for (int i = 0; i < 64; ++i) ((bf16*)(ws + WS_OB))[t * 512 + h * 64 + i] = f2bf(o[i] * il);
    }
}

typedef float f32x16 __attribute__((ext_vector_type(16)));
typedef short s16x4 __attribute__((ext_vector_type(4)));
typedef short v4i16_t __attribute__((ext_vector_type(4)));
__device__ __forceinline__ s16x4 vtr(const LAS unsigned char* p) { return __builtin_bit_cast(s16x4, __builtin_amdgcn_ds_read_tr16_b64_v4i16((LAS v4i16_t*)p)); }
__device__ __forceinline__ int crow(int r, int hi) { return (r & 3) + 8 * (r >> 2) + 4 * hi; }
__device__ __forceinline__ float max3f(float a, float b, float c) { float r; asm("v_max3_f32 %0, %1, %2, %3" : "=v"(r) : "v"(a), "v"(b), "v"(c)); return r; }
__device__ __forceinline__ float max2f(float a, float b) { float r; asm("v_max_f32_e32 %0, %1, %2" : "=v"(r) : "v"(a), "v"(b)); return r; }
__device__ __forceinline__ float rowmax32(const f32x16& p0, const f32x16& p1) {
    float a = max3f(p0[0], p0[1], p1[0]), b = max3f(p0[2], p0[3], p1[1]); a = max3f(a, p1[2], p1[3]);
#pragma unroll
    for (int r = 4; r < 16; r += 4) { a = max3f(a, p0[r], p0[r + 1]); b = max3f(b, p0[r + 2], p0[r + 3]); a = max3f(a, p1[r], p1[r + 1]); b = max3f(b, p1[r + 2], p1[r + 3]); }
    const float m = max2f(a, b);
    auto rr = __builtin_amdgcn_permlane32_swap(__float_as_uint(m), __float_as_uint(m), false, false);
    return max2f(__uint_as_float(rr[0]), __uint_as_float(rr[1]));
}
#define ATT_WAIT_BAR() asm volatile("s_waitcnt vmcnt(0) lgkmcnt(0)\n\ts_barrier" ::: "memory")
#define GLDS16(src, dst) __builtin_amdgcn_global_load_lds((const unsigned*)(src), (LAS unsigned*)(dst), 16, 0, 0)
__device__ __forceinline__ void glds16_asm(const void* gsrc, LAS unsigned char* dst) { unsigned keep; const unsigned d = (unsigned)__builtin_amdgcn_readfirstlane((int)(unsigned)(size_t)dst);
    asm volatile("s_mov_b32 %0, m0\n\ts_mov_b32 m0, %2\n\ts_nop 0\n\tglobal_load_lds_dwordx4 %1, off\n\ts_mov_b32 m0, %0" : "=&s"(keep) : "v"(gsrc), "s"(d) : "memory"); }

template <int NS>
__device__ __forceinline__ void sm_update(f32x16 (&p)[NS], float& m, float& l, f32x16& o0, f32x16& o1, bf16x8 (&pf)[2 * NS]) {
    float mx = p[0][0];
#pragma unroll
    for (int s = 0; s < NS; ++s)
#pragma unroll
        for (int r = 0; r < 16; ++r) mx = fmaxf(mx, p[s][r]);
    { auto rr = __builtin_amdgcn_permlane32_swap(__float_as_uint(mx), __float_as_uint(mx), false, false); mx = fmaxf(__uint_as_float(rr[0]), __uint_as_float(rr[1])); }
    const float mn = fmaxf(m, mx); const float al = __builtin_amdgcn_exp2f(m - mn); m = mn;
    float sum = 0.f;
#pragma unroll
    for (int s = 0; s < NS; ++s)
#pragma unroll
        for (int r = 0; r < 16; ++r) { p[s][r] = __builtin_amdgcn_exp2f(p[s][r] - mn); sum += p[s][r]; }
    l = l * al + sum;
#pragma unroll
    for (int r = 0; r < 16; ++r) { o0[r] *= al; o1[r] *= al; }
#pragma unroll
    for (int s = 0; s < NS; ++s)
#pragma unroll
        for (int k = 0; k < 2; ++k) { u32x4 w; w.x = cvtpk(p[s][8 * k + 0], p[s][8 * k + 1]); w.y = cvtpk(p[s][8 * k + 2], p[s][8 * k + 3]); w.z = cvtpk(p[s][8 * k + 4], p[s][8 * k + 5]); w.w = cvtpk(p[s][8 * k + 6], p[s][8 * k + 7]);
            pf[2 * s + k] = __builtin_bit_cast(bf16x8, w); }
}
__device__ __forceinline__ void pv_step(f32x16& o0, f32x16& o1, const LAS unsigned char* vp, int dstride, bf16x8 pfk) {
    const s16x4 a0 = vtr(vp), a1 = vtr(vp + 512), b0 = vtr(vp + dstride), b1 = vtr(vp + dstride + 512);
    const bf16x8 v0 = (bf16x8){a0[0], a0[1], a0[2], a0[3], a1[0], a1[1], a1[2], a1[3]};
    const bf16x8 v1 = (bf16x8){b0[0], b0[1], b0[2], b0[3], b1[0], b1[1], b1[2], b1[3]};
    o0 = __builtin_amdgcn_mfma_f32_32x32x16_bf16(v0, pfk, o0, 0, 0, 0);
    o1 = __builtin_amdgcn_mfma_f32_32x32x16_bf16(v1, pfk, o1, 0, 0, 0);
}
__device__ __forceinline__ void store_o(bf16* orow, const f32x16& o0, const f32x16& o1, float il, int hi) {
#pragma unroll
    for (int g = 0; g < 4; ++g) {
        u32x2 w0, w1; w0.x = cvtpk(o0[4 * g] * il, o0[4 * g + 1] * il); w0.y = cvtpk(o0[4 * g + 2] * il, o0[4 * g + 3] * il);
        w1.x = cvtpk(o1[4 * g] * il, o1[4 * g + 1] * il); w1.y = cvtpk(o1[4 * g + 2] * il, o1[4 * g + 3] * il);
        *(u32x2*)(orow + 8 * g + 4 * hi) = w0; *(u32x2*)(orow + 32 + 8 * g + 4 * hi) = w1; }
}


template <class RowPtr>
__device__ __forceinline__ void store_o_staged(LAS unsigned char* stg, const f32x16& o0, const f32x16& o1, float il, int lane, const RowPtr& rowptr) {
    const int r32 = lane & 31, hi = lane >> 5;
#pragma unroll
    for (int d0 = 0; d0 < 2; ++d0) {
        const f32x16& o = d0 ? o1 : o0;
#pragma unroll
        for (int g = 0; g < 4; ++g) { u32x2 w; w.x = cvtpk(o[4 * g] * il, o[4 * g + 1] * il); w.y = cvtpk(o[4 * g + 2] * il, o[4 * g + 3] * il);
            *(LAS u32x2*)(stg + r32 * 64 + ((g ^ ((r32 >> 1) & 3)) * 16) + hi * 8) = w; }
        LDS_WAIT();
#pragma unroll
        for (int j = 0; j < 2; ++j) { const int row = 16 * j + (lane >> 2), c = lane & 3;
            const u32x4 v = *(const LAS u32x4*)(stg + row * 64 + ((c ^ ((row >> 1) & 3)) * 16));
            *(u32x4*)(rowptr(row) + d0 * 32 + c * 8) = v; }
        LDS_WAIT();
    }
}

constexpr int B_KBUF = 12288, B_VBUF = 8192, B_VOFF = 3 * B_KBUF;
constexpr float B_THR = 40.f;
#define SBAR() __builtin_amdgcn_sched_barrier(0)
template <int ABL>
__device__ __forceinline__ void attnB_unit(const Frame& F, int b, int head, int qb) {
    unsigned char* ws = F.ws; LAS unsigned char* lds = F.lds;
    const int lane = F.lane, wave = F.wave, r32 = lane & 31, hi = lane >> 5;
    const bf16* QB = (const bf16*)(ws + WS_QB); const bf16* KB = (const bf16*)(ws + WS_KB); const bf16* VB = (const bf16*)(ws + WS_VB); const bf16* KR = (const bf16*)(ws + WS_KR);
    const size_t t0 = (size_t)b * SEQ;
    const size_t tq = t0 + qb * 256 + wave * 32 + r32;
    const int kr8 = 8 * wave + (lane >> 3), kr16 = 16 * (wave & 3) + (lane >> 2);
    const bf16* ksrc = KB + (t0 + kr8) * 512 + head * 64 + (((lane & 7) ^ ((kr8 >> 1) & 7)) * 8);
    const bf16* rsrc = KR + (t0 + kr16) * 32 + (((lane & 3) ^ ((kr16 >> 2) & 3)) * 8);
    const bf16* vsrc = VB + (t0 + kr8) * 512 + head * 64 + (((lane & 7) ^ (((kr8 >> 1) & 1) << 2)) * 8);
#define B_ISSUE_K(kt, boff) do { if (ABL & 2) break; glds16_asm(ksrc + (size_t)(kt) * 64 * 512, lds + (boff) + wave * 1024); \
        glds16_asm(rsrc + (size_t)(kt) * 64 * 32, lds + (boff) + 8192 + (wave & 3) * 1024); } while (0)
#define B_ISSUE_V(kt, boff) do { if (!(ABL & 2)) glds16_asm(vsrc + (size_t)(kt) * 64 * 512, lds + B_VOFF + (boff) + wave * 1024); } while (0)
    B_ISSUE_K(0, 0); B_ISSUE_V(0, 0); B_ISSUE_K(1, B_KBUF); B_ISSUE_V(1, B_VBUF); B_ISSUE_K(2, 2 * B_KBUF);
    bf16x8 qf[6];
#pragma unroll
    for (int ks = 0; ks < 6; ++ks) qf[ks] = *(const bf16x8*)(QB + tq * 768 + head * 96 + ks * 16 + hi * 8);
    float mref; f32x16 o0, o1, o2, negm;
#pragma unroll
    for (int r = 0; r < 16; ++r) { o0[r] = 0.f; o1[r] = 0.f; o2[r] = 0.f; }
    const bf16x8 onesf = (bf16x8){(short)0x3F80, (short)0x3F80, (short)0x3F80, (short)0x3F80, (short)0x3F80, (short)0x3F80, (short)0x3F80, (short)0x3F80};
    int kad[6];
#pragma unroll
    for (int ks = 0; ks < 4; ++ks) kad[ks] = r32 * 128 + (((2 * ks + hi) ^ ((r32 >> 1) & 7)) * 16);
#pragma unroll
    for (int j = 0; j < 2; ++j) kad[4 + j] = 8192 + r32 * 64 + (((2 * j + hi) ^ ((r32 >> 2) & 3)) * 16);
    const int vq = (lane & 15) >> 2;
    const int vbo0 = (4 * hi + vq) * 128 + (((((lane >> 4) & 1) * 2 + ((lane & 3) >> 1)) ^ (((vq >> 1) & 1) << 2)) * 16) + (lane & 1) * 8;
    constexpr int NT = SEQ / 64;
    f32x16 pA0, pA1, pB0, pB1;
    ATT_WAIT_BAR();
    {
        const LAS unsigned char* kb = lds;
#pragma unroll
        for (int r = 0; r < 16; ++r) { pA0[r] = 0.f; pA1[r] = 0.f; }
#pragma unroll
        for (int ks = 0; ks < 6; ++ks) {
            const bf16x8 k0 = *(const LAS bf16x8*)(kb + kad[ks]), k1 = *(const LAS bf16x8*)(kb + kad[ks] + (ks < 4 ? 4096 : 2048));
            pA0 = __builtin_amdgcn_mfma_f32_32x32x16_bf16(k0, qf[ks], pA0, 0, 0, 0);
            pA1 = __builtin_amdgcn_mfma_f32_32x32x16_bf16(k1, qf[ks], pA1, 0, 0, 0);
        }
        asm volatile("s_nop 15" : "+v"(pA0), "+v"(pA1));
        const float mx = rowmax32(pA0, pA1);
        mref = mx;
#pragma unroll
        for (int r = 0; r < 16; ++r) { negm[r] = -mref; pA0[r] = __builtin_amdgcn_exp2f(pA0[r] - mref); pA1[r] = __builtin_amdgcn_exp2f(pA1[r] - mref); }
    }
    ATT_WAIT_BAR();
    bool resc = false; float fres = 1.f;
#define B_PIN(x) asm volatile("" : "+v"(x))
#define B_GAPA(MF, A0, A1, A2, WI, WA, WB, WC, WD, KRD) do { MF; pw_[WI] = cvtpk(WA, WB); pw_[WI + 1] = cvtpk(WC, WD); B_PIN(pw_[WI]); B_PIN(pw_[WI + 1]); KRD; SBAR(); } while (0)
#define B_GAPA0(MF, A0, A1, A2) do { MF; SBAR(); } while (0)
#define B_KRD(i_) kf_[i_] = *(const LAS bf16x8*)(kb_ + kad[(i_) >> 1] + (((i_) & 1) ? (((i_) >> 1) < 4 ? 4096 : 2048) : 0))
#define B_EX4(X, B) do { X[B] = __builtin_amdgcn_exp2f(X[B]); X[B + 1] = __builtin_amdgcn_exp2f(X[B + 1]); X[B + 2] = __builtin_amdgcn_exp2f(X[B + 2]); X[B + 3] = __builtin_amdgcn_exp2f(X[B + 3]); B_PIN(X); } while (0)
#define B_EX4C(X, B) do { if (!(ABL & 1)) B_EX4(X, B); } while (0)
#define B_EXV(P0, P1, v) do { if ((v) < 16) P0[(v) & 15] = __builtin_amdgcn_exp2f(P0[(v) & 15]); else if ((v) < 32) P1[(v) & 15] = __builtin_amdgcn_exp2f(P1[(v) & 15]); } while (0)
#define B_EXNC(P0, P1, v, n) do { if (!(ABL & 1)) { B_EXV(P0, P1, v); B_EXV(P0, P1, (v) + 1); B_EXV(P0, P1, (v) + 2); if ((n) > 3) B_EXV(P0, P1, (v) + 3); B_PIN(P0); B_PIN(P1); } } while (0)
#define B_EX3C(P0, P1, v) do { if (!(ABL & 1)) { B_EXV(P0, P1, v); B_EXV(P0, P1, (v) + 1); B_EXV(P0, P1, (v) + 2); B_PIN(P0); B_PIN(P1); } } while (0)
#define B_MFQ(D, A, Bq, C) D = (ABL & 8) ? (C) : __builtin_amdgcn_mfma_f32_32x32x16_bf16(A, Bq, C, 0, 0, 0)
#define B_MFQ0(D, A, Bq, C) do { if (ABL & 8) D = (C); else asm volatile("v_mfma_f32_32x32x16_bf16 %0, %1, %2, %3" : "=&v"(D) : "v"(A), "v"(Bq), "v"(C)); } while (0)
#define B_MFP(D, A, Bq) do { if (!(ABL & 16)) D = __builtin_amdgcn_mfma_f32_32x32x16_bf16(A, Bq, D, 0, 0, 0); else { asm volatile("" :: "v"(A), "v"(Bq)); } } while (0)
#define B_STEP(PA0, PA1, PB0, PB1, t, HASN) do { \
      \
    const int krd_ = (i3 == 2 ? 0 : i3 + 1) * B_KBUF, kwr_ = i3 * B_KBUF, vrd_ = i3 * B_VBUF, vwr_ = (i3 == 0 ? 2 : i3 - 1) * B_VBUF; \
    if ((t) + 3 < NT) B_ISSUE_K((t) + 3, kwr_); \
    if ((t) + 2 < NT) B_ISSUE_V((t) + 2, vwr_); \
    unsigned pw_[16]; \
    if (HASN) { \
        const LAS unsigned char* kb_ = lds + krd_; bf16x8 kf_[12]; \
        B_KRD(0); B_KRD(1); B_KRD(2); B_KRD(3); \
        SBAR(); \
        B_GAPA(B_MFQ0(PB0, kf_[0], qf[0], negm), PA0[0], PA0[1], PA0[2],    0, PA0[0], PA0[1], PA0[2], PA0[3],     B_KRD(4)); \
        B_GAPA(B_MFQ0(PB1, kf_[1], qf[0], negm), PA0[3], PA0[4], PA0[5],    2, PA0[4], PA0[5], PA0[6], PA0[7],     B_KRD(5)); \
        B_GAPA(B_MFQ(PB0, kf_[2], qf[1], PB0),  PA0[6], PA0[7], PA0[8],    4, PA0[8], PA0[9], PA0[10], PA0[11],   B_KRD(6)); \
        B_GAPA(B_MFQ(PB1, kf_[3], qf[1], PB1),  PA0[9], PA0[10], PA0[11],  6, PA0[12], PA0[13], PA0[14], PA0[15], B_KRD(7)); \
        B_GAPA(B_MFQ(PB0, kf_[4], qf[2], PB0),  PA0[12], PA0[13], PA0[14], 8, PA1[0], PA1[1], PA1[2], PA1[3],     B_KRD(8)); \
        B_GAPA(B_MFQ(PB1, kf_[5], qf[2], PB1),  PA0[15], PA1[0], PA1[1],   10, PA1[4], PA1[5], PA1[6], PA1[7],    B_KRD(9)); \
        B_GAPA(B_MFQ(PB0, kf_[6], qf[3], PB0),  PA1[2], PA1[3], PA1[4],    12, PA1[8], PA1[9], PA1[10], PA1[11],  B_KRD(10)); \
        B_GAPA(B_MFQ(PB1, kf_[7], qf[3], PB1),  PA1[5], PA1[6], PA1[7],    14, PA1[12], PA1[13], PA1[14], PA1[15], B_KRD(11)); \
        B_GAPA0(B_MFQ(PB0, kf_[8], qf[4], PB0),  PA1[8], PA1[9], PA1[10]); \
        B_GAPA0(B_MFQ(PB1, kf_[9], qf[4], PB1),  PA1[11], PA1[12], PA1[13]); \
        B_GAPA0(B_MFQ(PB0, kf_[10], qf[5], PB0), PA1[14], PA1[15], 0.f); \
        B_MFQ(PB1, kf_[11], qf[5], PB1); SBAR(); \
    } else { \
        _Pragma("unroll") for (int i_ = 0; i_ < 8; ++i_) { pw_[i_] = cvtpk(PA0[2 * i_], PA0[2 * i_ + 1]); pw_[8 + i_] = cvtpk(PA1[2 * i_], PA1[2 * i_ + 1]); } \
    } \
    resc = false; \
    { const LAS unsigned char* vb_ = lds + B_VOFF + vrd_ + vbo0; const LAS unsigned char* vc_ = lds + B_VOFF + vrd_ + (vbo0 ^ 64); \
      const bf16x8 pf0_ = __builtin_bit_cast(bf16x8, ((u32x4){pw_[0], pw_[1], pw_[2], pw_[3]})), pf1_ = __builtin_bit_cast(bf16x8, ((u32x4){pw_[4], pw_[5], pw_[6], pw_[7]})), pf2_ = __builtin_bit_cast(bf16x8, ((u32x4){pw_[8], pw_[9], pw_[10], pw_[11]})), pf3_ = __builtin_bit_cast(bf16x8, ((u32x4){pw_[12], pw_[13], pw_[14], pw_[15]})); \
      s16x4 a0_ = vtr(vb_), a1_ = vtr(vb_ + 1024), b0_ = vtr(vc_), b1_ = vtr(vc_ + 1024), c0_, c1_, d0_, d1_; \
      c0_ = vtr(vb_ + 2048); c1_ = vtr(vb_ + 2048 + 1024); d0_ = vtr(vc_ + 2048); d1_ = vtr(vc_ + 2048 + 1024); \
      SBAR(); \
        \
      float ra_ = 0.f, rb_ = 0.f; \
      B_MFP(o0, ((bf16x8){a0_[0], a0_[1], a0_[2], a0_[3], a1_[0], a1_[1], a1_[2], a1_[3]}), pf0_); \
      if (HASN) { asm volatile("s_nop 15" : "+v"(PB0), "+v"(PB1)); \
          ra_ = max3f(PB0[0], PB0[1], PB1[0]); rb_ = max3f(PB0[2], PB0[3], PB1[1]); ra_ = max3f(ra_, PB1[2], PB1[3]); \
          ra_ = max3f(ra_, PB0[4], PB0[5]); rb_ = max3f(rb_, PB0[6], PB0[7]); ra_ = max3f(ra_, PB1[4], PB1[5]); rb_ = max3f(rb_, PB1[6], PB1[7]); B_PIN(ra_); B_PIN(rb_); } \
      SBAR(); \
      B_MFP(o1, ((bf16x8){b0_[0], b0_[1], b0_[2], b0_[3], b1_[0], b1_[1], b1_[2], b1_[3]}), pf0_); \
      if (HASN) { ra_ = max3f(ra_, PB0[8], PB0[9]); rb_ = max3f(rb_, PB0[10], PB0[11]); ra_ = max3f(ra_, PB1[8], PB1[9]); rb_ = max3f(rb_, PB1[10], PB1[11]); \
          ra_ = max3f(ra_, PB0[12], PB0[13]); rb_ = max3f(rb_, PB0[14], PB0[15]); ra_ = max3f(ra_, PB1[12], PB1[13]); rb_ = max3f(rb_, PB1[14], PB1[15]); ra_ = max2f(ra_, rb_); B_PIN(ra_); } \
      SBAR(); \
      B_MFP(o2, onesf, pf0_); \
      if (HASN) { auto rr_ = __builtin_amdgcn_permlane32_swap(__float_as_uint(ra_), __float_as_uint(ra_), false, false); const float mx_ = max2f(__uint_as_float(rr_[0]), __uint_as_float(rr_[1])); \
          if (__builtin_expect(__any(mx_ > B_THR), 0)) { const float dl_ = fmaxf(mx_, 0.f); mref += dl_; \
              _Pragma("unroll") for (int r = 0; r < 16; ++r) { PB0[r] -= dl_; PB1[r] -= dl_; negm[r] = -mref; } \
              fres = __builtin_amdgcn_exp2f(-dl_); resc = true; } } \
      SBAR(); \
        \
      a0_ = vtr(vb_ + 4096); a1_ = vtr(vb_ + 4096 + 1024); b0_ = vtr(vc_ + 4096); b1_ = vtr(vc_ + 4096 + 1024); \
      B_MFP(o0, ((bf16x8){c0_[0], c0_[1], c0_[2], c0_[3], c1_[0], c1_[1], c1_[2], c1_[3]}), pf1_); if (HASN) B_EXNC(PB0, PB1, 0, 4); SBAR(); \
      B_MFP(o1, ((bf16x8){d0_[0], d0_[1], d0_[2], d0_[3], d1_[0], d1_[1], d1_[2], d1_[3]}), pf1_); if (HASN) B_EXNC(PB0, PB1, 4, 4); SBAR(); \
      B_MFP(o2, onesf, pf1_); if (HASN) B_EXNC(PB0, PB1, 8, 3); SBAR(); \
        \
      c0_ = vtr(vb_ + 6144); c1_ = vtr(vb_ + 6144 + 1024); d0_ = vtr(vc_ + 6144); d1_ = vtr(vc_ + 6144 + 1024); \
      B_MFP(o0, ((bf16x8){a0_[0], a0_[1], a0_[2], a0_[3], a1_[0], a1_[1], a1_[2], a1_[3]}), pf2_); if (HASN) B_EXNC(PB0, PB1, 11, 4); SBAR(); \
      B_MFP(o1, ((bf16x8){b0_[0], b0_[1], b0_[2], b0_[3], b1_[0], b1_[1], b1_[2], b1_[3]}), pf2_); if (HASN) B_EXNC(PB0, PB1, 15, 4); SBAR(); \
      B_MFP(o2, onesf, pf2_); if (HASN) B_EXNC(PB0, PB1, 19, 3); SBAR(); \
        \
      B_MFP(o0, ((bf16x8){c0_[0], c0_[1], c0_[2], c0_[3], c1_[0], c1_[1], c1_[2], c1_[3]}), pf3_); if (HASN) B_EXNC(PB0, PB1, 22, 4); SBAR(); \
      B_MFP(o1, ((bf16x8){d0_[0], d0_[1], d0_[2], d0_[3], d1_[0], d1_[1], d1_[2], d1_[3]}), pf3_); if (HASN) B_EXNC(PB0, PB1, 26, 3); SBAR(); \
      B_MFP(o2, onesf, pf3_); if (HASN) B_EXNC(PB0, PB1, 29, 3); SBAR(); \
    } \
    if (resc) { o2[0] *= fres; _Pragma("unroll") for (int r = 0; r < 16; ++r) { o0[r] *= fres; o1[r] *= fres; } } \
    i3 = (i3 == 2) ? 0 : i3 + 1; \
    } while (0)
#define B_WAIT3() do { if (ABL & 4) asm volatile("s_waitcnt vmcnt(3) lgkmcnt(0)" ::: "memory"); else asm volatile("s_waitcnt vmcnt(3) lgkmcnt(0)\n\ts_barrier" ::: "memory"); } while (0)
#define B_WAIT1() asm volatile("s_waitcnt vmcnt(1) lgkmcnt(0)\n\ts_barrier" ::: "memory")
    int i3 = 0;
    for (int t = 0; t + 4 < NT; t += 2) {
        B_STEP(pA0, pA1, pB0, pB1, t, true);     B_WAIT3();
        B_STEP(pB0, pB1, pA0, pA1, t + 1, true); B_WAIT3();
    }
    B_STEP(pA0, pA1, pB0, pB1, NT - 4, true);  B_WAIT3();
    B_STEP(pB0, pB1, pA0, pA1, NT - 3, true);  B_WAIT1();
    B_STEP(pA0, pA1, pB0, pB1, NT - 2, true);  ATT_WAIT_BAR();
    B_STEP(pB0, pB1, pA0, pA1, NT - 1, false);
#undef B_WAIT3
#undef B_WAIT1
#undef B_STEP
#undef B_MFQ
#undef B_MFQ0
#undef B_MFP
#undef B_EX4C
#undef B_EX3C
#undef B_EXNC
#undef B_EXV
#undef B_GAPA
#undef B_GAPA0
#undef B_KRD
#undef B_PIN
#undef B_EX4
#undef B_ISSUE_K
#undef B_ISSUE_V
    const float l = o2[0];
    { bf16* obase = (bf16*)(ws + WS_OB) + (t0 + qb * 256 + wave * 32) * 512 + head * 64;
      store_o_staged(lds + B_VOFF + 3 * B_VBUF + wave * 2048, o0, o1, 1.f / l, lane, [=](int row) { return obase + (size_t)row * 512; }); }
    ATT_WAIT_BAR();
}
__device__ __forceinline__ void p_attnB(const Frame& F, bool abl) {
    if (F.G == 256) {
        const int x = F.vcu >> 5, j = F.vcu & 31;
        for (int r = 0; r < 4; ++r) { const int bh = 16 * x + 4 * r + (j >> 3); { if (PROBE_ABL != 0 && abl) attnB_unit<PROBE_ABL>(F, bh >> 3, bh & 7, j & 7); else attnB_unit<0>(F, bh >> 3, bh & 7, j & 7); } }
    } else {
        for (int u = F.vcu; u < BATCH * 8 * 8; u += F.G) { const int bh = u >> 3; attnB_unit<0>(F, bh >> 3, bh & 7, u & 7); }
    }
}

constexpr int A_NSL = 384, A_KOFF = 0, A_VOFF = A_NSL * 128, A_TAB = 2 * A_NSL * 128, A_TABB = 4096, A_OST = A_TAB + 2 * A_TABB;
constexpr float A_NEG = -30000.f;
struct AGeo { int b, head, pat, g, dil, L, nslots; };
__device__ __forceinline__ AGeo a_geo(int vcu, int k) { AGeo q;
    const int x = vcu >> 5, j = vcu & 31, bh = 16 * x + 4 * (k / 3) + (j >> 3); q.b = bh >> 3; q.head = bh & 7; q.pat = k % 3; q.g = j & 7;
    q.dil = (q.pat == 0) ? 1 : (q.pat == 1) ? 4 : 16; q.L = SEQ / q.dil; q.nslots = (q.pat == 2) ? 256 : 384; return q; }
__device__ __forceinline__ int a_pos(const AGeo& q, int s) {
    if (q.pat == 2) return 2 * q.g + (s >> 7) + 16 * (s & 127);
    if (q.pat == 1) { int kn = 256 * (q.g & 1) - 64 + s; kn = kn < 0 ? 0 : (kn > 511 ? 511 : kn); return (q.g >> 1) + 4 * kn; }
    int kn = 256 * q.g - 64 + s; return kn < 0 ? 0 : (kn > 2047 ? 2047 : kn); }
__device__ __forceinline__ void glds16_s(const void* sbase, unsigned voff, LAS unsigned char* dst) { unsigned keep; const unsigned d = (unsigned)__builtin_amdgcn_readfirstlane((int)(unsigned)(size_t)dst);
    asm volatile("s_mov_b32 %0, m0\n\ts_mov_b32 m0, %3\n\ts_nop 0\n\tglobal_load_lds_dwordx4 %1, %2\n\ts_mov_b32 m0, %0" : "=&s"(keep) : "v"(voff), "s"(sbase), "s"(d) : "memory"); }
__device__ __forceinline__ void a_issue(const Frame& F, const AGeo& q, bool isv) {
    const unsigned char* src = F.ws + (isv ? WS_VA : WS_KA) + ((size_t)q.b * SEQ * 512 + q.head * 64) * 2;
    const int s0 = 8 * F.wave + (F.lane >> 3);
    const unsigned coff = (unsigned)((F.lane & 7) ^ (isv ? (((s0 >> 1) & 1) << 2) : ((s0 >> 1) & 7))) * 16u;
    LAS unsigned char* dst = F.lds + (isv ? A_VOFF : A_KOFF) + F.wave * 1024;
    if (q.pat == 2) {
        const unsigned o0 = (unsigned)(2 * q.g + 16 * s0) * 1024u + coff;
        glds16_s(src, o0, dst); glds16_s(src, o0 + 1024u * 1024u, dst + 8192); glds16_s(src, o0 + 1024u, dst + 16384); glds16_s(src, o0 + 1025u * 1024u, dst + 24576);
    } else {
        const int hi = q.pat == 1 ? 511 : 2047, sh = q.pat == 1 ? 12 : 10;
        const unsigned cb = (q.pat == 1 ? (unsigned)(q.g >> 1) * 1024u : 0u) + coff;
        const int w0 = (q.pat == 1 ? 256 * (q.g & 1) : 256 * q.g) - 64 + s0;
#pragma unroll
        for (int i = 0; i < 6; ++i) { int kn = w0 + 64 * i; kn = kn < 0 ? 0 : (kn > hi ? hi : kn); glds16_s(src, cb + ((unsigned)kn << sh), dst + i * 8192); }
    }
}
__device__ __forceinline__ void a_wave_geo(const AGeo& q, int wave, int& c, int& n0, int& hb, int& wstart) {
    if (q.pat == 2) { c = 2 * q.g + (wave >> 2); n0 = 32 * (wave & 3); hb = 128 * (wave >> 2); wstart = 0; }
    else if (q.pat == 1) { c = q.g >> 1; n0 = 256 * (q.g & 1) + 32 * wave; hb = 0; wstart = 256 * (q.g & 1) - 64; }
    else { c = 0; n0 = 256 * q.g + 32 * wave; hb = 0; wstart = 256 * q.g - 64; } }
__device__ __forceinline__ void a_load_q(const Frame& F, const AGeo& q, bf16x8 (&qf)[4]) {
    int c, n0, hb, wstart; a_wave_geo(q, F.wave, c, n0, hb, wstart);
    const size_t tq = (size_t)q.b * SEQ + c + q.dil * (n0 + (F.lane & 31));
    const bf16* QA = (const bf16*)(F.ws + WS_QA);
#pragma unroll
    for (int ks = 0; ks < 4; ++ks) qf[ks] = *(const bf16x8*)(QA + tq * 512 + q.head * 64 + ks * 16 + (F.lane >> 5) * 8);
}
__device__ __forceinline__ void a_write_tab(const Frame& F, const AGeo& q, int tsel) {
    if (F.wave < 4) glds16_asm((const bf16*)(F.ws + WS_BIMG) + (size_t)(q.pat * 8 + q.head) * 2048 + F.wave * 512 + F.lane * 8, F.lds + A_TAB + tsel * A_TABB + F.wave * 1024);
}
__device__ __forceinline__ f32x16 mfma_dc(bf16x8 a, bf16x8 b, const f32x16& c) { f32x16 d; asm volatile("v_mfma_f32_32x32x16_bf16 %0, %1, %2, %3" : "=&v"(d) : "v"(a), "v"(b), "v"(c)); return d; }
template <int ABL>
__device__ __forceinline__ void p_attnA(const Frame& F, bf16* OA, float* LSE) {
    if (F.vcu >= 256) return;
    LAS unsigned char* lds = F.lds;
    const int lane = F.lane, wave = F.wave, r32 = lane & 31, hi = lane >> 5;
    int kad[4];
#pragma unroll
    for (int ks = 0; ks < 4; ++ks) kad[ks] = r32 * 128 + (((2 * ks + hi) ^ ((r32 >> 1) & 7)) * 16);
    const int vq = (lane & 15) >> 2;
    const int vbo0 = (4 * hi + vq) * 128 + (((((lane >> 4) & 1) * 2 + ((lane & 3) >> 1)) ^ (((vq >> 1) & 1) << 2)) * 16) + (lane & 1) * 8;
    const int bm = (7 - r32) & 7;
    const int bbo = bm * 400 + (159 - 128 - r32 + 8 * hi - bm) * 2;
    bf16x8 idn[2];
#pragma unroll
    for (int s2 = 0; s2 < 2; ++s2)
#pragma unroll
        for (int j = 0; j < 8; ++j) idn[s2][j] = (16 * s2 + 8 * hi + j == r32) ? (short)0x3F80 : (short)0;
    constexpr int NU = 12;
    AGeo q = a_geo(F.vcu, 0);
    if (!(ABL & 2)) { a_issue(F, q, false); a_issue(F, q, true); } a_write_tab(F, q, 0);
    bf16x8 qf[4]; a_load_q(F, q, qf);
    ATT_WAIT_BAR();
#pragma unroll 1
    for (int k = 0; k < NU; ++k) {
        int c, n0, hb, wstart; a_wave_geo(q, wave, c, n0, hb, wstart);
        const LAS unsigned char* tbb = lds + A_TAB + (k & 1) * A_TABB + bbo;
        f32x16 p[5]; bool val[5]; float mref; f32x16 negm;
        {   const LAS unsigned char* kb = lds + A_KOFF + (hb + n0 - wstart) * 128;
#pragma unroll
            for (int r = 0; r < 16; ++r) p[2][r] = 0.f;
#pragma unroll
            for (int ks = 0; ks < 4; ++ks) { const bf16x8 kf = *(const LAS bf16x8*)(kb + kad[ks]); if (!(ABL & 8)) p[2] = __builtin_amdgcn_mfma_f32_32x32x16_bf16(kf, qf[ks], p[2], 0, 0, 0); else asm volatile("" :: "v"(kf)); }
#pragma unroll
            for (int s2 = 0; s2 < 2; ++s2) { const bf16x8 bfr = *(const LAS bf16x8*)(tbb + (16 * s2 + 32 * 2) * 2); if (!(ABL & 8)) p[2] = __builtin_amdgcn_mfma_f32_32x32x16_bf16(bfr, idn[s2], p[2], 0, 0, 0); else asm volatile("" :: "v"(bfr)); }
            asm volatile("s_nop 15" : "+v"(p[2]));
            float a = max3f(p[2][0], p[2][1], p[2][2]), b2 = max3f(p[2][3], p[2][4], p[2][5]);
            a = max3f(a, p[2][6], p[2][7]); b2 = max3f(b2, p[2][8], p[2][9]); a = max3f(a, p[2][10], p[2][11]); b2 = max3f(b2, p[2][12], p[2][13]); a = max3f(a, p[2][14], p[2][15]);
            float mx = max2f(a, b2);
            { auto rr = __builtin_amdgcn_permlane32_swap(__float_as_uint(mx), __float_as_uint(mx), false, false); mx = max2f(__uint_as_float(rr[0]), __uint_as_float(rr[1])); }
            mref = mx;
#pragma unroll
            for (int r = 0; r < 16; ++r) { negm[r] = -mref; p[2][r] -= mref; }
            val[2] = true;
        }
#pragma unroll
        for (int i = 0; i < 5; ++i) {
            if (i == 2) continue;
            const int kt0 = n0 - 64 + 32 * i; val[i] = (kt0 >= 0 && kt0 < q.L);
            if (val[i]) {
                const LAS unsigned char* kb = lds + A_KOFF + (hb + kt0 - wstart) * 128;
                { const bf16x8 kf = *(const LAS bf16x8*)(kb + kad[0]); if (!(ABL & 8)) p[i] = mfma_dc(kf, qf[0], negm); else { p[i] = negm; asm volatile("" :: "v"(kf)); } }
#pragma unroll
                for (int ks = 1; ks < 4; ++ks) { const bf16x8 kf = *(const LAS bf16x8*)(kb + kad[ks]); if (!(ABL & 8)) p[i] = __builtin_amdgcn_mfma_f32_32x32x16_bf16(kf, qf[ks], p[i], 0, 0, 0); else asm volatile("" :: "v"(kf)); }
#pragma unroll
                for (int s2 = 0; s2 < 2; ++s2) { const bf16x8 bfr = *(const LAS bf16x8*)(tbb + (16 * s2 + 32 * (4 - i)) * 2); if (!(ABL & 8)) p[i] = __builtin_amdgcn_mfma_f32_32x32x16_bf16(bfr, idn[s2], p[i], 0, 0, 0); else asm volatile("" :: "v"(bfr)); }
            }
        }
        if (ABL & 4) asm volatile("s_waitcnt vmcnt(0) lgkmcnt(0)" ::: "memory"); else ATT_WAIT_BAR();
        AGeo qn = q; bf16x8 qfn[4];
        if (k + 1 < NU) { qn = a_geo(F.vcu, k + 1); if (!(ABL & 64)) a_write_tab(F, qn, (k + 1) & 1); a_load_q(F, qn, qfn); if (!(ABL & 2)) a_issue(F, qn, false); }
        float l = 0.f; f32x16 o0, o1;
#pragma unroll
        for (int r = 0; r < 16; ++r) { o0[r] = 0.f; o1[r] = 0.f; }
#pragma unroll
        for (int i = 0; i < 5; ++i) {
            if (val[i]) {
#pragma unroll
                for (int r = 0; r < 16; ++r) { if (!(ABL & 1)) p[i][r] = __builtin_amdgcn_exp2f(p[i][r]); l += p[i][r]; }
                const int kt0 = n0 - 64 + 32 * i;
                const LAS unsigned char* vb = lds + A_VOFF + (hb + kt0 - wstart) * 128;
#pragma unroll
                for (int s2 = 0; s2 < 2; ++s2) {
                    u32x4 w; w.x = cvtpk(p[i][8 * s2 + 0], p[i][8 * s2 + 1]); w.y = cvtpk(p[i][8 * s2 + 2], p[i][8 * s2 + 3]); w.z = cvtpk(p[i][8 * s2 + 4], p[i][8 * s2 + 5]); w.w = cvtpk(p[i][8 * s2 + 6], p[i][8 * s2 + 7]);
                    const bf16x8 pf = __builtin_bit_cast(bf16x8, w);
                    const LAS unsigned char* v0p = vb + s2 * 2048 + vbo0; const LAS unsigned char* v1p = vb + s2 * 2048 + (vbo0 ^ 64);
                    if (!(ABL & 16)) {
                    const s16x4 a0 = vtr(v0p), a1 = vtr(v0p + 1024), b0 = vtr(v1p), b1 = vtr(v1p + 1024);
                    o0 = __builtin_amdgcn_mfma_f32_32x32x16_bf16(((bf16x8){a0[0], a0[1], a0[2], a0[3], a1[0], a1[1], a1[2], a1[3]}), pf, o0, 0, 0, 0);
                    o1 = __builtin_amdgcn_mfma_f32_32x32x16_bf16(((bf16x8){b0[0], b0[1], b0[2], b0[3], b1[0], b1[1], b1[2], b1[3]}), pf, o1, 0, 0, 0);
                    } else asm volatile("" :: "v"(pf));
                }
            }
        }
        { auto rr = __builtin_amdgcn_permlane32_swap(__float_as_uint(l), __float_as_uint(l), false, false); l = __uint_as_float(rr[0]) + __uint_as_float(rr[1]); }
        const size_t tq0 = (size_t)q.pat * T + (size_t)q.b * SEQ + c + q.dil * n0;
        if (!(ABL & 32)) { bf16* obase = OA + tq0 * 512 + q.head * 64; const int rstride = q.dil * 512;
          store_o_staged(lds + A_OST + wave * 2048, o0, o1, 1.f / l, lane, [=](int row) { return obase + (size_t)row * rstride; }); }
        if (!(ABL & 32)) { if (hi == 0) LSE[(tq0 + q.dil * r32) * 8 + q.head] = mref + __builtin_amdgcn_logf(l); } else asm volatile("" :: "v"(l), "v"(o0), "v"(o1));
        if (ABL & 4) asm volatile("s_waitcnt vmcnt(5) lgkmcnt(0)" ::: "memory"); else asm volatile("s_waitcnt vmcnt(5) lgkmcnt(0)\n\ts_barrier" ::: "memory");
        if (k + 1 < NU) { if (!(ABL & 2)) a_issue(F, qn, true);
#pragma unroll
            for (int ks = 0; ks < 4; ++ks) qf[ks] = qfn[ks];
            q = qn; }
    }
}
constexpr int MQ = 4;
template <int NP>
__device__ __forceinline__ void p_mixnorm(const Frame& F, const bf16* __restrict__ OA, const float* __restrict__ LSE, int row0, int nrows, int wid, int nw) {
    unsigned char* ws = F.ws; const int lane = F.lane;
    const bf16* __restrict__ OBp = (const bf16*)(ws + WS_OB); bf16* __restrict__ MIX = (bf16*)(ws + WS_MIX);
    float ga[8], gb[8];
#pragma unroll
    for (int i = 0; i < 8; ++i) { ga[i] = F.in[8][lane * 8 + i]; gb[i] = F.in[9][lane * 8 + i]; }
    const int head = lane >> 3;
    for (int m0 = row0 + wid * MQ; m0 < row0 + nrows; m0 += nw * MQ) {
        u32x4 pa[MQ][NP], pb[MQ]; float w[MQ][NP];
#pragma unroll
        for (int q = 0; q < MQ; ++q) { const int m = m0 + q;
#pragma unroll
            for (int p = 0; p < NP; ++p) { pa[q][p] = *(const u32x4*)(OA + ((size_t)p * T + m) * 512 + lane * 8); w[q][p] = LSE[((size_t)p * T + m) * 8 + head]; }
            pb[q] = *(const u32x4*)(OBp + (size_t)m * 512 + lane * 8); }
#pragma unroll
        for (int q = 0; q < MQ; ++q) { const int m = m0 + q; float a[8], mx = -1e30f;
#pragma unroll
            for (int p = 0; p < NP; ++p) mx = fmaxf(mx, w[q][p]);
            float wsum = 0.f;
#pragma unroll
            for (int p = 0; p < NP; ++p) { w[q][p] = exp2f(w[q][p] - mx); wsum += w[q][p]; }
            const float iw = 1.f / wsum;
#pragma unroll
            for (int i = 0; i < 8; ++i) a[i] = 0.f;
#pragma unroll
            for (int p = 0; p < NP; ++p) { float t8[8]; unpack8(pa[q][p], t8); const float ww = w[q][p] * iw;
#pragma unroll
                for (int i = 0; i < 8; ++i) a[i] += ww * t8[i]; }
            float bv[8]; unpack8(pb[q], bv);
            float sa = 0.f, sb = 0.f;
#pragma unroll
            for (int i = 0; i < 8; ++i) { sa += a[i] * a[i]; sb += bv[i] * bv[i]; }
            sa = wave_sum(sa); sb = wave_sum(sb);
            const float ra = rsqrtf(sa * (1.f / 512.f) + EPS), rb = rsqrtf(sb * (1.f / 512.f) + EPS);
            u32x4 oa, ob;
            oa.x = pk2(a[0] * ra * ga[0], a[1] * ra * ga[1]); oa.y = pk2(a[2] * ra * ga[2], a[3] * ra * ga[3]); oa.z = pk2(a[4] * ra * ga[4], a[5] * ra * ga[5]); oa.w = pk2(a[6] * ra * ga[6], a[7] * ra * ga[7]);
            ob.x = pk2(bv[0] * rb * gb[0], bv[1] * rb * gb[1]); ob.y = pk2(bv[2] * rb * gb[2], bv[3] * rb * gb[3]); ob.z = pk2(bv[4] * rb * gb[4], bv[5] * rb * gb[5]); ob.w = pk2(bv[6] * rb * gb[6], bv[7] * rb * gb[7]);
            bf16* mix = MIX + (size_t)m * 1024;
            *(u32x4*)(mix + lane * 8) = oa; *(u32x4*)(mix + 512 + lane * 8) = ob; }
    }
}
constexpr int R_BUF = 96 * 512, R_LG = 2 * R_BUF, R_CNT = R_LG + 8 * 16 * 52 * 4;
__device__ __forceinline__ void p_router(const Frame& F) {
    unsigned char* ws = F.ws; const int lane = F.lane, wave = F.wave; LAS unsigned char* lds = F.lds;
    LAS float* lg = (LAS float*)(lds + R_LG + wave * (16 * 52 * 4));
    LAS int* cnt_l = (LAS int*)(lds + R_CNT); LAS int* base_l = cnt_l + 32;
    const bf16* X1 = (const bf16*)(ws + WS_X1); const bf16* WR = (const bf16*)(ws + WS_WR);
    const float* brg = F.in[13]; const float* bre = F.in[15];
    int* counts = (int*)(ws + WS_CTL) + CW_COUNTS; const float* ssq1 = (const float*)(ws + CTL_SSQ1);
    if (F.tid < 32) cnt_l[F.tid] = 0;
#define R_ISSUE(kc, buf) do { _Pragma("unroll") for (int i_ = 0; i_ < 6; ++i_) { const int p_ = wave + 8 * i_, row_ = 2 * p_ + (lane >> 5); \
        glds16_asm(WR + (size_t)row_ * 1024 + (kc) * 256 + (((lane & 31) ^ (row_ & 15)) * 8), lds + (buf) * R_BUF + p_ * 1024); } } while (0)
    const int col = lane & 15, kq = lane >> 4;
    for (int unit = F.vcu; unit < T / 128; unit += F.G) {
        const int tok0 = unit * 128 + wave * 16;
        f32x4 acc[3];
#pragma unroll
        for (int ct = 0; ct < 3; ++ct) acc[ct] = (f32x4){0.f, 0.f, 0.f, 0.f};
        const bf16* arow = X1 + (size_t)(tok0 + col) * 1024 + kq * 8;
        ATT_WAIT_BAR();
        R_ISSUE(0, 0);
#pragma unroll 1
        for (int kc = 0; kc < 4; ++kc) {
            bf16x8 af[8];
#pragma unroll
            for (int kk = 0; kk < 8; ++kk) af[kk] = *(const bf16x8*)(arow + kc * 256 + kk * 32);
            if (kc + 1 < 4) { R_ISSUE(kc + 1, (kc + 1) & 1); asm volatile("s_waitcnt vmcnt(6) lgkmcnt(0)\n\ts_barrier" ::: "memory"); }
            else ATT_WAIT_BAR();
            const LAS unsigned char* wb = lds + (kc & 1) * R_BUF;
#pragma unroll
            for (int kk = 0; kk < 8; ++kk) {
#pragma unroll
                for (int ct = 0; ct < 3; ++ct) {
                    const int rh = ct * 16 + col, rl = 48 + ct * 16 + col, c16 = kk * 4 + kq;
                    const bf16x8 bh = *(const LAS bf16x8*)(wb + rh * 512 + ((c16 ^ (rh & 15)) * 16)), bl = *(const LAS bf16x8*)(wb + rl * 512 + ((c16 ^ (rl & 15)) * 16));
                    acc[ct] = __builtin_amdgcn_mfma_f32_16x16x32_bf16(af[kk], bh, acc[ct], 0, 0, 0);
                    acc[ct] = __builtin_amdgcn_mfma_f32_16x16x32_bf16(af[kk], bl, acc[ct], 0, 0, 0);
                }
            }
            if (kc + 1 < 4) asm volatile("s_waitcnt lgkmcnt(0)\n\ts_barrier" ::: "memory");
            if (kc + 2 < 4) {   }
        }
#pragma unroll
        for (int ct = 0; ct < 3; ++ct)
#pragma unroll
            for (int j = 0; j < 4; ++j) lg[(4 * (lane >> 4) + j) * 52 + ct * 16 + (lane & 15)] = acc[ct][j];
        LDS_WAIT();
        int e1 = 0, e2 = 0, q1 = 0, q2 = 0; float g1 = 0.f, g2 = 0.f; const int m = tok0 + lane;
        if (lane < 16) {
            const float rs = rsqrtf(ssq1[m] * (1.f / D) + EPS);
            const LAS float* L = lg + lane * 52;
            int gi = 0; float gm = L[0] * rs + brg[0];
            float gl1 = L[1] * rs + brg[1], gl2 = L[2] * rs + brg[2], gl3 = L[3] * rs + brg[3]; const float gl0 = gm;
            if (gl1 > gm) { gm = gl1; gi = 1; } if (gl2 > gm) { gm = gl2; gi = 2; } if (gl3 > gm) { gm = gl3; gi = 3; }
            const float gs = __expf(gl0 - gm) + __expf(gl1 - gm) + __expf(gl2 - gm) + __expf(gl3 - gm);
            const float ggate = 1.f / gs;
            const LAS float* EL = L + 4 + gi * 8; const float* eb = bre + gi * 8;
            int i1 = 0; float m1 = EL[0] * rs + eb[0];
            for (int i = 1; i < 8; ++i) { const float v = EL[i] * rs + eb[i]; if (v > m1) { m1 = v; i1 = i; } }
            int i2 = -1; float m2 = -3.0e38f;
            for (int i = 0; i < 8; ++i) { const float v = EL[i] * rs + eb[i]; if (i != i1 && v > m2) { m2 = v; i2 = i; } }
            const float p2 = __expf(m2 - m1); g1 = ggate / (1.f + p2); g2 = ggate * p2 / (1.f + p2);
            e1 = gi * 8 + i1; e2 = gi * 8 + i2;
            q1 = __hip_atomic_fetch_add(cnt_l + e1, 1, __ATOMIC_RELAXED, __HIP_MEMORY_SCOPE_WORKGROUP);
            q2 = __hip_atomic_fetch_add(cnt_l + e2, 1, __ATOMIC_RELAXED, __HIP_MEMORY_SCOPE_WORKGROUP);
        }
        __syncthreads();
        if (F.tid < 32) { const int c = cnt_l[F.tid]; base_l[F.tid] = c ? atomicAdd(&counts[F.tid], c) : 0; }
        __syncthreads();
        if (lane < 16) {
            const int p1 = base_l[e1] + q1, pp2 = base_l[e2] + q2;
            ((int*)(ws + WS_TOK))[e1 * CAP + p1] = m; ((int*)(ws + WS_TOK))[e2 * CAP + pp2] = m;
            ((float*)(ws + WS_GATE))[e1 * CAP + p1] = g1; ((float*)(ws + WS_GATE))[e2 * CAP + pp2] = g2;
            ((int*)(ws + WS_AE))[m * 2] = e1; ((int*)(ws + WS_AE))[m * 2 + 1] = e2; ((int*)(ws + WS_APOS))[m * 2] = p1; ((int*)(ws + WS_APOS))[m * 2 + 1] = pp2;
        }
        __syncthreads();
        if (F.tid < 32) cnt_l[F.tid] = 0;
        __syncthreads();
    }
#undef R_ISSUE
}
__device__ __forceinline__ void moe_tables(const Frame& F) {
    LAS int* pst = (LAS int*)(F.lds + MOE_OFF); LAS int* cnt = pst + 40;
    const int* counts = (const int*)(F.ws + WS_CTL) + CW_COUNTS;
    __syncthreads();
    if (F.tid < NE) cnt[F.tid] = counts[F.tid];
    __syncthreads();
    if (F.tid == 0) { int acc = 0; for (int e = 0; e < NE; ++e) { pst[e] = acc; acc += (cnt[e] + 255) >> 8; } pst[NE] = acc; }
    __syncthreads();
}
constexpr int FQ = 2;
__device__ __forceinline__ void p_final(const Frame& F) {
    unsigned char* ws = F.ws; const int lane = F.lane; const float* __restrict__ gfin = F.in[19];
    const LAS int* pst = (const LAS int*)(F.lds + MOE_OFF);
    const int* __restrict__ AE = (const int*)(ws + WS_AE); const int* __restrict__ AP = (const int*)(ws + WS_APOS);
    const bf16* __restrict__ X1 = (const bf16*)(ws + WS_X1); const bf16* __restrict__ YB = (const bf16*)(ws + WS_YB);
    float* __restrict__ out = F.out;
    f32x4 g4[4];
#pragma unroll
    for (int j = 0; j < 2; ++j) { g4[2 * j] = *((const f32x4*)gfin + 2 * lane + 128 * j); g4[2 * j + 1] = *((const f32x4*)gfin + 2 * lane + 128 * j + 1); }
    const int step = F.G * NWAVES * FQ;
    int m0 = (F.vcu * NWAVES + F.wave) * FQ;
    if (m0 >= T) return;
    u32x2 ie[FQ], ip[FQ];
    u32x4 xa[FQ][2], ya[FQ][2], yb[FQ][2], xn[FQ][2], yan[FQ][2], ybn[FQ][2];
#define FIN_IDX(mm) do { _Pragma("unroll") for (int q = 0; q < FQ; ++q) { ie[q] = *(const u32x2*)(AE + ((mm) + q) * 2); ip[q] = *(const u32x2*)(AP + ((mm) + q) * 2); } } while (0)
#define FIN_ROWS(mm, XA, YA, YB_) do { _Pragma("unroll") for (int q = 0; q < FQ; ++q) { const int m = (mm) + q; \
        const int r1 = (int)ip[q].x + pst[ie[q].x] * 256, r2 = (int)ip[q].y + pst[ie[q].y] * 256; \
        _Pragma("unroll") for (int j = 0; j < 2; ++j) { XA[q][j] = *((const u32x4*)(X1 + (size_t)m * 1024) + lane + 64 * j); YA[q][j] = *((const u32x4*)(YB + (size_t)r1 * 1024) + lane + 64 * j); YB_[q][j] = *((const u32x4*)(YB + (size_t)r2 * 1024) + lane + 64 * j); } } } while (0)
    FIN_IDX(m0); FIN_ROWS(m0, xa, ya, yb);
    if (m0 + step < T) FIN_IDX(m0 + step);
    for (; m0 < T; m0 += step) {
        const bool more = (m0 + step < T);
        if (more) { FIN_ROWS(m0 + step, xn, yan, ybn); if (m0 + 2 * step < T) FIN_IDX(m0 + 2 * step); }
#pragma unroll
        for (int q = 0; q < FQ; ++q) { const int m = m0 + q; float v[2][8]; float s = 0.f;
#pragma unroll
            for (int j = 0; j < 2; ++j) { float a[8], b[8], c[8]; unpack8(xa[q][j], a); unpack8(ya[q][j], b); unpack8(yb[q][j], c);
#pragma unroll
                for (int i = 0; i < 8; ++i) { v[j][i] = a[i] + b[i] + c[i]; s += v[j][i] * v[j][i]; } }
            s = wave_sum(s); const float rs = rsqrtf(s * (1.f / D) + EPS);
#pragma unroll
            for (int j = 0; j < 2; ++j) { f32x4 o0, o1;
                o0.x = v[j][0] * rs * g4[2 * j].x; o0.y = v[j][1] * rs * g4[2 * j].y; o0.z = v[j][2] * rs * g4[2 * j].z; o0.w = v[j][3] * rs * g4[2 * j].w;
                o1.x = v[j][4] * rs * g4[2 * j + 1].x; o1.y = v[j][5] * rs * g4[2 * j + 1].y; o1.z = v[j][6] * rs * g4[2 * j + 1].z; o1.w = v[j][7] * rs * g4[2 * j + 1].w;
                f32x4* op = (f32x4*)(out + (size_t)m * D) + 2 * lane + 128 * j; op[0] = o0; op[1] = o1; } }
        if (more) {
#pragma unroll
            for (int q = 0; q < FQ; ++q)
#pragma unroll
                for (int j = 0; j < 2; ++j) { xa[q][j] = xn[q][j]; ya[q][j] = yan[q][j]; yb[q][j] = ybn[q][j]; } }
    }
#undef FIN_IDX
#undef FIN_ROWS
}

__global__ void __launch_bounds__(NWAVES * 64, 2) mk_fwd(Args args) {
    extern __shared__ __attribute__((aligned(16))) unsigned char lds_raw[];
    Frame F;
    F.lds = (LAS unsigned char*)lds_raw;
    F.tid = threadIdx.x; F.lane = F.tid & 63; F.wave = __builtin_amdgcn_readfirstlane(F.tid >> 6);
    F.G = gridDim.x; { const int bx = blockIdx.x; F.vcu = (F.G % 8 == 0) ? (bx % 8) * (F.G / 8) + bx / 8 : bx; }
    F.in = args.in; F.out = args.out; F.ws = args.ws; F.pflags = args.flags;
    unsigned char* ws = args.ws;
    for (int u = F.tid; u < (LDS_BYTES - LDSCTL_OFF) / 4; u += NWAVES * 64) ((LAS unsigned*)(F.lds + LDSCTL_OFF))[u] = 0u;
    __syncthreads();
#if MK_SPLIT
#define GRID_BAR() do { } while (0)
#else
    volatile LAS unsigned* MISC = (volatile LAS unsigned*)(F.lds + MISC_OFF);
    XcdBarrier bar = xcd_barrier_post((unsigned*)(ws + WS_CTL) + CW_BAR, MISC + 8);
#define GRID_BAR() xcd_barrier(bar)
#endif
#ifndef SLACK_PCT
#define SLACK_PCT 0
#endif
#define STAGGER_SLACK(n_units, t_unit_ticks, myid) do { const int nu_ = (n_units), rounds_ = (nu_ + F.G - 1) / F.G; const int mine_ = (nu_ - (myid) + F.G - 1) / F.G; \
        if (SLACK_PCT > 0 && mine_ < rounds_) { const unsigned long long t0_ = __builtin_amdgcn_s_memrealtime(); \
            const unsigned long long d_ = (unsigned long long)(t_unit_ticks) * SLACK_PCT / 100 * (unsigned)((F.vcu * 37) & 63) / 64; \
            while (__builtin_amdgcn_s_memrealtime() - t0_ < d_) __builtin_amdgcn_s_sleep(8); } } while (0)
    const int lo = args.ph_lo, hi = args.ph_hi;
#ifndef PH_MASK
#define PH_MASK 0x3ff
#endif
#define IN(k) (((PH_MASK >> (k)) & 1) && lo <= (k) && (k) < hi)
#define BOTH(k) (IN(k) && IN((k) + 1))
    bf16* OA = (bf16*)args.out; float* LSE = (float*)(ws + WS_LSE);
    const LAS int* pst = (const LAS int*)(F.lds + MOE_OFF); const LAS int* cnt = pst + 40;

#ifndef ATTN_A_NAIVE
#define ATTN_A_NAIVE 0
#endif
    static_assert(ATTN_A_NAIVE == 0, "the naive mixer-A body writes one partial; the fused merge expects three");
#ifndef ATTN_B_NAIVE
#define ATTN_B_NAIVE 0
#endif
    if (IN(0)) { p_prologue(F); if (BOTH(0)) GRID_BAR(); }
    if (IN(1)) {
        PlainSched S; S.so.init(T, NINP, F.G, (int)blockIdx.x); S.A = (const bf16*)(ws + WS_XB); S.Bt = (const bf16*)(ws + WS_WI); S.lda = 1024; S.ldb = 1024; S.acol_pn = 1 << 30; S.acol_off = 0;
        EpiInProj E{ws};
        pg8::gemm_phase<EpiInProj, PlainSched, true>(F.lds, 1024, 1024, S, E);
        if (BOTH(1)) GRID_BAR();
    }
    if (IN(2)) {
        PlainSched S; S.so.init(T, 768 + 1024, F.G, (int)blockIdx.x); S.A = (const bf16*)(ws + WS_LAT); S.Bt = (const bf16*)(ws + WS_WQKV); S.lda = 512; S.ldb = 256; S.acol_pn = 3; S.acol_off = 256;
        EpiUps E{ws};
        STAGGER_SLACK(896, 1500, (int)blockIdx.x);
        pg8::gemm_phase<EpiUps, PlainSched, true>(F.lds, 256, 256, S, E);
        if (!(args.flags & 2)) { if (ATTN_A_NAIVE) p_attnA_naive(F, OA, LSE); else if (PROBE_ABL != 0 && (args.flags & 8)) p_attnA<PROBE_ABL>(F, OA, LSE); else p_attnA<0>(F, OA, LSE); }
        { const int r_ = S.so.nwg % F.G, c_ = (int)blockIdx.x;
          if (r_ == 0) p_convert_experts(F, 0, c_ * NWAVES + F.wave, F.G * NWAVES); else if (c_ >= r_) p_convert_experts(F, 0, (c_ - r_) * NWAVES + F.wave, (F.G - r_) * NWAVES); }
        if (BOTH(2)) GRID_BAR();
    }
    if (IN(3)) {
        if (!(args.flags & 1)) { if (ATTN_B_NAIVE) p_attnB_naive(F); else p_attnB(F, (args.flags & 4) != 0); }
        if (BOTH(3)) GRID_BAR(); }
    if (IN(4)) { p_mixnorm<3>(F, OA, LSE, 0, T, F.vcu * NWAVES + F.wave, F.G * NWAVES); if (BOTH(4)) GRID_BAR(); }
    if (IN(5)) {
        EpiOut E{ws, (args.flags >> 9) & 7};
        PlainSched S; S.so.init(T, 1024, F.G, (int)blockIdx.x); S.A = (const bf16*)(ws + WS_MIX); S.Bt = (const bf16*)(ws + WS_WO); S.lda = 1024; S.ldb = 1024; S.acol_pn = 1 << 30; S.acol_off = 0;
        pg8::gemm_phase<EpiOut, PlainSched, true>(F.lds, 1024, 1024, S, E, (args.flags & 4096) != 0, (args.flags & 8192) != 0);
        if (BOTH(5)) GRID_BAR();
    }
    if (IN(6)) { p_router(F); if (BOTH(6)) GRID_BAR(); }
    if (IN(7)) {
        moe_tables(F);
        MoeSched S; S.G = F.G; S.c = F.vcu;      S.NT = 2; S.npanels = pst[NE]; S.pst = pst; S.cnt = cnt; S.toks = (const int*)(ws + WS_TOK);
        S.A = (const bf16*)(ws + WS_X1); S.Bt = (const bf16*)(ws + WS_WGU); S.lda = 1024; S.ldb = 1024; S.bstride = (size_t)512 * 1024; S.gather = true; S.mode = 0;
        EpiGateUp E{ws, cnt};
        STAGGER_SLACK(pst[NE] * 2, 2700, F.vcu);
        pg8::gemm_phase<EpiGateUp, MoeSched, true>(F.lds, 1024, 1024, S, E);
        S.mode = 1; pg8::gemm_phase<EpiGateUp, MoeSched, true, true>(F.lds, 1024, 1024, S, E);
        { const int r_ = S.tail_wgs(), c_ = F.vcu;
          if (r_ == 0) p_convert_experts(F, 1, c_ * NWAVES + F.wave, F.G * NWAVES); else if (c_ >= r_) p_convert_experts(F, 1, (c_ - r_) * NWAVES + F.wave, (F.G - r_) * NWAVES); }
        if (BOTH(7)) GRID_BAR();
    }
    if (IN(8)) {
        moe_tables(F);
        MoeSched S; S.G = F.G; S.c = F.vcu;      S.NT = 4; S.npanels = pst[NE]; S.pst = pst; S.cnt = cnt; S.toks = (const int*)(ws + WS_TOK);
        S.A = (const bf16*)(ws + WS_HB); S.Bt = (const bf16*)(ws + WS_WD); S.lda = 256; S.ldb = 256; S.bstride = (size_t)1024 * 256; S.gather = false; S.mode = 0;
        EpiDown E{ws, cnt, (args.flags >> 4) & 3};
        STAGGER_SLACK(pst[NE] * 4, 1400, F.vcu);
        pg8::gemm_phase<EpiDown, MoeSched, true>(F.lds, 256, 256, S, E, (args.flags & 32) != 0, (args.flags & 64) != 0);
        S.mode = 1; pg8::gemm_phase<EpiDown, MoeSched, true, true>(F.lds, 256, 256, S, E);
        if (BOTH(8)) GRID_BAR();
    }
    if (IN(9)) { moe_tables(F); p_final(F); }
#undef IN
#undef BOTH
}
}

extern "C" void kernel_launch(void* const* d_in, const int* in_sizes, int n_in, void* d_out, int out_size, void* d_ws, size_t ws_size, hipStream_t stream) {
    static int grid = 0;
    if (grid == 0) {
        if (n_in != 20 || ws_size < WS_END || out_size != T * D) { fprintf(stderr, "kernel_launch: unexpected shapes (n_in %d, ws %zu, out %d)\n", n_in, ws_size, out_size); grid = -1; return; }
        int dev = 0, cus = 0, per_cu = 0;
        if (hipGetDevice(&dev) != hipSuccess || hipDeviceGetAttribute(&cus, hipDeviceAttributeMultiprocessorCount, dev) != hipSuccess) { grid = -1; return; }
        if (hipFuncSetAttribute((const void*)mk_fwd, hipFuncAttributeMaxDynamicSharedMemorySize, LDS_BYTES) != hipSuccess) { fprintf(stderr, "kernel_launch: hipFuncSetAttribute failed\n"); grid = -1; return; }
        if (hipOccupancyMaxActiveBlocksPerMultiprocessor(&per_cu, (const void*)mk_fwd, NWAVES * 64, LDS_BYTES) != hipSuccess || per_cu < 1) { fprintf(stderr, "kernel_launch: occupancy query says %d\n", per_cu); }
        (void)hipGetLastError();
        if (cus < 256) { fprintf(stderr, "kernel_launch: this kernel's unit maps are written for a 256-workgroup grid, one workgroup per CU; the device has %d CUs; nothing launched\n", cus); grid = -1; return; }
        grid = 256;
    }
    if (grid < 0) return;
    (void)hipMemsetAsync((char*)d_ws + WS_CTL, 0, CTL_BYTES, stream);
    Args a{};
    for (int i = 0; i < 20; ++i) a.in[i] = (const float*)d_in[i];
    a.out = (float*)d_out; a.ws = (unsigned char*)d_ws;
#if MK_SPLIT
    for (int p = 0; p < NPHASE; ++p) { a.ph_lo = p; a.ph_hi = p + 1; hipLaunchKernelGGL(mk_fwd, dim3(grid), dim3(NWAVES * 64), LDS_BYTES, stream, a); }
#else
#ifndef PROBE_PREFIX
#define PROBE_PREFIX -1
#endif
#ifndef PROBE_FLAGS
#define PROBE_FLAGS 0
#endif
    if (PROBE_PREFIX >= 0) {
        a.ph_lo = 0; a.ph_hi = PROBE_PREFIX + 1; a.flags = PROBE_FLAGS;
        hipLaunchKernelGGL(mk_fwd, dim3(grid), dim3(NWAVES * 64), LDS_BYTES, stream, a);
        (void)hipMemsetAsync((char*)d_ws + WS_CTL, 0, CTL_BYTES, stream);
    }
    a.ph_lo = 0; a.ph_hi = NPHASE; a.flags = 0;
    hipLaunchKernelGGL(mk_fwd, dim3(grid), dim3(NWAVES * 64), LDS_BYTES, stream, a);
#endif
}
```
